# Optimizing an MI355X kernel written in HIP

```python
import math
import jax, jax.numpy as jnp
from jax import lax
import numpy as np

D_MODEL = 1024
BATCH = 4
SEQ = 8192
DEPTH = 1

PLE_DIM = 256
RET_HEADS = 8
RET_QK = D_MODEL // RET_HEADS
RET_V = 2 * RET_QK
RET_QKW = RET_HEADS * RET_QK
RET_VW = RET_HEADS * RET_V
RET_CHUNK = 128
XPOS_BASE = 10000.0
DIFF_HEADS = 8
DIFF_HD = D_MODEL // DIFF_HEADS // 2
DIFF_QW = 2 * DIFF_HEADS * DIFF_HD
DIFF_VW = DIFF_HEADS * 2 * DIFF_HD
Q_BLOCK = 128
REL_BUCKETS = 32
REL_MAX_DIST = 128
N_BRANCH = 2
SPLITS = (RET_QKW, RET_QKW, RET_VW, RET_VW, DIFF_QW, DIFF_QW, DIFF_VW, N_BRANCH * D_MODEL)
IN_COLS = sum(SPLITS)
N_EXPERTS = 256
TOP_K = 8
N_GROUPS = 8
TOPK_GROUPS = 4
D_EXPERT = 256
D_SHARED = 256
ROUTED_SCALE = 2.5
EXPERT_BLOCK = 128
DN_ALPHA = (2.0 * DEPTH) ** 0.25
DN_BETA = (8.0 * DEPTH) ** -0.25
EPS = 1e-5

kernel_name = "hybrid_retention_diffattn_moe_block"


def layer_norm(x, g, b):
    xf = x.astype(jnp.float32)
    mu = jnp.mean(xf, -1, keepdims=True)
    var = jnp.mean(jnp.square(xf - mu), -1, keepdims=True)
    return ((xf - mu) * lax.rsqrt(var + EPS) * g + b).astype(x.dtype)


def swiglu(h, wg, wu, wd):
    return (jax.nn.silu(h @ wg) * (h @ wu)) @ wd


def xpos_rotate(t, pos):
    half = t.shape[-1] // 2
    theta = 1.0 / (XPOS_BASE ** jnp.linspace(0.0, 1.0, half, dtype=jnp.float32))
    ang = pos[:, None] * theta[None, :]
    cos = jnp.cos(ang)[None, :, None, :]
    sin = jnp.sin(ang)[None, :, None, :]
    t1, t2 = t[..., :half], t[..., half:]
    return jnp.concatenate([t1 * cos - t2 * sin, t2 * cos + t1 * sin], axis=-1)


def retention_chunkwise(q, k, v):
    b, s, h, dk = q.shape
    dv = v.shape[-1]
    c = RET_CHUNK
    n = s // c
    log_gamma = jnp.log(1.0 - 2.0 ** (-5.0 - jnp.arange(h, dtype=jnp.float32)))
    idx = jnp.arange(c, dtype=jnp.float32)
    rel = idx[:, None] - idx[None, :]
    inner = jnp.where(rel >= 0, jnp.exp(jnp.maximum(rel, 0.0)[None] * log_gamma[:, None, None]), 0.0)
    q_dec = jnp.exp((idx + 1.0)[None, :] * log_gamma[:, None])
    k_dec = jnp.exp((c - 1.0 - idx)[None, :] * log_gamma[:, None])
    c_dec = jnp.exp(c * log_gamma)
    k = k * dk ** -0.5

    def to_chunks(t):
        return t.reshape(b, n, c, h, t.shape[-1]).transpose(1, 0, 3, 2, 4)

    def step(state, inp):
        qc, kc, vc = inp
        scores = jnp.einsum('bhid,bhjd->bhij', qc, kc) * inner
        o = (jnp.einsum('bhij,bhjv->bhiv', scores, vc)
             + jnp.einsum('bhid,bhdv->bhiv', qc * q_dec[..., None], state))
        state = c_dec[:, None, None] * state + jnp.einsum('bhjd,bhjv->bhdv', kc * k_dec[..., None], vc)
        return state, o

    state0 = jnp.zeros((b, h, dk, dv), jnp.float32)
    _, o = lax.scan(step, state0, (to_chunks(q), to_chunks(k), to_chunks(v)))
    return o.transpose(1, 0, 3, 2, 4).reshape(b, s, h, dv)


def t5_bucket(n):
    max_exact = REL_BUCKETS // 2
    nf = jnp.maximum(n, 1).astype(jnp.float32)
    large = max_exact + (jnp.log(nf / max_exact) / math.log(REL_MAX_DIST / max_exact)
                         * (REL_BUCKETS - max_exact)).astype(jnp.int32)
    large = jnp.minimum(large, REL_BUCKETS - 1)
    return jnp.where(n < max_exact, n, large)


def diff_attention(q, k, v, rel_bias, lam):
    b, s, h, _, d = q.shape
    scale = d ** -0.5
    outs = []
    for i in range(s // Q_BLOCK):
        q0 = i * Q_BLOCK
        kl = q0 + Q_BLOCK
        qb, kb, vb = q[:, q0:kl], k[:, :kl], v[:, :kl]
        dist = jnp.arange(q0, kl)[:, None] - jnp.arange(kl)[None, :]
        causal = dist >= 0
        bias = jnp.take(rel_bias, t5_bucket(jnp.maximum(dist, 0)), axis=0).astype(jnp.float32)
        bias = jnp.transpose(bias, (2, 0, 1))[None, :, None]
        logits = jnp.einsum('bqhmd,bkhmd->bhmqk', qb, kb).astype(jnp.float32) * scale + bias
        logits = jnp.where(causal, logits, -jnp.inf)
        a = jax.nn.softmax(logits, axis=-1)
        a = a[:, :, 0] - lam * a[:, :, 1]
        outs.append(jnp.einsum('bhqk,bkhv->bqhv', a.astype(vb.dtype), vb))
    return jnp.concatenate(outs, axis=1)


def routed_experts(hf, expert_idx, w, wg, wu, wd):
    n, d = hf.shape
    a = n * TOP_K
    g = EXPERT_BLOCK
    e_flat = expert_idx.reshape(a).astype(jnp.int32)
    order = jnp.argsort(e_flat)
    e_sorted = e_flat[order]
    tok_sorted = (order // TOP_K).astype(jnp.int32)
    w_sorted = w.reshape(a)[order]
    counts = jnp.bincount(e_flat, length=N_EXPERTS)
    padded = (counts + g - 1) // g * g
    start = jnp.cumsum(counts) - counts
    pend = jnp.cumsum(padded)
    pstart = pend - padded
    dest = pstart[e_sorted] + jnp.arange(a, dtype=jnp.int32) - start[e_sorted]
    n_rows = -(-(a + N_EXPERTS * (g - 1)) // g) * g
    n_blocks = n_rows // g
    row_tok = jnp.full((n_rows,), n, jnp.int32).at[dest].set(tok_sorted)
    row_w = jnp.zeros((n_rows,), jnp.float32).at[dest].set(w_sorted)
    block_e = jnp.minimum(jnp.searchsorted(pend, jnp.arange(n_blocks, dtype=jnp.int32) * g, side='right'),
                          N_EXPERTS - 1)
    h_pad = jnp.concatenate([hf, jnp.zeros((1, d), hf.dtype)], axis=0)

    def expert_block(args):
        rows, e = args
        return swiglu(h_pad[rows], wg[e], wu[e], wd[e])

    y = lax.map(expert_block, (row_tok.reshape(n_blocks, g), block_e))
    y = y.reshape(n_rows, d) * row_w[:, None].astype(y.dtype)
    return jnp.zeros((n + 1, d), y.dtype).at[row_tok].add(y)[:n]


def moe_ffn(h, router_w, router_bias, wg, wu, wd, sg, su, sd):
    b, s, d = h.shape
    n = b * s
    hf = h.reshape(n, d)
    scores = jax.nn.sigmoid((hf @ router_w).astype(jnp.float32))
    choice = scores + router_bias.astype(jnp.float32)
    grouped = choice.reshape(n, N_GROUPS, N_EXPERTS // N_GROUPS)
    group_score = jnp.sum(lax.top_k(grouped, 2)[0], axis=-1)
    _, top_groups = lax.top_k(group_score, TOPK_GROUPS)
    group_ok = jnp.sum(jax.nn.one_hot(top_groups, N_GROUPS, dtype=jnp.float32), axis=1) > 0
    masked = jnp.where(group_ok[:, :, None], grouped, -jnp.inf).reshape(n, N_EXPERTS)
    _, expert_idx = lax.top_k(masked, TOP_K)
    w = jnp.take_along_axis(scores, expert_idx, axis=-1)
    w = w / jnp.sum(w, axis=-1, keepdims=True) * ROUTED_SCALE
    routed = routed_experts(hf, expert_idx, w, wg, wu, wd)
    return (routed + swiglu(hf, sg, su, sd)).reshape(b, s, d)


def setup_inputs(seed: int = 0) -> dict:
    key = jax.random.key(seed)
    ks = jax.random.split(key, 32)

    def nrm(k, shape, scale):
        return jax.random.normal(k, shape, jnp.float32) * scale

    seg_scale = [1.0, 1.0, DN_BETA, 1.0, 1.0, 1.0, DN_BETA, 1.0]
    col_scale = jnp.asarray(np.concatenate([np.full((w_,), s_, np.float32)
                                            for w_, s_ in zip(SPLITS, seg_scale)]))
    return {
        "x": nrm(ks[0], (BATCH, SEQ, D_MODEL), 1.0),
        "p": nrm(ks[1], (DEPTH, BATCH, SEQ, PLE_DIM), 1.0),
        "ln_in_g": 1.0 + nrm(ks[2], (D_MODEL,), 0.02),
        "ln_in_b": nrm(ks[3], (D_MODEL,), 0.02),
        "rel_bias": nrm(ks[4], (REL_BUCKETS, DIFF_HEADS), 0.2),
        "w_in": nrm(ks[5], (DEPTH, D_MODEL, IN_COLS), D_MODEL ** -0.5) * col_scale,
        "ret_gn_g": 1.0 + nrm(ks[6], (DEPTH, RET_VW), 0.02),
        "lambda_q1": nrm(ks[7], (DEPTH, DIFF_HD), 0.1),
        "lambda_k1": nrm(ks[8], (DEPTH, DIFF_HD), 0.1),
        "lambda_q2": nrm(ks[9], (DEPTH, DIFF_HD), 0.1),
        "lambda_k2": nrm(ks[10], (DEPTH, DIFF_HD), 0.1),
        "diff_subln_g": 1.0 + nrm(ks[11], (DEPTH, 2 * DIFF_HD), 0.02),
        "w_ret_o": nrm(ks[12], (DEPTH, RET_VW, D_MODEL), RET_VW ** -0.5 * DN_BETA),
        "w_diff_o": nrm(ks[13], (DEPTH, DIFF_VW, D_MODEL), DIFF_VW ** -0.5 * DN_BETA),
        "w_o": nrm(ks[14], (DEPTH, D_MODEL, D_MODEL), D_MODEL ** -0.5 * DN_BETA),
        "ln1_g": 1.0 + nrm(ks[15], (DEPTH, D_MODEL), 0.02),
        "ln1_b": nrm(ks[16], (DEPTH, D_MODEL), 0.02),
        "router_w": nrm(ks[17], (DEPTH, D_MODEL, N_EXPERTS), D_MODEL ** -0.5),
        "router_bias": nrm(ks[18], (DEPTH, N_EXPERTS), 0.01),
        "exp_w_gate": nrm(ks[19], (DEPTH, N_EXPERTS, D_MODEL, D_EXPERT), D_MODEL ** -0.5),
        "exp_w_up": nrm(ks[20], (DEPTH, N_EXPERTS, D_MODEL, D_EXPERT), D_MODEL ** -0.5),
        "exp_w_down": nrm(ks[21], (DEPTH, N_EXPERTS, D_EXPERT, D_MODEL), D_EXPERT ** -0.5 * DN_BETA),
        "sh_w_gate": nrm(ks[22], (DEPTH, D_MODEL, D_SHARED), D_MODEL ** -0.5),
        "sh_w_up": nrm(ks[23], (DEPTH, D_MODEL, D_SHARED), D_MODEL ** -0.5),
        "sh_w_down": nrm(ks[24], (DEPTH, D_SHARED, D_MODEL), D_SHARED ** -0.5 * DN_BETA),
        "ple_w": nrm(ks[25], (DEPTH, PLE_DIM, D_MODEL), PLE_DIM ** -0.5 * DN_BETA),
        "ple_gate_w": nrm(ks[26], (DEPTH, D_MODEL, D_MODEL), D_MODEL ** -0.5),
        "ln2_g": 1.0 + nrm(ks[27], (DEPTH, D_MODEL), 0.02),
        "ln2_b": nrm(ks[28], (DEPTH, D_MODEL), 0.02),
    }


def reference(x, p, ln_in_g, ln_in_b, rel_bias, w_in, ret_gn_g, lambda_q1, lambda_k1, lambda_q2,
              lambda_k2, diff_subln_g, w_ret_o, w_diff_o, w_o, ln1_g, ln1_b, router_w, router_bias,
              exp_w_gate, exp_w_up, exp_w_down, sh_w_gate, sh_w_up, sh_w_down, ple_w, ple_gate_w,
              ln2_g, ln2_b):
    b, s, _ = x.shape
    pos = jnp.arange(s, dtype=jnp.float32)
    offsets = np.cumsum(SPLITS)[:-1].tolist()
    h = layer_norm(x, ln_in_g, ln_in_b)
    for i in range(DEPTH):
        proj = h @ w_in[i]
        q_r, k_r, v_r, g_r, q_d, k_d, v_d, gate_logits = jnp.split(proj, offsets, axis=-1)

        q_r = xpos_rotate(q_r.reshape(b, s, RET_HEADS, RET_QK).astype(jnp.float32), pos)
        k_r = xpos_rotate(k_r.reshape(b, s, RET_HEADS, RET_QK).astype(jnp.float32), pos)
        v_r = v_r.reshape(b, s, RET_HEADS, RET_V).astype(jnp.float32)
        o_r = retention_chunkwise(q_r, k_r, v_r)
        mu = jnp.mean(o_r, -1, keepdims=True)
        var = jnp.mean(jnp.square(o_r - mu), -1, keepdims=True)
        o_r = ((o_r - mu) * lax.rsqrt(var + EPS)).reshape(b, s, RET_VW) * ret_gn_g[i]
        y_r = (jax.nn.silu(g_r) * o_r.astype(x.dtype)) @ w_ret_o[i]

        lam_init = 0.8 - 0.6 * math.exp(-0.3 * i)
        lam = (jnp.exp(jnp.sum(lambda_q1[i].astype(jnp.float32) * lambda_k1[i].astype(jnp.float32)))
               - jnp.exp(jnp.sum(lambda_q2[i].astype(jnp.float32) * lambda_k2[i].astype(jnp.float32)))
               + lam_init)
        o_d = diff_attention(q_d.reshape(b, s, DIFF_HEADS, 2, DIFF_HD),
                             k_d.reshape(b, s, DIFF_HEADS, 2, DIFF_HD),
                             v_d.reshape(b, s, DIFF_HEADS, 2 * DIFF_HD), rel_bias, lam)
        o_d = o_d.astype(jnp.float32)
        o_d = o_d * lax.rsqrt(jnp.mean(jnp.square(o_d), -1, keepdims=True) + EPS) * diff_subln_g[i] * (1.0 - lam_init)
        y_d = o_d.reshape(b, s, DIFF_VW).astype(x.dtype) @ w_diff_o[i]

        gates = jax.nn.sigmoid(gate_logits.reshape(b, s, N_BRANCH, D_MODEL))
        mix = (gates[:, :, 0] * y_r + gates[:, :, 1] * y_d) @ w_o[i]
        h = layer_norm(DN_ALPHA * h + mix, ln1_g[i], ln1_b[i])

        ffn = moe_ffn(h, router_w[i], router_bias[i], exp_w_gate[i], exp_w_up[i], exp_w_down[i],
                      sh_w_gate[i], sh_w_up[i], sh_w_down[i])
        ple = (p[i] @ ple_w[i]) * jax.nn.sigmoid(h @ ple_gate_w[i])
        h = layer_norm(DN_ALPHA * h + ffn + ple, ln2_g[i], ln2_b[i])
    return h
```

```cpp
#include <hip/hip_runtime.h>
#include <hip/hip_bf16.h>
#include <cstdio>
#include <cstdint>

#ifndef DEBUG_CHECK
#define DEBUG_CHECK 0
#endif

constexpr int NTOK = 32768, DM = 1024, SEQ = 8192, NBATCH = 4, PLE = 256;
constexpr int INCOLS = 11264;
constexpr int NEXP = 256, TOPK = 8, DEXP = 256;
constexpr float LN_EPS = 1e-5f;
constexpr float DN_ALPHA = 1.189207115002721f;
constexpr float LOG2E = 1.4426950408889634f;
constexpr float QD_SCALE = 0.125f * LOG2E;
constexpr float KR_SCALE = 0.08838834764831845f;

constexpr size_t MiB = 1u << 20;
constexpr size_t WS_CTL = 0, CTL_ZERO_BYTES = 1 * MiB;
constexpr size_t WS_WIN_T = 1 * MiB;
constexpr size_t WS_WRO_T = 23 * MiB;
constexpr size_t WS_WDO_T = 27 * MiB;
constexpr size_t WS_WO_T  = 29 * MiB;
constexpr size_t WS_ROUT_T = 31 * MiB;
constexpr size_t WS_PLEW_T = 31 * MiB + 512 * 1024;
constexpr size_t WS_PLEG_T = 32 * MiB;
constexpr size_t WS_SHGU_T = 34 * MiB;
constexpr size_t WS_SHD_T  = 35 * MiB;
constexpr size_t WS_XN   = 48 * MiB;
constexpr size_t WS_PB   = 112 * MiB;
constexpr size_t WS_QR   = 128 * MiB;
constexpr size_t WS_KR   = 192 * MiB;
constexpr size_t WS_VR   = 256 * MiB;
constexpr size_t WS_GR   = 384 * MiB;
constexpr size_t WS_QD   = 512 * MiB;
constexpr size_t WS_KD   = 576 * MiB;
constexpr size_t WS_VD   = 640 * MiB;
constexpr size_t WS_GT   = 704 * MiB;
constexpr size_t WS_M    = 832 * MiB;
constexpr size_t WS_GNST = 896 * MiB;
constexpr size_t WS_Z    = 128 * MiB;
constexpr size_t WS_H1   = 960 * MiB;
constexpr size_t WS_LOGIT = 48 * MiB;
constexpr size_t WS_META = 944 * MiB;
constexpr size_t WS_EGU_T = 256 * MiB;
constexpr size_t WS_ED_T  = 576 * MiB;
constexpr size_t WS_ACT  = 704 * MiB;
constexpr size_t WS_BASE = 880 * MiB;
constexpr size_t WS_Y    = 48 * MiB;
constexpr size_t WS_END  = 1024 * MiB;
constexpr size_t WS_DBGV = 912 * MiB;
constexpr int NROWS_MAX = 1280 * 256;
constexpr int SH_ACT_ROW0 = NROWS_MAX;
constexpr size_t M_IDX = WS_META, M_W = WS_META + 1 * MiB, M_RASSIGN = WS_META + 2 * MiB, M_RTOK = WS_META + 4 * MiB, M_RW = WS_META + 6 * MiB,
                 M_BLKE = WS_META + 8 * MiB, M_NBLK = WS_META + 8 * MiB + 65536, M_IDENT = WS_META + 9 * MiB;

constexpr int CW_TMO = 0, CW_CODE = 1;
constexpr int CW_DBG = 64;
constexpr int CW_BAR = 4096;
constexpr int CW_CNT = 16384;
constexpr int CW_CUR = 16384 + 256;

constexpr int RING_BYTES = 131072;
constexpr int LDSCTL_OFF = RING_BYTES, MISC_OFF = LDSCTL_OFF + 320;
constexpr int LDS_BYTES = 147456;
constexpr int NWAVES = 8;

#define GAS __attribute__((address_space(1)))
#define LAS __attribute__((address_space(3)))
typedef unsigned short bf16_t;
typedef unsigned v4u __attribute__((ext_vector_type(4)));
typedef float f32x4 __attribute__((ext_vector_type(4)));
typedef float f32x2 __attribute__((ext_vector_type(2)));
typedef short bf16x8 __attribute__((ext_vector_type(8)));
typedef GAS unsigned gu32;
#define RLX_AGENT __ATOMIC_RELAXED, __HIP_MEMORY_SCOPE_AGENT
#define LDS_WAIT() asm volatile("s_waitcnt lgkmcnt(0)" ::: "memory")
#define VM_WAIT() asm volatile("s_waitcnt vmcnt(0)" ::: "memory")

__device__ __forceinline__ unsigned f2bf(float f) { unsigned u = __builtin_bit_cast(unsigned, f); return (u + 0x7fffu + ((u >> 16) & 1u)) >> 16; }
__device__ __forceinline__ unsigned pk2(float lo, float hi) { return f2bf(lo) | (f2bf(hi) << 16); }
__device__ __forceinline__ float bf2f(unsigned short b) { return __builtin_bit_cast(float, (unsigned)b << 16); }
__device__ __forceinline__ float bflo(unsigned w) { return __builtin_bit_cast(float, w << 16); }
__device__ __forceinline__ float bfhi(unsigned w) { return __builtin_bit_cast(float, w & 0xffff0000u); }
__device__ __forceinline__ unsigned cvt_pk_bf16(float lo, float hi) { unsigned r; asm volatile("v_cvt_pk_bf16_f32 %0, %1, %2" : "=v"(r) : "v"(lo), "v"(hi)); return r; }
__device__ __forceinline__ float fast_sigmoid(float x) { return __builtin_amdgcn_rcpf(1.f + __builtin_amdgcn_exp2f(-x * LOG2E)); }
__device__ __forceinline__ float fast_silu(float x) { return x * fast_sigmoid(x); }
__device__ __forceinline__ float wave_sum(float v) {
#pragma unroll
    for (int o = 1; o < 64; o <<= 1) v += __shfl_xor(v, o);
    return v;
}

namespace pg8 {
constexpr int BM = 256, BK = 64, HALF = 128, HTB = HALF * BK * 2, STAGE_BYTES = 8 * HTB, NXCD = 8, WGM = 8;
__host__ __device__ __forceinline__ int lds_byte(int r, int c) { const int st = (r >> 4) * 2 + (c >> 5), rr = r & 15, cc = c & 31, ob = rr * 64 + cc * 2; return st * 1024 + (ob ^ (((ob >> 9) & 1) << 5)); }
__host__ __device__ __forceinline__ void stage_rc(int b, int& R, int& C) { const int st = b / 1024, sb = b % 1024, swz = sb ^ (((sb >> 9) & 1) << 5); R = (st >> 1) * 16 + swz / 64; C = (st & 1) * 32 + (swz % 64) / 2; }
__host__ __device__ __forceinline__ int perm32(int rho) { const int n = rho >> 4, i = rho & 15; return 8 * (i >> 2) + 4 * n + (i & 3); }

struct Unit { int pm, pn, type, aux; const char* A; const char* B; int grow; };
__device__ __forceinline__ bool tile_order(long L, int nM, int nN, int& pm, int& pn) {
    const int nwg = nM * nN; if (L >= nwg) return false;
    int wgid = (int)L; { const int q = nwg / NXCD, r = nwg % NXCD, xcd = wgid % NXCD, off = wgid / NXCD; wgid = (xcd < r ? xcd * (q + 1) : r * (q + 1) + (xcd - r) * q) + off; }
    const int nig = WGM * nN, gid = wgid / nig, fm = gid * WGM, gsz = (nM - fm) < WGM ? (nM - fm) : WGM;
    pm = fm + ((wgid % nig) % gsz); pn = (wgid % nig) / gsz; return true;
}
struct DenseOrder {
    const char* A; const char* Bt; int nM, nN, G, c; size_t tstep; int type;
    __device__ void init(const void* A_, const void* Bt_, int M, int N, int K, int G_, int c_, int type_ = 0) { A = (const char*)A_; Bt = (const char*)Bt_; nM = M / BM; nN = N / BM; G = G_; c = c_; tstep = (size_t)BM * K * 2; type = type_; }
    __device__ __forceinline__ bool next(int i, Unit& u) const {
        int pm, pn; if (!tile_order((long)i * G + c, nM, nN, pm, pn)) return false;
        u.pm = pm; u.pn = pn; u.type = type; u.aux = 0; u.A = A + (size_t)pm * tstep; u.B = Bt + (size_t)pn * tstep; u.grow = -1; return true;
    }
};

template <class Epi, class Sched, bool GATHER>
__device__ __forceinline__ void gemm_phase(LAS unsigned char* lds, const int K, const Sched& S, const Epi& E, const int* __restrict__ rowtok) {
    const int tid = threadIdx.x, wid = __builtin_amdgcn_readfirstlane(tid >> 6), lane = tid & 63, wr = wid >> 2, wc = wid & 3, fr = lane & 15, fq = lane >> 4;
    const int nt = K / BK;
    int RA[2], CA[2];
    unsigned voffB[2], voffAc[2][2], voffAn[2][2];
#pragma unroll
    for (int i = 0; i < 2; ++i) { int R, C; stage_rc(tid * 16 + i * 8192, R, C); const int Rb = Epi::PERM ? ((R & ~31) + perm32(R & 31)) : R;
        RA[i] = R; CA[i] = C; voffB[i] = (unsigned)(Rb * K + C) * 2u;
        voffAc[0][i] = voffAc[1][i] = voffAn[0][i] = voffAn[1][i] = (unsigned)(R * K + C) * 2u; }
    const size_t kstep = (size_t)(BK * 2);
    const size_t hstepB = (size_t)HALF * K * 2;
    const size_t hstepA = GATHER ? 0 : hstepB;
    const unsigned ldsw = (unsigned)wid * 1024u;
    const int aoff = lds_byte(wr * 64 + fr, fq * 8), boff = lds_byte(wc * 32 + fr, fq * 8);
#define PG8_SA(b, h) (((b) * 2 + (h)) * HTB)
#define PG8_SB(b, h) ((4 + (b) * 2 + (h)) * HTB)
#define PG8_STAGE(bufoff, gbase, voff) do { _Pragma("unroll") for (int _i = 0; _i < 2; ++_i) \
        __builtin_amdgcn_global_load_lds((const unsigned*)((const char*)(gbase) + (voff)[_i]), (LAS unsigned*)(lds + (bufoff) + ldsw + _i * 8192), 16, 0, 0); } while (0)
#define PG8_LDA(dst, b, h) do { _Pragma("unroll") for (int m = 0; m < 4; ++m) _Pragma("unroll") for (int k = 0; k < 2; ++k) dst[m][k] = *(const LAS bf16x8*)(lds + PG8_SA(b, h) + aoff + m * 2048 + k * 1024); } while (0)
#define PG8_LDB(dst, b, h) do { _Pragma("unroll") for (int n = 0; n < 2; ++n) _Pragma("unroll") for (int k = 0; k < 2; ++k) dst[n][k] = *(const LAS bf16x8*)(lds + PG8_SB(b, h) + boff + n * 2048 + k * 1024); } while (0)
#define PG8_MMA(ai, bj, At, Bt) do { __builtin_amdgcn_s_setprio(1); _Pragma("unroll") for (int m = 0; m < 4; ++m) _Pragma("unroll") for (int n = 0; n < 2; ++n) _Pragma("unroll") for (int k = 0; k < 2; ++k) \
        acc[ai][bj][m][n] = __builtin_amdgcn_mfma_f32_16x16x32_bf16(Bt[n][k], At[m][k], acc[ai][bj][m][n], 0, 0, 0); __builtin_amdgcn_s_setprio(0); } while (0)
#define PG8_WAIT_V(n) asm volatile("s_waitcnt vmcnt(" #n ")" ::: "memory")
#define PG8_WAIT_L(n) asm volatile("s_waitcnt lgkmcnt(" #n ")" ::: "memory")
#define PG8_BAR __builtin_amdgcn_s_barrier()
#define PG8_SCHED __builtin_amdgcn_sched_barrier(0)
#define PG8_GOFF(dst, u) do { if (GATHER) { _Pragma("unroll") for (int h = 0; h < 2; ++h) _Pragma("unroll") for (int i = 0; i < 2; ++i) { \
        const int tok = rowtok[(u).grow + h * HALF + RA[i]]; dst[h][i] = (unsigned)(tok * K + CA[i]) * 2u; } } } while (0)
    Unit cur, nxt; int ui = 0;
    if (!S.next(0, cur)) return;
    PG8_GOFF(voffAc, cur);
    f32x4 acc[2][2][4][2];
#pragma unroll
    for (int a = 0; a < 2; ++a)
#pragma unroll
        for (int b = 0; b < 2; ++b)
#pragma unroll
            for (int m = 0; m < 4; ++m)
#pragma unroll
                for (int n = 0; n < 2; ++n) acc[a][b][m][n] = (f32x4){0.f, 0.f, 0.f, 0.f};
    bf16x8 At[4][2], B0[2][2], B1[2][2];
    const char* cA = cur.A; const char* cB = cur.B;
    PG8_STAGE(PG8_SB(0, 0), cB, voffB); PG8_STAGE(PG8_SB(0, 1), cB + hstepB, voffB); PG8_STAGE(PG8_SA(0, 0), cA, voffAc[0]); PG8_STAGE(PG8_SA(0, 1), cA + hstepA, voffAc[1]);
    if (wr == 1) PG8_BAR;
    PG8_WAIT_V(2); PG8_BAR;
    PG8_STAGE(PG8_SB(1, 0), cB + kstep, voffB); PG8_STAGE(PG8_SA(1, 0), cA + kstep, voffAc[0]); PG8_STAGE(PG8_SB(1, 1), cB + hstepB + kstep, voffB);
    PG8_WAIT_V(6); PG8_BAR;
    for (;;) {
        const bool has_next = S.next(ui + 1, nxt);
        if (has_next) { PG8_GOFF(voffAn, nxt); }
        else { if (GATHER) { _Pragma("unroll") for (int h = 0; h < 2; ++h) _Pragma("unroll") for (int i = 0; i < 2; ++i) voffAn[h][i] = voffAc[h][i]; } }
        const char* nA = has_next ? nxt.A : cA; const char* nB = has_next ? nxt.B : cB;
        _Pragma("unroll 1") for (int t = 0; t < nt; t += 2) {
            const bool last = (t == nt - 2);
            const char* a1 = cA + (size_t)(t + 1) * kstep;
            const char* a2 = last ? nA : cA + (size_t)(t + 2) * kstep; const char* b2 = last ? nB : cB + (size_t)(t + 2) * kstep;
            const char* a3 = a2 + kstep; const char* b3 = b2 + kstep;
            unsigned va2[2][2];
#pragma unroll
            for (int h = 0; h < 2; ++h)
#pragma unroll
                for (int i = 0; i < 2; ++i) va2[h][i] = (GATHER && last) ? voffAn[h][i] : voffAc[h][i];
            PG8_LDB(B0, 0, 0); PG8_LDB(B1, 0, 1); PG8_SCHED; PG8_LDA(At, 0, 0); PG8_STAGE(PG8_SA(1, 1), a1 + hstepA, voffAc[1]);
            PG8_WAIT_V(8); PG8_WAIT_L(0); PG8_BAR; PG8_MMA(0, 0, At, B0); PG8_MMA(0, 1, At, B1); PG8_BAR; PG8_SCHED;
            PG8_LDA(At, 0, 1); PG8_STAGE(PG8_SB(0, 0), b2, voffB); PG8_STAGE(PG8_SB(0, 1), b2 + hstepB, voffB); PG8_STAGE(PG8_SA(0, 0), a2, va2[0]);
            PG8_WAIT_V(8); PG8_WAIT_L(0); PG8_BAR; PG8_MMA(1, 0, At, B0); PG8_MMA(1, 1, At, B1); PG8_BAR; PG8_SCHED;
            PG8_LDB(B0, 1, 0); PG8_LDB(B1, 1, 1); PG8_SCHED; PG8_LDA(At, 1, 0); PG8_STAGE(PG8_SA(0, 1), a2 + hstepA, va2[1]);
            PG8_WAIT_V(8); PG8_WAIT_L(0); PG8_BAR; PG8_MMA(0, 0, At, B0); PG8_MMA(0, 1, At, B1); PG8_BAR; PG8_SCHED;
            PG8_LDA(At, 1, 1); PG8_STAGE(PG8_SB(1, 0), b3, voffB); PG8_STAGE(PG8_SB(1, 1), b3 + hstepB, voffB); PG8_STAGE(PG8_SA(1, 0), a3, va2[0]);
            PG8_WAIT_V(8); PG8_WAIT_L(0); PG8_BAR; PG8_MMA(1, 0, At, B0); PG8_MMA(1, 1, At, B1); PG8_BAR; PG8_SCHED;
        }
        if (wr == 0) PG8_BAR;
        E(acc, cur, wr, wc, fr, fq);
        if (!has_next) break;
#pragma unroll
        for (int a = 0; a < 2; ++a)
#pragma unroll
            for (int b = 0; b < 2; ++b)
#pragma unroll
                for (int m = 0; m < 4; ++m)
#pragma unroll
                    for (int n = 0; n < 2; ++n) acc[a][b][m][n] = (f32x4){0.f, 0.f, 0.f, 0.f};
        cur = nxt; cA = nA; cB = nB; ++ui;
        if (GATHER) { _Pragma("unroll") for (int h = 0; h < 2; ++h) _Pragma("unroll") for (int i = 0; i < 2; ++i) voffAc[h][i] = voffAn[h][i]; }
        if (wr == 1) PG8_BAR;
    }
    PG8_WAIT_V(0);
    PG8_BAR;
#undef PG8_SA
#undef PG8_SB
#undef PG8_STAGE
#undef PG8_LDA
#undef PG8_LDB
#undef PG8_MMA
#undef PG8_WAIT_V
#undef PG8_WAIT_L
#undef PG8_BAR
#undef PG8_SCHED
#undef PG8_GOFF
}
typedef f32x4 Acc[2][2][4][2];
}

#define XB_TMO      128
#define XB_XCNT(j)  (256  + 64 * (j))
#define XB_XSUB(j)  (1280 + 64 * (j))
#define XB_XGEN(j)  (2304 + 64 * (j))
#define XB_TOP      3328
#define XB_TOPGEN   3392
#define XCD_BAR_WORDS 3456
#define XB_SPIN_CAP (1u << 18)
__device__ __forceinline__ unsigned xb_ld(unsigned* p)              { return __hip_atomic_load(p, __ATOMIC_RELAXED, __HIP_MEMORY_SCOPE_AGENT); }
__device__ __forceinline__ unsigned xb_add(unsigned* p, unsigned v) { return __hip_atomic_fetch_add(p, v, __ATOMIC_RELAXED, __HIP_MEMORY_SCOPE_AGENT); }
__device__ __forceinline__ unsigned xb_xcc_id() { return (unsigned)__builtin_amdgcn_s_getreg((3 << 11) | 20) & 0xFu; }
#define XB_SPIN(cond, bar) do { unsigned _sp = 0; while (cond) { __builtin_amdgcn_s_sleep(1); \
    if ((++_sp & 255u) == 0u) { if (xb_ld(&(bar)[XB_TMO])) break; if (_sp > XB_SPIN_CAP) { atomicAdd(&(bar)[XB_TMO], 1u); break; } } } } while (0)
struct XcdBarrier { unsigned* bar; unsigned x; volatile LAS unsigned* st; };
__device__ __forceinline__ XcdBarrier xcd_barrier_post(unsigned* bar, volatile LAS unsigned* st) {
    XcdBarrier b; b.bar = bar; b.x = xb_xcc_id(); b.st = st;
    if (threadIdx.x == 0) (void)xb_add(&bar[XB_XCNT(b.x)], 1u);
    return b;
}
__device__ __forceinline__ void xcd_barrier_complete(unsigned* bar, unsigned x, unsigned& nloc, unsigned& nx) {
    const unsigned G = gridDim.x * gridDim.y * gridDim.z;
    unsigned sum, cnt, mine, sp = 0u;
    for (;;) {
        sum = 0u; cnt = 0u; mine = 0u;
#pragma unroll
        for (unsigned j = 0; j < 16; ++j) { const unsigned c = xb_ld(&bar[XB_XCNT(j)]); sum += c; cnt += (c > 0u) ? 1u : 0u; mine = (j == x) ? c : mine; }
        if (sum == G) break;
        __builtin_amdgcn_s_sleep(1);
        if ((++sp & 255u) == 0u) { if (xb_ld(&bar[XB_TMO])) break; if (sp > XB_SPIN_CAP) { atomicAdd(&bar[XB_TMO], 1u); break; } }
    }
    nloc = mine > 0u ? mine : 1u; nx = cnt > 0u ? cnt : 1u;
}
__device__ __forceinline__ void xcd_barrier(const XcdBarrier& b) {
    asm volatile("s_waitcnt vmcnt(0)" ::: "memory");
    __syncthreads();
    if (threadIdx.x == 0) {
        unsigned* bar = b.bar;
        __builtin_amdgcn_s_waitcnt(0);
        unsigned nloc = b.st[0], nx = b.st[1];
        if (nloc == 0u) { xcd_barrier_complete(bar, b.x, nloc, nx); b.st[0] = nloc; b.st[1] = nx; }
        const unsigned old = xb_add(&bar[XB_XSUB(b.x)], 1u);
        const unsigned gen = old / nloc;
        if (old + 1u == (gen + 1u) * nloc) {
            __builtin_amdgcn_fence(__ATOMIC_RELEASE, "agent");
            asm volatile("s_waitcnt vmcnt(0)" ::: "memory");
            const unsigned og = xb_add(&bar[XB_TOP], 1u);
            const unsigned tg = og / nx;
            if (og + 1u == (tg + 1u) * nx) xb_add(&bar[XB_TOPGEN], 1u);
            else XB_SPIN(xb_ld(&bar[XB_TOPGEN]) == tg, bar);
            __builtin_amdgcn_fence(__ATOMIC_ACQUIRE, "agent");
            xb_add(&bar[XB_XGEN(b.x)], 1u);
            asm volatile("s_waitcnt vmcnt(0)" ::: "memory");
        } else {
            XB_SPIN(xb_ld(&bar[XB_XGEN(b.x)]) == gen, bar);
            __builtin_amdgcn_fence(__ATOMIC_ACQUIRE, "agent");
            asm volatile("s_waitcnt vmcnt(0)" ::: "memory");
        }
    }
    __syncthreads();
}

struct Args { const float* in[29]; float* out; unsigned char* ws; int ph_lo, ph_hi; };
enum { I_X = 0, I_P, I_LNIN_G, I_LNIN_B, I_RELB, I_WIN, I_GN_G, I_LQ1, I_LK1, I_LQ2, I_LK2, I_SUBLN_G, I_WRO, I_WDO, I_WO, I_LN1_G, I_LN1_B,
       I_ROUT_W, I_ROUT_B, I_EG, I_EU, I_ED, I_SG, I_SU, I_SD, I_PLE_W, I_PLE_GW, I_LN2_G, I_LN2_B };

struct Frame {
    LAS unsigned char* lds;
    volatile LAS unsigned* MISC;
    gu32* ctl;
    int tid, lane, wave, vcu, G;
};

__device__ __forceinline__ void p0_transpose_item(const float* W, int K, int N, bf16_t* WT, int k0, int n0, int dstrow0, LAS float* scr, int lane) {
#pragma unroll 8
    for (int i = 0; i < 32; ++i) { const int kk = 2 * i + (lane >> 5); scr[kk * 33 + (lane & 31)] = W[(size_t)(k0 + kk) * N + n0 + (lane & 31)]; }
    LDS_WAIT(); asm volatile("" ::: "memory");
    const int c = lane & 7;
#pragma unroll
    for (int j = 0; j < 4; ++j) { const int n = (lane >> 3) + 8 * j; const LAS float* s = scr + (8 * c) * 33 + n;
        v4u o; o.x = pk2(s[0 * 33], s[1 * 33]); o.y = pk2(s[2 * 33], s[3 * 33]); o.z = pk2(s[4 * 33], s[5 * 33]); o.w = pk2(s[6 * 33], s[7 * 33]);
        *(GAS v4u*)(WT + (size_t)(dstrow0 + n) * K + k0 + 8 * c) = o; }
    LDS_WAIT(); asm volatile("" ::: "memory");
}
__host__ __device__ __forceinline__ int win_dst_row(int c) {
    if (c >= 2048) return c;
    const int sb = c & ~1023, cs = c & 1023, hd = cs >> 7, half = (cs >> 6) & 1, j = cs & 63;
    return sb + (hd >> 1) * 256 + half * 128 + (hd & 1) * 64 + j;
}
__device__ __forceinline__ void ln_row_to_bf16(int lane, const float* xrow, const float* g, const float* b, bf16_t* orow) {
    const GAS f32x4* xr = (const GAS f32x4*)xrow + lane;
    f32x4 v[4]; float s = 0.f;
#pragma unroll
    for (int j = 0; j < 4; ++j) { v[j] = xr[64 * j]; s += (v[j].x + v[j].y) + (v[j].z + v[j].w); }
    const float mean = wave_sum(s) * (1.f / DM); float s2 = 0.f;
#pragma unroll
    for (int j = 0; j < 4; ++j) { v[j] = v[j] - mean; s2 += (v[j].x * v[j].x + v[j].y * v[j].y) + (v[j].z * v[j].z + v[j].w * v[j].w); }
    const float rstd = 1.f / sqrtf(wave_sum(s2) * (1.f / DM) + LN_EPS);
    GAS unsigned long long* o8 = (GAS unsigned long long*)orow + lane;
#pragma unroll
    for (int j = 0; j < 4; ++j) { const f32x4 gg = *((const GAS f32x4*)g + lane + 64 * j), bb = *((const GAS f32x4*)b + lane + 64 * j);
        const f32x4 y = v[j] * rstd * gg + bb;
        o8[64 * j] = (unsigned long long)pk2(y.x, y.y) | ((unsigned long long)pk2(y.z, y.w) << 32); }
}

__device__ __forceinline__ void p0_prologue(Frame& F, const Args& a) {
    LAS float* scr = (LAS float*)(F.lds + F.wave * 16384);
    const int gw = F.vcu * NWAVES + F.wave, NGW = F.G * NWAVES;
    unsigned char* ws = a.ws;
    constexpr int I_WINc = 16 * (INCOLS / 32);
    constexpr int I_WROc = 32 * 32, I_WDOc = 16 * 32, I_WOc = 16 * 32, I_ROUTc = 16 * 8, I_PLEWc = 4 * 32, I_PLEGc = 16 * 32, I_SGc = 16 * 8, I_SUc = 16 * 8, I_SDc = 4 * 32;
    constexpr int NITEMS = I_WINc + I_WROc + I_WDOc + I_WOc + I_ROUTc + I_PLEWc + I_PLEGc + I_SGc + I_SUc + I_SDc;
    for (int it = gw; it < NITEMS; it += NGW) {
        int r = it; const float* W; int K, N; bf16_t* WT; int kind = 0;
        if (r < I_WINc) { W = a.in[I_WIN]; K = 1024; N = INCOLS; WT = (bf16_t*)(ws + WS_WIN_T); kind = 1; }
        else if ((r -= I_WINc) < I_WROc) { W = a.in[I_WRO]; K = 2048; N = 1024; WT = (bf16_t*)(ws + WS_WRO_T); }
        else if ((r -= I_WROc) < I_WDOc) { W = a.in[I_WDO]; K = 1024; N = 1024; WT = (bf16_t*)(ws + WS_WDO_T); }
        else if ((r -= I_WDOc) < I_WOc) { W = a.in[I_WO]; K = 1024; N = 1024; WT = (bf16_t*)(ws + WS_WO_T); }
        else if ((r -= I_WOc) < I_ROUTc) { W = a.in[I_ROUT_W]; K = 1024; N = 256; WT = (bf16_t*)(ws + WS_ROUT_T); }
        else if ((r -= I_ROUTc) < I_PLEWc) { W = a.in[I_PLE_W]; K = 256; N = 1024; WT = (bf16_t*)(ws + WS_PLEW_T); }
        else if ((r -= I_PLEWc) < I_PLEGc) { W = a.in[I_PLE_GW]; K = 1024; N = 1024; WT = (bf16_t*)(ws + WS_PLEG_T); }
        else if ((r -= I_PLEGc) < I_SGc) { W = a.in[I_SG]; K = 1024; N = 256; WT = (bf16_t*)(ws + WS_SHGU_T); kind = 2; }
        else if ((r -= I_SGc) < I_SUc) { W = a.in[I_SU]; K = 1024; N = 256; WT = (bf16_t*)(ws + WS_SHGU_T); kind = 3; }
        else { r -= I_SUc; W = a.in[I_SD]; K = 256; N = 1024; WT = (bf16_t*)(ws + WS_SHD_T); }
        const int nblk = N / 32, kb = r / nblk, nb = r % nblk, n0 = 32 * nb;
        int d0 = n0;
        if (kind == 1) d0 = win_dst_row(n0);
        else if (kind == 2) d0 = (n0 >> 7) * 256 + (n0 & 127);
        else if (kind == 3) d0 = (n0 >> 7) * 256 + 128 + (n0 & 127);
        p0_transpose_item(W, K, N, WT, 64 * kb, n0, d0, scr, F.lane);
    }
    for (int m = gw; m < NTOK; m += NGW) ln_row_to_bf16(F.lane, a.in[I_X] + (size_t)m * DM, a.in[I_LNIN_G], a.in[I_LNIN_B], (bf16_t*)(ws + WS_XN) + (size_t)m * DM);
    { const size_t n8 = (size_t)NTOK * PLE / 8; const GAS f32x4* src = (const GAS f32x4*)a.in[I_P]; GAS v4u* dst = (GAS v4u*)(ws + WS_PB);
      for (size_t i = (size_t)F.vcu * 512 + F.tid; i < n8; i += (size_t)F.G * 512) { const f32x4 x0 = src[2 * i], x1 = src[2 * i + 1];
          v4u o; o.x = pk2(x0.x, x0.y); o.y = pk2(x0.z, x0.w); o.z = pk2(x1.x, x1.y); o.w = pk2(x1.z, x1.w); dst[i] = o; } }
}

struct EpiInProj {
    static constexpr bool PERM = true;
    unsigned char* ws;
    __device__ __forceinline__ void operator()(const pg8::Acc& acc, const pg8::Unit& u, int wr, int wc, int fr, int fq) const {
        const int pn = u.pn; int seg, t0, ld; size_t boff;
        if (pn < 4) { seg = 0; t0 = 0; boff = WS_QR; ld = 1024; } else if (pn < 8) { seg = 1; t0 = 4; boff = WS_KR; ld = 1024; }
        else if (pn < 16) { seg = 2; t0 = 8; boff = WS_VR; ld = 2048; } else if (pn < 24) { seg = 3; t0 = 16; boff = WS_GR; ld = 2048; }
        else if (pn < 28) { seg = 4; t0 = 24; boff = WS_QD; ld = 1024; } else if (pn < 32) { seg = 5; t0 = 28; boff = WS_KD; ld = 1024; }
        else if (pn < 36) { seg = 6; t0 = 32; boff = WS_VD; ld = 1024; } else { seg = 7; t0 = 36; boff = WS_GT; ld = 2048; }
        bf16_t* base = (bf16_t*)(ws + boff);
        const int tl = pn - t0;
        const int row0 = u.pm * 256 + wr * 64 + fr;
        if (seg <= 1) {
            const int hl = wc >> 1, j0 = 32 * (wc & 1) + 8 * fq, head = 2 * tl + hl;
            const float sc = seg == 1 ? KR_SCALE : 1.f;
            float th[8];
#pragma unroll
            for (int i = 0; i < 8; ++i) th[i] = exp2f(-(float)(j0 + i) * (13.287712379549449f / 63.f));
#pragma unroll
            for (int ai = 0; ai < 2; ++ai)
#pragma unroll
                for (int m = 0; m < 4; ++m) {
                    const int row = row0 + ai * 128 + m * 16; const float pos = (float)(row & (SEQ - 1));
                    float o1[8], o2[8];
#pragma unroll
                    for (int i = 0; i < 8; ++i) {
                        const float t1 = acc[ai][0][m][i >> 2][i & 3], t2 = acc[ai][1][m][i >> 2][i & 3];
                        const float ang = pos * th[i]; const float k = rintf(ang * 0.15915494309189535f);
                        float r = fmaf(-k, 6.2831855f, ang); r = fmaf(-k, -1.7484555e-7f, r);
                        const float rr = r * 0.15915494309189535f;
                        const float c = __builtin_amdgcn_cosf(rr), s = __builtin_amdgcn_sinf(rr);
                        o1[i] = (t1 * c - t2 * s) * sc; o2[i] = (t2 * c + t1 * s) * sc;
                    }
                    bf16_t* rp = base + (size_t)row * ld + head * 128 + j0;
                    v4u w; w.x = cvt_pk_bf16(o1[0], o1[1]); w.y = cvt_pk_bf16(o1[2], o1[3]); w.z = cvt_pk_bf16(o1[4], o1[5]); w.w = cvt_pk_bf16(o1[6], o1[7]);
                    *(v4u*)rp = w;
                    w.x = cvt_pk_bf16(o2[0], o2[1]); w.y = cvt_pk_bf16(o2[2], o2[3]); w.z = cvt_pk_bf16(o2[4], o2[5]); w.w = cvt_pk_bf16(o2[6], o2[7]);
                    *(v4u*)(rp + 64) = w;
                }
        } else {
            const int col0 = tl * 256 + wc * 32 + 8 * fq;
#pragma unroll
            for (int ai = 0; ai < 2; ++ai)
#pragma unroll
                for (int m = 0; m < 4; ++m) {
                    bf16_t* rp = base + (size_t)(row0 + ai * 128 + m * 16) * ld + col0;
#pragma unroll
                    for (int bj = 0; bj < 2; ++bj) {
                        f32x4 v0 = acc[ai][bj][m][0], v1 = acc[ai][bj][m][1];
                        if (seg == 3) { for (int i = 0; i < 4; ++i) { v0[i] = fast_silu(v0[i]); v1[i] = fast_silu(v1[i]); } }
                        else if (seg == 7) { for (int i = 0; i < 4; ++i) { v0[i] = fast_sigmoid(v0[i]); v1[i] = fast_sigmoid(v1[i]); } }
                        else if (seg == 4) { v0 = v0 * QD_SCALE; v1 = v1 * QD_SCALE; }
                        v4u w; w.x = cvt_pk_bf16(v0[0], v0[1]); w.y = cvt_pk_bf16(v0[2], v0[3]); w.z = cvt_pk_bf16(v1[0], v1[1]); w.w = cvt_pk_bf16(v1[2], v1[3]);
                        *(v4u*)(rp + bj * 128) = w;
                    }
                }
        }
    }
};


namespace att {
using f32x16 = __attribute__((ext_vector_type(16))) float;
using s16x4  = __attribute__((ext_vector_type(4))) short;
constexpr int SHM_V = 16384, SHM_K64 = 8192;
constexpr int A_V = 0, A_K = 32768, A_WS = 49152, A_TAB = 51200, A_ST = 52736;
constexpr int R_KS = 0, R_KI = 32768, R_VI = 65536, R_ST = 98304, R_STP = 272, R_OS = 107008;
#define KSWZ(row, colB) ((row) * 256 + ((colB) ^ (((row) & 7) << 4)))
#define KSWZ64(row, colB) ((row) * 128 + ((colB) ^ ((((row) >> 1) & 7) << 4)))
#define SBAR() __builtin_amdgcn_sched_barrier(0)
__device__ __forceinline__ int crow(int r, int hi) { return (r & 3) + 8 * (r >> 2) + 4 * hi; }
__device__ __forceinline__ int v_st(int k, int c) { const int kk = (k & ~0xC) | ((k & 4) << 1) | ((k & 8) >> 1); return ((kk >> 3) * 4 + (c >> 5)) * 512 + ((kk & 7) * 32 + (c & 31)) * 2; }
__device__ __forceinline__ int v_rd_base(int lane) { return ((lane & 3) << 3) | (((lane >> 2) & 3) << 6) | (((lane >> 4) & 1) << 5) | (((lane >> 5) & 1) << 8); }
constexpr int v_rd_off(int d0, int ks, int half) { return d0 * 512 + ks * 4096 + half * 2048; }
template <int OFF> __device__ __forceinline__ s16x4 tr_read(int vb) {
  s16x4 r; asm volatile("ds_read_b64_tr_b16 %0, %1 offset:%2" : "=&v"(r) : "v"(vb), "i"(OFF) : "memory"); return r;
}
#define PKF(L, H) (bf16x8){L[0], L[1], L[2], L[3], H[0], H[1], H[2], H[3]}
template <int D0> __device__ __forceinline__ void pv_one(f32x16& od, int vb, bf16x8 pa0, bf16x8 pa1, bf16x8 pa2, bf16x8 pa3) {
  const s16x4 l0 = tr_read<v_rd_off(D0, 0, 0)>(vb), h0 = tr_read<v_rd_off(D0, 0, 1)>(vb), l1 = tr_read<v_rd_off(D0, 1, 0)>(vb), h1 = tr_read<v_rd_off(D0, 1, 1)>(vb);
  const s16x4 l2 = tr_read<v_rd_off(D0, 2, 0)>(vb), h2 = tr_read<v_rd_off(D0, 2, 1)>(vb), l3 = tr_read<v_rd_off(D0, 3, 0)>(vb), h3 = tr_read<v_rd_off(D0, 3, 1)>(vb);
  asm volatile("s_waitcnt lgkmcnt(0)" ::: "memory"); SBAR();
  od = __builtin_amdgcn_mfma_f32_32x32x16_bf16(pa0, PKF(l0, h0), od, 0, 0, 0);
  od = __builtin_amdgcn_mfma_f32_32x32x16_bf16(pa1, PKF(l1, h1), od, 0, 0, 0);
  od = __builtin_amdgcn_mfma_f32_32x32x16_bf16(pa2, PKF(l2, h2), od, 0, 0, 0);
  od = __builtin_amdgcn_mfma_f32_32x32x16_bf16(pa3, PKF(l3, h3), od, 0, 0, 0);
}
__device__ __forceinline__ void pv_d0(f32x16* o, int vb, bf16x8 pa0, bf16x8 pa1, bf16x8 pa2, bf16x8 pa3) {
  pv_one<0>(o[0], vb, pa0, pa1, pa2, pa3); pv_one<1>(o[1], vb, pa0, pa1, pa2, pa3); pv_one<2>(o[2], vb, pa0, pa1, pa2, pa3); pv_one<3>(o[3], vb, pa0, pa1, pa2, pa3);
}
#define PK4(P, BASE, OUT) do { unsigned a0 = cvt_pk_bf16(P[BASE + 0], P[BASE + 1]), a1 = cvt_pk_bf16(P[BASE + 2], P[BASE + 3]);   \
    unsigned b0 = cvt_pk_bf16(P[BASE + 4], P[BASE + 5]), b1 = cvt_pk_bf16(P[BASE + 6], P[BASE + 7]);                              \
    auto r0 = __builtin_amdgcn_permlane32_swap(a0, b0, false, false); auto r1 = __builtin_amdgcn_permlane32_swap(a1, b1, false, false); \
    v4u w = {r0[0], r1[0], r0[1], r1[1]}; OUT = *reinterpret_cast<bf16x8*>(&w); } while (0)

__device__ __forceinline__ int t5_bucket(int n) {
  if (n < 16) return n;
  int b = 16;
  b += (n >= 19); b += (n >= 21); b += (n >= 24); b += (n >= 27); b += (n >= 31); b += (n >= 35); b += (n >= 40); b += (n >= 46);
  b += (n >= 52); b += (n >= 59); b += (n >= 67); b += (n >= 77); b += (n >= 87); b += (n >= 99); b += (n >= 113);
  return b;
}
constexpr float THR2 = 8.f;
__device__ __forceinline__ void partialSM(f32x16& p0, f32x16& p1, float& m_reg, float& mn, float& alpha) {
  float pmax = p0[0];
#pragma unroll
  for (int r = 1; r < 16; ++r) pmax = fmaxf(pmax, p0[r]);
#pragma unroll
  for (int r = 0; r < 16; ++r) pmax = fmaxf(pmax, p1[r]);
  { auto rr = __builtin_amdgcn_permlane32_swap(__float_as_uint(pmax), __float_as_uint(pmax), false, false);
    pmax = fmaxf(__uint_as_float(rr[0]), __uint_as_float(rr[1])); }
  if (__builtin_expect(__all(pmax - m_reg <= THR2), 1)) { mn = m_reg; alpha = 1.f; }
  else { mn = fmaxf(m_reg, pmax); alpha = __builtin_amdgcn_exp2f(m_reg - mn); m_reg = mn; }
#pragma unroll
  for (int r = 0; r < 16; ++r) { p0[r] = p0[r] - mn; p1[r] = p1[r] - mn; }
#pragma unroll
  for (int r = 0; r < 16; ++r) p0[r] = __builtin_amdgcn_exp2f(p0[r]);
}
__device__ __forceinline__ void finishSM(f32x16& p0, f32x16& p1, float alpha, float& l_reg, bf16x8& pa0, bf16x8& pa1, bf16x8& pa2, bf16x8& pa3) {
#pragma unroll
  for (int r = 0; r < 16; ++r) p1[r] = __builtin_amdgcn_exp2f(p1[r]);
  float ps = 0;
#pragma unroll
  for (int r = 0; r < 16; ++r) ps += p0[r];
#pragma unroll
  for (int r = 0; r < 16; ++r) ps += p1[r];
  { auto rr = __builtin_amdgcn_permlane32_swap(__float_as_uint(ps), __float_as_uint(ps), false, false);
    ps = __uint_as_float(rr[0]) + __uint_as_float(rr[1]); }
  l_reg = l_reg * alpha + ps;
  PK4(p0, 0, pa0); PK4(p0, 8, pa1); PK4(p1, 0, pa2); PK4(p1, 8, pa3);
}
__device__ __forceinline__ void qkt64(f32x16& p0, f32x16& p1, const char* Ks, const bf16x8* qr, int r32, int hi, float init) {
#pragma unroll
  for (int r = 0; r < 16; ++r) { p0[r] = init; p1[r] = init; }
#pragma unroll
  for (int d0 = 0; d0 < 4; ++d0) { const int cb = d0 * 32 + hi * 16;
    const bf16x8 b0 = *reinterpret_cast<const bf16x8*>(Ks + KSWZ64(r32, cb));
    const bf16x8 b1 = *reinterpret_cast<const bf16x8*>(Ks + KSWZ64(32 + r32, cb));
    p0 = __builtin_amdgcn_mfma_f32_32x32x16_bf16(b0, qr[d0], p0, 0, 0, 0);
    p1 = __builtin_amdgcn_mfma_f32_32x32x16_bf16(b1, qr[d0], p1, 0, 0, 0); }
}
__device__ __forceinline__ void bias_mask(f32x16& p0, f32x16& p1, const float* tab, int dbase) {
#pragma unroll
  for (int r = 0; r < 16; ++r) {
    const int d0 = dbase - ((r & 3) + 8 * (r >> 2)), d1 = d0 - 32;
    const float b0 = tab[min(max(d0, 0), 383)], b1 = tab[min(max(d1, 0), 383)];
    p0[r] = d0 >= 0 ? p0[r] + b0 : -INFINITY; p1[r] = d1 >= 0 ? p1[r] + b1 : -INFINITY;
  }
}

__device__ __forceinline__ void attn_unit(int b, int h, int qb, bf16_t* QD, const bf16_t* __restrict__ KD, const bf16_t* __restrict__ VD,
                                          const float* relb, const float* subg, float lam, char* lds) {
  int tid = threadIdx.x; asm volatile("" : "+v"(tid));
  const int lane = tid & 63, r32 = lane & 31, hi = lane >> 5; const int wid = __builtin_amdgcn_readfirstlane(tid >> 6);
  char* V_lds = lds + A_V; char* K_lds = lds + A_K;
  float* wsf = (float*)(lds + A_WS) + wid * 64; float* li_l = wsf; float* al_l = wsf + 32;
  float* tab = (float*)(lds + A_TAB);
  unsigned* stash = (unsigned*)(lds + A_ST) + wid * 2048;
  const int q0 = qb * 256; const long rowbase = (long)b * SEQ;
  if (tid < 384) tab[tid] = relb[t5_bucket(tid) * 8 + h] * LOG2E;
  const float c31 = relb[31 * 8 + h] * LOG2E;
  const int NT = 4 * (qb + 1);
  const int sr = tid >> 4, sc = (tid & 15) * 8, vst0 = v_st(sr, sc), vst1 = v_st(32 + sr, sc);
  const int kr = tid >> 3, kcb = (tid & 7) * 16, kst = KSWZ64(kr, kcb);
  const int vb0 = (int)(uintptr_t)V_lds + v_rd_base(lane);
  const int qw = q0 + wid * 32;
  f32x16 o[4];
  for (int m = 0; m < 2; ++m) {
    const bf16_t* Kh = KD + rowbase * 1024 + h * 128 + m * 64; const bf16_t* Vh = VD + rowbase * 1024 + h * 128;
    const bf16_t* Qw = QD + (rowbase + qw + r32) * 1024 + h * 128 + m * 64 + hi * 8;
    bf16x8 qr[4];
#pragma unroll
    for (int d0 = 0; d0 < 4; ++d0) qr[d0] = *reinterpret_cast<const bf16x8*>(Qw + d0 * 16);
    float m_reg = -1e30f, l_reg = 0;
#pragma unroll
    for (int d = 0; d < 4; ++d)
#pragma unroll
      for (int r = 0; r < 16; ++r) o[d][r] = 0.f;
    bf16x8 vs0, vs1, ks;
#define SLOAD(k0) do { vs0 = *reinterpret_cast<const bf16x8*>(&Vh[(long)((k0) + sr) * 1024 + sc]); vs1 = *reinterpret_cast<const bf16x8*>(&Vh[(long)((k0) + 32 + sr) * 1024 + sc]); \
    ks = *reinterpret_cast<const bf16x8*>(&Kh[(long)((k0) + kr) * 1024 + (tid & 7) * 8]); } while (0)
#define SWRITE(bb) do { *(bf16x8*)(V_lds + (bb) * SHM_V + vst0) = vs0; *(bf16x8*)(V_lds + (bb) * SHM_V + vst1) = vs1; \
    *(bf16x8*)(K_lds + (bb) * SHM_K64 + kst) = ks; } while (0)
    SLOAD(0); SWRITE(0); SLOAD(64); __syncthreads();
    for (int t = 0; t < NT; ++t) {
      const int bb = t & 1;
      const bool far = (qw - 64 * t - 63) >= 128;
      f32x16 p0, p1; float mn, al; bf16x8 pa0, pa1, pa2, pa3;
      qkt64(p0, p1, K_lds + bb * SHM_K64, qr, r32, hi, far ? c31 : 0.f);
      if (!far) bias_mask(p0, p1, tab, qw + r32 - 64 * t - 4 * hi);
      partialSM(p0, p1, m_reg, mn, al);
      if (__any(al < 1.f)) { if (hi == 0) al_l[r32] = al; asm volatile("s_waitcnt lgkmcnt(0)" ::: "memory");
#pragma unroll
        for (int d = 0; d < 4; ++d)
#pragma unroll
          for (int r = 0; r < 16; ++r) o[d][r] *= al_l[crow(r, hi)]; }
      finishSM(p0, p1, al, l_reg, pa0, pa1, pa2, pa3); SBAR();
      pv_d0(o, vb0 + bb * SHM_V, pa0, pa1, pa2, pa3);
      if (t + 1 < NT) { SWRITE(bb ^ 1); if (t + 2 < NT) SLOAD((t + 2) * 64); }
      __syncthreads();
    }
#undef SLOAD
#undef SWRITE
    if (hi == 0) li_l[r32] = l_reg; asm volatile("s_waitcnt lgkmcnt(0)" ::: "memory");
    float rli[16];
#pragma unroll
    for (int r = 0; r < 16; ++r) rli[r] = __builtin_amdgcn_rcpf(li_l[crow(r, hi)]);
    if (m == 0) {
#pragma unroll
      for (int d = 0; d < 4; ++d)
#pragma unroll
        for (int r = 0; r < 16; r += 2) stash[(d * 8 + (r >> 1)) * 64 + lane] = pk2(o[d][r] * rli[r], o[d][r + 1] * rli[r + 1]);
    } else {
      float ss[16];
#pragma unroll
      for (int r = 0; r < 16; ++r) ss[r] = 0.f;
#pragma unroll
      for (int d = 0; d < 4; ++d)
#pragma unroll
        for (int r = 0; r < 16; r += 2) { const unsigned w = stash[(d * 8 + (r >> 1)) * 64 + lane];
          o[d][r] = bflo(w) - lam * o[d][r] * rli[r]; o[d][r + 1] = bfhi(w) - lam * o[d][r + 1] * rli[r + 1];
          ss[r] += o[d][r] * o[d][r]; ss[r + 1] += o[d][r + 1] * o[d][r + 1]; }
#pragma unroll
      for (int off = 1; off < 32; off <<= 1)
#pragma unroll
        for (int r = 0; r < 16; ++r) ss[r] += __shfl_xor(ss[r], off);
      float gv[4];
#pragma unroll
      for (int d = 0; d < 4; ++d) gv[d] = subg[d * 32 + r32] * 0.8f;
      char* stg = (char*)stash;
#pragma unroll
      for (int r = 0; r < 16; ++r) { const float rs = 1.f / sqrtf(ss[r] * (1.f / 128.f) + LN_EPS); const int orow = crow(r, hi);
#pragma unroll
        for (int d = 0; d < 4; ++d) *(bf16_t*)(stg + orow * 256 + (d * 32 + r32) * 2) = (bf16_t)f2bf(o[d][r] * rs * gv[d]); }
      asm volatile("s_waitcnt lgkmcnt(0)" ::: "memory");
      char* Ob = (char*)(QD + (rowbase + qw) * 1024 + h * 128) + (size_t)(lane >> 4) * 2048 + (lane & 15) * 16;
#pragma unroll
      for (int i = 0; i < 8; ++i) { const v4u v = *(const v4u*)(stg + (i * 4 + (lane >> 4)) * 256 + (lane & 15) * 16); *(v4u*)(Ob + (size_t)i * 8192) = v; }
    }
    __syncthreads();
  }
}

__device__ __forceinline__ void ret_chain(int b, int h, int j, const bf16_t* __restrict__ QR, const bf16_t* __restrict__ KR, bf16_t* VR, f32x2* gnst, char* lds) {
  int tid = threadIdx.x; asm volatile("" : "+v"(tid));
  const int lane = tid & 63, r32 = lane & 31, hi = lane >> 5; const int wid = __builtin_amdgcn_readfirstlane(tid >> 6);
  char* KS = lds + R_KS; char* KI = lds + R_KI; char* VI = lds + R_VI; char* ST = lds + R_ST;
  const float lg = log2f(1.f - exp2f(-5.f - (float)h));
  const float c_dec = exp2f(128.f * lg);
  const long rowbase = (long)b * SEQ;
  for (int i = tid; i < 32 * R_STP / 4; i += 512) ((unsigned*)ST)[i] = 0u;
  const int sr = tid >> 4, sc = (tid & 15) * 8;
  const int vt = tid >> 2, vc = (tid & 3) * 8;
  const bf16_t* Kg = KR + rowbase * 1024 + h * 128 + sc;
  const bf16_t* Vg = VR + rowbase * 2048 + h * 256 + j * 32 + vc;
  const bf16_t* Qg = QR + (rowbase + (wid & 3) * 32 + r32) * 1024 + h * 128 + hi * 8;
  const int vbV = (int)(uintptr_t)VI + v_rd_base(lane);
  const int vbK = (int)(uintptr_t)KI + v_rd_base(lane) + (wid & 3) * 512;
  const float kd = exp2f((float)(127 - vt) * lg);
  bf16x8 kreg[4], vreg;
#pragma unroll
  for (int i = 0; i < 4; ++i) kreg[i] = *reinterpret_cast<const bf16x8*>(Kg + (long)(sr + 32 * i) * 1024);
  vreg = *reinterpret_cast<const bf16x8*>(Vg + (long)vt * 2048);
  f32x16 sacc;
#pragma unroll
  for (int r = 0; r < 16; ++r) sacc[r] = 0.f;
  for (int n = 0; n < SEQ / 128; ++n) {
    const long t0 = (long)n * 128;
    float lgv = lg; asm volatile("" : "+v"(lgv));
#pragma unroll
    for (int i = 0; i < 4; ++i) { const int tok = sr + 32 * i;
      *(bf16x8*)(KS + KSWZ(tok, sc * 2)) = kreg[i];
      *(bf16x8*)(KI + (i >> 1) * SHM_V + v_st(tok & 63, sc)) = kreg[i]; }
    { *(bf16x8*)(VI + (vt >> 6) * SHM_V + v_st(vt & 63, vc)) = vreg;
      bf16x8 vd;
#pragma unroll
      for (int e = 0; e < 8; ++e) vd[e] = (short)f2bf(bf2f((unsigned short)vreg[e]) * kd);
      *(bf16x8*)(VI + (vt >> 6) * SHM_V + v_st(vt & 63, 32 + vc)) = vd; }
    bf16x8 qr[8];
    if (wid < 4) {
#pragma unroll
      for (int d0 = 0; d0 < 8; ++d0) qr[d0] = *reinterpret_cast<const bf16x8*>(Qg + t0 * 1024 + d0 * 16);
    }
    if (n + 1 < SEQ / 128) {
#pragma unroll
      for (int i = 0; i < 4; ++i) kreg[i] = *reinterpret_cast<const bf16x8*>(Kg + (t0 + 128 + sr + 32 * i) * 1024);
      vreg = *reinterpret_cast<const bf16x8*>(Vg + (t0 + 128 + vt) * 2048);
    }
    __syncthreads();
    if (wid < 4) {
      f32x16 acc;
#pragma unroll
      for (int r = 0; r < 16; ++r) acc[r] = 0.f;
#pragma unroll
      for (int d0 = 0; d0 < 8; ++d0) { const bf16x8 bs = *reinterpret_cast<const bf16x8*>(ST + r32 * R_STP + (16 * d0 + 8 * hi) * 2);
        acc = __builtin_amdgcn_mfma_f32_32x32x16_bf16(qr[d0], bs, acc, 0, 0, 0); }
#pragma unroll
      for (int r = 0; r < 16; ++r) acc[r] *= __builtin_amdgcn_exp2f((float)(32 * wid + crow(r, hi) + 1) * lgv);
#define RET_KB(kb) if ((kb) <= wid) { f32x16 p; _Pragma("unroll") for (int r = 0; r < 16; ++r) p[r] = 0.f; \
        _Pragma("unroll") for (int d0 = 0; d0 < 8; ++d0) { const bf16x8 kf = *reinterpret_cast<const bf16x8*>(KS + KSWZ(32 * (kb) + r32, (16 * d0 + 8 * hi) * 2)); \
          p = __builtin_amdgcn_mfma_f32_32x32x16_bf16(kf, qr[d0], p, 0, 0, 0); } \
        _Pragma("unroll") for (int r = 0; r < 16; ++r) { const int rel = 32 * (wid - (kb)) + r32 - crow(r, hi); p[r] = rel >= 0 ? p[r] * __builtin_amdgcn_exp2f((float)rel * lgv) : 0.f; } \
        bf16x8 pa0, pa1; PK4(p, 0, pa0); PK4(p, 8, pa1); \
        const s16x4 l0 = tr_read<v_rd_off(0, ((kb) & 1) * 2 + 0, 0) + ((kb) >> 1) * SHM_V>(vbV), h0 = tr_read<v_rd_off(0, ((kb) & 1) * 2 + 0, 1) + ((kb) >> 1) * SHM_V>(vbV); \
        const s16x4 l1 = tr_read<v_rd_off(0, ((kb) & 1) * 2 + 1, 0) + ((kb) >> 1) * SHM_V>(vbV), h1 = tr_read<v_rd_off(0, ((kb) & 1) * 2 + 1, 1) + ((kb) >> 1) * SHM_V>(vbV); \
        asm volatile("s_waitcnt lgkmcnt(0)" ::: "memory"); SBAR(); \
        acc = __builtin_amdgcn_mfma_f32_32x32x16_bf16(pa0, PKF(l0, h0), acc, 0, 0, 0); \
        acc = __builtin_amdgcn_mfma_f32_32x32x16_bf16(pa1, PKF(l1, h1), acc, 0, 0, 0); }
      RET_KB(0) RET_KB(1) RET_KB(2) RET_KB(3)
#undef RET_KB
      char* stg = lds + R_OS + wid * 2048;
#pragma unroll
      for (int r = 0; r < 16; ++r) *(bf16_t*)(stg + crow(r, hi) * 64 + r32 * 2) = (bf16_t)f2bf(acc[r]);
      asm volatile("s_waitcnt lgkmcnt(0)" ::: "memory");
      { const v4u v0 = *(const v4u*)(stg + (lane >> 1) * 64 + (lane & 1) * 32), v1 = *(const v4u*)(stg + (lane >> 1) * 64 + (lane & 1) * 32 + 16);
        const long orow = rowbase + t0 + 32 * wid + (lane >> 1);
        char* Ob = (char*)(VR + orow * 2048 + h * 256 + j * 32) + (lane & 1) * 32;
        *(v4u*)Ob = v0; *(v4u*)(Ob + 16) = v1;
        float s1 = 0.f, s2 = 0.f;
#pragma unroll
        for (int e = 0; e < 4; ++e) { const float a0 = bflo(v0[e]), a1 = bfhi(v0[e]), a2 = bflo(v1[e]), a3 = bfhi(v1[e]);
          s1 += (a0 + a1) + (a2 + a3); s2 += (a0 * a0 + a1 * a1) + (a2 * a2 + a3 * a3); }
        s1 += __shfl_xor(s1, 1); s2 += __shfl_xor(s2, 1);
        if ((lane & 1) == 0) gnst[((size_t)j * NTOK + orow) * 8 + h] = (f32x2){s1, s2}; }
    } else {
#pragma unroll
      for (int r = 0; r < 16; ++r) sacc[r] *= c_dec;
#define RET_KS(im, ks) { const s16x4 al = tr_read<v_rd_off(1, ks, 0) + (im) * SHM_V>(vbV), ah = tr_read<v_rd_off(1, ks, 1) + (im) * SHM_V>(vbV); \
        const s16x4 bl = tr_read<v_rd_off(0, ks, 0) + (im) * SHM_V>(vbK), bh = tr_read<v_rd_off(0, ks, 1) + (im) * SHM_V>(vbK); \
        asm volatile("s_waitcnt lgkmcnt(0)" ::: "memory"); SBAR(); \
        sacc = __builtin_amdgcn_mfma_f32_32x32x16_bf16(PKF(al, ah), PKF(bl, bh), sacc, 0, 0, 0); }
      RET_KS(0, 0) RET_KS(0, 1) RET_KS(0, 2) RET_KS(0, 3) RET_KS(1, 0) RET_KS(1, 1) RET_KS(1, 2) RET_KS(1, 3)
#undef RET_KS
    }
    __syncthreads();
    if (wid >= 4) {
#pragma unroll
      for (int r = 0; r < 16; ++r) *(bf16_t*)(ST + crow(r, hi) * R_STP + (32 * (wid - 4) + r32) * 2) = (bf16_t)f2bf(sacc[r]);
    }
  }
  __syncthreads();
}
#undef SBAR
}

__device__ __forceinline__ void gn_pass(Frame& F, unsigned char* ws, const float* gn_g) {
    const int gw = F.vcu * NWAVES + F.wave, NGW = F.G * NWAVES, lane = F.lane;
    const f32x2* gnst = (const f32x2*)(ws + WS_GNST);
    for (int t = gw; t < NTOK; t += NGW) {
        float mean = 0.f, rstd = 0.f;
        if (lane < 8) { float s = 0.f, q = 0.f;
#pragma unroll
            for (int j = 0; j < 8; ++j) { const f32x2 v = gnst[((size_t)j * NTOK + t) * 8 + lane]; s += v.x; q += v.y; }
            mean = s * (1.f / 256.f); rstd = 1.f / sqrtf(fmaxf(q * (1.f / 256.f) - mean * mean, 0.f) + LN_EPS); }
        const GAS v4u* o4 = (const GAS v4u*)(ws + WS_VR + (size_t)t * 4096); GAS v4u* g4 = (GAS v4u*)(ws + WS_GR + (size_t)t * 4096);
#pragma unroll
        for (int i = 0; i < 4; ++i) { const int c8 = i * 64 + lane, hd = c8 >> 5;
            const float mu = __shfl(mean, hd), rs = __shfl(rstd, hd);
            const v4u ov = o4[c8], gv = g4[c8];
            const f32x4 w0 = *((const GAS f32x4*)gn_g + 2 * c8), w1 = *((const GAS f32x4*)gn_g + 2 * c8 + 1);
            v4u r;
            r.x = pk2(bflo(gv.x) * w0.x * (bflo(ov.x) - mu) * rs, bfhi(gv.x) * w0.y * (bfhi(ov.x) - mu) * rs);
            r.y = pk2(bflo(gv.y) * w0.z * (bflo(ov.y) - mu) * rs, bfhi(gv.y) * w0.w * (bfhi(ov.y) - mu) * rs);
            r.z = pk2(bflo(gv.z) * w1.x * (bflo(ov.z) - mu) * rs, bfhi(gv.z) * w1.y * (bfhi(ov.z) - mu) * rs);
            r.w = pk2(bflo(gv.w) * w1.z * (bflo(ov.w) - mu) * rs, bfhi(gv.w) * w1.w * (bfhi(ov.w) - mu) * rs);
            g4[c8] = r; }
    }
}


__device__ __forceinline__ void unpack8(const v4u w, float* f) { f[0] = bflo(w.x); f[1] = bfhi(w.x); f[2] = bflo(w.y); f[3] = bfhi(w.y); f[4] = bflo(w.z); f[5] = bfhi(w.z); f[6] = bflo(w.w); f[7] = bfhi(w.w); }
__device__ __forceinline__ v4u pack8(const float* f) { v4u w; w.x = cvt_pk_bf16(f[0], f[1]); w.y = cvt_pk_bf16(f[2], f[3]); w.z = cvt_pk_bf16(f[4], f[5]); w.w = cvt_pk_bf16(f[6], f[7]); return w; }
#define EPI_ROWS_BEGIN const int row0 = u.pm * 256 + wr * 64 + fr; const int colw = wc * 32 + 8 * fq; \
    _Pragma("unroll") for (int ai = 0; ai < 2; ++ai) _Pragma("unroll") for (int m = 0; m < 4; ++m) { const int row = row0 + ai * 128 + m * 16; (void)row; \
    _Pragma("unroll") for (int bj = 0; bj < 2; ++bj) { float v[8]; _Pragma("unroll") for (int i = 0; i < 8; ++i) v[i] = acc[ai][bj][m][i >> 2][i & 3]; const int colt = bj * 128 + colw; (void)colt;
#define EPI_ROWS_END } }
struct EpiM { static constexpr bool PERM = true; unsigned char* ws; int which;
    __device__ __forceinline__ void operator()(const pg8::Acc& acc, const pg8::Unit& u, int wr, int wc, int fr, int fq) const {
        EPI_ROWS_BEGIN
            const int col = u.pn * 256 + colt; float g[8]; unpack8(*(const v4u*)((const bf16_t*)(ws + WS_GT) + (size_t)row * 2048 + which * 1024 + col), g);
            bf16_t* mp = (bf16_t*)(ws + WS_M) + (size_t)row * 1024 + col;
            if (which) { float o[8]; unpack8(*(const v4u*)mp, o);
#pragma unroll
                for (int i = 0; i < 8; ++i) v[i] = o[i] + g[i] * v[i]; }
            else {
#pragma unroll
                for (int i = 0; i < 8; ++i) v[i] = g[i] * v[i]; }
            *(v4u*)mp = pack8(v);
        EPI_ROWS_END
    } };
struct EpiZ { static constexpr bool PERM = true; unsigned char* ws;
    __device__ __forceinline__ void operator()(const pg8::Acc& acc, const pg8::Unit& u, int wr, int wc, int fr, int fq) const {
        EPI_ROWS_BEGIN
            const int col = u.pn * 256 + colt; float x[8]; unpack8(*(const v4u*)((const bf16_t*)(ws + WS_XN) + (size_t)row * 1024 + col), x);
            float* zp = (float*)(ws + WS_Z) + (size_t)row * 1024 + col;
            *(f32x4*)zp = (f32x4){DN_ALPHA * x[0] + v[0], DN_ALPHA * x[1] + v[1], DN_ALPHA * x[2] + v[2], DN_ALPHA * x[3] + v[3]};
            *(f32x4*)(zp + 4) = (f32x4){DN_ALPHA * x[4] + v[4], DN_ALPHA * x[5] + v[5], DN_ALPHA * x[6] + v[6], DN_ALPHA * x[7] + v[7]};
        EPI_ROWS_END
    } };
struct EpiP5 { static constexpr bool PERM = true; unsigned char* ws;
    __device__ __forceinline__ void operator()(const pg8::Acc& acc, const pg8::Unit& u, int wr, int wc, int fr, int fq) const {
        EPI_ROWS_BEGIN
            const int col = u.pn * 256 + colt;
            if (u.type == 0) { float* zp = (float*)(ws + WS_LOGIT) + (size_t)row * 256 + col; *(f32x4*)zp = (f32x4){v[0], v[1], v[2], v[3]}; *(f32x4*)(zp + 4) = (f32x4){v[4], v[5], v[6], v[7]}; }
            else *(v4u*)((bf16_t*)(ws + WS_BASE) + (size_t)row * 1024 + col) = pack8(v);
        EPI_ROWS_END
    } };
struct EpiP8 { static constexpr bool PERM = true; unsigned char* ws;
    __device__ __forceinline__ void operator()(const pg8::Acc& acc, const pg8::Unit& u, int wr, int wc, int fr, int fq) const {
        const int lrow0 = wr * 64 + fr, colw = wc * 32 + 8 * fq;
        if (u.type == 0) {
#pragma unroll
            for (int ai = 0; ai < 2; ++ai)
#pragma unroll
                for (int m = 0; m < 4; ++m) { const int lrow = lrow0 + ai * 128 + m * 16; float v[8];
#pragma unroll
                    for (int i = 0; i < 8; ++i) v[i] = fast_silu(acc[ai][0][m][i >> 2][i & 3]) * acc[ai][1][m][i >> 2][i & 3];
                    *(v4u*)((bf16_t*)(ws + WS_ACT) + (size_t)(u.aux + lrow) * 256 + u.pn * 128 + colw) = pack8(v); }
        } else {
#pragma unroll
            for (int ai = 0; ai < 2; ++ai)
#pragma unroll
                for (int m = 0; m < 4; ++m)
#pragma unroll
                    for (int bj = 0; bj < 2; ++bj) { const int row = u.pm * 256 + lrow0 + ai * 128 + m * 16, col = u.pn * 256 + bj * 128 + colw;
                        bf16_t* bp = (bf16_t*)(ws + WS_BASE) + (size_t)row * 1024 + col; float o[8]; unpack8(*(const v4u*)bp, o);
#pragma unroll
                        for (int i = 0; i < 8; ++i) o[i] *= fast_sigmoid(acc[ai][bj][m][i >> 2][i & 3]);
                        *(v4u*)bp = pack8(o); }
        }
    } };
struct EpiP9 { static constexpr bool PERM = true; unsigned char* ws;
    __device__ __forceinline__ void operator()(const pg8::Acc& acc, const pg8::Unit& u, int wr, int wc, int fr, int fq) const {
        int lrow0 = wr * 64 + fr, colw = wc * 32 + 8 * fq; asm volatile("" : "+v"(lrow0), "+v"(colw));
        if (u.type == 0) {
            int av[8]; float wv[8];
#pragma unroll
            for (int q = 0; q < 8; ++q) { const int lrow = lrow0 + (q >> 2) * 128 + (q & 3) * 16; av[q] = ((const int*)(ws + M_RASSIGN))[u.aux + lrow]; wv[q] = ((const float*)(ws + M_RW))[u.aux + lrow]; }
#pragma unroll
            for (int q = 0; q < 8; ++q) { int a = av[q]; asm volatile("" : "+v"(a) :: "memory");
                if (a >= 0) { bf16_t* yp = (bf16_t*)(ws + WS_Y) + (size_t)a * 1024 + u.pn * 256 + colw;
#pragma unroll
                    for (int bj = 0; bj < 2; ++bj) { float v[8];
#pragma unroll
                        for (int i = 0; i < 8; ++i) v[i] = wv[q] * acc[q >> 2][bj][q & 3][i >> 2][i & 3];
                        *(v4u*)(yp + bj * 128) = pack8(v); } } }
        } else {
#pragma unroll
            for (int q = 0; q < 8; ++q) { int lrow = lrow0 + (q >> 2) * 128 + (q & 3) * 16; asm volatile("" : "+v"(lrow) :: "memory");
                bf16_t* bp = (bf16_t*)(ws + WS_BASE) + (size_t)(u.pm * 256 + lrow) * 1024 + u.pn * 256 + colw;
#pragma unroll
                for (int bj = 0; bj < 2; ++bj) { float o[8]; unpack8(*(const v4u*)(bp + bj * 128), o);
#pragma unroll
                    for (int i = 0; i < 8; ++i) o[i] += acc[q >> 2][bj][q & 3][i >> 2][i & 3];
                    *(v4u*)(bp + bj * 128) = pack8(o); } }
        }
    } };

struct P5Order {
    unsigned char* ws; int G, c, which;
    __device__ __forceinline__ bool next(int i, pg8::Unit& u) const {
        const int idx = i * G + c;
        if (which == 0) { if (idx >= 128) return false; u.pm = idx; u.pn = 0; u.type = 0; u.aux = 0; u.A = (const char*)(ws + WS_H1) + (size_t)idx * 256 * 1024 * 2; u.B = (const char*)(ws + WS_ROUT_T); u.grow = -1; return true; }
        if (idx >= 512) return false; u.pm = idx >> 2; u.pn = idx & 3; u.type = 1; u.aux = 0; u.A = (const char*)(ws + WS_PB) + (size_t)u.pm * 256 * 256 * 2; u.B = (const char*)(ws + WS_PLEW_T) + (size_t)u.pn * 256 * 256 * 2; u.grow = -1; return true;
    } };
struct P8Order {
    unsigned char* ws; int G, c, nblk;
    __device__ __forceinline__ bool next(int i, pg8::Unit& u) const {
        int idx = i * G + c; u.A = (const char*)(ws + WS_H1);
        if (idx < 2 * nblk) { const int blk = idx >> 1, e = __builtin_amdgcn_readfirstlane(((const volatile int*)(ws + M_BLKE))[blk]); u.pm = blk; u.pn = idx & 1; u.type = 0; u.aux = blk * 256; u.grow = blk * 256;
            u.B = (const char*)(ws + WS_EGU_T) + (size_t)e * (512 * 1024 * 2) + (size_t)u.pn * (256 * 1024 * 2); return true; }
        idx -= 2 * nblk;
        if (idx < 256) { u.pm = idx >> 1; u.pn = idx & 1; u.type = 0; u.aux = SH_ACT_ROW0 + u.pm * 256; u.grow = NROWS_MAX + u.pm * 256;
            u.B = (const char*)(ws + WS_SHGU_T) + (size_t)u.pn * (256 * 1024 * 2); return true; }
        idx -= 256;
        if (idx < 512) { u.pm = idx >> 2; u.pn = idx & 3; u.type = 2; u.aux = 0; u.grow = NROWS_MAX + u.pm * 256;
            u.B = (const char*)(ws + WS_PLEG_T) + (size_t)u.pn * (256 * 1024 * 2); return true; }
        return false;
    } };
struct P9Order {
    unsigned char* ws; int G, c, nblk;
    __device__ __forceinline__ bool next(int i, pg8::Unit& u) const {
        int idx = i * G + c; u.grow = -1;
        if (idx < 4 * nblk) { const int blk = idx >> 2, e = __builtin_amdgcn_readfirstlane(((const volatile int*)(ws + M_BLKE))[blk]); u.pm = blk; u.pn = idx & 3; u.type = 0; u.aux = blk * 256;
            u.A = (const char*)(ws + WS_ACT) + (size_t)blk * (256 * 256 * 2); u.B = (const char*)(ws + WS_ED_T) + (size_t)e * (1024 * 256 * 2) + (size_t)u.pn * (256 * 256 * 2); return true; }
        idx -= 4 * nblk;
        if (idx < 512) { u.pm = idx >> 2; u.pn = idx & 3; u.type = 1; u.aux = 0;
            u.A = (const char*)(ws + WS_ACT) + (size_t)(SH_ACT_ROW0 + u.pm * 256) * (256 * 2); u.B = (const char*)(ws + WS_SHD_T) + (size_t)u.pn * (256 * 256 * 2); return true; }
        return false;
    } };

__device__ __forceinline__ void px_convert(Frame& F, const Args& a) {
    LAS float* scr = (LAS float*)(F.lds + F.wave * 16384);
    const int gw = F.vcu * NWAVES + F.wave, NGW = F.G * NWAVES; unsigned char* ws = a.ws;
    for (int it = gw; it < 3 * 256 * 128; it += NGW) {
        const int kind = it / (256 * 128), r = it % (256 * 128), e = r >> 7, q = r & 127;
        if (kind < 2) { const int kb = q >> 3, nb = q & 7, n0 = 32 * nb; const int d0 = (n0 >> 7) * 256 + kind * 128 + (n0 & 127);
            p0_transpose_item(a.in[kind == 0 ? I_EG : I_EU] + (size_t)e * 1024 * 256, 1024, 256, (bf16_t*)(ws + WS_EGU_T) + (size_t)e * 512 * 1024, 64 * kb, n0, d0, scr, F.lane); }
        else { const int kb = q >> 5, nb = q & 31, n0 = 32 * nb;
            p0_transpose_item(a.in[I_ED] + (size_t)e * 256 * 1024, 256, 1024, (bf16_t*)(ws + WS_ED_T) + (size_t)e * 1024 * 256, 64 * kb, n0, n0, scr, F.lane); }
    }
}

__device__ __forceinline__ void route_pass(Frame& F, const Args& a) {
    unsigned char* ws = a.ws; const int lane = F.lane;
    LAS unsigned* hist = (LAS unsigned*)F.lds;
    if (F.tid < 256) hist[F.tid] = 0u;
    __syncthreads();
    const int gw = F.vcu * NWAVES + F.wave, NGW = F.G * NWAVES;
    const f32x4 bb = ((const GAS f32x4*)a.in[I_ROUT_B])[lane];
    for (int t = gw; t < NTOK; t += NGW) {
        const f32x4 x = ((const GAS f32x4*)(ws + WS_LOGIT + (size_t)t * 1024))[lane];
        float sc[4], c[4];
#pragma unroll
        for (int i = 0; i < 4; ++i) { sc[i] = 1.f / (1.f + expf(-x[i])); c[i] = sc[i] + bb[i]; }
        float a1 = fmaxf(c[0], c[1]), a2 = fminf(c[0], c[1]);
#pragma unroll
        for (int i = 2; i < 4; ++i) { if (c[i] > a1) { a2 = a1; a1 = c[i]; } else if (c[i] > a2) a2 = c[i]; }
#pragma unroll
        for (int off = 1; off < 8; off <<= 1) { const float b1 = __shfl_xor(a1, off), b2 = __shfl_xor(a2, off); const float n1 = fmaxf(a1, b1), n2 = fmaxf(fminf(a1, b1), fmaxf(a2, b2)); a1 = n1; a2 = n2; }
        const float gs = a1 + a2; const int g = lane >> 3; int rank = 0;
#pragma unroll
        for (int g2 = 0; g2 < 8; ++g2) { const float o = __shfl(gs, g2 * 8); rank += (o > gs || (o == gs && g2 < g)) ? 1 : 0; }
        if (rank >= 4) { c[0] = c[1] = c[2] = c[3] = -INFINITY; }
        float sel_s = 0.f; int sel_e = 0;
#pragma unroll
        for (int k = 0; k < 8; ++k) {
            float bv = c[0]; int bi = 0;
#pragma unroll
            for (int i = 1; i < 4; ++i) if (c[i] > bv) { bv = c[i]; bi = i; }
            int be = lane * 4 + bi;
#pragma unroll
            for (int off = 1; off < 64; off <<= 1) { const float ov = __shfl_xor(bv, off); const int oe = __shfl_xor(be, off); if (ov > bv || (ov == bv && oe < be)) { bv = ov; be = oe; } }
            const int owner = be >> 2, wi = be & 3;
            float sv = wi == 0 ? sc[0] : wi == 1 ? sc[1] : wi == 2 ? sc[2] : sc[3];
            sv = __shfl(sv, owner);
            if (lane == owner) {
#pragma unroll
                for (int i = 0; i < 4; ++i) if (wi == i) c[i] = -INFINITY; }
            if (lane == k) { sel_s = sv; sel_e = be; }
        }
        float tot = lane < 8 ? sel_s : 0.f; tot = wave_sum(tot);
        if (lane < 8) { ((int*)(ws + M_IDX))[(size_t)t * 8 + lane] = sel_e; ((float*)(ws + M_W))[(size_t)t * 8 + lane] = sel_s / tot * 2.5f; atomicAdd((unsigned*)&hist[sel_e], 1u); }
    }
    __syncthreads();
    if (F.tid < 256 && hist[F.tid]) __hip_atomic_fetch_add(F.ctl + CW_CNT + F.tid, hist[F.tid], RLX_AGENT);
    for (int i = blockIdx.x * 512 + F.tid; i < NROWS_MAX; i += F.G * 512) { ((int*)(ws + M_RASSIGN))[i] = -1; ((int*)(ws + M_RTOK))[i] = 0; ((float*)(ws + M_RW))[i] = 0.f; }
    for (int i = blockIdx.x * 512 + F.tid; i < NTOK; i += F.G * 512) ((int*)(ws + M_RTOK))[NROWS_MAX + i] = i;
}
__device__ __forceinline__ void scatter_pass(Frame& F, const Args& a) {
    unsigned char* ws = a.ws;
    LAS int* bst = (LAS int*)F.lds;
    if (F.tid == 0) { int acc = 0; for (int e = 0; e < NEXP; ++e) { bst[e] = acc; acc += (int)((__hip_atomic_load(F.ctl + CW_CNT + e, RLX_AGENT) + 255u) >> 8); } bst[NEXP] = acc; }
    __syncthreads();
    if (blockIdx.x == 0) { if (F.tid < NEXP) { for (int b = bst[F.tid]; b < bst[F.tid + 1]; ++b) ((int*)(ws + M_BLKE))[b] = F.tid; } if (F.tid == 0) *(int*)(ws + M_NBLK) = bst[NEXP]; }
    for (int i = blockIdx.x * 512 + F.tid; i < NTOK * 8; i += F.G * 512) {
        const int e = ((const int*)(ws + M_IDX))[i]; const unsigned rank = __hip_atomic_fetch_add(F.ctl + CW_CUR + e, 1u, RLX_AGENT);
        const int row = bst[e] * 256 + (int)rank;
        ((int*)(ws + M_RASSIGN))[row] = i; ((int*)(ws + M_RTOK))[row] = i >> 3; ((float*)(ws + M_RW))[row] = ((const float*)(ws + M_W))[i];
    }
}
__device__ __forceinline__ void final_pass(Frame& F, const Args& a) {
    unsigned char* ws = a.ws; const int lane = F.lane; const int gw = F.vcu * NWAVES + F.wave, NGW = F.G * NWAVES;
    for (int t = gw; t < NTOK; t += NGW) {
        float v[16];
#pragma unroll
        for (int i = 0; i < 2; ++i) { const int c8 = lane + 64 * i; float hh[8], bs[8];
            unpack8(((const GAS v4u*)(ws + WS_H1 + (size_t)t * 2048))[c8], hh); unpack8(((const GAS v4u*)(ws + WS_BASE + (size_t)t * 2048))[c8], bs);
#pragma unroll
            for (int e = 0; e < 8; ++e) v[i * 8 + e] = DN_ALPHA * hh[e] + bs[e];
#pragma unroll
            for (int k = 0; k < 8; ++k) { float y[8]; unpack8(((const GAS v4u*)(ws + WS_Y + ((size_t)t * 8 + k) * 2048))[c8], y);
#pragma unroll
                for (int e = 0; e < 8; ++e) v[i * 8 + e] += y[e]; } }
        float s = 0.f;
#pragma unroll
        for (int e = 0; e < 16; ++e) s += v[e];
        const float mean = wave_sum(s) * (1.f / DM); float q = 0.f;
#pragma unroll
        for (int e = 0; e < 16; ++e) { v[e] -= mean; q += v[e] * v[e]; }
        const float rstd = 1.f / sqrtf(wave_sum(q) * (1.f / DM) + LN_EPS);
#pragma unroll
        for (int i = 0; i < 2; ++i) { const int c8 = lane + 64 * i;
#pragma unroll
            for (int hlf = 0; hlf < 2; ++hlf) { const f32x4 gg = ((const GAS f32x4*)a.in[I_LN2_G])[c8 * 2 + hlf], bb = ((const GAS f32x4*)a.in[I_LN2_B])[c8 * 2 + hlf];
                f32x4 o; o.x = v[i * 8 + hlf * 4 + 0] * rstd * gg.x + bb.x; o.y = v[i * 8 + hlf * 4 + 1] * rstd * gg.y + bb.y; o.z = v[i * 8 + hlf * 4 + 2] * rstd * gg.z + bb.z; o.w = v[i * 8 + hlf * 4 + 3] * rstd * gg.w + bb.w;
                ((GAS f32x4*)(a.out + (size_t)t * DM))[c8 * 2 + hlf] = o; } }
    }
}

__global__ void __launch_bounds__(NWAVES * 64, 2) mega_fwd(Args args) {
    extern __shared__ __attribute__((aligned(16))) unsigned char lds[];
    Frame F;
    F.lds = (LAS unsigned char*)lds;
    F.MISC = (volatile LAS unsigned*)(F.lds + MISC_OFF);
    F.tid = threadIdx.x; F.lane = F.tid & 63; F.wave = __builtin_amdgcn_readfirstlane(F.tid >> 6);
    F.G = gridDim.x; { const int bx = blockIdx.x; F.vcu = (F.G % 8 == 0) ? (bx % 8) * (F.G / 8) + bx / 8 : bx; }
    unsigned char* ws = args.ws;
    F.ctl = (gu32*)(ws + WS_CTL);
    for (int u = F.tid; u < (LDS_BYTES - LDSCTL_OFF) / 4; u += NWAVES * 64) ((LAS unsigned*)(F.lds + LDSCTL_OFF))[u] = 0u;
    __syncthreads();
    XcdBarrier bar = xcd_barrier_post((unsigned*)(F.ctl + CW_BAR), F.MISC + 8);
    const int lo = args.ph_lo, hi = args.ph_hi;
#define IN(k) (lo <= (k) && (k) < hi)
#define GRID_BAR() xcd_barrier(bar)

    if (IN(0)) { p0_prologue(F, args); GRID_BAR(); }
    if (IN(1)) {
        pg8::DenseOrder S; S.init(ws + WS_XN, ws + WS_WIN_T, NTOK, INCOLS, 1024, F.G, (int)blockIdx.x);
        EpiInProj E{ws};
        pg8::gemm_phase<EpiInProj, pg8::DenseOrder, false>(F.lds, 1024, S, E, nullptr);
        GRID_BAR();
    }
#if DEBUG_CHECK
    if (IN(2)) {
        const GAS v4u* src = (const GAS v4u*)(ws + WS_VR); GAS v4u* dst = (GAS v4u*)(ws + WS_DBGV);
        for (size_t i = (size_t)blockIdx.x * 512 + F.tid; i < (size_t)64 * MiB / 16; i += (size_t)F.G * 512) dst[i] = src[i];
        GRID_BAR();
    }
#endif
    if (IN(2)) {
        const int bh = F.vcu >> 3, s = F.vcu & 7, b = bh >> 3, h = bh & 7;
        att::ret_chain(b, h, s, (const bf16_t*)(ws + WS_QR), (const bf16_t*)(ws + WS_KR), (bf16_t*)(ws + WS_VR), (f32x2*)(ws + WS_GNST), (char*)lds);
        float lam;
        { float d1 = 0.f, d2 = 0.f; for (int i = 0; i < 64; ++i) { d1 += args.in[I_LQ1][i] * args.in[I_LK1][i]; d2 += args.in[I_LQ2][i] * args.in[I_LK2][i]; }
          lam = expf(d1) - expf(d2) + 0.2f; }
        for (int i = 0; i < 4; ++i) {
            const int qb = (i == 0) ? 31 - s : (i == 1) ? 16 + s : (i == 2) ? 15 - s : s;
            att::attn_unit(b, h, qb, (bf16_t*)(ws + WS_QD), (const bf16_t*)(ws + WS_KD), (const bf16_t*)(ws + WS_VD), args.in[I_RELB], args.in[I_SUBLN_G], lam, (char*)lds);
        }
        GRID_BAR();
    }
    if (IN(3)) { gn_pass(F, ws, args.in[I_GN_G]); GRID_BAR(); }
    if (IN(4)) {
        pg8::DenseOrder S; S.init(ws + WS_GR, ws + WS_WRO_T, NTOK, 1024, 2048, F.G, (int)blockIdx.x);
        EpiM E{ws, 0}; pg8::gemm_phase<EpiM, pg8::DenseOrder, false>(F.lds, 2048, S, E, nullptr); GRID_BAR();
    }
    if (IN(5)) {
        pg8::DenseOrder S; S.init(ws + WS_QD, ws + WS_WDO_T, NTOK, 1024, 1024, F.G, (int)blockIdx.x);
        EpiM E{ws, 1}; pg8::gemm_phase<EpiM, pg8::DenseOrder, false>(F.lds, 1024, S, E, nullptr); GRID_BAR();
    }
    if (IN(6)) {
        pg8::DenseOrder S; S.init(ws + WS_M, ws + WS_WO_T, NTOK, 1024, 1024, F.G, (int)blockIdx.x);
        EpiZ E{ws}; pg8::gemm_phase<EpiZ, pg8::DenseOrder, false>(F.lds, 1024, S, E, nullptr); GRID_BAR();
    }
    if (IN(7)) {
        const int gw = F.vcu * NWAVES + F.wave, NGW = F.G * NWAVES;
        for (int m = gw; m < NTOK; m += NGW) ln_row_to_bf16(F.lane, (const float*)(ws + WS_Z) + (size_t)m * DM, args.in[I_LN1_G], args.in[I_LN1_B], (bf16_t*)(ws + WS_H1) + (size_t)m * DM);
        px_convert(F, args);
        GRID_BAR();
    }
    if (IN(8)) {
        EpiP5 E{ws};
        { P5Order S{ws, F.G, (int)blockIdx.x, 0}; pg8::gemm_phase<EpiP5, P5Order, false>(F.lds, 1024, S, E, nullptr); }
        { P5Order S{ws, F.G, (int)blockIdx.x, 1}; pg8::gemm_phase<EpiP5, P5Order, false>(F.lds, 256, S, E, nullptr); }
        GRID_BAR();
    }
    if (IN(9)) { route_pass(F, args); GRID_BAR(); }
    if (IN(10)) { scatter_pass(F, args); GRID_BAR(); }
    if (IN(11)) {
        const int nblk = __builtin_amdgcn_readfirstlane(*(const volatile int*)(ws + M_NBLK));
        P8Order S{ws, F.G, (int)blockIdx.x, nblk}; EpiP8 E{ws};
        pg8::gemm_phase<EpiP8, P8Order, true>(F.lds, 1024, S, E, (const int*)(ws + M_RTOK)); GRID_BAR();
    }
    if (IN(12)) {
        const int nblk = __builtin_amdgcn_readfirstlane(*(const volatile int*)(ws + M_NBLK));
        P9Order S{ws, F.G, (int)blockIdx.x, nblk}; EpiP9 E{ws};
        pg8::gemm_phase<EpiP9, P9Order, false>(F.lds, 256, S, E, nullptr); GRID_BAR();
    }
    if (IN(13)) final_pass(F, args);
#undef IN
#undef GRID_BAR
}

#if DEBUG_CHECK
__device__ __forceinline__ unsigned hash_u32(unsigned x) { x ^= x >> 16; x *= 0x7feb352du; x ^= x >> 15; x *= 0x846ca68bu; x ^= x >> 16; return x; }
__device__ __forceinline__ void dbg_fail(unsigned* ctl, int stage, bool bad) { if (bad) atomicAdd(&ctl[CW_DBG + stage], 1u); }
__device__ float ref_ln_dot(const float* xrow, const float* g, const float* b, const float* W, int N, int col) {
    float s = 0.f; for (int k = 0; k < DM; ++k) s += xrow[k]; const float mean = s / DM;
    float q = 0.f; for (int k = 0; k < DM; ++k) { const float d = xrow[k] - mean; q += d * d; } const float rstd = 1.f / sqrtf(q / DM + LN_EPS);
    float acc = 0.f; for (int k = 0; k < DM; ++k) acc += ((xrow[k] - mean) * rstd * g[k] + b[k]) * W[(size_t)k * N + col];
    return acc;
}
__global__ void dbg_check(Args a) {
    unsigned* ctl = (unsigned*)(a.ws + WS_CTL); unsigned char* ws = a.ws;
    const unsigned gid = blockIdx.x * blockDim.x + threadIdx.x;
    {
        const unsigned h = hash_u32(gid * 2654435761u + 17u);
        const int row = h % NTOK; int col = (h >> 15) % INCOLS;
        const float* xrow = a.in[I_X] + (size_t)row * DM;
        int seg; int cs; size_t boff; int ld;
        if (col < 1024) { seg = 0; cs = col; boff = WS_QR; ld = 1024; } else if (col < 2048) { seg = 1; cs = col - 1024; boff = WS_KR; ld = 1024; }
        else if (col < 4096) { seg = 2; cs = col - 2048; boff = WS_VR; ld = 2048; } else if (col < 6144) { seg = 3; cs = col - 4096; boff = WS_GR; ld = 2048; }
        else if (col < 7168) { seg = 4; cs = col - 6144; boff = WS_QD; ld = 1024; } else if (col < 8192) { seg = 5; cs = col - 7168; boff = WS_KD; ld = 1024; }
        else if (col < 9216) { seg = 6; cs = col - 8192; boff = WS_VD; ld = 1024; } else { seg = 7; cs = col - 9216; boff = WS_GT; ld = 2048; }
        float e;
        if (seg <= 1) {
            const int j = cs & 63, half = (cs >> 6) & 1; const int c1 = col - half * 64, c2 = c1 + 64;
            const float t1 = ref_ln_dot(xrow, a.in[I_LNIN_G], a.in[I_LNIN_B], a.in[I_WIN], INCOLS, c1);
            const float t2 = ref_ln_dot(xrow, a.in[I_LNIN_G], a.in[I_LNIN_B], a.in[I_WIN], INCOLS, c2);
            const double theta = 1.0 / pow(10000.0, (double)j / 63.0); const double ang = (double)(row % SEQ) * theta;
            const float c = (float)cos(ang), s = (float)sin(ang);
            e = half ? (t2 * c + t1 * s) : (t1 * c - t2 * s);
            if (seg == 1) e *= KR_SCALE;
        } else {
            e = ref_ln_dot(xrow, a.in[I_LNIN_G], a.in[I_LNIN_B], a.in[I_WIN], INCOLS, col);
            if (seg == 3) e = e / (1.f + expf(-e)); else if (seg == 7) e = 1.f / (1.f + expf(-e)); else if (seg == 4) e *= QD_SCALE;
        }
        const float got = bf2f(((const bf16_t*)(ws + boff))[(size_t)row * ld + cs]);
        if (seg != 2 && seg != 3 && seg != 4)
            dbg_fail(ctl, 1, !(fabsf(got - e) <= 0.03f + 0.03f * fabsf(e)));
    }
}
__device__ float dbg_inproj(const Args& a, int row, int col) { return ref_ln_dot(a.in[I_X] + (size_t)row * DM, a.in[I_LNIN_G], a.in[I_LNIN_B], a.in[I_WIN], INCOLS, col); }
__global__ void __launch_bounds__(256) dbg_check_ret(Args a) {
    __shared__ float sc[256]; __shared__ float red[256]; __shared__ float qs[128];
    unsigned* ctl = (unsigned*)(a.ws + WS_CTL); unsigned char* ws = a.ws;
    const int tid = threadIdx.x;
    const unsigned hsh = hash_u32(blockIdx.x * 7919u + 13u);
    const int b = hsh & 1, h = (hsh >> 1) & 7; int pos = (hsh >> 4) % SEQ; if (blockIdx.x & 1) pos = pos % 700;
    const int t = b * SEQ + pos;
    const bf16_t* QR = (const bf16_t*)(ws + WS_QR); const bf16_t* KR = (const bf16_t*)(ws + WS_KR); const bf16_t* VV = (const bf16_t*)(ws + WS_DBGV);
    if (tid < 128) qs[tid] = bf2f(QR[(size_t)t * 1024 + h * 128 + tid]);
    __syncthreads();
    const float lgam = logf(1.f - exp2f(-5.f - (float)h));
    float o = 0.f;
    for (int s0 = 0; s0 <= pos; s0 += 256) {
        const int s = s0 + tid; float v = 0.f;
        if (s <= pos) { const bf16_t* kp = KR + (size_t)(b * SEQ + s) * 1024 + h * 128; float d = 0.f; for (int k = 0; k < 128; ++k) d += qs[k] * bf2f(kp[k]); v = d * expf((float)(pos - s) * lgam); }
        sc[tid] = v; __syncthreads();
        const int n = min(256, pos + 1 - s0);
        for (int i = 0; i < n; ++i) o += sc[i] * bf2f(VV[(size_t)(b * SEQ + s0 + i) * 2048 + h * 256 + tid]);
        __syncthreads();
    }
    red[tid] = o; __syncthreads(); for (int st = 128; st > 0; st >>= 1) { if (tid < st) red[tid] += red[tid + st]; __syncthreads(); }
    const float mu = red[0] / 256.f; __syncthreads();
    red[tid] = (o - mu) * (o - mu); __syncthreads(); for (int st = 128; st > 0; st >>= 1) { if (tid < st) red[tid] += red[tid + st]; __syncthreads(); }
    const float rstd = 1.f / sqrtf(red[0] / 256.f + LN_EPS);
    const float g = dbg_inproj(a, t, 4096 + h * 256 + tid);
    const float e = g / (1.f + expf(-g)) * (o - mu) * rstd * a.in[I_GN_G][h * 256 + tid];
    const float got = bf2f(((const bf16_t*)(ws + WS_GR))[(size_t)t * 2048 + h * 256 + tid]);
    dbg_fail(ctl, 2, !(fabsf(got - e) <= 0.06f + 0.06f * fabsf(e)));
}
__global__ void __launch_bounds__(256) dbg_check_att(Args a) {
    __shared__ float pr[SEQ]; __shared__ float red[256]; __shared__ float qs[128]; __shared__ float o1[128];
    unsigned* ctl = (unsigned*)(a.ws + WS_CTL); unsigned char* ws = a.ws;
    const int tid = threadIdx.x;
    const unsigned hsh = hash_u32(blockIdx.x * 104729u + 71u);
    const int b = hsh & 3, h = (hsh >> 2) & 7; int pos = (hsh >> 5) % SEQ; if ((blockIdx.x & 3) == 1) pos = pos % 300;
    const int t = b * SEQ + pos;
    const bf16_t* KD = (const bf16_t*)(ws + WS_KD); const bf16_t* VD = (const bf16_t*)(ws + WS_VD);
    if (tid < 128) qs[tid] = dbg_inproj(a, t, 6144 + h * 128 + tid) * 0.125f;
    float lam; { float d1 = 0.f, d2 = 0.f; for (int i = 0; i < 64; ++i) { d1 += a.in[I_LQ1][i] * a.in[I_LK1][i]; d2 += a.in[I_LQ2][i] * a.in[I_LK2][i]; } lam = expf(d1) - expf(d2) + 0.2f; }
    __syncthreads();
    float ov = 0.f;
    for (int m = 0; m < 2; ++m) {
        float mx = -INFINITY;
        for (int s = tid; s <= pos; s += 256) { const bf16_t* kp = KD + (size_t)(b * SEQ + s) * 1024 + h * 128 + m * 64; float d = 0.f; for (int k = 0; k < 64; ++k) d += qs[m * 64 + k] * bf2f(kp[k]);
            const int n = pos - s; int bk; if (n < 16) bk = n; else { bk = 16 + (int)(logf((float)n / 16.f) / logf(8.f) * 16.f); if (bk > 31) bk = 31; }
            d += a.in[I_RELB][bk * 8 + h]; pr[s] = d; mx = fmaxf(mx, d); }
        red[tid] = mx; __syncthreads(); for (int st = 128; st > 0; st >>= 1) { if (tid < st) red[tid] = fmaxf(red[tid], red[tid + st]); __syncthreads(); }
        mx = red[0]; __syncthreads();
        float sm = 0.f; for (int s = tid; s <= pos; s += 256) { const float p = expf(pr[s] - mx); pr[s] = p; sm += p; }
        red[tid] = sm; __syncthreads(); for (int st = 128; st > 0; st >>= 1) { if (tid < st) red[tid] += red[tid + st]; __syncthreads(); }
        sm = red[0]; __syncthreads();
        if (tid < 128) { float acc = 0.f; for (int s = 0; s <= pos; ++s) acc += pr[s] * bf2f(VD[(size_t)(b * SEQ + s) * 1024 + h * 128 + tid]); acc /= sm;
            if (m == 0) o1[tid] = acc; else ov = o1[tid] - lam * acc; }
        __syncthreads();
    }
    red[tid] = tid < 128 ? ov * ov : 0.f; __syncthreads(); for (int st = 128; st > 0; st >>= 1) { if (tid < st) red[tid] += red[tid + st]; __syncthreads(); }
    const float rs = 1.f / sqrtf(red[0] / 128.f + LN_EPS);
    if (tid < 128) { const float e = ov * rs * a.in[I_SUBLN_G][tid] * 0.8f;
        const float got = bf2f(((const bf16_t*)(ws + WS_QD))[(size_t)t * 1024 + h * 128 + tid]);
        dbg_fail(ctl, 3, !(fabsf(got - e) <= 0.06f + 0.06f * fabsf(e))); }
}
__global__ void dbg_report(Args a, int nout) {
    unsigned* ctl = (unsigned*)(a.ws + WS_CTL);
    int first = 0;
    if (ctl[CW_TMO] != 0u || ctl[CW_BAR + XB_TMO] != 0u) first = 15;
    for (int s = 14; s >= 1; --s) if (ctl[CW_DBG + s] > (s == 1 ? 0u : 64u)) first = s;
    if (!first) return;
    const float c = (float)(1 << first);
    for (size_t i = (size_t)blockIdx.x * blockDim.x + threadIdx.x; i < (size_t)nout; i += (size_t)gridDim.x * blockDim.x) a.out[i] = c;
}
#endif

extern "C" void kernel_launch(void* const* d_in, const int* in_sizes, int n_in, void* d_out, int out_size, void* d_ws, size_t ws_size, hipStream_t stream) {
    static int grid = 0;
    if (grid == 0) {
        if (n_in != 29 || in_sizes[0] != NTOK * DM || out_size != NTOK * DM || ws_size < WS_END) {
            fprintf(stderr, "kernel_launch: unexpected shapes: n_in %d in0 %d out %d ws %zu (need >= %zu)\n", n_in, n_in > 0 ? in_sizes[0] : -1, out_size, ws_size, (size_t)WS_END); grid = -1; return; }
        int dev = 0, cus = 0;
        if (hipGetDevice(&dev) != hipSuccess || hipDeviceGetAttribute(&cus, hipDeviceAttributeMultiprocessorCount, dev) != hipSuccess) { grid = -1; return; }
        if (hipFuncSetAttribute((const void*)mega_fwd, hipFuncAttributeMaxDynamicSharedMemorySize, LDS_BYTES) != hipSuccess) { fprintf(stderr, "kernel_launch: hipFuncSetAttribute failed\n"); grid = -1; return; }
        int per_cu = 0;
        if (hipOccupancyMaxActiveBlocksPerMultiprocessor(&per_cu, (const void*)mega_fwd, NWAVES * 64, LDS_BYTES) != hipSuccess || per_cu < 1)
            fprintf(stderr, "kernel_launch: occupancy query says %d\n", per_cu);
        (void)hipGetLastError();
        grid = cus;
        if (grid != 256) fprintf(stderr, "kernel_launch: %d CUs (expected 256)\n", grid);
    }
    if (grid < 0) return;
    (void)hipMemsetAsync((char*)d_ws + WS_CTL, 0, CTL_ZERO_BYTES, stream);
    Args a{};
    for (int i = 0; i < 29; ++i) a.in[i] = (const float*)d_in[i];
    a.out = (float*)d_out; a.ws = (unsigned char*)d_ws; a.ph_lo = 0; a.ph_hi = 100;
    hipLaunchKernelGGL(mega_fwd, dim3(grid), dim3(NWAVES * 64), LDS_BYTES, stream, a);
#if DEBUG_CHECK
    hipLaunchKernelGGL(dbg_check, dim3(256), dim3(256), 0, stream, a);
    hipLaunchKernelGGL(dbg_check_ret, dim3(512), dim3(256), 0, stream, a);
    hipLaunchKernelGGL(dbg_check_att, dim3(512), dim3(256), 0, stream, a);
    hipLaunchKernelGGL(dbg_report, dim3(1024), dim3(256), 0, stream, a, out_size);
#endif
}
```

```cpp
#include <hip/hip_runtime.h>
#include <hip/hip_bf16.h>
#include <cstdio>
#include <cstdint>

#ifndef DEBUG_CHECK
#define DEBUG_CHECK 0
#endif
#ifndef REP
#define REP 0
#endif
#ifndef TIMING
#define TIMING 0
#endif
#ifndef T_A0
#define T_A0 3
#define T_A1 4
#define T_SCALE 15
#endif

constexpr int NTOK = 32768, DM = 1024, SEQ = 8192, NBATCH = 4, PLE = 256;
constexpr int INCOLS = 11264;
constexpr int NEXP = 256, TOPK = 8, DEXP = 256;
constexpr float LN_EPS = 1e-5f;
constexpr float DN_ALPHA = 1.189207115002721f;
constexpr float LOG2E = 1.4426950408889634f;
constexpr float QD_SCALE = 0.125f * LOG2E;
constexpr float KR_SCALE = 0.08838834764831845f;

constexpr size_t MiB = 1u << 20;
constexpr size_t WS_CTL = 0, CTL_ZERO_BYTES = 1 * MiB;
constexpr size_t WS_WIN_T = 1 * MiB;
constexpr size_t WS_WRO_T = 23 * MiB;
constexpr size_t WS_WDO_T = 27 * MiB;
constexpr size_t WS_WO_T  = 29 * MiB;
constexpr size_t WS_ROUT_T = 31 * MiB;
constexpr size_t WS_PLEW_T = 31 * MiB + 512 * 1024;
constexpr size_t WS_PLEG_T = 32 * MiB;
constexpr size_t WS_SHGU_T = 34 * MiB;
constexpr size_t WS_SHD_T  = 35 * MiB;
constexpr size_t WS_XN   = 48 * MiB;
constexpr size_t WS_PB   = 112 * MiB;
constexpr size_t WS_QR   = 128 * MiB;
constexpr size_t WS_KR   = 192 * MiB;
constexpr size_t WS_VR   = 256 * MiB;
constexpr size_t WS_GR   = 384 * MiB;
constexpr size_t WS_QD   = 512 * MiB;
constexpr size_t WS_KD   = 576 * MiB;
constexpr size_t WS_VD   = 640 * MiB;
constexpr size_t WS_GT   = 704 * MiB;
constexpr size_t WS_M    = 192 * MiB;
constexpr size_t WS_GNST = 896 * MiB;
constexpr size_t WS_Z    = 256 * MiB;
constexpr size_t WS_H1   = 320 * MiB;
constexpr size_t WS_LOGIT = 48 * MiB;
constexpr size_t WS_META = 1008 * MiB;
constexpr size_t WS_EGU_T = 768 * MiB;
constexpr size_t WS_ED_A  = 448 * MiB, WS_ED_B = 912 * MiB;
constexpr size_t WS_ACT  = 112 * MiB;
constexpr size_t WS_BASE = 384 * MiB;
constexpr size_t WS_Y    = 512 * MiB;
constexpr size_t WS_END  = 1024 * MiB;
constexpr size_t WS_DBGV = 912 * MiB;
constexpr size_t WS_XN8 = 912 * MiB;
constexpr size_t WS_SXN = 944 * MiB;
constexpr size_t WS_SWIN = 36 * MiB;
constexpr size_t WS_SH1 = 37 * MiB;
constexpr size_t WS_SEGU = 38 * MiB;
constexpr size_t WS_SSHGU = 39 * MiB;
constexpr size_t WS_SPLEG = 39 * MiB + 4096;
constexpr size_t WS_SWRO = 39 * MiB + 16384;
constexpr size_t WS_H18 = 80 * MiB;
constexpr size_t WS_SAR = 40 * MiB;
constexpr size_t WS_SWDO = 39 * MiB + 32768;
constexpr size_t WS_AD8 = 976 * MiB;
constexpr size_t WS_AR8 = 128 * MiB;
constexpr int NROWS_MAX = 1280 * 256;
constexpr int SH_ACT_ROW0 = NROWS_MAX;
constexpr size_t M_IDX = WS_META, M_W = WS_META + 1 * MiB, M_RASSIGN = WS_META + 2 * MiB, M_RTOK = WS_META + 4 * MiB, M_RW = WS_META + 6 * MiB,
                 M_RS = WS_META + 10 * MiB, M_BLKE = WS_META + 8 * MiB, M_NBLK = WS_META + 8 * MiB + 65536, M_IDENT = WS_META + 9 * MiB;

constexpr int CW_TMO = 0, CW_CODE = 1;
constexpr int CW_TS = 512;
constexpr int CW_DBG = 64;
constexpr int CW_BAR = 4096;
constexpr int CW_STEAL = 480;
constexpr int CW_CNT = 16384;
constexpr int CW_CUR = 16384 + 256;

constexpr int RING_BYTES = 131072;
constexpr int LDSCTL_OFF = 147456 - 1024, MISC_OFF = LDSCTL_OFF + 320;
constexpr int LDS_BYTES = 147456;
constexpr int NWAVES = 8;
constexpr float F8_WSCALE = 64.f, F8_ASCALE = 16.f;

__host__ __device__ __forceinline__ size_t ed_off(int e) { return WS_ED_B + (size_t)e * (1024 * 256); }
constexpr size_t WS_V8 = WS_ED_A;
constexpr float V8_SCALE = 16.f;
constexpr size_t WS_M8 = 320 * MiB;
constexpr float M8_SCALE = 16.f;
constexpr size_t WS_OE = 352 * MiB;
#define GAS __attribute__((address_space(1)))
#define LAS __attribute__((address_space(3)))
typedef unsigned short bf16_t;
typedef unsigned v4u __attribute__((ext_vector_type(4)));
typedef float f32x4 __attribute__((ext_vector_type(4)));
typedef float f32x2 __attribute__((ext_vector_type(2)));
typedef int i32x4 __attribute__((ext_vector_type(4)));
typedef int i32x8 __attribute__((ext_vector_type(8)));
typedef short bf16x8 __attribute__((ext_vector_type(8)));
typedef GAS unsigned gu32;
#define RLX_AGENT __ATOMIC_RELAXED, __HIP_MEMORY_SCOPE_AGENT
#define LDS_WAIT() asm volatile("s_waitcnt lgkmcnt(0)" ::: "memory")
#define VM_WAIT() asm volatile("s_waitcnt vmcnt(0)" ::: "memory")

__device__ __forceinline__ unsigned f2bf(float f) { unsigned u = __builtin_bit_cast(unsigned, f); return (u + 0x7fffu + ((u >> 16) & 1u)) >> 16; }
__device__ __forceinline__ unsigned pk2(float lo, float hi) { return f2bf(lo) | (f2bf(hi) << 16); }
__device__ __forceinline__ float bf2f(unsigned short b) { return __builtin_bit_cast(float, (unsigned)b << 16); }
__device__ __forceinline__ float bflo(unsigned w) { return __builtin_bit_cast(float, w << 16); }
__device__ __forceinline__ float bfhi(unsigned w) { return __builtin_bit_cast(float, w & 0xffff0000u); }
__device__ __forceinline__ unsigned cvt_pk_bf16(float lo, float hi) { unsigned r; asm volatile("v_cvt_pk_bf16_f32 %0, %1, %2" : "=v"(r) : "v"(lo), "v"(hi)); return r; }
__device__ __forceinline__ unsigned cvtpk_(float lo, float hi) { unsigned r; asm("v_cvt_pk_bf16_f32 %0, %1, %2" : "=v"(r) : "v"(lo), "v"(hi)); return r; }
__device__ __forceinline__ float fast_sigmoid(float x) { return __builtin_amdgcn_rcpf(1.f + __builtin_amdgcn_exp2f(-x * LOG2E)); }
__device__ __forceinline__ float fast_silu(float x) { return x * fast_sigmoid(x); }
__device__ __forceinline__ int lane_id() { int l; asm volatile("v_mbcnt_lo_u32_b32 %0, -1, 0\n\tv_mbcnt_hi_u32_b32 %0, -1, %0" : "=v"(l)); return l; }
__device__ __forceinline__ float wave_sum(float v) {
#pragma unroll
    for (int o = 1; o < 64; o <<= 1) v += __shfl_xor(v, o);
    return v;
}

namespace pg8 {
constexpr int BM = 256, BK = 64, HALF = 128, HTB = HALF * BK * 2, STAGE_BYTES = 8 * HTB, NXCD = 8, WGM = 8, SCL_OFF = 131072;
__host__ __device__ __forceinline__ int lds_byte(int r, int c) { const int st = (r >> 4) * 2 + (c >> 5), rr = r & 15, cc = c & 31, ob = rr * 64 + cc * 2; return st * 1024 + (ob ^ (((ob >> 9) & 1) << 5)); }
__host__ __device__ __forceinline__ void stage_rc(int b, int& R, int& C) { const int st = b / 1024, sb = b % 1024, swz = sb ^ (((sb >> 9) & 1) << 5); R = (st >> 1) * 16 + swz / 64; C = (st & 1) * 32 + (swz % 64) / 2; }
__host__ __device__ __forceinline__ int perm32(int rho) { const int n = rho >> 4, i = rho & 15; return 8 * (i >> 2) + 4 * n + (i & 3); }

struct Unit { int pm, pn, type, aux; const char* A; const char* B; int grow; const float* cs; };
__device__ __forceinline__ bool tile_order(long L, int nM, int nN, int& pm, int& pn) {
    const int nwg = nM * nN; if (L >= nwg) return false;
    int wgid = (int)L; { const int q = nwg / NXCD, r = nwg % NXCD, xcd = wgid % NXCD, off = wgid / NXCD; wgid = (xcd < r ? xcd * (q + 1) : r * (q + 1) + (xcd - r) * q) + off; }
    const int nig = WGM * nN, gid = wgid / nig, fm = gid * WGM, gsz = (nM - fm) < WGM ? (nM - fm) : WGM;
    pm = fm + ((wgid % nig) % gsz); pn = (wgid % nig) / gsz; return true;
}
struct DenseOrder {
    const char* A; const char* Bt; int nM, nN, G, c; size_t tstep; int type;
    __device__ void init(const void* A_, const void* Bt_, int M, int N, int K, int G_, int c_, int type_ = 0) { A = (const char*)A_; Bt = (const char*)Bt_; nM = M / BM; nN = N / BM; G = G_; c = c_; tstep = (size_t)BM * K * 2; type = type_; }
    __device__ __forceinline__ bool next(int i, Unit& u) const {
        int pm, pn; if (!tile_order((long)i * G + c, nM, nN, pm, pn)) return false;
        u.pm = pm; u.pn = pn; u.type = type; u.aux = 0; u.A = A + (size_t)pm * tstep; u.B = Bt + (size_t)pn * tstep; u.grow = -1; return true;
    }
};

template <class Epi, class Sched, bool GATHER, bool I8 = false, bool F8 = false>
__device__ __forceinline__ void gemm_phase(LAS unsigned char* lds, const int K, const Sched& S, const Epi& E, const int* __restrict__ rowtok, const int wave_) {
    const int wid = __builtin_amdgcn_readfirstlane(wave_), lane = lane_id(), tid = wid * 64 + lane, wr = wid >> 2, wc = wid & 3, fr = lane & 15, fq = lane >> 4;
    const int nt = K / BK;
    int RA[2], CA[2];
    unsigned voffB[2], voffAc[2][2], voffAn[2][2];
#pragma unroll
    for (int i = 0; i < 2; ++i) { int R, C; stage_rc(tid * 16 + i * 8192, R, C); const int Rb = Epi::WIDE ? (64 * (R >> 5) + perm32(R & 31)) : (Epi::PERM ? ((R & ~31) + perm32(R & 31)) : R);
        RA[i] = R; CA[i] = C; voffB[i] = (unsigned)(Rb * K + C) * 2u;
        voffAc[0][i] = voffAc[1][i] = voffAn[0][i] = voffAn[1][i] = (unsigned)(R * K + C) * 2u; }
    const size_t kstep = (size_t)(BK * 2);
    const size_t hstepB = Epi::WIDE ? (size_t)32 * K * 2 : (size_t)HALF * K * 2;
    const size_t hstepA = GATHER ? 0 : (size_t)HALF * K * 2;
    const unsigned ldsw = (unsigned)wid * 1024u;
    const int aoff = lds_byte(wr * 64 + fr, fq * 8), boff = lds_byte(wc * 32 + fr, fq * 8);
#define PG8_SA(b, h) (((b) * 2 + (h)) * HTB)
#define PG8_SB(b, h) ((4 + (b) * 2 + (h)) * HTB)
#define PG8_STAGE(bufoff, gbase, voff) do { _Pragma("unroll") for (int _i = 0; _i < 2; ++_i) \
        __builtin_amdgcn_global_load_lds((const unsigned*)((const char*)(gbase) + (voff)[_i]), (LAS unsigned*)(lds + (bufoff) + ldsw + _i * 8192), 16, 0, 0); } while (0)
#define PG8_LDA(dst, b, h) do { _Pragma("unroll") for (int m = 0; m < 4; ++m) _Pragma("unroll") for (int k = 0; k < 2; ++k) dst[m][k] = *(const LAS bf16x8*)(lds + PG8_SA(b, h) + aoff + m * 2048 + k * 1024); } while (0)
#define PG8_LDB(dst, b, h) do { _Pragma("unroll") for (int n = 0; n < 2; ++n) _Pragma("unroll") for (int k = 0; k < 2; ++k) dst[n][k] = *(const LAS bf16x8*)(lds + PG8_SB(b, h) + boff + n * 2048 + k * 1024); } while (0)
#define PG8_MMA(ai, bj, At, Bt) do { __builtin_amdgcn_s_setprio(1); _Pragma("unroll") for (int m = 0; m < 4; ++m) _Pragma("unroll") for (int n = 0; n < 2; ++n) _Pragma("unroll") for (int k = 0; k < 2; ++k) { \
        if constexpr (F8) {   \
          const i32x4 b_ = __builtin_bit_cast(i32x4, Bt[n][k]), a_ = __builtin_bit_cast(i32x4, At[m][k]); \
          acc[ai][bj][m][n] = __builtin_amdgcn_mfma_f32_16x16x32_fp8_fp8((long)(((unsigned long long)(unsigned)b_[1] << 32) | (unsigned)b_[0]), (long)(((unsigned long long)(unsigned)a_[1] << 32) | (unsigned)a_[0]), acc[ai][bj][m][n], 0, 0, 0); \
          acc[ai][bj][m][n] = __builtin_amdgcn_mfma_f32_16x16x32_fp8_fp8((long)(((unsigned long long)(unsigned)b_[3] << 32) | (unsigned)b_[2]), (long)(((unsigned long long)(unsigned)a_[3] << 32) | (unsigned)a_[2]), acc[ai][bj][m][n], 0, 0, 0); } \
        else if constexpr (I8) acc[ai][bj][m][n] = __builtin_bit_cast(f32x4, __builtin_amdgcn_mfma_i32_16x16x64_i8(__builtin_bit_cast(i32x4, Bt[n][k]), __builtin_bit_cast(i32x4, At[m][k]), __builtin_bit_cast(i32x4, acc[ai][bj][m][n]), 0, 0, 0)); \
        else acc[ai][bj][m][n] = __builtin_amdgcn_mfma_f32_16x16x32_bf16(Bt[n][k], At[m][k], acc[ai][bj][m][n], 0, 0, 0); } __builtin_amdgcn_s_setprio(0); } while (0)
#define PG8_WAIT_V(n) asm volatile("s_waitcnt vmcnt(" #n ")" ::: "memory")
#define PG8_WAIT_L(n) asm volatile("s_waitcnt lgkmcnt(" #n ")" ::: "memory")
#define PG8_BAR __builtin_amdgcn_s_barrier()
#define PG8_SCHED __builtin_amdgcn_sched_barrier(0)
#define PG8_GOFF(dst, u) do { if (GATHER) { _Pragma("unroll") for (int h = 0; h < 2; ++h) _Pragma("unroll") for (int i = 0; i < 2; ++i) { \
        const int tok = rowtok[(u).grow + h * HALF + RA[i]]; dst[h][i] = (unsigned)(tok * K + CA[i]) * 2u; } } } while (0)
    Unit cur, nxt; int ui = 0;
    if (!S.next(0, cur)) return;
    PG8_GOFF(voffAc, cur);
#define PG8_SCALES(u, buf) do { if constexpr (I8 || Epi::PRE) { const float* src_ = (wid < 4 ? E.rowscale_ptr(u) + wid * 64 : E.colscale(u) + (wid - 4) * 64) + lane; \
        __builtin_amdgcn_global_load_lds((const unsigned*)src_, (LAS unsigned*)(lds + SCL_OFF + (buf) * 2048 + wid * 256), 4, 0, 0); } } while (0)
    PG8_SCALES(cur, 0);
    f32x4 acc[2][2][4][2];
#pragma unroll
    for (int a = 0; a < 2; ++a)
#pragma unroll
        for (int b = 0; b < 2; ++b)
#pragma unroll
            for (int m = 0; m < 4; ++m)
#pragma unroll
                for (int n = 0; n < 2; ++n) acc[a][b][m][n] = (f32x4){0.f, 0.f, 0.f, 0.f};
    bf16x8 At[4][2], B0[2][2], B1[2][2];
    const char* cA = cur.A; const char* cB = cur.B;
    PG8_STAGE(PG8_SB(0, 0), cB, voffB); PG8_STAGE(PG8_SB(0, 1), cB + hstepB, voffB); PG8_STAGE(PG8_SA(0, 0), cA, voffAc[0]); PG8_STAGE(PG8_SA(0, 1), cA + hstepA, voffAc[1]);
    if (wr == 1) PG8_BAR;
    PG8_WAIT_V(2); PG8_BAR;
    PG8_STAGE(PG8_SB(1, 0), cB + kstep, voffB); PG8_STAGE(PG8_SA(1, 0), cA + kstep, voffAc[0]); PG8_STAGE(PG8_SB(1, 1), cB + hstepB + kstep, voffB);
    PG8_WAIT_V(6); PG8_BAR;
    for (;;) {
        const bool has_next = S.next(ui + 1, nxt);
        if (has_next) { PG8_GOFF(voffAn, nxt); }
        else { if (GATHER) { _Pragma("unroll") for (int h = 0; h < 2; ++h) _Pragma("unroll") for (int i = 0; i < 2; ++i) voffAn[h][i] = voffAc[h][i]; } }
        const char* nA = has_next ? nxt.A : cA; const char* nB = has_next ? nxt.B : cB;
        _Pragma("unroll 1") for (int t = 0; t < nt; t += 2) {
            const bool last = (t == nt - 2);
            const char* a1 = cA + (size_t)(t + 1) * kstep;
            const char* a2 = last ? nA : cA + (size_t)(t + 2) * kstep; const char* b2 = last ? nB : cB + (size_t)(t + 2) * kstep;
            const char* a3 = a2 + kstep; const char* b3 = b2 + kstep;
            unsigned va2[2][2];
#pragma unroll
            for (int h = 0; h < 2; ++h)
#pragma unroll
                for (int i = 0; i < 2; ++i) va2[h][i] = (GATHER && last) ? voffAn[h][i] : voffAc[h][i];
            PG8_LDB(B0, 0, 0); PG8_LDB(B1, 0, 1); PG8_SCHED; PG8_LDA(At, 0, 0); PG8_STAGE(PG8_SA(1, 1), a1 + hstepA, voffAc[1]);
            PG8_WAIT_V(8); PG8_WAIT_L(0); PG8_BAR; PG8_MMA(0, 0, At, B0); PG8_MMA(0, 1, At, B1); PG8_BAR; PG8_SCHED;
            PG8_LDA(At, 0, 1); PG8_STAGE(PG8_SB(0, 0), b2, voffB); PG8_STAGE(PG8_SB(0, 1), b2 + hstepB, voffB); PG8_STAGE(PG8_SA(0, 0), a2, va2[0]);
            PG8_WAIT_V(8); PG8_WAIT_L(0); PG8_BAR; PG8_MMA(1, 0, At, B0); PG8_MMA(1, 1, At, B1); PG8_BAR; PG8_SCHED;
            PG8_LDB(B0, 1, 0); PG8_LDB(B1, 1, 1); PG8_SCHED; PG8_LDA(At, 1, 0); PG8_STAGE(PG8_SA(0, 1), a2 + hstepA, va2[1]);
            PG8_WAIT_V(8); PG8_WAIT_L(0); PG8_BAR; PG8_MMA(0, 0, At, B0); PG8_MMA(0, 1, At, B1); PG8_BAR; PG8_SCHED;
            PG8_LDA(At, 1, 1); PG8_STAGE(PG8_SB(1, 0), b3, voffB); PG8_STAGE(PG8_SB(1, 1), b3 + hstepB, voffB); PG8_STAGE(PG8_SA(1, 0), a3, va2[0]);
            PG8_WAIT_V(8); PG8_WAIT_L(0); PG8_BAR; PG8_MMA(1, 0, At, B0); PG8_MMA(1, 1, At, B1); PG8_BAR; PG8_SCHED;
            if (t == 0 && has_next) PG8_SCALES(nxt, (ui + 1) & 1);
        }
        if (wr == 0) PG8_BAR;
        if constexpr (I8) {
            int lr0 = wr * 64 + fr, cw = wc * 32 + 8 * fq; asm volatile("" : "+v"(lr0), "+v"(cw));
            const LAS unsigned char* scl = lds + SCL_OFF + (ui & 1) * 2048;
            f32x4 csv[2][2];
#pragma unroll
            for (int bj = 0; bj < 2; ++bj)
#pragma unroll
                for (int n = 0; n < 2; ++n) csv[bj][n] = *(const LAS f32x4*)(scl + 1024 + 4 * ((Epi::WIDE ? 64 * wc + 32 * bj + 8 * fq : bj * 128 + cw) + 4 * n));
#pragma unroll
            for (int ai = 0; ai < 2; ++ai)
#pragma unroll
                for (int m = 0; m < 4; ++m) { const float rsv = E.fixed_rowscale() ? E.fixed_rs_value() : *(const LAS float*)(scl + 4 * (lr0 + ai * 128 + m * 16));
#pragma unroll
                    for (int bj = 0; bj < 2; ++bj)
#pragma unroll
                        for (int n = 0; n < 2; ++n) acc[ai][bj][m][n] = __builtin_convertvector(__builtin_bit_cast(i32x4, acc[ai][bj][m][n]), f32x4) * rsv * csv[bj][n]; }
        }
        if constexpr (Epi::PRE) E(acc, cur, wr, wc, fr, fq, lds + SCL_OFF + (ui & 1) * 2048); else E(acc, cur, wr, wc, fr, fq);
        if (!has_next) break;
#pragma unroll
        for (int a = 0; a < 2; ++a)
#pragma unroll
            for (int b = 0; b < 2; ++b)
#pragma unroll
                for (int m = 0; m < 4; ++m)
#pragma unroll
                    for (int n = 0; n < 2; ++n) acc[a][b][m][n] = (f32x4){0.f, 0.f, 0.f, 0.f};
        cur = nxt; cA = nA; cB = nB; ++ui;
        if (GATHER) { _Pragma("unroll") for (int h = 0; h < 2; ++h) _Pragma("unroll") for (int i = 0; i < 2; ++i) voffAc[h][i] = voffAn[h][i]; }
        if (wr == 1) PG8_BAR;
    }
    PG8_WAIT_V(0);
    PG8_BAR;
#undef PG8_SA
#undef PG8_SB
#undef PG8_STAGE
#undef PG8_LDA
#undef PG8_LDB
#undef PG8_MMA
#undef PG8_WAIT_V
#undef PG8_WAIT_L
#undef PG8_BAR
#undef PG8_SCHED
#undef PG8_GOFF
#undef PG8_SCALES
}
typedef f32x4 Acc[2][2][4][2];
}

#define XB_TMO      128
#define XB_XCNT(j)  (256  + 64 * (j))
#define XB_XSUB(j)  (1280 + 64 * (j))
#define XB_XGEN(j)  (2304 + 64 * (j))
#define XB_TOP      3328
#define XB_TOPGEN   3392
#define XCD_BAR_WORDS 3456
#define XB_SPIN_CAP (1u << 18)
__device__ __forceinline__ unsigned xb_ld(unsigned* p)              { return __hip_atomic_load(p, __ATOMIC_RELAXED, __HIP_MEMORY_SCOPE_AGENT); }
__device__ __forceinline__ unsigned xb_add(unsigned* p, unsigned v) { return __hip_atomic_fetch_add(p, v, __ATOMIC_RELAXED, __HIP_MEMORY_SCOPE_AGENT); }
__device__ __forceinline__ unsigned xb_xcc_id() { return (unsigned)__builtin_amdgcn_s_getreg((3 << 11) | 20) & 0xFu; }
#define XB_SPIN(cond, bar) do { unsigned _sp = 0; while (cond) { __builtin_amdgcn_s_sleep(1); \
    if ((++_sp & 255u) == 0u) { if (xb_ld(&(bar)[XB_TMO])) break; if (_sp > XB_SPIN_CAP) { atomicAdd(&(bar)[XB_TMO], 1u); break; } } } } while (0)
struct XcdBarrier { unsigned* bar; unsigned x; volatile LAS unsigned* st; };
__device__ __forceinline__ XcdBarrier xcd_barrier_post(unsigned* bar, volatile LAS unsigned* st) {
    XcdBarrier b; b.bar = bar; b.x = xb_xcc_id(); b.st = st;
    if (threadIdx.x == 0) (void)xb_add(&bar[XB_XCNT(b.x)], 1u);
    return b;
}
__device__ __forceinline__ void xcd_barrier_complete(unsigned* bar, unsigned x, unsigned& nloc, unsigned& nx) {
    const unsigned G = gridDim.x * gridDim.y * gridDim.z;
    unsigned sum, cnt, mine, sp = 0u;
    for (;;) {
        sum = 0u; cnt = 0u; mine = 0u;
#pragma unroll
        for (unsigned j = 0; j < 16; ++j) { const unsigned c = xb_ld(&bar[XB_XCNT(j)]); sum += c; cnt += (c > 0u) ? 1u : 0u; mine = (j == x) ? c : mine; }
        if (sum == G) break;
        __builtin_amdgcn_s_sleep(1);
        if ((++sp & 255u) == 0u) { if (xb_ld(&bar[XB_TMO])) break; if (sp > XB_SPIN_CAP) { atomicAdd(&bar[XB_TMO], 1u); break; } }
    }
    nloc = mine > 0u ? mine : 1u; nx = cnt > 0u ? cnt : 1u;
}
__device__ __forceinline__ void xcd_barrier(const XcdBarrier& b) {
    asm volatile("s_waitcnt vmcnt(0)" ::: "memory");
    __syncthreads();
    if (threadIdx.x == 0) {
        unsigned* bar = b.bar;
        __builtin_amdgcn_s_waitcnt(0);
        unsigned nloc = b.st[0], nx = b.st[1];
        if (nloc == 0u) { xcd_barrier_complete(bar, b.x, nloc, nx); b.st[0] = nloc; b.st[1] = nx; }
        const unsigned old = xb_add(&bar[XB_XSUB(b.x)], 1u);
        const unsigned gen = old / nloc;
        if (old + 1u == (gen + 1u) * nloc) {
            __builtin_amdgcn_fence(__ATOMIC_RELEASE, "agent");
            asm volatile("s_waitcnt vmcnt(0)" ::: "memory");
            const unsigned og = xb_add(&bar[XB_TOP], 1u);
            const unsigned tg = og / nx;
            if (og + 1u == (tg + 1u) * nx) xb_add(&bar[XB_TOPGEN], 1u);
            else XB_SPIN(xb_ld(&bar[XB_TOPGEN]) == tg, bar);
            __builtin_amdgcn_fence(__ATOMIC_ACQUIRE, "agent");
            xb_add(&bar[XB_XGEN(b.x)], 1u);
            asm volatile("s_waitcnt vmcnt(0)" ::: "memory");
        } else {
            XB_SPIN(xb_ld(&bar[XB_XGEN(b.x)]) == gen, bar);
            __builtin_amdgcn_fence(__ATOMIC_ACQUIRE, "agent");
            asm volatile("s_waitcnt vmcnt(0)" ::: "memory");
        }
    }
    __syncthreads();
}

struct Args { const float* in[29]; float* out; unsigned char* ws; int ph_lo, ph_hi; };
enum { I_X = 0, I_P, I_LNIN_G, I_LNIN_B, I_RELB, I_WIN, I_GN_G, I_LQ1, I_LK1, I_LQ2, I_LK2, I_SUBLN_G, I_WRO, I_WDO, I_WO, I_LN1_G, I_LN1_B,
       I_ROUT_W, I_ROUT_B, I_EG, I_EU, I_ED, I_SG, I_SU, I_SD, I_PLE_W, I_PLE_GW, I_LN2_G, I_LN2_B };

struct Frame {
    LAS unsigned char* lds;
    volatile LAS unsigned* MISC;
    gu32* ctl;
    int wave, vcu, G;
};
#define FTID (F.wave * 64 + lane_id())
#define FLANE (lane_id())

__device__ __forceinline__ void p0_transpose_item(const float* W, int K, int N, bf16_t* WT, int k0, int n0, int dstrow0, LAS float* scr, int lane) {
    const int cg = lane & 7, r = lane >> 3;
    f32x4 v[8];
#pragma unroll
    for (int i = 0; i < 8; ++i) v[i] = *(const f32x4*)(W + (size_t)(k0 + r + 8 * i) * N + n0 + 4 * cg);
#pragma unroll
    for (int i = 0; i < 8; ++i) { LAS float* d = scr + (r + 8 * i) * 33 + 4 * cg; d[0] = v[i].x; d[1] = v[i].y; d[2] = v[i].z; d[3] = v[i].w; }
    LDS_WAIT(); asm volatile("" ::: "memory");
    const int c = lane & 7;
#pragma unroll
    for (int j = 0; j < 4; ++j) { const int n = (lane >> 3) + 8 * j; const LAS float* s = scr + (8 * c) * 33 + n;
        v4u o; o.x = pk2(s[0 * 33], s[1 * 33]); o.y = pk2(s[2 * 33], s[3 * 33]); o.z = pk2(s[4 * 33], s[5 * 33]); o.w = pk2(s[6 * 33], s[7 * 33]);
        *(GAS v4u*)(WT + (size_t)(dstrow0 + n) * K + k0 + 8 * c) = o; }
    LDS_WAIT(); asm volatile("" ::: "memory");
}
__device__ __forceinline__ void p0_transpose_item_f8(const float* W, int K, int N, unsigned char* WT8, int k0, int n0, int dstrow0, LAS float* scr, int lane, const float scale) {
    const int cg = lane & 7, r = lane >> 3;
    f32x4 v[8];
#pragma unroll
    for (int i = 0; i < 8; ++i) v[i] = *(const f32x4*)(W + (size_t)(k0 + r + 8 * i) * N + n0 + 4 * cg);
#pragma unroll
    for (int i = 0; i < 8; ++i) { LAS float* d = scr + (r + 8 * i) * 33 + 4 * cg; d[0] = v[i].x * scale; d[1] = v[i].y * scale; d[2] = v[i].z * scale; d[3] = v[i].w * scale; }
    LDS_WAIT(); asm volatile("" ::: "memory");
    const int c = lane & 7;
#pragma unroll
    for (int j = 0; j < 4; ++j) { const int n = (lane >> 3) + 8 * j; const LAS float* s = scr + (8 * c) * 33 + n;
        int w0 = 0, w1 = 0;
        w0 = __builtin_amdgcn_cvt_pk_fp8_f32(s[0 * 33], s[1 * 33], w0, false); w0 = __builtin_amdgcn_cvt_pk_fp8_f32(s[2 * 33], s[3 * 33], w0, true);
        w1 = __builtin_amdgcn_cvt_pk_fp8_f32(s[4 * 33], s[5 * 33], w1, false); w1 = __builtin_amdgcn_cvt_pk_fp8_f32(s[6 * 33], s[7 * 33], w1, true);
        *(GAS unsigned long long*)(WT8 + (size_t)(dstrow0 + n) * K + k0 + 8 * c) = (unsigned long long)(unsigned)w0 | ((unsigned long long)(unsigned)w1 << 32); }
    LDS_WAIT(); asm volatile("" ::: "memory");
}
__host__ __device__ __forceinline__ int win_dst_row(int c) {
    if (c >= 2048) return c;
    const int sb = c & ~1023, cs = c & 1023, hd = cs >> 7, half = (cs >> 6) & 1, j = cs & 63;
    return sb + (hd >> 1) * 256 + 64 * (2 * (hd & 1) + (j >> 5)) + 32 * half + (j & 31);
}
__device__ __forceinline__ void ln_row_to_bf16(int lane, const float* xrow, const float* g, const float* b, bf16_t* orow) {
    const GAS f32x4* xr = (const GAS f32x4*)xrow + lane;
    f32x4 v[4]; float s = 0.f;
#pragma unroll
    for (int j = 0; j < 4; ++j) { v[j] = xr[64 * j]; s += (v[j].x + v[j].y) + (v[j].z + v[j].w); }
    const float mean = wave_sum(s) * (1.f / DM); float s2 = 0.f;
#pragma unroll
    for (int j = 0; j < 4; ++j) { v[j] = v[j] - mean; s2 += (v[j].x * v[j].x + v[j].y * v[j].y) + (v[j].z * v[j].z + v[j].w * v[j].w); }
    const float rstd = 1.f / sqrtf(wave_sum(s2) * (1.f / DM) + LN_EPS);
    GAS unsigned long long* o8 = (GAS unsigned long long*)orow + lane;
#pragma unroll
    for (int j = 0; j < 4; ++j) { const f32x4 gg = *((const GAS f32x4*)g + lane + 64 * j), bb = *((const GAS f32x4*)b + lane + 64 * j);
        const f32x4 y = v[j] * rstd * gg + bb;
        o8[64 * j] = (unsigned long long)pk2(y.x, y.y) | ((unsigned long long)pk2(y.z, y.w) << 32); }
}

template <bool BF16IN>
__device__ __forceinline__ void ln_row_to_bf16_i8(int lane, const void* xrow, const float* g, const float* b, bf16_t* orow, signed char* qrow, float* srow) {
    f32x4 v[4]; float s = 0.f;
#pragma unroll
    for (int j = 0; j < 4; ++j) {
        if constexpr (BF16IN) { const unsigned long long w = ((const GAS unsigned long long*)xrow)[lane + 64 * j]; v[j] = (f32x4){bflo((unsigned)w), bfhi((unsigned)w), bflo((unsigned)(w >> 32)), bfhi((unsigned)(w >> 32))}; }
        else v[j] = ((const GAS f32x4*)xrow)[lane + 64 * j];
        s += (v[j].x + v[j].y) + (v[j].z + v[j].w); }
    const float mean = wave_sum(s) * (1.f / DM); float s2 = 0.f;
#pragma unroll
    for (int j = 0; j < 4; ++j) { v[j] = v[j] - mean; s2 += (v[j].x * v[j].x + v[j].y * v[j].y) + (v[j].z * v[j].z + v[j].w * v[j].w); }
    const float rstd = 1.f / sqrtf(wave_sum(s2) * (1.f / DM) + LN_EPS);
    GAS unsigned long long* o8 = (GAS unsigned long long*)orow + lane;
    float mx = 0.f;
#pragma unroll
    for (int j = 0; j < 4; ++j) { const f32x4 gg = *((const GAS f32x4*)g + lane + 64 * j), bb = *((const GAS f32x4*)b + lane + 64 * j);
        v[j] = v[j] * rstd * gg + bb;
        o8[64 * j] = (unsigned long long)pk2(v[j].x, v[j].y) | ((unsigned long long)pk2(v[j].z, v[j].w) << 32);
        mx = fmaxf(mx, fmaxf(fmaxf(fabsf(v[j].x), fabsf(v[j].y)), fmaxf(fabsf(v[j].z), fabsf(v[j].w)))); }
#pragma unroll
    for (int o = 1; o < 64; o <<= 1) mx = fmaxf(mx, __shfl_xor(mx, o));
    const float sc = mx > 0.f ? mx * (1.f / 127.f) : 1.f, inv = 1.f / sc;
    GAS unsigned* q4 = (GAS unsigned*)qrow + lane;
#pragma unroll
    for (int j = 0; j < 4; ++j) { const int q0 = (int)rintf(v[j].x * inv), q1 = (int)rintf(v[j].y * inv), q2 = (int)rintf(v[j].z * inv), q3 = (int)rintf(v[j].w * inv);
        q4[64 * j] = (unsigned)(q0 & 255) | ((unsigned)(q1 & 255) << 8) | ((unsigned)(q2 & 255) << 16) | ((unsigned)(q3 & 255) << 24); }
    if (lane == 0) *srow = sc;
}
template <bool BF16IN>
__device__ __forceinline__ void ln_rows_bf16_i8(int lane, const void* X, const float* g, const float* b, bf16_t* O, signed char* Q, float* S, int m0, int mstep, int M) {
    f32x4 gg[4], bb[4];
#pragma unroll
    for (int j = 0; j < 4; ++j) { gg[j] = *((const GAS f32x4*)g + lane + 64 * j); bb[j] = *((const GAS f32x4*)b + lane + 64 * j); }
    f32x4 cv[4], nv[4]; unsigned long long cw[4], nw[4];
#define LN_LOAD(dv, dw, m_) do { _Pragma("unroll") for (int j = 0; j < 4; ++j) { \
        if constexpr (BF16IN) dw[j] = ((const GAS unsigned long long*)((const bf16_t*)X + (size_t)(m_) * DM))[lane + 64 * j]; \
        else dv[j] = ((const GAS f32x4*)((const float*)X + (size_t)(m_) * DM))[lane + 64 * j]; } } while (0)
    int m = m0;
    if (m < M) LN_LOAD(cv, cw, m);
    while (m < M) {
        const int mn = m + mstep;
        if (mn < M) LN_LOAD(nv, nw, mn);
        f32x4 v[4]; float s = 0.f;
#pragma unroll
        for (int j = 0; j < 4; ++j) {
            if constexpr (BF16IN) { const unsigned long long w = cw[j]; v[j] = (f32x4){bflo((unsigned)w), bfhi((unsigned)w), bflo((unsigned)(w >> 32)), bfhi((unsigned)(w >> 32))}; }
            else v[j] = cv[j];
            s += (v[j].x + v[j].y) + (v[j].z + v[j].w); }
        const float mean = wave_sum(s) * (1.f / DM); float s2 = 0.f;
#pragma unroll
        for (int j = 0; j < 4; ++j) { v[j] = v[j] - mean; s2 += (v[j].x * v[j].x + v[j].y * v[j].y) + (v[j].z * v[j].z + v[j].w * v[j].w); }
        const float rstd = 1.f / sqrtf(wave_sum(s2) * (1.f / DM) + LN_EPS);
        GAS unsigned long long* o8 = (GAS unsigned long long*)(O + (size_t)m * DM) + lane;
        float mx = 0.f;
#pragma unroll
        for (int j = 0; j < 4; ++j) {
            v[j] = v[j] * rstd * gg[j] + bb[j];
            o8[64 * j] = (unsigned long long)pk2(v[j].x, v[j].y) | ((unsigned long long)pk2(v[j].z, v[j].w) << 32);
            mx = fmaxf(mx, fmaxf(fmaxf(fabsf(v[j].x), fabsf(v[j].y)), fmaxf(fabsf(v[j].z), fabsf(v[j].w)))); }
#pragma unroll
        for (int o = 1; o < 64; o <<= 1) mx = fmaxf(mx, __shfl_xor(mx, o));
        const float sc = mx > 0.f ? mx * (1.f / 127.f) : 1.f, inv = 1.f / sc;
        GAS unsigned* q4 = (GAS unsigned*)(Q + (size_t)m * DM) + lane;
#pragma unroll
        for (int j = 0; j < 4; ++j) { const int q0 = (int)rintf(v[j].x * inv), q1 = (int)rintf(v[j].y * inv), q2 = (int)rintf(v[j].z * inv), q3 = (int)rintf(v[j].w * inv);
            q4[64 * j] = (unsigned)(q0 & 255) | ((unsigned)(q1 & 255) << 8) | ((unsigned)(q2 & 255) << 16) | ((unsigned)(q3 & 255) << 24); }
        if (lane == 0) S[m] = sc;
#pragma unroll
        for (int j = 0; j < 4; ++j) { if constexpr (BF16IN) cw[j] = nw[j]; else cv[j] = nv[j]; }
        m = mn;
    }
#undef LN_LOAD
}
template <int KP>
__device__ __forceinline__ void quant_cols32(LAS unsigned char* lds, const float* W, int N, int n0, signed char* WT, float* scl, int dst0, int wave, int lane) {
    const int t = wave * 64 + lane, cg = t & 7, rg = t >> 3;
    constexpr int PITCH = 1040, K = 1024 * KP;
    LAS float* red = (LAS float*)(lds + 32 * PITCH);
    const float* Wp = W + (size_t)(4 * rg) * N + n0 + 4 * cg;
    f32x4 v[4][4]; f32x4 mx = (f32x4){0.f, 0.f, 0.f, 0.f};
#pragma unroll 1
    for (int part = 0; part < KP; ++part) {
#pragma unroll
        for (int i = 0; i < 4; ++i)
#pragma unroll
            for (int j = 0; j < 4; ++j) v[i][j] = *(const f32x4*)(Wp + (size_t)(1024 * part + 256 * i + j) * N);
#pragma unroll
        for (int i = 0; i < 4; ++i)
#pragma unroll
            for (int j = 0; j < 4; ++j) mx = __builtin_elementwise_max(mx, __builtin_elementwise_abs(v[i][j]));
    }
#pragma unroll
    for (int off = 8; off < 64; off <<= 1)
#pragma unroll
        for (int c = 0; c < 4; ++c) mx[c] = fmaxf(mx[c], __shfl_xor(mx[c], off));
    if (lane < 8) *(LAS f32x4*)(red + wave * 32 + 4 * cg) = mx;
    __syncthreads();
    f32x4 cm = *(const LAS f32x4*)(red + 4 * cg);
#pragma unroll
    for (int w = 1; w < 8; ++w) cm = __builtin_elementwise_max(cm, *(const LAS f32x4*)(red + w * 32 + 4 * cg));
    f32x4 sc, inv;
#pragma unroll
    for (int c = 0; c < 4; ++c) { sc[c] = cm[c] > 0.f ? cm[c] * (1.f / 127.f) : 1.f; inv[c] = 1.f / sc[c]; }
    if (t < 8) *(f32x4*)(scl + dst0 + 4 * cg) = sc;
#pragma unroll 1
    for (int part = 0; part < KP; ++part) {
        if (KP > 1) {
#pragma unroll
            for (int i = 0; i < 4; ++i)
#pragma unroll
                for (int j = 0; j < 4; ++j) v[i][j] = *(const f32x4*)(Wp + (size_t)(1024 * part + 256 * i + j) * N);
        }
#pragma unroll
        for (int i = 0; i < 4; ++i)
#pragma unroll
            for (int c = 0; c < 4; ++c) { const int q0 = (int)rintf(v[i][0][c] * inv[c]), q1 = (int)rintf(v[i][1][c] * inv[c]), q2 = (int)rintf(v[i][2][c] * inv[c]), q3 = (int)rintf(v[i][3][c] * inv[c]);
                *(LAS unsigned*)(lds + (4 * cg + c) * PITCH + 256 * i + 4 * rg) = (unsigned)(q0 & 255) | ((unsigned)(q1 & 255) << 8) | ((unsigned)(q2 & 255) << 16) | ((unsigned)(q3 & 255) << 24); }
        __syncthreads();
        { const int row = t >> 4, ch = t & 15;
#pragma unroll
          for (int e = 0; e < 4; ++e) *(GAS v4u*)(WT + (size_t)(dst0 + row) * K + 1024 * part + ch * 64 + e * 16) = *(const LAS v4u*)(lds + row * PITCH + ch * 64 + e * 16); }
        __syncthreads();
    }
}
__device__ __forceinline__ void quant_cols32_k1024(LAS unsigned char* lds, const float* W, int N, int n0, signed char* WT, float* scl, int dst0, int wave, int lane) { quant_cols32<1>(lds, W, N, n0, WT, scl, dst0, wave, lane); }
__device__ __forceinline__ void p0_prologue(Frame& F, const Args& a) {
    LAS float* scr = (LAS float*)(F.lds + F.wave * 16384);
    const int gw = F.vcu * NWAVES + F.wave, NGW = F.G * NWAVES;
    unsigned char* ws = a.ws;
    constexpr int I_WINc = 0;
    constexpr int I_WROc = 0, I_WDOc = 0, I_WOc = 16 * 32, I_ROUTc = 16 * 8, I_PLEWc = 4 * 32, I_PLEGc = 0, I_SGc = 0, I_SUc = 0, I_SDc = 4 * 32;
    constexpr int NITEMS = I_WINc + I_WROc + I_WDOc + I_WOc + I_ROUTc + I_PLEWc + I_PLEGc + I_SGc + I_SUc + I_SDc;
    for (int it = gw; it < NITEMS; it += NGW) {
        int r = it; const float* W; int K, N; bf16_t* WT; int kind = 0;
        if (r < I_WINc) { W = a.in[I_WIN]; K = 1024; N = INCOLS; WT = (bf16_t*)(ws + WS_WIN_T); kind = 1; }
        else if ((r -= I_WINc) < I_WROc) { W = a.in[I_WRO]; K = 2048; N = 1024; WT = (bf16_t*)(ws + WS_WRO_T); }
        else if ((r -= I_WROc) < I_WDOc) { W = a.in[I_WDO]; K = 1024; N = 1024; WT = (bf16_t*)(ws + WS_WDO_T); }
        else if ((r -= I_WDOc) < I_WOc) { W = a.in[I_WO]; K = 1024; N = 1024; WT = (bf16_t*)(ws + WS_WO_T); }
        else if ((r -= I_WOc) < I_ROUTc) { W = a.in[I_ROUT_W]; K = 1024; N = 256; WT = (bf16_t*)(ws + WS_ROUT_T); }
        else if ((r -= I_ROUTc) < I_PLEWc) { W = a.in[I_PLE_W]; K = 256; N = 1024; WT = (bf16_t*)(ws + WS_PLEW_T); }
        else if ((r -= I_PLEWc) < I_PLEGc) { W = a.in[I_PLE_GW]; K = 1024; N = 1024; WT = (bf16_t*)(ws + WS_PLEG_T); }
        else if ((r -= I_PLEGc) < I_SGc) { W = a.in[I_SG]; K = 1024; N = 256; WT = (bf16_t*)(ws + WS_SHGU_T); kind = 2; }
        else if ((r -= I_SGc) < I_SUc) { W = a.in[I_SU]; K = 1024; N = 256; WT = (bf16_t*)(ws + WS_SHGU_T); kind = 3; }
        else { r -= I_SUc; W = a.in[I_SD]; K = 256; N = 1024; WT = (bf16_t*)(ws + WS_SHD_T); }
        const int nblk = N / 32, kb = r / nblk, nb = r % nblk, n0 = 32 * nb;
        int d0 = n0;
        if (kind == 1) d0 = win_dst_row(n0);
        else if (kind == 2) d0 = (n0 >> 7) * 256 + (n0 & 127);
        else if (kind == 3) d0 = (n0 >> 7) * 256 + 128 + (n0 & 127);
        if (W == a.in[I_SD] || W == a.in[I_WO]) p0_transpose_item_f8(W, K, N, (unsigned char*)WT, 64 * kb, n0, d0, scr, FLANE, F8_WSCALE);
        else p0_transpose_item(W, K, N, WT, 64 * kb, n0, d0, scr, FLANE);
    }
    __syncthreads();
    for (int it = F.vcu; it < 32 + INCOLS / 32 + 32 + 16 + 32; it += F.G) {
        int r = it;
        if (r < 32) { quant_cols32<2>(F.lds, a.in[I_WRO], 1024, 32 * r, (signed char*)(ws + WS_WRO_T), (float*)(ws + WS_SWRO), 32 * r, F.wave, FLANE); continue; } r -= 32;
        if (r < INCOLS / 32) { quant_cols32_k1024(F.lds, a.in[I_WIN], INCOLS, 32 * r, (signed char*)(ws + WS_WIN_T), (float*)(ws + WS_SWIN), win_dst_row(32 * r), F.wave, FLANE); continue; } r -= INCOLS / 32;
        if (r < 32) { quant_cols32_k1024(F.lds, a.in[I_WDO], 1024, 32 * r, (signed char*)(ws + WS_WDO_T), (float*)(ws + WS_SWDO), 32 * r, F.wave, FLANE); continue; } r -= 32;
        if (r < 16) { const int up = r >> 3, n0 = 32 * (r & 7); quant_cols32_k1024(F.lds, a.in[up ? I_SU : I_SG], 256, n0, (signed char*)(ws + WS_SHGU_T), (float*)(ws + WS_SSHGU), (n0 >> 7) * 256 + up * 128 + (n0 & 127), F.wave, FLANE); continue; } r -= 16;
        quant_cols32_k1024(F.lds, a.in[I_PLE_GW], 1024, 32 * r, (signed char*)(ws + WS_PLEG_T), (float*)(ws + WS_SPLEG), 32 * r, F.wave, FLANE);
    }
    ln_rows_bf16_i8<false>(FLANE, a.in[I_X], a.in[I_LNIN_G], a.in[I_LNIN_B], (bf16_t*)(ws + WS_XN), (signed char*)(ws + WS_XN8), (float*)(ws + WS_SXN), gw, NGW, NTOK);
    { const size_t n8 = (size_t)NTOK * PLE / 8; const GAS f32x4* src = (const GAS f32x4*)a.in[I_P]; GAS v4u* dst = (GAS v4u*)(ws + WS_PB);
      for (size_t i = (size_t)F.vcu * 512 + FTID; i < n8; i += (size_t)F.G * 512) { const f32x4 x0 = src[2 * i], x1 = src[2 * i + 1];
          v4u o; o.x = pk2(x0.x, x0.y); o.y = pk2(x0.z, x0.w); o.z = pk2(x1.x, x1.y); o.w = pk2(x1.z, x1.w); dst[i] = o; } }
}

__device__ __forceinline__ void unpack8(const v4u w, float* f) { f[0] = bflo(w.x); f[1] = bfhi(w.x); f[2] = bflo(w.y); f[3] = bfhi(w.y); f[4] = bflo(w.z); f[5] = bfhi(w.z); f[6] = bflo(w.w); f[7] = bfhi(w.w); }
__device__ __forceinline__ unsigned long long pack8_fp8(const float* f) { int w0 = 0, w1 = 0;
    w0 = __builtin_amdgcn_cvt_pk_fp8_f32(f[0], f[1], w0, false); w0 = __builtin_amdgcn_cvt_pk_fp8_f32(f[2], f[3], w0, true);
    w1 = __builtin_amdgcn_cvt_pk_fp8_f32(f[4], f[5], w1, false); w1 = __builtin_amdgcn_cvt_pk_fp8_f32(f[6], f[7], w1, true);
    return (unsigned long long)(unsigned)w0 | ((unsigned long long)(unsigned)w1 << 32); }
__device__ __forceinline__ void unpack8_fp8(const unsigned long long yw, float* f) { const int w0 = (int)(unsigned)yw, w1 = (int)(unsigned)(yw >> 32);
    const auto f0 = __builtin_amdgcn_cvt_pk_f32_fp8(w0, false), f1 = __builtin_amdgcn_cvt_pk_f32_fp8(w0, true), f2 = __builtin_amdgcn_cvt_pk_f32_fp8(w1, false), f3 = __builtin_amdgcn_cvt_pk_f32_fp8(w1, true);
    f[0] = f0[0]; f[1] = f0[1]; f[2] = f1[0]; f[3] = f1[1]; f[4] = f2[0]; f[5] = f2[1]; f[6] = f3[0]; f[7] = f3[1]; }
__device__ __forceinline__ v4u pack8(const float* f) { v4u w; w.x = cvt_pk_bf16(f[0], f[1]); w.y = cvt_pk_bf16(f[2], f[3]); w.z = cvt_pk_bf16(f[4], f[5]); w.w = cvt_pk_bf16(f[6], f[7]); return w; }
struct EpiInProj {
    static constexpr bool PERM = true, WIDE = true, PRE = false;
    unsigned char* ws;
    __device__ __forceinline__ const float* rowscale_ptr(const pg8::Unit& u) const { return (const float*)(ws + WS_SXN) + u.pm * 256; }
    __device__ __forceinline__ bool fixed_rowscale() const { return false; }
    __device__ __forceinline__ float fixed_rs_value() const { return 1.f; }
    __device__ __forceinline__ const float* colscale(const pg8::Unit& u) const { return (const float*)(ws + WS_SWIN) + u.pn * 256; }
    __device__ __forceinline__ void operator()(const pg8::Acc& acc, const pg8::Unit& u, int wr, int wc, int fr, int fq) const {
        const int pn = u.pn; int seg, t0, ld; size_t boff;
        if (pn < 4) { seg = 0; t0 = 0; boff = WS_QR; ld = 1024; } else if (pn < 8) { seg = 1; t0 = 4; boff = WS_KR; ld = 1024; }
        else if (pn < 16) { seg = 2; t0 = 8; boff = WS_V8; ld = 2048; } else if (pn < 24) { seg = 3; t0 = 16; boff = WS_GR; ld = 2048; }
        else if (pn < 28) { seg = 4; t0 = 24; boff = WS_QD; ld = 1024; } else if (pn < 32) { seg = 5; t0 = 28; boff = WS_KD; ld = 1024; }
        else if (pn < 36) { seg = 6; t0 = 32; boff = WS_VD; ld = 1024; } else { seg = 7; t0 = 36; boff = WS_GT; ld = 2048; }
        bf16_t* base = (bf16_t*)(ws + boff);
        const int tl = pn - t0;
        const int row0 = u.pm * 256 + wr * 64 + fr;
        if (seg <= 1) {
            const int hl = wc >> 1, j0 = 32 * (wc & 1) + 8 * fq, head = 2 * tl + hl;
            const float sc = seg == 1 ? KR_SCALE : 1.f;
            float th[8];
#pragma unroll
            for (int i = 0; i < 8; ++i) th[i] = exp2f(-(float)(j0 + i) * (13.287712379549449f / 63.f));
#pragma unroll
            for (int ai = 0; ai < 2; ++ai)
#pragma unroll
                for (int m = 0; m < 4; ++m) {
                    const int row = row0 + ai * 128 + m * 16; const float pos = (float)(row & (SEQ - 1));
                    float o1[8], o2[8];
#pragma unroll
                    for (int i = 0; i < 8; ++i) {
                        const float t1 = acc[ai][0][m][i >> 2][i & 3], t2 = acc[ai][1][m][i >> 2][i & 3];
                        const float ang = pos * th[i]; const float k = rintf(ang * 0.15915494309189535f);
                        float r = fmaf(-k, 6.2831855f, ang); r = fmaf(-k, -1.7484555e-7f, r);
                        const float rr = r * 0.15915494309189535f;
                        const float c = __builtin_amdgcn_cosf(rr), s = __builtin_amdgcn_sinf(rr);
                        o1[i] = (t1 * c - t2 * s) * sc; o2[i] = (t2 * c + t1 * s) * sc;
                    }
                    bf16_t* rp = base + (size_t)row * ld + head * 128 + j0;
                    v4u w; w.x = cvt_pk_bf16(o1[0], o1[1]); w.y = cvt_pk_bf16(o1[2], o1[3]); w.z = cvt_pk_bf16(o1[4], o1[5]); w.w = cvt_pk_bf16(o1[6], o1[7]);
                    *(v4u*)rp = w;
                    w.x = cvt_pk_bf16(o2[0], o2[1]); w.y = cvt_pk_bf16(o2[2], o2[3]); w.z = cvt_pk_bf16(o2[4], o2[5]); w.w = cvt_pk_bf16(o2[6], o2[7]);
                    *(v4u*)(rp + 64) = w;
                }
        } else {
            const bool lo = fr < 8; const int rl = fr & 7;
            const int colb = tl * 256 + 64 * wc + 8 * fq;
            const bool f8 = (seg == 2 || seg == 3 || seg == 7);
#pragma unroll
            for (int ai = 0; ai < 2; ++ai)
#pragma unroll
                for (int m = 0; m < 4; ++m) {
                    const int rbase = u.pm * 256 + wr * 64 + ai * 128 + m * 16;
                    float vv[2][8];
#pragma unroll
                    for (int bj = 0; bj < 2; ++bj) {
                        f32x4 v0 = acc[ai][bj][m][0], v1 = acc[ai][bj][m][1];
                        if (seg == 3) { for (int i = 0; i < 4; ++i) { v0[i] = fast_silu(v0[i]); v1[i] = fast_silu(v1[i]); } }
                        else if (seg == 7) { for (int i = 0; i < 4; ++i) { v0[i] = fast_sigmoid(v0[i]); v1[i] = fast_sigmoid(v1[i]); } }
                        else if (seg == 4) { v0 = v0 * QD_SCALE; v1 = v1 * QD_SCALE; }
                        else if (seg == 2) { v0 = v0 * V8_SCALE; v1 = v1 * V8_SCALE; }
#pragma unroll
                        for (int i = 0; i < 4; ++i) { vv[bj][i] = v0[i]; vv[bj][4 + i] = v1[i]; }
                    }
                    if (f8) {
                        const unsigned long long p0 = pack8_fp8(vv[0]), p1 = pack8_fp8(vv[1]);
                        const unsigned p1l = (unsigned)p1, p1h = (unsigned)(p1 >> 32);
                        const unsigned tl_ = (unsigned)__builtin_amdgcn_update_dpp(0, (int)p1l, 0x118, 0xf, 0xf, false), th_ = (unsigned)__builtin_amdgcn_update_dpp(0, (int)p1h, 0x118, 0xf, 0xf, false);
                        const unsigned ul_ = (unsigned)__builtin_amdgcn_update_dpp(0, (int)p1l, 0x108, 0xf, 0xf, false), uh_ = (unsigned)__builtin_amdgcn_update_dpp(0, (int)p1h, 0x108, 0xf, 0xf, false);
                        const unsigned long long tt = (unsigned long long)tl_ | ((unsigned long long)th_ << 32), uu = (unsigned long long)ul_ | ((unsigned long long)uh_ << 32);
                        unsigned char* bp = (unsigned char*)base + colb + (lo ? 0 : 32);
                        *(unsigned long long*)(bp + (size_t)(rbase + rl) * 2048) = lo ? p0 : tt;
                        bp = (unsigned char*)base + colb + (lo ? 32 : 0);
                        *(unsigned long long*)(bp + (size_t)(rbase + 8 + rl) * 2048) = lo ? uu : p0;
                    } else {
                        const v4u w0 = pack8(vv[0]), w1 = pack8(vv[1]); v4u tt, uu;
#pragma unroll
                        for (int k = 0; k < 4; ++k) { tt[k] = (unsigned)__builtin_amdgcn_update_dpp(0, (int)w1[k], 0x118, 0xf, 0xf, false); uu[k] = (unsigned)__builtin_amdgcn_update_dpp(0, (int)w1[k], 0x108, 0xf, 0xf, false); }
                        bf16_t* bp = base + colb + (lo ? 0 : 32);
                        *(v4u*)(bp + (size_t)(rbase + rl) * ld) = lo ? w0 : tt;
                        bp = base + colb + (lo ? 32 : 0);
                        *(v4u*)(bp + (size_t)(rbase + 8 + rl) * ld) = lo ? uu : w0;
                    }
                }
        }
    }
};

namespace att {
using f32x16 = __attribute__((ext_vector_type(16))) float;
using s16x4  = __attribute__((ext_vector_type(4))) short;
constexpr int SHM_V = 16384, SHM_K64 = 8192;
constexpr int A_V = 0, A_K = 49152, A_WS = 73728, A_TAB = 75776, A_ST = 77312;
constexpr int R_KS = 0, R_KI = 32768, R_VI = 65536, R_ST = 98304, R_STP = 272, R_OS = 107008;
#define KSWZ(row, colB) ((row) * 256 + ((colB) ^ (((row) & 7) << 4)))
#define KSWZ64(row, colB) ((row) * 128 + ((colB) ^ ((((row) >> 1) & 7) << 4)))
#define SBAR() __builtin_amdgcn_sched_barrier(0)
__device__ __forceinline__ int crow(int r, int hi) { return (r & 3) + 8 * (r >> 2) + 4 * hi; }
__device__ __forceinline__ int v_st(int k, int c) { const int kk = (k & ~0xC) | ((k & 4) << 1) | ((k & 8) >> 1); return ((kk >> 3) * 4 + (c >> 5)) * 512 + ((kk & 7) * 32 + (c & 31)) * 2; }
__device__ __forceinline__ int v_rd_base(int lane) { return ((lane & 3) << 3) | (((lane >> 2) & 3) << 6) | (((lane >> 4) & 1) << 5) | (((lane >> 5) & 1) << 8); }
constexpr int v_rd_off(int d0, int ks, int half) { return d0 * 512 + ks * 4096 + half * 2048; }
template <int OFF> __device__ __forceinline__ s16x4 tr_read(int vb) {
  s16x4 r; asm volatile("ds_read_b64_tr_b16 %0, %1 offset:%2" : "=&v"(r) : "v"(vb), "i"(OFF) : "memory"); return r;
}
#define PKF(L, H) (bf16x8){L[0], L[1], L[2], L[3], H[0], H[1], H[2], H[3]}
template <int D0> __device__ __forceinline__ void pv_one(f32x16& od, int vb, bf16x8 pa0, bf16x8 pa1, bf16x8 pa2, bf16x8 pa3) {
  const s16x4 l0 = tr_read<v_rd_off(D0, 0, 0)>(vb), h0 = tr_read<v_rd_off(D0, 0, 1)>(vb), l1 = tr_read<v_rd_off(D0, 1, 0)>(vb), h1 = tr_read<v_rd_off(D0, 1, 1)>(vb);
  const s16x4 l2 = tr_read<v_rd_off(D0, 2, 0)>(vb), h2 = tr_read<v_rd_off(D0, 2, 1)>(vb), l3 = tr_read<v_rd_off(D0, 3, 0)>(vb), h3 = tr_read<v_rd_off(D0, 3, 1)>(vb);
  asm volatile("s_waitcnt lgkmcnt(0)" ::: "memory"); SBAR();
  od = __builtin_amdgcn_mfma_f32_32x32x16_bf16(pa0, PKF(l0, h0), od, 0, 0, 0);
  od = __builtin_amdgcn_mfma_f32_32x32x16_bf16(pa1, PKF(l1, h1), od, 0, 0, 0);
  od = __builtin_amdgcn_mfma_f32_32x32x16_bf16(pa2, PKF(l2, h2), od, 0, 0, 0);
  od = __builtin_amdgcn_mfma_f32_32x32x16_bf16(pa3, PKF(l3, h3), od, 0, 0, 0);
}
__device__ __forceinline__ void pv_d0(f32x16* o, int vb, bf16x8 pa0, bf16x8 pa1, bf16x8 pa2, bf16x8 pa3) {
  pv_one<0>(o[0], vb, pa0, pa1, pa2, pa3); pv_one<1>(o[1], vb, pa0, pa1, pa2, pa3); pv_one<2>(o[2], vb, pa0, pa1, pa2, pa3); pv_one<3>(o[3], vb, pa0, pa1, pa2, pa3);
}
#define PK4(P, BASE, OUT) do { unsigned a0 = cvt_pk_bf16(P[BASE + 0], P[BASE + 1]), a1 = cvt_pk_bf16(P[BASE + 2], P[BASE + 3]);   \
    unsigned b0 = cvt_pk_bf16(P[BASE + 4], P[BASE + 5]), b1 = cvt_pk_bf16(P[BASE + 6], P[BASE + 7]);                              \
    auto r0 = __builtin_amdgcn_permlane32_swap(a0, b0, false, false); auto r1 = __builtin_amdgcn_permlane32_swap(a1, b1, false, false); \
    v4u w = {r0[0], r1[0], r0[1], r1[1]}; OUT = *reinterpret_cast<bf16x8*>(&w); } while (0)

__device__ __forceinline__ int t5_bucket(int n) {
  if (n < 16) return n;
  int b = 16;
  b += (n >= 19); b += (n >= 21); b += (n >= 24); b += (n >= 27); b += (n >= 31); b += (n >= 35); b += (n >= 40); b += (n >= 46);
  b += (n >= 52); b += (n >= 59); b += (n >= 67); b += (n >= 77); b += (n >= 87); b += (n >= 99); b += (n >= 113);
  return b;
}
constexpr float THR2 = 8.f;
template <bool FIRST>
__device__ __forceinline__ void partialSM(f32x16& p0, f32x16& p1, float& m_reg, float& alpha) {
  float pmax = p0[0];
#pragma unroll
  for (int r = 1; r < 16; ++r) pmax = fmaxf(pmax, p0[r]);
#pragma unroll
  for (int r = 0; r < 16; ++r) pmax = fmaxf(pmax, p1[r]);
  { auto rr = __builtin_amdgcn_permlane32_swap(__float_as_uint(pmax), __float_as_uint(pmax), false, false);
    pmax = fmaxf(__uint_as_float(rr[0]), __uint_as_float(rr[1])); }
  if (FIRST) { m_reg = pmax; alpha = 1.f;
#pragma unroll
    for (int r = 0; r < 16; ++r) { p0[r] = p0[r] - pmax; p1[r] = p1[r] - pmax; } }
  else if (__builtin_expect(__all(pmax <= THR2), 1)) { alpha = 1.f; }
  else { const float d = fmaxf(pmax, 0.f); alpha = __builtin_amdgcn_exp2f(-d); m_reg += d;
#pragma unroll
    for (int r = 0; r < 16; ++r) { p0[r] = p0[r] - d; p1[r] = p1[r] - d; } }
#pragma unroll
  for (int r = 0; r < 16; ++r) p0[r] = __builtin_amdgcn_exp2f(p0[r]);
}
__device__ __forceinline__ void finishSM(f32x16& p0, f32x16& p1, float alpha, float& l_reg, bf16x8& pa0, bf16x8& pa1, bf16x8& pa2, bf16x8& pa3) {
#pragma unroll
  for (int r = 0; r < 16; ++r) p1[r] = __builtin_amdgcn_exp2f(p1[r]);
  f32x2 ps2 = (f32x2){p0[0], p0[1]};
#pragma unroll
  for (int r = 2; r < 16; r += 2) ps2 += (f32x2){p0[r], p0[r + 1]};
#pragma unroll
  for (int r = 0; r < 16; r += 2) ps2 += (f32x2){p1[r], p1[r + 1]};
  float ps = ps2.x + ps2.y;
  { auto rr = __builtin_amdgcn_permlane32_swap(__float_as_uint(ps), __float_as_uint(ps), false, false);
    ps = __uint_as_float(rr[0]) + __uint_as_float(rr[1]); }
  l_reg = l_reg * alpha + ps;
  PK4(p0, 0, pa0); PK4(p0, 8, pa1); PK4(p1, 0, pa2); PK4(p1, 8, pa3);
}
__device__ __forceinline__ void qkt64(f32x16& p0, f32x16& p1, const char* Ks, const bf16x8* qr, int r32, int hi, float init) {
#pragma unroll
  for (int r = 0; r < 16; ++r) { p0[r] = init; p1[r] = init; }
#pragma unroll
  for (int d0 = 0; d0 < 4; ++d0) { const int cb = d0 * 32 + hi * 16;
    const bf16x8 b0 = *reinterpret_cast<const bf16x8*>(Ks + KSWZ64(r32, cb));
    const bf16x8 b1 = *reinterpret_cast<const bf16x8*>(Ks + KSWZ64(32 + r32, cb));
    p0 = __builtin_amdgcn_mfma_f32_32x32x16_bf16(b0, qr[d0], p0, 0, 0, 0);
    p1 = __builtin_amdgcn_mfma_f32_32x32x16_bf16(b1, qr[d0], p1, 0, 0, 0); }
}
__device__ __forceinline__ void bias_mask(f32x16& p0, f32x16& p1, const float* tab, int dbase) {
#pragma unroll
  for (int r = 0; r < 16; ++r) {
    const int d0 = dbase - ((r & 3) + 8 * (r >> 2)), d1 = d0 - 32;
    const float b0 = tab[min(max(d0, 0), 383)], b1 = tab[min(max(d1, 0), 383)];
    p0[r] = d0 >= 0 ? p0[r] + b0 : -INFINITY; p1[r] = d1 >= 0 ? p1[r] + b1 : -INFINITY;
  }
}

__device__ __forceinline__ void attn_unit(int b, int h, int qb, const bf16_t* QD, signed char* OD, const float ad_inv, const bf16_t* __restrict__ KD, const bf16_t* __restrict__ VD,
                                          const float* relb, const float* subg, float lam, char* lds, const int wave_, bf16x8& vs0, bf16x8& vs1, bf16x8& ks, const bool have0) {
  const int wid = __builtin_amdgcn_readfirstlane(wave_); int lane = lane_id(); asm volatile("" : "+v"(lane));
  const int tid = wid * 64 + lane, r32 = lane & 31, hi = lane >> 5;
  char* V_lds = lds + A_V; char* K_lds = lds + A_K;
  float* wsf = (float*)(lds + A_WS) + wid * 64; float* li_l = wsf; float* al_l = wsf + 32;
  float* tab = (float*)(lds + A_TAB);
  unsigned* stash = (unsigned*)(lds + A_ST) + wid * 2048;
  const int q0 = qb * 256; const long rowbase = (long)b * SEQ;
  if (tid < 384) tab[tid] = relb[t5_bucket(tid) * 8 + h] * LOG2E;
  const float c31 = relb[31 * 8 + h] * LOG2E;
  const int NT = 4 * (qb + 1);
  const int sr = tid >> 4, sc = (tid & 15) * 8, vst0 = v_st(sr, sc), vst1 = v_st(32 + sr, sc);
  const int kr = tid >> 3, kcb = (tid & 7) * 16, kst = KSWZ64(kr, kcb);
  const int vb0 = (int)(uintptr_t)V_lds + v_rd_base(lane);
  const int qw = q0 + wid * 32;
  f32x16 o[4];
  bf16x8 qr[4];
  for (int m = 0; m < 2; ++m) {
    const bf16_t* Kh = KD + rowbase * 1024 + h * 128 + m * 64; const bf16_t* Vh = VD + rowbase * 1024 + h * 128;
    const bf16_t* Qw = QD + (rowbase + qw + r32) * 1024 + h * 128 + m * 64 + hi * 8;
#pragma unroll
    for (int d0 = 0; d0 < 4; ++d0) qr[d0] = *reinterpret_cast<const bf16x8*>(Qw + d0 * 16);
    float m_reg = 0.f, l_reg = 0;
#pragma unroll
    for (int d = 0; d < 4; ++d)
#pragma unroll
      for (int r = 0; r < 16; ++r) o[d][r] = 0.f;
    const unsigned vo0 = (unsigned)(sr * 1024 + sc) * 2u, vo1 = vo0 + 32u * 2048u, ko = (unsigned)(kr * 1024 + (tid & 7) * 8) * 2u;
    const __amdgpu_buffer_rsrc_t rsV = __builtin_amdgcn_make_buffer_rsrc((void*)Vh, 0, SEQ * 2048, 0x00020000), rsK = __builtin_amdgcn_make_buffer_rsrc((void*)Kh, 0, SEQ * 2048, 0x00020000);
#define SLOAD(k0) do { const int so_ = (k0) * 2048; vs0 = __builtin_bit_cast(bf16x8, __builtin_amdgcn_raw_buffer_load_b128(rsV, vo0, so_, 0)); \
    vs1 = __builtin_bit_cast(bf16x8, __builtin_amdgcn_raw_buffer_load_b128(rsV, vo1, so_, 0)); ks = __builtin_bit_cast(bf16x8, __builtin_amdgcn_raw_buffer_load_b128(rsK, ko, so_, 0)); } while (0)
#define SWRITE(bb) do { *(bf16x8*)(V_lds + (bb) * SHM_V + vst0) = vs0; *(bf16x8*)(V_lds + (bb) * SHM_V + vst1) = vs1; \
    *(bf16x8*)(K_lds + (bb) * SHM_K64 + kst) = ks; } while (0)
    const int E = (qb >= 1) ? 4 * qb - 4 : -1;
    if (E >= 0) {
      f32x16 pA0, pA1, pB0, pB1; float alA, alB; bf16x8 pa0, pa1, pa2, pa3;
#define RESC(a) do { if (__any((a) < 1.f)) { if (hi == 0) al_l[r32] = (a); asm volatile("s_waitcnt lgkmcnt(0)" ::: "memory"); \
    _Pragma("unroll") for (int d = 0; d < 4; ++d) _Pragma("unroll") for (int r = 0; r < 16; ++r) o[d][r] *= al_l[crow(r, hi)]; } } while (0)
      if (m == 0 && !have0) SLOAD(0);
      SWRITE(0); SLOAD(64); __syncthreads();
      qkt64(pA0, pA1, K_lds, qr, r32, hi, c31); partialSM<true>(pA0, pA1, m_reg, alA);
      SWRITE(1); SLOAD(2 * 64); __syncthreads();
      int sK = SHM_K64, sV = 0, sW = 2;
      for (int j = 1; j + 1 <= E; j += 2) {
        SBAR(); qkt64(pB0, pB1, K_lds + sK, qr, r32, hi, c31 - m_reg);
        finishSM(pA0, pA1, alA, l_reg, pa0, pa1, pa2, pa3); SBAR();
        SWRITE(sW); SLOAD((j + 2) * 64); SBAR();
        pv_d0(o, vb0 + sV, pa0, pa1, pa2, pa3); partialSM<false>(pB0, pB1, m_reg, alB);
        RESC(alB); __syncthreads();
        sK = (sK == 2 * SHM_K64) ? 0 : sK + SHM_K64; sV = (sV == 2 * SHM_V) ? 0 : sV + SHM_V; sW = (sW == 2) ? 0 : sW + 1;
        SBAR(); qkt64(pA0, pA1, K_lds + sK, qr, r32, hi, c31 - m_reg);
        finishSM(pB0, pB1, alB, l_reg, pa0, pa1, pa2, pa3); SBAR();
        SWRITE(sW); SLOAD((j + 3) * 64); SBAR();
        pv_d0(o, vb0 + sV, pa0, pa1, pa2, pa3); partialSM<false>(pA0, pA1, m_reg, alA);
        RESC(alA); __syncthreads();
        sK = (sK == 2 * SHM_K64) ? 0 : sK + SHM_K64; sV = (sV == 2 * SHM_V) ? 0 : sV + SHM_V; sW = (sW == 2) ? 0 : sW + 1;
      }
      finishSM(pA0, pA1, alA, l_reg, pa0, pa1, pa2, pa3); SBAR();
      pv_d0(o, vb0 + sV, pa0, pa1, pa2, pa3);
      __syncthreads();
#undef RESC
    } else {
      if (m == 0 && !have0) SLOAD(0);
      SWRITE(0); SLOAD(64); __syncthreads();
    }
    for (int t = E + 1; t < NT; ++t) {
      const int bb = t % 3, bn = (t + 1) % 3;
      const bool far = (qw - 64 * t - 63) >= 128;
      if (64 * t <= qw + 31) {
      f32x16 p0, p1; float al; bf16x8 pa0, pa1, pa2, pa3;
      const bool first = (E < 0) && (t == 0);
      qkt64(p0, p1, K_lds + bb * SHM_K64, qr, r32, hi, (far ? c31 : 0.f) - (first ? 0.f : m_reg));
      if (!far) bias_mask(p0, p1, tab, qw + r32 - 64 * t - 4 * hi);
      if (first) partialSM<true>(p0, p1, m_reg, al); else partialSM<false>(p0, p1, m_reg, al);
      if (__any(al < 1.f)) { if (hi == 0) al_l[r32] = al; asm volatile("s_waitcnt lgkmcnt(0)" ::: "memory");
#pragma unroll
        for (int d = 0; d < 4; ++d)
#pragma unroll
          for (int r = 0; r < 16; ++r) o[d][r] *= al_l[crow(r, hi)]; }
      finishSM(p0, p1, al, l_reg, pa0, pa1, pa2, pa3); SBAR();
      pv_d0(o, vb0 + bb * SHM_V, pa0, pa1, pa2, pa3);
      }
      if (t + 1 < NT) { SWRITE(bn); if (t + 2 < NT) SLOAD((t + 2) * 64); }
      __syncthreads();
    }
    {
      const __amdgpu_buffer_rsrc_t rsKn = __builtin_amdgcn_make_buffer_rsrc((void*)(m == 0 ? Kh + 64 : Kh - 64), 0, SEQ * 2048, 0x00020000);
      vs0 = __builtin_bit_cast(bf16x8, __builtin_amdgcn_raw_buffer_load_b128(rsV, vo0, 0, 0)); vs1 = __builtin_bit_cast(bf16x8, __builtin_amdgcn_raw_buffer_load_b128(rsV, vo1, 0, 0));
      ks = __builtin_bit_cast(bf16x8, __builtin_amdgcn_raw_buffer_load_b128(rsKn, ko, 0, 0)); }
#undef SLOAD
#undef SWRITE
    if (hi == 0) li_l[r32] = l_reg; asm volatile("s_waitcnt lgkmcnt(0)" ::: "memory");
    float rli[16];
#pragma unroll
    for (int r = 0; r < 16; ++r) rli[r] = __builtin_amdgcn_rcpf(li_l[crow(r, hi)]);
    if (m == 0) {
#pragma unroll
      for (int d = 0; d < 4; ++d)
#pragma unroll
        for (int r = 0; r < 16; r += 2) stash[(d * 8 + (r >> 1)) * 64 + lane] = pk2(o[d][r] * rli[r], o[d][r + 1] * rli[r + 1]);
    } else {
      float ss[16];
#pragma unroll
      for (int r = 0; r < 16; ++r) ss[r] = 0.f;
#pragma unroll
      for (int d = 0; d < 4; ++d)
#pragma unroll
        for (int r = 0; r < 16; r += 2) { const unsigned w = stash[(d * 8 + (r >> 1)) * 64 + lane];
          o[d][r] = bflo(w) - lam * o[d][r] * rli[r]; o[d][r + 1] = bfhi(w) - lam * o[d][r + 1] * rli[r + 1];
          ss[r] += o[d][r] * o[d][r]; ss[r + 1] += o[d][r + 1] * o[d][r + 1]; }
#pragma unroll
      for (int off = 1; off < 32; off <<= 1)
#pragma unroll
        for (int r = 0; r < 16; ++r) ss[r] += __shfl_xor(ss[r], off);
      float gv[4];
#pragma unroll
      for (int d = 0; d < 4; ++d) gv[d] = subg[d * 32 + r32] * 0.8f;
      char* stg = (char*)stash;
#pragma unroll
      for (int r = 0; r < 16; ++r) { const float rs = 1.f / sqrtf(ss[r] * (1.f / 128.f) + LN_EPS); const int orow = crow(r, hi);
#pragma unroll
        for (int d = 0; d < 4; ++d) *(signed char*)(stg + orow * 128 + d * 32 + r32) = (signed char)(int)rintf(fminf(fmaxf(o[d][r] * rs * gv[d] * ad_inv, -127.f), 127.f)); }
      asm volatile("s_waitcnt lgkmcnt(0)" ::: "memory");
      char* Ob = (char*)OD + ((size_t)(rowbase + qw) * 1024 + h * 128) + (size_t)(lane >> 3) * 1024 + (lane & 7) * 16;
#pragma unroll
      for (int i = 0; i < 4; ++i) { const v4u v = *(const v4u*)(stg + (i * 8 + (lane >> 3)) * 128 + (lane & 7) * 16); *(v4u*)(Ob + (size_t)i * 8192) = v; }
    }
    __syncthreads();
  }
}

__device__ __forceinline__ void ret_chain(int b, int h, int j, const bf16_t* __restrict__ QR, const bf16_t* __restrict__ KR, const bf16_t* VR, bf16_t* VRo, const long omask, f32x2* gnst, char* lds, const int wave_) {
  const int wid = __builtin_amdgcn_readfirstlane(wave_); int lane = lane_id(); asm volatile("" : "+v"(lane));
  const int tid = wid * 64 + lane, r32 = lane & 31, hi = lane >> 5;
  char* KS = lds + R_KS; char* KI = lds + R_KI; char* VI = lds + R_VI; char* ST = lds + R_ST;
  const float lg = log2f(1.f - exp2f(-5.f - (float)h));
  const float c_dec = exp2f(128.f * lg);
  const long rowbase = (long)b * SEQ;
  for (int i = tid; i < 32 * R_STP / 4; i += 512) ((unsigned*)ST)[i] = 0u;
  const int sr = tid >> 4, sc = (tid & 15) * 8;
  const int vt = tid >> 2, vc = (tid & 3) * 8;
  const bf16_t* Kg = KR + rowbase * 1024 + h * 128 + sc;
  const bf16_t* Vg = VR + rowbase * 2048 + h * 256 + j * 32 + vc;
  const bf16_t* Qg = QR + (rowbase + (wid & 3) * 32 + r32) * 1024 + h * 128 + hi * 8;
  const int vbV = (int)(uintptr_t)VI + v_rd_base(lane);
  const int vbK = (int)(uintptr_t)KI + v_rd_base(lane) + (wid & 3) * 512;
  const float kd = exp2f((float)(127 - vt) * lg);
  bf16x8 kreg[4], vreg;
#pragma unroll
  for (int i = 0; i < 4; ++i) kreg[i] = *reinterpret_cast<const bf16x8*>(Kg + (long)(sr + 32 * i) * 1024);
  vreg = *reinterpret_cast<const bf16x8*>(Vg + (long)vt * 2048);
  f32x16 sacc;
#pragma unroll
  for (int r = 0; r < 16; ++r) sacc[r] = 0.f;
  bf16x8 qr[8];
#pragma unroll
  for (int d0 = 0; d0 < 8; ++d0) qr[d0] = *reinterpret_cast<const bf16x8*>(Qg + d0 * 16);
  for (int n = 0; n < SEQ / 128; ++n) {
    const long t0 = (long)n * 128;
    float lgv = lg; asm volatile("" : "+v"(lgv));
#pragma unroll
    for (int i = 0; i < 4; ++i) { const int tok = sr + 32 * i;
      *(bf16x8*)(KS + KSWZ(tok, sc * 2)) = kreg[i];
      *(bf16x8*)(KI + (i >> 1) * SHM_V + v_st(tok & 63, sc)) = kreg[i]; }
    { *(bf16x8*)(VI + (vt >> 6) * SHM_V + v_st(vt & 63, vc)) = vreg;
      bf16x8 vd;
#pragma unroll
      for (int e = 0; e < 8; ++e) vd[e] = (short)f2bf(bf2f((unsigned short)vreg[e]) * kd);
      *(bf16x8*)(VI + (vt >> 6) * SHM_V + v_st(vt & 63, 32 + vc)) = vd; }
    if (n + 1 < SEQ / 128) {
#pragma unroll
      for (int i = 0; i < 4; ++i) kreg[i] = *reinterpret_cast<const bf16x8*>(Kg + (t0 + 128 + sr + 32 * i) * 1024);
      vreg = *reinterpret_cast<const bf16x8*>(Vg + (t0 + 128 + vt) * 2048);
    }
    __syncthreads();
    if (wid < 4) {
      f32x16 acc;
#pragma unroll
      for (int r = 0; r < 16; ++r) acc[r] = 0.f;
#pragma unroll
      for (int d0 = 0; d0 < 8; ++d0) { const bf16x8 bs = *reinterpret_cast<const bf16x8*>(ST + r32 * R_STP + (16 * d0 + 8 * hi) * 2);
        acc = __builtin_amdgcn_mfma_f32_32x32x16_bf16(qr[d0], bs, acc, 0, 0, 0); }
#pragma unroll
      for (int r = 0; r < 16; ++r) acc[r] *= __builtin_amdgcn_exp2f((float)(32 * wid + crow(r, hi) + 1) * lgv);
#define RET_KB(kb) if ((kb) <= wid) { f32x16 p; _Pragma("unroll") for (int r = 0; r < 16; ++r) p[r] = 0.f; \
        _Pragma("unroll") for (int d0 = 0; d0 < 8; ++d0) { const bf16x8 kf = *reinterpret_cast<const bf16x8*>(KS + KSWZ(32 * (kb) + r32, (16 * d0 + 8 * hi) * 2)); \
          p = __builtin_amdgcn_mfma_f32_32x32x16_bf16(kf, qr[d0], p, 0, 0, 0); } \
        _Pragma("unroll") for (int r = 0; r < 16; ++r) { const int rel = 32 * (wid - (kb)) + r32 - crow(r, hi); p[r] = rel >= 0 ? p[r] * __builtin_amdgcn_exp2f((float)rel * lgv) : 0.f; } \
        bf16x8 pa0, pa1; PK4(p, 0, pa0); PK4(p, 8, pa1); \
        const s16x4 l0 = tr_read<v_rd_off(0, ((kb) & 1) * 2 + 0, 0) + ((kb) >> 1) * SHM_V>(vbV), h0 = tr_read<v_rd_off(0, ((kb) & 1) * 2 + 0, 1) + ((kb) >> 1) * SHM_V>(vbV); \
        const s16x4 l1 = tr_read<v_rd_off(0, ((kb) & 1) * 2 + 1, 0) + ((kb) >> 1) * SHM_V>(vbV), h1 = tr_read<v_rd_off(0, ((kb) & 1) * 2 + 1, 1) + ((kb) >> 1) * SHM_V>(vbV); \
        asm volatile("s_waitcnt lgkmcnt(0)" ::: "memory"); SBAR(); \
        acc = __builtin_amdgcn_mfma_f32_32x32x16_bf16(pa0, PKF(l0, h0), acc, 0, 0, 0); \
        acc = __builtin_amdgcn_mfma_f32_32x32x16_bf16(pa1, PKF(l1, h1), acc, 0, 0, 0); }
      RET_KB(0) RET_KB(1) RET_KB(2) RET_KB(3)
#undef RET_KB
      if (n + 1 < SEQ / 128) {
#pragma unroll
        for (int d0 = 0; d0 < 8; ++d0) qr[d0] = *reinterpret_cast<const bf16x8*>(Qg + (t0 + 128) * 1024 + d0 * 16);
      }
      char* stg = lds + R_OS + wid * 2048;
#pragma unroll
      for (int r = 0; r < 16; ++r) *(bf16_t*)(stg + crow(r, hi) * 64 + r32 * 2) = (bf16_t)f2bf(acc[r]);
      asm volatile("s_waitcnt lgkmcnt(0)" ::: "memory");
      { const v4u v0 = *(const v4u*)(stg + (lane >> 1) * 64 + (lane & 1) * 32), v1 = *(const v4u*)(stg + (lane >> 1) * 64 + (lane & 1) * 32 + 16);
        const long orow = rowbase + t0 + 32 * wid + (lane >> 1);
        char* Ob = (char*)(VRo + (orow & omask) * 2048 + h * 256 + j * 32) + (lane & 1) * 32;
        *(v4u*)Ob = v0; *(v4u*)(Ob + 16) = v1;
        float s1 = 0.f, s2 = 0.f;
#pragma unroll
        for (int e = 0; e < 4; ++e) { const float a0 = bflo(v0[e]), a1 = bfhi(v0[e]), a2 = bflo(v1[e]), a3 = bfhi(v1[e]);
          s1 += (a0 + a1) + (a2 + a3); s2 += (a0 * a0 + a1 * a1) + (a2 * a2 + a3 * a3); }
        s1 += __shfl_xor(s1, 1); s2 += __shfl_xor(s2, 1);
        if ((lane & 1) == 0) gnst[((size_t)j * NTOK + orow) * 8 + h] = (f32x2){s1, s2}; }
    } else {
#pragma unroll
      for (int r = 0; r < 16; ++r) sacc[r] *= c_dec;
#define RET_KS(im, ks) { const s16x4 al = tr_read<v_rd_off(1, ks, 0) + (im) * SHM_V>(vbV), ah = tr_read<v_rd_off(1, ks, 1) + (im) * SHM_V>(vbV); \
        const s16x4 bl = tr_read<v_rd_off(0, ks, 0) + (im) * SHM_V>(vbK), bh = tr_read<v_rd_off(0, ks, 1) + (im) * SHM_V>(vbK); \
        asm volatile("s_waitcnt lgkmcnt(0)" ::: "memory"); SBAR(); \
        sacc = __builtin_amdgcn_mfma_f32_32x32x16_bf16(PKF(al, ah), PKF(bl, bh), sacc, 0, 0, 0); }
      RET_KS(0, 0) RET_KS(0, 1) RET_KS(0, 2) RET_KS(0, 3) RET_KS(1, 0) RET_KS(1, 1) RET_KS(1, 2) RET_KS(1, 3)
#undef RET_KS
    }
    __syncthreads();
    if (wid >= 4) {
#pragma unroll
      for (int r = 0; r < 16; ++r) *(bf16_t*)(ST + crow(r, hi) * R_STP + (32 * (wid - 4) + r32) * 2) = (bf16_t)f2bf(sacc[r]);
    }
  }
  __syncthreads();
}
__device__ __forceinline__ bf16x8 f8_to_bf8(const unsigned long long w) { float f[8]; unpack8_fp8(w, f); v4u o;
#pragma unroll
  for (int k = 0; k < 4; ++k) o[k] = cvtpk_(f[2 * k] * (1.f / V8_SCALE), f[2 * k + 1] * (1.f / V8_SCALE));
  return __builtin_bit_cast(bf16x8, o); }
constexpr int R2_KS = 0, R2_KI = 32768, R2_VI = 65536, R2_ST = 98304, R2_OS = R2_ST + 4 * 32 * R_STP;
constexpr int RA_KI = 0, RA_VI = 32768;
__device__ __forceinline__ bf16x8 scale8(bf16x8 v, float f) { bf16x8 o;
#pragma unroll
  for (int e = 0; e < 8; ++e) o[e] = (short)f2bf(bf2f((unsigned short)v[e]) * f);
  return o; }
#define RET_KS2(sa, S, im, ks) { const s16x4 al = tr_read<v_rd_off(S, ks, 0) + (im) * SHM_V>(vbV), ah = tr_read<v_rd_off(S, ks, 1) + (im) * SHM_V>(vbV); \
        const s16x4 bl = tr_read<v_rd_off(0, ks, 0) + (im) * SHM_V>(vbK), bh = tr_read<v_rd_off(0, ks, 1) + (im) * SHM_V>(vbK); \
        asm volatile("s_waitcnt lgkmcnt(0)" ::: "memory"); SBAR(); \
        sa = __builtin_amdgcn_mfma_f32_32x32x16_bf16(PKF(al, ah), PKF(bl, bh), sa, 0, 0, 0); }
template <int S> __device__ __forceinline__ void ret_state_slice(f32x16& sa, const float c_dec, const int vbV, const int vbK) {
#pragma unroll
  for (int r = 0; r < 16; ++r) sa[r] *= c_dec;
  RET_KS2(sa, S, 0, 0) RET_KS2(sa, S, 0, 1) RET_KS2(sa, S, 0, 2) RET_KS2(sa, S, 0, 3) RET_KS2(sa, S, 1, 0) RET_KS2(sa, S, 1, 1) RET_KS2(sa, S, 1, 2) RET_KS2(sa, S, 1, 3)
}
__device__ __forceinline__ void ret_passA(int b, int h, int seg, const bf16_t* __restrict__ KR, const unsigned char* __restrict__ V8, bf16_t* Sloc, char* lds, const int wave_) {
  const int wid = __builtin_amdgcn_readfirstlane(wave_); int lane = lane_id(); asm volatile("" : "+v"(lane));
  const int tid = wid * 64 + lane;
  char* KI = lds + RA_KI; char* VI = lds + RA_VI;
  const float lg = log2f(1.f - exp2f(-5.f - (float)h));
  const float c_dec = exp2f(128.f * lg);
  const long rowbase = (long)b * SEQ + (long)seg * 1024;
  const int sr = tid >> 4, sc = (tid & 15) * 8;
  const int vtk = tid >> 5, vcl = (tid & 31) * 8;
  const bf16_t* Kg = KR + rowbase * 1024 + h * 128 + sc;
  const unsigned char* Vg = V8 + (rowbase + vtk) * 2048 + h * 256 + vcl;
  const int vbV = (int)(uintptr_t)VI + v_rd_base(lane) + (wid >> 2) * 2 * SHM_V;
  const int vbK = (int)(uintptr_t)KI + v_rd_base(lane) + (wid & 3) * 512;
  bf16x8 kreg[4]; unsigned long long vreg[8];
#pragma unroll
  for (int i = 0; i < 4; ++i) kreg[i] = *reinterpret_cast<const bf16x8*>(Kg + (long)(sr + 32 * i) * 1024);
#pragma unroll
  for (int e = 0; e < 8; ++e) vreg[e] = *reinterpret_cast<const unsigned long long*>(Vg + (long)(16 * e) * 2048);
  f32x16 sacc[4];
#pragma unroll
  for (int s = 0; s < 4; ++s)
#pragma unroll
    for (int r = 0; r < 16; ++r) sacc[s][r] = 0.f;
  for (int n = 0; n < 8; ++n) {
    const long t0 = (long)n * 128;
    float lgv = lg; asm volatile("" : "+v"(lgv));
#pragma unroll
    for (int i = 0; i < 4; ++i) { const int tok = sr + 32 * i;
      *(bf16x8*)(KI + (i >> 1) * SHM_V + v_st(tok & 63, sc)) = scale8(kreg[i], __builtin_amdgcn_exp2f((float)(127 - tok) * lgv)); }
#pragma unroll
    for (int e = 0; e < 8; ++e) { const int tok = vtk + 16 * e;
      *(bf16x8*)(VI + ((vcl >> 7) * 2 + (tok >> 6)) * SHM_V + v_st(tok & 63, vcl & 127)) = f8_to_bf8(vreg[e]); }
    if (n + 1 < 8) {
#pragma unroll
      for (int i = 0; i < 4; ++i) kreg[i] = *reinterpret_cast<const bf16x8*>(Kg + (t0 + 128 + sr + 32 * i) * 1024);
#pragma unroll
      for (int e = 0; e < 8; ++e) vreg[e] = *reinterpret_cast<const unsigned long long*>(Vg + (t0 + 128 + 16 * e) * 2048);
    }
    __syncthreads();
    ret_state_slice<0>(sacc[0], c_dec, vbV, vbK); ret_state_slice<1>(sacc[1], c_dec, vbV, vbK); ret_state_slice<2>(sacc[2], c_dec, vbV, vbK); ret_state_slice<3>(sacc[3], c_dec, vbV, vbK);
    __syncthreads();
  }
#pragma unroll
  for (int s = 0; s < 4; ++s) { const int tile = (4 * (wid >> 2) + s) * 4 + (wid & 3); v4u o0, o1;
    o0.x = pk2(sacc[s][0], sacc[s][1]); o0.y = pk2(sacc[s][2], sacc[s][3]); o0.z = pk2(sacc[s][4], sacc[s][5]); o0.w = pk2(sacc[s][6], sacc[s][7]);
    o1.x = pk2(sacc[s][8], sacc[s][9]); o1.y = pk2(sacc[s][10], sacc[s][11]); o1.z = pk2(sacc[s][12], sacc[s][13]); o1.w = pk2(sacc[s][14], sacc[s][15]);
    v4u* dst = (v4u*)(Sloc + ((size_t)tile * 64 + lane) * 16); dst[0] = o0; dst[1] = o1; }
}
template <int S> __device__ __forceinline__ void ret_out_slice(const bf16x8* qr, const bf16x8 (&pa)[4][2], const float* qdv, const char* ST, const int vbV, char* stg, unsigned char* O8row, unsigned char* oe, f32x2* gn, const int wid, int lane) {
  asm volatile("" : "+v"(lane));
  const int r32 = lane & 31, hi = lane >> 5;
  f32x16 acc;
#pragma unroll
  for (int r = 0; r < 16; ++r) acc[r] = 0.f;
#pragma unroll
  for (int d0 = 0; d0 < 8; ++d0) { const bf16x8 bs = *reinterpret_cast<const bf16x8*>(ST + (32 * S + r32) * R_STP + (16 * d0 + 8 * hi) * 2);
    acc = __builtin_amdgcn_mfma_f32_32x32x16_bf16(qr[d0], bs, acc, 0, 0, 0); }
#pragma unroll
  for (int r = 0; r < 16; ++r) acc[r] *= qdv[r];
#define RET_PV2(kb) if ((kb) <= wid) { \
    const s16x4 l0 = tr_read<v_rd_off(S, ((kb) & 1) * 2 + 0, 0) + ((kb) >> 1) * SHM_V>(vbV), h0 = tr_read<v_rd_off(S, ((kb) & 1) * 2 + 0, 1) + ((kb) >> 1) * SHM_V>(vbV); \
    const s16x4 l1 = tr_read<v_rd_off(S, ((kb) & 1) * 2 + 1, 0) + ((kb) >> 1) * SHM_V>(vbV), h1 = tr_read<v_rd_off(S, ((kb) & 1) * 2 + 1, 1) + ((kb) >> 1) * SHM_V>(vbV); \
    asm volatile("s_waitcnt lgkmcnt(0)" ::: "memory"); SBAR(); \
    acc = __builtin_amdgcn_mfma_f32_32x32x16_bf16(pa[kb][0], PKF(l0, h0), acc, 0, 0, 0); \
    acc = __builtin_amdgcn_mfma_f32_32x32x16_bf16(pa[kb][1], PKF(l1, h1), acc, 0, 0, 0); }
  RET_PV2(0) RET_PV2(1) RET_PV2(2) RET_PV2(3)
#undef RET_PV2
#pragma unroll
  for (int r = 0; r < 16; ++r) *(bf16_t*)(stg + crow(r, hi) * 64 + r32 * 2) = (bf16_t)f2bf(acc[r]);
  asm volatile("s_waitcnt lgkmcnt(0)" ::: "memory");
  { const v4u v0 = *(const v4u*)(stg + (lane >> 1) * 64 + (lane & 1) * 32), v1 = *(const v4u*)(stg + (lane >> 1) * 64 + (lane & 1) * 32 + 16);
    float a[16];
#pragma unroll
    for (int e = 0; e < 4; ++e) { a[2 * e] = bflo(v0[e]); a[2 * e + 1] = bfhi(v0[e]); a[8 + 2 * e] = bflo(v1[e]); a[8 + 2 * e + 1] = bfhi(v1[e]); }
    float mx = 0.f;
#pragma unroll
    for (int e = 0; e < 16; ++e) mx = fmaxf(mx, fabsf(a[e]));
    mx = fmaxf(mx, __shfl_xor(mx, 1));
    int eb = (int)((__float_as_uint(mx) >> 23) & 255u); if (eb < 8) eb = 0;
    const float sc = eb ? __uint_as_float((unsigned)(261 - eb) << 23) : 0.f, inv = eb ? __uint_as_float((unsigned)(eb - 7) << 23) : 0.f;
#pragma unroll
    for (int e = 0; e < 16; ++e) a[e] *= sc;
    const unsigned long long q0 = pack8_fp8(a), q1 = pack8_fp8(a + 8);
    unsigned char* Ob = (unsigned char*)O8row + (size_t)(lane >> 1) * 2048 + (lane & 1) * 16;
    *(v4u*)Ob = (v4u){(unsigned)q0, (unsigned)(q0 >> 32), (unsigned)q1, (unsigned)(q1 >> 32)};
    if ((lane & 1) == 0) oe[(size_t)(lane >> 1) * 64] = (unsigned char)eb;
    float d[16]; unpack8_fp8(q0, d); unpack8_fp8(q1, d + 8);
    float s1 = 0.f, s2 = 0.f;
#pragma unroll
    for (int e = 0; e < 16; ++e) { const float x = d[e] * inv; s1 += x; s2 += x * x; }
    s1 += __shfl_xor(s1, 1); s2 += __shfl_xor(s2, 1);
    if ((lane & 1) == 0) gn[(size_t)(lane >> 1) * 8] = (f32x2){s1, s2}; }
  asm volatile("s_waitcnt lgkmcnt(0)" ::: "memory");
}
__device__ __forceinline__ void ret_passB(int b, int h, int seg, const bf16_t* __restrict__ QR, const bf16_t* __restrict__ KR, const unsigned char* __restrict__ V8, bf16_t* VR, unsigned char* OE, const bf16_t* Sall, f32x2* gnst, char* lds, const int wave_) {
  const int wid = __builtin_amdgcn_readfirstlane(wave_);
  char* KS = lds + R2_KS; char* KI = lds + R2_KI; char* VI = lds + R2_VI; char* ST = lds + R2_ST;
  const float lg = log2f(1.f - exp2f(-5.f - (float)h));
  const float c_dec = exp2f(128.f * lg);
  const long rowbase = (long)b * SEQ + (long)seg * 1024;
#define R2_LANE() int lane = lane_id(); asm volatile("" : "+v"(lane)); const int tid = wid * 64 + lane, r32 = lane & 31, hi = lane >> 5; (void)r32; (void)hi; \
  const int sr = tid >> 4, sc = (tid & 15) * 8, vtk = tid >> 4, vcl = (tid & 15) * 8; \
  const bf16_t* Kg = KR + rowbase * 1024 + h * 128 + sc; const unsigned char* Vg = V8 + (rowbase + vtk) * 2048 + h * 256 + vcl; \
  const int vbV = (int)(uintptr_t)VI + v_rd_base(lane); const int vbK = (int)(uintptr_t)KI + v_rd_base(lane) + (wid & 3) * 512; (void)vbK;
  bf16x8 kreg[4]; unsigned long long vreg[4];
  { R2_LANE();
#pragma unroll
    for (int i = 0; i < 4; ++i) kreg[i] = *reinterpret_cast<const bf16x8*>(Kg + (long)(sr + 32 * i) * 1024);
#pragma unroll
    for (int e = 0; e < 4; ++e) vreg[e] = *reinterpret_cast<const unsigned long long*>(Vg + (long)(32 * e) * 2048); }
#define R2_STAGE_A() do { _Pragma("unroll") for (int i = 0; i < 4; ++i) { const int tok = sr + 32 * i; \
      *(bf16x8*)(KS + KSWZ(tok, sc * 2)) = kreg[i]; \
      *(bf16x8*)(KI + (i >> 1) * SHM_V + v_st(tok & 63, sc)) = scale8(kreg[i], __builtin_amdgcn_exp2f((float)(127 - tok) * lgv)); } \
    _Pragma("unroll") for (int e = 0; e < 4; ++e) { const int tok = vtk + 32 * e; *(bf16x8*)(VI + (tok >> 6) * SHM_V + v_st(tok & 63, vcl)) = f8_to_bf8(vreg[e]); } } while (0)
#define R2_STAGE_B() do { _Pragma("unroll") for (int e = 0; e < 4; ++e) { const int tok = vtk + 32 * e; *(bf16x8*)(VI + (tok >> 6) * SHM_V + v_st(tok & 63, vcl)) = f8_to_bf8(vreg[e]); } } while (0)
#define R2_PREF_A() do { if (n + 1 < 8) { _Pragma("unroll") for (int i = 0; i < 4; ++i) kreg[i] = *reinterpret_cast<const bf16x8*>(Kg + (t0 + 128 + sr + 32 * i) * 1024); } \
      _Pragma("unroll") for (int e = 0; e < 4; ++e) vreg[e] = *reinterpret_cast<const unsigned long long*>(Vg + (t0 + 32 * e) * 2048 + 128); } while (0)
#define R2_PREF_B() do { if (n + 1 < 8) { _Pragma("unroll") for (int e = 0; e < 4; ++e) vreg[e] = *reinterpret_cast<const unsigned long long*>(Vg + (t0 + 128 + 32 * e) * 2048); } } while (0)
  if (wid < 4) {
    bf16x8 qr[8];
    { R2_LANE(); const bf16_t* Qg = QR + (rowbase + wid * 32 + r32) * 1024 + h * 128 + hi * 8;
#pragma unroll
      for (int d0 = 0; d0 < 8; ++d0) qr[d0] = *reinterpret_cast<const bf16x8*>(Qg + d0 * 16); }
    char* stg = lds + R2_OS + wid * 2048;
    for (int n = 0; n < 8; ++n) {
      const long t0 = (long)n * 128;
      float lgv = lg; asm volatile("" : "+v"(lgv));
      R2_LANE();
      R2_STAGE_A(); R2_PREF_A();
      __syncthreads();
      bf16x8 pa[4][2]; float qdv[16];
      unsigned char* Orow = (unsigned char*)VR + (rowbase + t0 + 32 * wid) * 2048 + h * 256;
      unsigned char* oeb = OE + (rowbase + t0 + 32 * wid) * 64 + h * 8;
      f32x2* gn = gnst + ((size_t)(rowbase + t0 + 32 * wid)) * 8 + h;
#define RET_SC2(kb) if ((kb) <= wid) { f32x16 p; _Pragma("unroll") for (int r = 0; r < 16; ++r) p[r] = 0.f; \
        _Pragma("unroll") for (int d0 = 0; d0 < 8; ++d0) { const bf16x8 kf = *reinterpret_cast<const bf16x8*>(KS + KSWZ(32 * (kb) + r32, (16 * d0 + 8 * hi) * 2)); \
          p = __builtin_amdgcn_mfma_f32_32x32x16_bf16(kf, qr[d0], p, 0, 0, 0); } \
        _Pragma("unroll") for (int r = 0; r < 16; ++r) { const int rel = 32 * (wid - (kb)) + r32 - crow(r, hi); p[r] = rel >= 0 ? p[r] * __builtin_amdgcn_exp2f((float)rel * lgv) : 0.f; } \
        PK4(p, 0, pa[kb][0]); PK4(p, 8, pa[kb][1]); }
      RET_SC2(0) RET_SC2(1) RET_SC2(2) RET_SC2(3)
#undef RET_SC2
#pragma unroll
      for (int r = 0; r < 16; ++r) qdv[r] = __builtin_amdgcn_exp2f((float)(32 * wid + crow(r, hi) + 1) * lgv);
      ret_out_slice<0>(qr, pa, qdv, ST, vbV, stg, Orow + 0 * 32, oeb + 0, gn + (size_t)0 * NTOK * 8, wid, lane);
      ret_out_slice<1>(qr, pa, qdv, ST, vbV, stg, Orow + 1 * 32, oeb + 1, gn + (size_t)1 * NTOK * 8, wid, lane);
      ret_out_slice<2>(qr, pa, qdv, ST, vbV, stg, Orow + 2 * 32, oeb + 2, gn + (size_t)2 * NTOK * 8, wid, lane);
      ret_out_slice<3>(qr, pa, qdv, ST, vbV, stg, Orow + 3 * 32, oeb + 3, gn + (size_t)3 * NTOK * 8, wid, lane);
      __syncthreads();
      R2_STAGE_B(); R2_PREF_B();
      __syncthreads();
      ret_out_slice<0>(qr, pa, qdv, ST, vbV, stg, Orow + 4 * 32, oeb + 4, gn + (size_t)4 * NTOK * 8, wid, lane);
      ret_out_slice<1>(qr, pa, qdv, ST, vbV, stg, Orow + 5 * 32, oeb + 5, gn + (size_t)5 * NTOK * 8, wid, lane);
      ret_out_slice<2>(qr, pa, qdv, ST, vbV, stg, Orow + 6 * 32, oeb + 6, gn + (size_t)6 * NTOK * 8, wid, lane);
      ret_out_slice<3>(qr, pa, qdv, ST, vbV, stg, Orow + 7 * 32, oeb + 7, gn + (size_t)7 * NTOK * 8, wid, lane);
      if (n + 1 < 8) { const bf16_t* Qg = QR + (rowbase + wid * 32 + r32) * 1024 + h * 128 + hi * 8;
#pragma unroll
        for (int d0 = 0; d0 < 8; ++d0) qr[d0] = *reinterpret_cast<const bf16x8*>(Qg + (t0 + 128) * 1024 + d0 * 16);
      }
      __syncthreads();
    }
  } else {
    f32x16 sacc[8];
#pragma unroll
    for (int s = 0; s < 8; ++s)
#pragma unroll
      for (int r = 0; r < 16; ++r) sacc[s][r] = 0.f;
    for (int sp = 0; sp < seg; ++sp) {
      int lane = lane_id(); asm volatile("" : "+v"(lane));
      const float f = exp2f(1024.f * lg * (float)(seg - 1 - sp));
      const bf16_t* Sp = Sall + (size_t)sp * (256 * 128);
#pragma unroll
      for (int s = 0; s < 8; ++s) { const int tile = s * 4 + (wid - 4);
        const v4u* src = (const v4u*)(Sp + ((size_t)tile * 64 + lane) * 16); const v4u a0 = src[0], a1 = src[1];
#pragma unroll
        for (int k = 0; k < 4; ++k) { sacc[s][2 * k] += f * bflo(a0[k]); sacc[s][2 * k + 1] += f * bfhi(a0[k]); sacc[s][8 + 2 * k] += f * bflo(a1[k]); sacc[s][8 + 2 * k + 1] += f * bfhi(a1[k]); } }
    }
#define R2_ST_WRITE(base) do { _Pragma("unroll") for (int s = 0; s < 4; ++s) _Pragma("unroll") for (int r = 0; r < 16; ++r) \
      *(bf16_t*)(ST + (32 * s + crow(r, hi)) * R_STP + (32 * (wid - 4) + r32) * 2) = (bf16_t)f2bf(sacc[(base) + s][r]); } while (0)
    for (int n = 0; n < 8; ++n) {
      const long t0 = (long)n * 128;
      float lgv = lg; asm volatile("" : "+v"(lgv));
      R2_LANE();
      R2_STAGE_A(); R2_ST_WRITE(0); R2_PREF_A();
      __syncthreads();
      ret_state_slice<0>(sacc[0], c_dec, vbV, vbK); ret_state_slice<1>(sacc[1], c_dec, vbV, vbK); ret_state_slice<2>(sacc[2], c_dec, vbV, vbK); ret_state_slice<3>(sacc[3], c_dec, vbV, vbK);
      __syncthreads();
      R2_STAGE_B(); R2_ST_WRITE(4); R2_PREF_B();
      __syncthreads();
      ret_state_slice<0>(sacc[4], c_dec, vbV, vbK); ret_state_slice<1>(sacc[5], c_dec, vbV, vbK); ret_state_slice<2>(sacc[6], c_dec, vbV, vbK); ret_state_slice<3>(sacc[7], c_dec, vbV, vbK);
      __syncthreads();
    }
#undef R2_ST_WRITE
  }
#undef R2_LANE
#undef R2_STAGE_A
#undef R2_STAGE_B
#undef R2_PREF_A
#undef R2_PREF_B
}
#undef RET_KS2
#undef SBAR
}

__device__ __forceinline__ void gn_pass(Frame& F, unsigned char* ws, const float* gn_g, const bool dummy) {
    const int gw = F.vcu * NWAVES + F.wave, NGW = F.G * NWAVES, lane = FLANE;
    const f32x2* gnst = (const f32x2*)(ws + WS_GNST);
    f32x4 w0[4], w1[4];
#pragma unroll
    for (int i = 0; i < 4; ++i) { const int c8 = i * 64 + lane; w0[i] = *((const GAS f32x4*)gn_g + 2 * c8); w1[i] = *((const GAS f32x4*)gn_g + 2 * c8 + 1); }
    unsigned long long co[4], no[4]; unsigned ce[4], ne[4]; unsigned long long cg[4], ng[4]; f32x2 cs[8], ns[8];
#define GN_LOAD(o_, e_, g_, s_, t_) do { const GAS unsigned long long* o4 = (const GAS unsigned long long*)(ws + WS_VR + (size_t)(t_) * 2048); const GAS unsigned long long* g4 = (const GAS unsigned long long*)(ws + WS_GR + (size_t)(t_) * 2048); \
        const GAS unsigned char* e4 = (const GAS unsigned char*)(ws + WS_OE + (size_t)(t_) * 64); \
        _Pragma("unroll") for (int i = 0; i < 4; ++i) { o_[i] = o4[i * 64 + lane]; e_[i] = e4[(i * 64 + lane) >> 2]; g_[i] = g4[i * 64 + lane]; } \
        _Pragma("unroll") for (int j = 0; j < 8; ++j) s_[j] = gnst[((size_t)j * NTOK + (t_)) * 8 + (lane & 7)]; } while (0)
    int t = gw;
    if (t < NTOK) GN_LOAD(co, ce, cg, cs, t);
    while (t < NTOK) {
        const int tn = t + NGW;
        if (tn < NTOK) GN_LOAD(no, ne, ng, ns, tn);
        float mean, rstd;
        { float s = 0.f, q = 0.f;
#pragma unroll
          for (int j = 0; j < 8; ++j) { s += cs[j].x; q += cs[j].y; }
          mean = s * (1.f / 256.f); rstd = 1.f / sqrtf(fmaxf(q * (1.f / 256.f) - mean * mean, 0.f) + LN_EPS); }
        float y[4][8]; float mx = 0.f;
#pragma unroll
        for (int i = 0; i < 4; ++i) { const int c8 = i * 64 + lane, hd = c8 >> 5;
            const float mu = __shfl(mean, hd), rs = __shfl(rstd, hd);
            float of[8], gf[8]; unpack8_fp8(co[i], of); unpack8_fp8(cg[i], gf);
            { const float inv = ce[i] ? __uint_as_float((ce[i] - 7u) << 23) : 0.f;
#pragma unroll
              for (int e = 0; e < 8; ++e) of[e] *= inv; }
            const float wv[8] = {w0[i].x, w0[i].y, w0[i].z, w0[i].w, w1[i].x, w1[i].y, w1[i].z, w1[i].w};
#pragma unroll
            for (int e = 0; e < 8; ++e) { y[i][e] = gf[e] * wv[e] * (of[e] - mu) * rs; mx = fmaxf(mx, fabsf(y[i][e])); } }
#pragma unroll
        for (int o = 1; o < 64; o <<= 1) mx = fmaxf(mx, __shfl_xor(mx, o));
        const float sc = mx > 0.f ? mx * (1.f / 127.f) : 1.f, inv = 1.f / sc;
        if (!dummy) {
            GAS unsigned long long* q8 = (GAS unsigned long long*)(ws + WS_AR8 + (size_t)t * 2048);
#pragma unroll
            for (int i = 0; i < 4; ++i) { unsigned long long w = 0;
#pragma unroll
                for (int e = 0; e < 8; ++e) w |= (unsigned long long)((unsigned)((int)rintf(y[i][e] * inv) & 255)) << (8 * e);
                q8[i * 64 + lane] = w; }
            if (lane == 0) ((float*)(ws + WS_SAR))[t] = sc;
        }
#pragma unroll
        for (int i = 0; i < 4; ++i) { co[i] = no[i]; ce[i] = ne[i]; cg[i] = ng[i]; }
#pragma unroll
        for (int j = 0; j < 8; ++j) cs[j] = ns[j];
        t = tn;
    }
#undef GN_LOAD
}

#define EPI_ROWS_BEGIN const int row0 = u.pm * 256 + wr * 64 + fr; const int colw = wc * 32 + 8 * fq; \
    _Pragma("unroll") for (int ai = 0; ai < 2; ++ai) _Pragma("unroll") for (int m = 0; m < 4; ++m) { const int row = row0 + ai * 128 + m * 16; (void)row; \
    _Pragma("unroll") for (int bj = 0; bj < 2; ++bj) { float v[8]; _Pragma("unroll") for (int i = 0; i < 8; ++i) v[i] = acc[ai][bj][m][i >> 2][i & 3]; const int colt = bj * 128 + colw; (void)colt;
#define EPI_ROWS_END } }
struct EpiM { static constexpr bool PERM = true, WIDE = false, PRE = false; unsigned char* ws; int which; int dummy; float fixed_rs;
    __device__ __forceinline__ const float* rowscale_ptr(const pg8::Unit& u) const { return (const float*)(ws + WS_SAR) + u.pm * 256; }
    __device__ __forceinline__ bool fixed_rowscale() const { return which != 0; }
    __device__ __forceinline__ float fixed_rs_value() const { return fixed_rs; }
    __device__ __forceinline__ const float* colscale(const pg8::Unit& u) const { return (const float*)(ws + (which ? WS_SWDO : WS_SWRO)) + u.pn * 256; }
    __device__ __forceinline__ void operator()(const pg8::Acc& acc, const pg8::Unit& u, int wr, int wc, int fr, int fq) const {
        EPI_ROWS_BEGIN
            const int col = u.pn * 256 + colt; float g[8]; unpack8_fp8(*(const unsigned long long*)(ws + WS_GT + (size_t)row * 2048 + which * 1024 + col), g);
            bf16_t* mp = (bf16_t*)(ws + WS_M) + (size_t)row * 1024 + col;
            if (which) { float o[8]; unpack8(*(const v4u*)mp, o);
#pragma unroll
                for (int i = 0; i < 8; ++i) v[i] = o[i] + g[i] * v[i]; }
            else {
#pragma unroll
                for (int i = 0; i < 8; ++i) v[i] = g[i] * v[i]; }
            if (!dummy) { if (which) {
#pragma unroll
                    for (int i = 0; i < 8; ++i) v[i] *= M8_SCALE;
                    *(unsigned long long*)(ws + WS_M8 + (size_t)row * 1024 + col) = pack8_fp8(v); }
                else *(v4u*)mp = pack8(v); }
        EPI_ROWS_END
    } };
struct EpiZ { static constexpr bool PERM = true, WIDE = false, PRE = false; unsigned char* ws;
    __device__ __forceinline__ void operator()(const pg8::Acc& acc, const pg8::Unit& u, int wr, int wc, int fr, int fq) const {
        EPI_ROWS_BEGIN
            const int col = u.pn * 256 + colt; float x[8]; unpack8(*(const v4u*)((const bf16_t*)(ws + WS_XN) + (size_t)row * 1024 + col), x);
#pragma unroll
            for (int i = 0; i < 8; ++i) v[i] = DN_ALPHA * x[i] + v[i] * (1.f / (M8_SCALE * F8_WSCALE));
            *(v4u*)((bf16_t*)(ws + WS_Z) + (size_t)row * 1024 + col) = pack8(v);
        EPI_ROWS_END
    } };
struct EpiP5 { static constexpr bool PERM = true, WIDE = false, PRE = false; unsigned char* ws;
    __device__ __forceinline__ void operator()(const pg8::Acc& acc, const pg8::Unit& u, int wr, int wc, int fr, int fq) const {
        EPI_ROWS_BEGIN
            const int col = u.pn * 256 + colt;
            if (u.type == 0) { float* zp = (float*)(ws + WS_LOGIT) + (size_t)row * 256 + col; *(f32x4*)zp = (f32x4){v[0], v[1], v[2], v[3]}; *(f32x4*)(zp + 4) = (f32x4){v[4], v[5], v[6], v[7]}; }
            else *(v4u*)((bf16_t*)(ws + WS_BASE) + (size_t)row * 1024 + col) = pack8(v);
        EPI_ROWS_END
    } };
struct EpiP8 { static constexpr bool PERM = true, WIDE = false, PRE = false; unsigned char* ws; int dummy;
    __device__ __forceinline__ const float* rowscale_ptr(const pg8::Unit& u) const { return (const float*)(ws + M_RS) + u.grow; }
    __device__ __forceinline__ bool fixed_rowscale() const { return false; }
    __device__ __forceinline__ float fixed_rs_value() const { return 1.f; }
    __device__ __forceinline__ const float* colscale(const pg8::Unit& u) const { return u.cs; }
    __device__ __forceinline__ void operator()(const pg8::Acc& acc, const pg8::Unit& u, int wr, int wc, int fr, int fq) const {
        const int lrow0 = wr * 64 + fr, colw = wc * 32 + 8 * fq;
        if (u.type == 0) {
#pragma unroll
            for (int ai = 0; ai < 2; ++ai)
#pragma unroll
                for (int m = 0; m < 4; ++m) { const int lrow = lrow0 + ai * 128 + m * 16; float v[8];
#pragma unroll
                    for (int i = 0; i < 8; ++i) v[i] = fast_silu(acc[ai][0][m][i >> 2][i & 3]) * acc[ai][1][m][i >> 2][i & 3];
#pragma unroll
                    for (int i = 0; i < 8; ++i) v[i] *= F8_ASCALE;
                    *(unsigned long long*)(ws + WS_ACT + (size_t)(u.aux + lrow) * 256 + u.pn * 128 + colw) = pack8_fp8(v); }
        } else {
#pragma unroll
            for (int ai = 0; ai < 2; ++ai)
#pragma unroll
                for (int m = 0; m < 4; ++m)
#pragma unroll
                    for (int bj = 0; bj < 2; ++bj) { const int row = u.pm * 256 + lrow0 + ai * 128 + m * 16, col = u.pn * 256 + bj * 128 + colw;
                        bf16_t* bp = (bf16_t*)(ws + WS_BASE) + (size_t)row * 1024 + col; float o[8]; unpack8(*(const v4u*)bp, o);
#pragma unroll
                        for (int i = 0; i < 8; ++i) o[i] *= fast_sigmoid(acc[ai][bj][m][i >> 2][i & 3]);
                        if (!dummy) *(v4u*)bp = pack8(o); }
        }
    } };
struct EpiP9 { static constexpr bool PERM = true, WIDE = false, PRE = true; unsigned char* ws; int dummy;
    __device__ __forceinline__ const float* rowscale_ptr(const pg8::Unit& u) const { return (const float*)(ws + M_RASSIGN) + u.aux; }
    __device__ __forceinline__ const float* colscale(const pg8::Unit& u) const { return (const float*)(ws + M_RW) + u.aux; }
    __device__ __forceinline__ void operator()(const pg8::Acc& acc, const pg8::Unit& u, int wr, int wc, int fr, int fq, const LAS unsigned char* scl) const {
        int lrow0 = wr * 64 + fr, colw = wc * 32 + 8 * fq; asm volatile("" : "+v"(lrow0), "+v"(colw));
        if (u.type == 0) {
            int av[8]; float wv[8];
#pragma unroll
            for (int q = 0; q < 8; ++q) { const int lrow = lrow0 + (q >> 2) * 128 + (q & 3) * 16; av[q] = *(const LAS int*)(scl + 4 * lrow); wv[q] = *(const LAS float*)(scl + 1024 + 4 * lrow); }
#pragma unroll
            for (int q = 0; q < 8; ++q) { int a = av[q]; asm volatile("" : "+v"(a) :: "memory");
                if (a >= 0) { unsigned char* yp = ws + WS_Y + (size_t)a * 1024 + u.pn * 256 + colw * 2;
                    const float w16 = wv[q] * (16.f / (F8_WSCALE * F8_ASCALE)); v4u o;
#pragma unroll
                    for (int bj = 0; bj < 2; ++bj) { float v[8];
#pragma unroll
                        for (int i = 0; i < 8; ++i) v[i] = w16 * acc[q >> 2][bj][q & 3][i >> 2][i & 3];
                        int w0 = 0, w1 = 0;
                        w0 = __builtin_amdgcn_cvt_pk_fp8_f32(v[0], v[1], w0, false); w0 = __builtin_amdgcn_cvt_pk_fp8_f32(v[2], v[3], w0, true);
                        w1 = __builtin_amdgcn_cvt_pk_fp8_f32(v[4], v[5], w1, false); w1 = __builtin_amdgcn_cvt_pk_fp8_f32(v[6], v[7], w1, true);
                        o[2 * bj] = (unsigned)w0; o[2 * bj + 1] = (unsigned)w1; }
                    *(v4u*)yp = o; } }
        } else {
#pragma unroll
            for (int q = 0; q < 8; ++q) { int lrow = lrow0 + (q >> 2) * 128 + (q & 3) * 16; asm volatile("" : "+v"(lrow) :: "memory");
                bf16_t* bp = (bf16_t*)(ws + WS_BASE) + (size_t)(u.pm * 256 + lrow) * 1024 + u.pn * 256 + colw;
#pragma unroll
                for (int bj = 0; bj < 2; ++bj) { float o[8]; unpack8(*(const v4u*)(bp + bj * 128), o);
#pragma unroll
                    for (int i = 0; i < 8; ++i) o[i] += acc[q >> 2][bj][q & 3][i >> 2][i & 3] * (1.f / (F8_WSCALE * F8_ASCALE));
                    if (!dummy) *(v4u*)(bp + bj * 128) = pack8(o); } }
        }
    } };

struct P5Order {
    unsigned char* ws; int G, c, which;
    __device__ __forceinline__ bool next(int i, pg8::Unit& u) const {
        int idx = i * G + c;
        if (which == 1 && G == 256) { if (c < 128 || i >= 4) return false; idx = i * 128 + (c - 128); }
        if (which == 0) { if (idx >= 128) return false; u.pm = idx; u.pn = 0; u.type = 0; u.aux = 0; u.A = (const char*)(ws + WS_H1) + (size_t)idx * 256 * 1024 * 2; u.B = (const char*)(ws + WS_ROUT_T); u.grow = -1; return true; }
        if (idx >= 512) return false; u.pm = idx >> 2; u.pn = idx & 3; u.type = 1; u.aux = 0; u.A = (const char*)(ws + WS_PB) + (size_t)u.pm * 256 * 256 * 2; u.B = (const char*)(ws + WS_PLEW_T) + (size_t)u.pn * 256 * 256 * 2; u.grow = -1; return true;
    } };
struct P8Order {
    unsigned char* ws; int G, c, nblk;
    __device__ __forceinline__ bool next(int i, pg8::Unit& u) const {
        int idx = i * G + c; u.A = (const char*)(ws + WS_H18);
        if (idx < 2 * nblk) { const int blk = idx >> 1, e = __builtin_amdgcn_readfirstlane(((const volatile int*)(ws + M_BLKE))[blk]); u.pm = blk; u.pn = idx & 1; u.type = 0; u.aux = blk * 256; u.grow = blk * 256;
            u.B = (const char*)(ws + WS_EGU_T) + (size_t)e * (512 * 1024) + (size_t)u.pn * (256 * 1024); u.cs = (const float*)(ws + WS_SEGU) + e * 512 + u.pn * 256; return true; }
        idx -= 2 * nblk;
        if (idx < 256) { u.pm = idx >> 1; u.pn = idx & 1; u.type = 0; u.aux = SH_ACT_ROW0 + u.pm * 256; u.grow = NROWS_MAX + u.pm * 256;
            u.B = (const char*)(ws + WS_SHGU_T) + (size_t)u.pn * (256 * 1024); u.cs = (const float*)(ws + WS_SSHGU) + u.pn * 256; return true; }
        idx -= 256;
        if (idx < 512) { u.pm = idx >> 2; u.pn = idx & 3; u.type = 2; u.aux = 0; u.grow = NROWS_MAX + u.pm * 256;
            u.B = (const char*)(ws + WS_PLEG_T) + (size_t)u.pn * (256 * 1024); u.cs = (const float*)(ws + WS_SPLEG) + u.pn * 256; return true; }
        return false;
    } };
struct P9Order {
    unsigned char* ws; int G, c, nblk;
    __device__ __forceinline__ bool next(int i, pg8::Unit& u) const {
        int idx = i * G + c; u.grow = -1;
        if (idx < 4 * nblk) { const int blk = idx >> 2, e = __builtin_amdgcn_readfirstlane(((const volatile int*)(ws + M_BLKE))[blk]); u.pm = blk; u.pn = idx & 3; u.type = 0; u.aux = blk * 256;
            u.A = (const char*)(ws + WS_ACT) + (size_t)blk * (256 * 256); u.B = (const char*)(ws + ed_off(e)) + (size_t)u.pn * (256 * 256); return true; }
        idx -= 4 * nblk;
        if (idx < 512) { u.pm = idx >> 2; u.pn = idx & 3; u.type = 1; u.aux = 0;
            u.A = (const char*)(ws + WS_ACT) + (size_t)(SH_ACT_ROW0 + u.pm * 256) * 256; u.B = (const char*)(ws + WS_SHD_T) + (size_t)u.pn * (256 * 256); return true; }
        return false;
    } };

__device__ __forceinline__ void px_convert(Frame& F, const Args& a) {
    LAS float* scr = (LAS float*)(F.lds + F.wave * 16384);
    const int gw = F.vcu * NWAVES + F.wave, NGW = F.G * NWAVES; unsigned char* ws = a.ws;
    for (int it = gw; it < 256 * 128; it += NGW) { const int e = it >> 7, q = it & 127, kb = q >> 5, nb = q & 31, n0 = 32 * nb;
        p0_transpose_item_f8(a.in[I_ED] + (size_t)e * 256 * 1024, 256, 1024, ws + ed_off(e), 64 * kb, n0, n0, scr, FLANE, F8_WSCALE); }
    __syncthreads();
}
__device__ __forceinline__ void px_convert_dyn(Frame& F, const Args& a) {
    unsigned char* ws = a.ws;
    unsigned nx = 0u; if (FTID == 0) nx = __hip_atomic_fetch_add(F.ctl + CW_STEAL, 1u, RLX_AGENT);
    for (;;) {
        if (FTID == 0) F.MISC[4] = nx;
        __syncthreads();
        const int it = __builtin_amdgcn_readfirstlane((int)F.MISC[4]);
        if (it >= 256 * 16) break;
        if (FTID == 0) nx = __hip_atomic_fetch_add(F.ctl + CW_STEAL, 1u, RLX_AGENT);
        const int e = it >> 4, up = (it >> 3) & 1, n0 = 32 * (it & 7);
        quant_cols32_k1024(F.lds, a.in[up ? I_EU : I_EG] + (size_t)e * 1024 * 256, 256, n0, (signed char*)(ws + WS_EGU_T) + (size_t)e * 512 * 1024, (float*)(ws + WS_SEGU) + e * 512,
                           (n0 >> 7) * 256 + up * 128 + (n0 & 127), F.wave, FLANE);
    }
    __syncthreads();
}

__device__ __forceinline__ void route_pass(Frame& F, const Args& a, const bool dummy) {
    unsigned char* ws = a.ws; const int lane = FLANE;
    LAS unsigned* hist = (LAS unsigned*)F.lds;
    if (FTID < 256) hist[FTID] = 0u;
    __syncthreads();
    const int gw = F.vcu * NWAVES + F.wave, NGW = F.G * NWAVES;
    const f32x4 bb = ((const GAS f32x4*)a.in[I_ROUT_B])[lane];
    f32x4 xn = (f32x4){0.f, 0.f, 0.f, 0.f};
    if (gw < NTOK) xn = ((const GAS f32x4*)(ws + WS_LOGIT + (size_t)gw * 1024))[lane];
    for (int t = gw; t < NTOK; t += NGW) {
        const f32x4 x = xn;
        if (t + NGW < NTOK) xn = ((const GAS f32x4*)(ws + WS_LOGIT + (size_t)(t + NGW) * 1024))[lane];
        float sc[4], c[4];
#pragma unroll
        for (int i = 0; i < 4; ++i) { sc[i] = 1.f / (1.f + expf(-x[i])); c[i] = sc[i] + bb[i]; }
        float a1 = fmaxf(c[0], c[1]), a2 = fminf(c[0], c[1]);
#pragma unroll
        for (int i = 2; i < 4; ++i) { if (c[i] > a1) { a2 = a1; a1 = c[i]; } else if (c[i] > a2) a2 = c[i]; }
#pragma unroll
        for (int off = 1; off < 8; off <<= 1) { const float b1 = __shfl_xor(a1, off), b2 = __shfl_xor(a2, off); const float n1 = fmaxf(a1, b1), n2 = fmaxf(fminf(a1, b1), fmaxf(a2, b2)); a1 = n1; a2 = n2; }
        const float gs = a1 + a2; const int g = lane >> 3; int rank = 0;
#pragma unroll
        for (int g2 = 0; g2 < 8; ++g2) { const float o = __shfl(gs, g2 * 8); rank += (o > gs || (o == gs && g2 < g)) ? 1 : 0; }
        if (rank >= 4) { c[0] = c[1] = c[2] = c[3] = -INFINITY; }
        float sel_s = 0.f; int sel_e = 0;
#pragma unroll
        for (int k = 0; k < 8; ++k) {
            float bv = c[0]; int bi = 0;
#pragma unroll
            for (int i = 1; i < 4; ++i) if (c[i] > bv) { bv = c[i]; bi = i; }
            int be = lane * 4 + bi;
#pragma unroll
            for (int off = 1; off < 64; off <<= 1) { const float ov = __shfl_xor(bv, off); const int oe = __shfl_xor(be, off); if (ov > bv || (ov == bv && oe < be)) { bv = ov; be = oe; } }
            const int owner = be >> 2, wi = be & 3;
            float sv = wi == 0 ? sc[0] : wi == 1 ? sc[1] : wi == 2 ? sc[2] : sc[3];
            sv = __shfl(sv, owner);
            if (lane == owner) {
#pragma unroll
                for (int i = 0; i < 4; ++i) if (wi == i) c[i] = -INFINITY; }
            if (lane == k) { sel_s = sv; sel_e = be; }
        }
        float tot = lane < 8 ? sel_s : 0.f; tot = wave_sum(tot);
        if (lane < 8) { ((int*)(ws + M_IDX))[(size_t)t * 8 + lane] = sel_e; ((float*)(ws + M_W))[(size_t)t * 8 + lane] = sel_s / tot * 2.5f; atomicAdd((unsigned*)&hist[sel_e], 1u); }
    }
    __syncthreads();
    if (!dummy && FTID < 256 && hist[FTID]) __hip_atomic_fetch_add(F.ctl + CW_CNT + FTID, hist[FTID], RLX_AGENT);
    __syncthreads();
    for (int i = blockIdx.x * 512 + FTID; i < NROWS_MAX; i += F.G * 512) { ((int*)(ws + M_RASSIGN))[i] = -1; ((int*)(ws + M_RTOK))[i] = 0; ((float*)(ws + M_RW))[i] = 0.f; ((float*)(ws + M_RS))[i] = 0.f; }
    for (int i = blockIdx.x * 512 + FTID; i < NTOK; i += F.G * 512) { ((int*)(ws + M_RTOK))[NROWS_MAX + i] = i; ((float*)(ws + M_RS))[NROWS_MAX + i] = ((const float*)(ws + WS_SH1))[i]; }
}
__device__ __forceinline__ void scatter_pass(Frame& F, const Args& a) {
    unsigned char* ws = a.ws;
    LAS int* bst = (LAS int*)F.lds;
    LAS int* nbk = bst + 320;
    { const int t = FTID; if (t < NEXP) nbk[t] = (int)((__hip_atomic_load(F.ctl + CW_CNT + t, RLX_AGENT) + 255u) >> 8); }
    __syncthreads();
    if (F.wave == 0) {
        const int l = lane_id(); const int c0 = nbk[4 * l], c1 = nbk[4 * l + 1], c2 = nbk[4 * l + 2], c3 = nbk[4 * l + 3];
        int tot = c0 + c1 + c2 + c3, inc = tot;
#pragma unroll
        for (int off = 1; off < 64; off <<= 1) { const int o = __shfl_up(inc, off); if (l >= off) inc += o; }
        const int ex = inc - tot;
        bst[4 * l] = ex; bst[4 * l + 1] = ex + c0; bst[4 * l + 2] = ex + c0 + c1; bst[4 * l + 3] = ex + c0 + c1 + c2;
        if (l == 63) bst[NEXP] = inc;
    }
    __syncthreads();
    if (blockIdx.x == 0) { if (FTID < NEXP) { for (int b = bst[FTID]; b < bst[FTID + 1]; ++b) ((int*)(ws + M_BLKE))[b] = FTID; } if (FTID == 0) *(int*)(ws + M_NBLK) = bst[NEXP]; }
    for (int i = blockIdx.x * 512 + FTID; i < NTOK * 8; i += F.G * 512) {
        const int e = ((const int*)(ws + M_IDX))[i]; const unsigned rank = __hip_atomic_fetch_add(F.ctl + CW_CUR + e, 1u, RLX_AGENT);
        const int row = bst[e] * 256 + (int)rank;
        ((int*)(ws + M_RASSIGN))[row] = i; ((int*)(ws + M_RTOK))[row] = i >> 3; ((float*)(ws + M_RW))[row] = ((const float*)(ws + M_W))[i]; ((float*)(ws + M_RS))[row] = ((const float*)(ws + WS_SH1))[i >> 3];
    }
}
__device__ __forceinline__ void final_pass(Frame& F, const Args& a) {
    unsigned char* ws = a.ws; const int lane = FLANE; const int gw = F.vcu * NWAVES + F.wave, NGW = F.G * NWAVES;
    for (int t = gw; t < NTOK; t += NGW) {
        float v[16];
#pragma unroll
        for (int i = 0; i < 2; ++i) { const int c8 = lane + 64 * i; float hh[8], bs[8];
            unpack8(((const GAS v4u*)(ws + WS_H1 + (size_t)t * 2048))[c8], hh); unpack8(((const GAS v4u*)(ws + WS_BASE + (size_t)t * 2048))[c8], bs);
#pragma unroll
            for (int e = 0; e < 8; ++e) v[i * 8 + e] = DN_ALPHA * hh[e] + bs[e];
            float ys[8] = {0.f, 0.f, 0.f, 0.f, 0.f, 0.f, 0.f, 0.f};
            const int p8 = (c8 & ~31) | ((c8 & 15) << 1) | ((c8 >> 4) & 1);
#pragma unroll
            for (int k = 0; k < 8; ++k) { const unsigned long long yw = ((const GAS unsigned long long*)(ws + WS_Y + ((size_t)t * 8 + k) * 1024))[p8];
                const int w0 = (int)(unsigned)yw, w1 = (int)(unsigned)(yw >> 32);
                const auto f0 = __builtin_amdgcn_cvt_pk_f32_fp8(w0, false), f1 = __builtin_amdgcn_cvt_pk_f32_fp8(w0, true), f2 = __builtin_amdgcn_cvt_pk_f32_fp8(w1, false), f3 = __builtin_amdgcn_cvt_pk_f32_fp8(w1, true);
                ys[0] += f0[0]; ys[1] += f0[1]; ys[2] += f1[0]; ys[3] += f1[1]; ys[4] += f2[0]; ys[5] += f2[1]; ys[6] += f3[0]; ys[7] += f3[1]; }
#pragma unroll
            for (int e = 0; e < 8; ++e) v[i * 8 + e] += ys[e] * (1.f / 16.f); }
        float s = 0.f;
#pragma unroll
        for (int e = 0; e < 16; ++e) s += v[e];
        const float mean = wave_sum(s) * (1.f / DM); float q = 0.f;
#pragma unroll
        for (int e = 0; e < 16; ++e) { v[e] -= mean; q += v[e] * v[e]; }
        const float rstd = 1.f / sqrtf(wave_sum(q) * (1.f / DM) + LN_EPS);
#pragma unroll
        for (int i = 0; i < 2; ++i) { const int c8 = lane + 64 * i;
#pragma unroll
            for (int hlf = 0; hlf < 2; ++hlf) { const f32x4 gg = ((const GAS f32x4*)a.in[I_LN2_G])[c8 * 2 + hlf], bb = ((const GAS f32x4*)a.in[I_LN2_B])[c8 * 2 + hlf];
                f32x4 o; o.x = v[i * 8 + hlf * 4 + 0] * rstd * gg.x + bb.x; o.y = v[i * 8 + hlf * 4 + 1] * rstd * gg.y + bb.y; o.z = v[i * 8 + hlf * 4 + 2] * rstd * gg.z + bb.z; o.w = v[i * 8 + hlf * 4 + 3] * rstd * gg.w + bb.w;
                ((GAS f32x4*)(a.out + (size_t)t * DM))[c8 * 2 + hlf] = o; } }
    }
}

__global__ void __launch_bounds__(NWAVES * 64, 2) mega_fwd(Args args) {
    extern __shared__ __attribute__((aligned(16))) unsigned char lds[];
    Frame F;
    F.lds = (LAS unsigned char*)lds;
    F.MISC = (volatile LAS unsigned*)(F.lds + MISC_OFF);
    F.wave = __builtin_amdgcn_readfirstlane((int)threadIdx.x >> 6);
    F.G = gridDim.x; { const int bx = blockIdx.x; F.vcu = (F.G % 8 == 0) ? (bx % 8) * (F.G / 8) + bx / 8 : bx; }
    unsigned char* ws = args.ws;
    F.ctl = (gu32*)(ws + WS_CTL);
    for (int u = FTID; u < (LDS_BYTES - LDSCTL_OFF) / 4; u += NWAVES * 64) ((LAS unsigned*)(F.lds + LDSCTL_OFF))[u] = 0u;
    __syncthreads();
    XcdBarrier bar = xcd_barrier_post((unsigned*)(F.ctl + CW_BAR), F.MISC + 8);
    const int lo = args.ph_lo, hi = args.ph_hi;
#define STAMP(k) do { if (TIMING && F.wave == 0) { const unsigned long long t_ = __builtin_amdgcn_s_memrealtime(); F.MISC[16 + 2 * (k)] = (unsigned)t_; F.MISC[17 + 2 * (k)] = (unsigned)(t_ >> 32); } } while (0)
    STAMP(0);
#define IN(k) (lo <= (k) && (k) < hi)
#define GRID_BAR() xcd_barrier(bar)

    if (IN(0)) { p0_prologue(F, args); if (REP & 1) p0_prologue(F, args); GRID_BAR(); }
    STAMP(1);
    if (IN(1)) {
        pg8::DenseOrder S; S.init(ws + WS_XN8, ws + WS_WIN_T, NTOK, INCOLS, 512, F.G, (int)blockIdx.x);
        EpiInProj E{ws};
        pg8::gemm_phase<EpiInProj, pg8::DenseOrder, false, true>(F.lds, 512, S, E, nullptr, F.wave);
        if (REP & 2) pg8::gemm_phase<EpiInProj, pg8::DenseOrder, false, true>(F.lds, 512, S, E, nullptr, F.wave);
        GRID_BAR();
    }
    STAMP(2);
#if DEBUG_CHECK
    if (IN(2)) {
        const GAS v4u* src = (const GAS v4u*)(ws + WS_VR); GAS v4u* dst = (GAS v4u*)(ws + WS_DBGV);
        for (size_t i = (size_t)blockIdx.x * 512 + FTID; i < (size_t)64 * MiB / 16; i += (size_t)F.G * 512) dst[i] = src[i];
        GRID_BAR();
    }
#endif
    if (IN(2)) {
        const int bh = F.vcu >> 3, s = F.vcu & 7, b = bh >> 3, h = bh & 7;
        if (REP & 8) att::ret_chain(b, h, s, (const bf16_t*)(ws + WS_QR), (const bf16_t*)(ws + WS_KR), (const bf16_t*)(ws + WS_VR), (bf16_t*)(ws + WS_DBGV), 16383L, (f32x2*)(ws + WS_GNST), (char*)lds, F.wave);
        if (s < 7) att::ret_passA(b, h, s, (const bf16_t*)(ws + WS_KR), (const unsigned char*)(ws + WS_V8), (bf16_t*)(ws + WS_META) + (size_t)F.vcu * (256 * 128), (char*)lds, F.wave);
        GRID_BAR();
        att::ret_passB(b, h, s, (const bf16_t*)(ws + WS_QR), (const bf16_t*)(ws + WS_KR), (const unsigned char*)(ws + WS_V8), (bf16_t*)(ws + WS_VR), ws + WS_OE, (const bf16_t*)(ws + WS_META) + (size_t)(bh * 8) * (256 * 128), (f32x2*)(ws + WS_GNST), (char*)lds, F.wave);
        STAMP(3);
        float lam;
        { float d1 = 0.f, d2 = 0.f; for (int i = 0; i < 64; ++i) { d1 += args.in[I_LQ1][i] * args.in[I_LK1][i]; d2 += args.in[I_LQ2][i] * args.in[I_LK2][i]; }
          lam = expf(d1) - expf(d2) + 0.2f; }
        float gmax = 0.f; for (int i = 0; i < 128; ++i) gmax = fmaxf(gmax, fabsf(args.in[I_SUBLN_G][i]));
        const float ad_scale = fmaxf(gmax, 1e-20f) * (0.8f * 11.313708499f / 127.f), ad_inv = 1.f / ad_scale;
        bf16x8 avs0, avs1, aks;
        if (REP & 4) for (int i = 0; i < 4; ++i) {
            const int qb = (i == 0) ? 31 - s : (i == 1) ? 16 + s : (i == 2) ? 15 - s : s;
            att::attn_unit(b, h, qb, (const bf16_t*)(ws + WS_QD), (signed char*)(ws + WS_DBGV), ad_inv, (const bf16_t*)(ws + WS_KD), (const bf16_t*)(ws + WS_VD), args.in[I_RELB], args.in[I_SUBLN_G], lam, (char*)lds, F.wave, avs0, avs1, aks, i > 0);
        }
        for (int i = 0; i < 4; ++i) {
            const int qb = (i == 0) ? 31 - s : (i == 1) ? 16 + s : (i == 2) ? 15 - s : s;
            att::attn_unit(b, h, qb, (const bf16_t*)(ws + WS_QD), (signed char*)(ws + WS_AD8), ad_inv, (const bf16_t*)(ws + WS_KD), (const bf16_t*)(ws + WS_VD), args.in[I_RELB], args.in[I_SUBLN_G], lam, (char*)lds, F.wave, avs0, avs1, aks, i > 0);
            if (i == (bh & 3)) { px_convert(F, args); if (REP & 128) px_convert(F, args); }
        }
        px_convert_dyn(F, args);
        GRID_BAR();
    }
    STAMP(4);
    if (IN(3)) { if (REP & 256) gn_pass(F, ws, args.in[I_GN_G], true); gn_pass(F, ws, args.in[I_GN_G], false); GRID_BAR(); }
    STAMP(5);
    if (IN(4)) {
        pg8::DenseOrder S; S.init(ws + WS_AR8, ws + WS_WRO_T, NTOK, 1024, 1024, F.G, (int)blockIdx.x);
        EpiM E{ws, 0, 0, 0.f}; pg8::gemm_phase<EpiM, pg8::DenseOrder, false, true>(F.lds, 1024, S, E, nullptr, F.wave);
        __syncthreads();
    }
    STAMP(6);
    if (IN(5)) {
        pg8::DenseOrder S; S.init(ws + WS_AD8, ws + WS_WDO_T, NTOK, 1024, 512, F.G, (int)blockIdx.x);
        float gmax = 0.f; for (int i = 0; i < 128; ++i) gmax = fmaxf(gmax, fabsf(args.in[I_SUBLN_G][i]));
        EpiM E{ws, 1, 0, fmaxf(gmax, 1e-20f) * (0.8f * 11.313708499f / 127.f)}; pg8::gemm_phase<EpiM, pg8::DenseOrder, false, true>(F.lds, 512, S, E, nullptr, F.wave); GRID_BAR();
    }
    STAMP(7);
    if (IN(6)) {
        pg8::DenseOrder S; S.init(ws + WS_M8, ws + WS_WO_T, NTOK, 1024, 512, F.G, (int)blockIdx.x);
        EpiZ E{ws}; pg8::gemm_phase<EpiZ, pg8::DenseOrder, false, false, true>(F.lds, 512, S, E, nullptr, F.wave); GRID_BAR();
    }
    STAMP(8);
    if (IN(7)) {
        const int gw = F.vcu * NWAVES + F.wave, NGW = F.G * NWAVES;
        ln_rows_bf16_i8<true>(FLANE, ws + WS_Z, args.in[I_LN1_G], args.in[I_LN1_B], (bf16_t*)(ws + WS_H1), (signed char*)(ws + WS_H18), (float*)(ws + WS_SH1), gw, NGW, NTOK);
        GRID_BAR();
    }
    STAMP(9);
    if (IN(8)) {
        EpiP5 E{ws};
        { P5Order S{ws, F.G, F.vcu, 0}; pg8::gemm_phase<EpiP5, P5Order, false>(F.lds, 1024, S, E, nullptr, F.wave); }
        { P5Order S{ws, F.G, F.vcu, 1}; pg8::gemm_phase<EpiP5, P5Order, false>(F.lds, 256, S, E, nullptr, F.wave); }
        if (REP & 1024) { { P5Order S{ws, F.G, F.vcu, 0}; pg8::gemm_phase<EpiP5, P5Order, false>(F.lds, 1024, S, E, nullptr, F.wave); }
          { P5Order S{ws, F.G, F.vcu, 1}; pg8::gemm_phase<EpiP5, P5Order, false>(F.lds, 256, S, E, nullptr, F.wave); } }
        GRID_BAR();
    }
    STAMP(10);
    if (IN(9)) { if (REP & 16384) route_pass(F, args, true); route_pass(F, args, false); GRID_BAR(); }
    STAMP(11);
    if (IN(10)) { scatter_pass(F, args); GRID_BAR(); }
    STAMP(12);
    if (IN(11)) {
        const int nblk = __builtin_amdgcn_readfirstlane(*(const volatile int*)(ws + M_NBLK));
        P8Order S{ws, F.G, F.vcu  , nblk}; EpiP8 E{ws, 0};
        if (REP & 2048) { EpiP8 E2{ws, 1}; pg8::gemm_phase<EpiP8, P8Order, true, true>(F.lds, 512, S, E2, (const int*)(ws + M_RTOK), F.wave); }
        pg8::gemm_phase<EpiP8, P8Order, true, true>(F.lds, 512, S, E, (const int*)(ws + M_RTOK), F.wave); GRID_BAR();
    }
    STAMP(13);
    if (IN(12)) {
        const int nblk = __builtin_amdgcn_readfirstlane(*(const volatile int*)(ws + M_NBLK));
        P9Order S{ws, F.G, F.vcu, nblk}; EpiP9 E{ws, 0};
        if (REP & 4096) { EpiP9 E2{ws, 1}; pg8::gemm_phase<EpiP9, P9Order, false, false, true>(F.lds, 128, S, E2, nullptr, F.wave); }
        pg8::gemm_phase<EpiP9, P9Order, false, false, true>(F.lds, 128, S, E, nullptr, F.wave); GRID_BAR();
    }
    STAMP(14);
    if (REP & 32768) { for (int i = 0; i < 20; ++i) GRID_BAR(); }
    if (IN(13)) { final_pass(F, args); if (REP & 8192) final_pass(F, args); }
#if TIMING
    GRID_BAR(); STAMP(15);
    if (blockIdx.x == 0 && FTID == 0) {
      const unsigned long long t1 = ((unsigned long long)F.MISC[17 + 2 * T_A1] << 32) | F.MISC[16 + 2 * T_A1], t0 = ((unsigned long long)F.MISC[17 + 2 * T_A0] << 32) | F.MISC[16 + 2 * T_A0];
      args.out[0] = 10.f + (float)(t1 - t0) * 0.01f / (float)(T_SCALE); }
#endif
#undef IN
#undef GRID_BAR
}

#if DEBUG_CHECK
__device__ __forceinline__ unsigned hash_u32(unsigned x) { x ^= x >> 16; x *= 0x7feb352du; x ^= x >> 15; x *= 0x846ca68bu; x ^= x >> 16; return x; }
__device__ __forceinline__ void dbg_fail(unsigned* ctl, int stage, bool bad) { if (bad) atomicAdd(&ctl[CW_DBG + stage], 1u); }
__device__ float ref_ln_dot(const float* xrow, const float* g, const float* b, const float* W, int N, int col) {
    float s = 0.f; for (int k = 0; k < DM; ++k) s += xrow[k]; const float mean = s / DM;
    float q = 0.f; for (int k = 0; k < DM; ++k) { const float d = xrow[k] - mean; q += d * d; } const float rstd = 1.f / sqrtf(q / DM + LN_EPS);
    float acc = 0.f; for (int k = 0; k < DM; ++k) acc += ((xrow[k] - mean) * rstd * g[k] + b[k]) * W[(size_t)k * N + col];
    return acc;
}
__global__ void dbg_check(Args a) {
    unsigned* ctl = (unsigned*)(a.ws + WS_CTL); unsigned char* ws = a.ws;
    const unsigned gid = blockIdx.x * blockDim.x + threadIdx.x;
    {
        const unsigned h = hash_u32(gid * 2654435761u + 17u);
        const int row = h % NTOK; int col = (h >> 15) % INCOLS;
        const float* xrow = a.in[I_X] + (size_t)row * DM;
        int seg; int cs; size_t boff; int ld;
        if (col < 1024) { seg = 0; cs = col; boff = WS_QR; ld = 1024; } else if (col < 2048) { seg = 1; cs = col - 1024; boff = WS_KR; ld = 1024; }
        else if (col < 4096) { seg = 2; cs = col - 2048; boff = WS_VR; ld = 2048; } else if (col < 6144) { seg = 3; cs = col - 4096; boff = WS_GR; ld = 2048; }
        else if (col < 7168) { seg = 4; cs = col - 6144; boff = WS_QD; ld = 1024; } else if (col < 8192) { seg = 5; cs = col - 7168; boff = WS_KD; ld = 1024; }
        else if (col < 9216) { seg = 6; cs = col - 8192; boff = WS_VD; ld = 1024; } else { seg = 7; cs = col - 9216; boff = WS_GT; ld = 2048; }
        float e;
        if (seg <= 1) {
            const int j = cs & 63, half = (cs >> 6) & 1; const int c1 = col - half * 64, c2 = c1 + 64;
            const float t1 = ref_ln_dot(xrow, a.in[I_LNIN_G], a.in[I_LNIN_B], a.in[I_WIN], INCOLS, c1);
            const float t2 = ref_ln_dot(xrow, a.in[I_LNIN_G], a.in[I_LNIN_B], a.in[I_WIN], INCOLS, c2);
            const double theta = 1.0 / pow(10000.0, (double)j / 63.0); const double ang = (double)(row % SEQ) * theta;
            const float c = (float)cos(ang), s = (float)sin(ang);
            e = half ? (t2 * c + t1 * s) : (t1 * c - t2 * s);
            if (seg == 1) e *= KR_SCALE;
        } else {
            e = ref_ln_dot(xrow, a.in[I_LNIN_G], a.in[I_LNIN_B], a.in[I_WIN], INCOLS, col);
            if (seg == 3) e = e / (1.f + expf(-e)); else if (seg == 7) e = 1.f / (1.f + expf(-e)); else if (seg == 4) e *= QD_SCALE;
        }
        const float got = bf2f(((const bf16_t*)(ws + boff))[(size_t)row * ld + cs]);
        if (seg != 2 && seg != 3 && seg != 4)
            dbg_fail(ctl, 1, !(fabsf(got - e) <= 0.08f + 0.05f * fabsf(e)));
    }
}
__device__ float dbg_inproj(const Args& a, int row, int col) { return ref_ln_dot(a.in[I_X] + (size_t)row * DM, a.in[I_LNIN_G], a.in[I_LNIN_B], a.in[I_WIN], INCOLS, col); }
__global__ void __launch_bounds__(256) dbg_check_ret(Args a) {
    __shared__ float sc[256]; __shared__ float red[256]; __shared__ float qs[128];
    unsigned* ctl = (unsigned*)(a.ws + WS_CTL); unsigned char* ws = a.ws;
    const int tid = threadIdx.x;
    const unsigned hsh = hash_u32(blockIdx.x * 7919u + 13u);
    const int b = hsh & 1, h = (hsh >> 1) & 7; int pos = (hsh >> 4) % SEQ; if (blockIdx.x & 1) pos = pos % 700;
    const int t = b * SEQ + pos;
    const bf16_t* QR = (const bf16_t*)(ws + WS_QR); const bf16_t* KR = (const bf16_t*)(ws + WS_KR); const bf16_t* VV = (const bf16_t*)(ws + WS_DBGV);
    if (tid < 128) qs[tid] = bf2f(QR[(size_t)t * 1024 + h * 128 + tid]);
    __syncthreads();
    const float lgam = logf(1.f - exp2f(-5.f - (float)h));
    float o = 0.f;
    for (int s0 = 0; s0 <= pos; s0 += 256) {
        const int s = s0 + tid; float v = 0.f;
        if (s <= pos) { const bf16_t* kp = KR + (size_t)(b * SEQ + s) * 1024 + h * 128; float d = 0.f; for (int k = 0; k < 128; ++k) d += qs[k] * bf2f(kp[k]); v = d * expf((float)(pos - s) * lgam); }
        sc[tid] = v; __syncthreads();
        const int n = min(256, pos + 1 - s0);
        for (int i = 0; i < n; ++i) o += sc[i] * bf2f(VV[(size_t)(b * SEQ + s0 + i) * 2048 + h * 256 + tid]);
        __syncthreads();
    }
    red[tid] = o; __syncthreads(); for (int st = 128; st > 0; st >>= 1) { if (tid < st) red[tid] += red[tid + st]; __syncthreads(); }
    const float mu = red[0] / 256.f; __syncthreads();
    red[tid] = (o - mu) * (o - mu); __syncthreads(); for (int st = 128; st > 0; st >>= 1) { if (tid < st) red[tid] += red[tid + st]; __syncthreads(); }
    const float rstd = 1.f / sqrtf(red[0] / 256.f + LN_EPS);
    const float g = dbg_inproj(a, t, 4096 + h * 256 + tid);
    const float e = g / (1.f + expf(-g)) * (o - mu) * rstd * a.in[I_GN_G][h * 256 + tid];
    const float got = bf2f(((const bf16_t*)(ws + WS_GR))[(size_t)t * 2048 + h * 256 + tid]);
    dbg_fail(ctl, 2, !(fabsf(got - e) <= 0.06f + 0.06f * fabsf(e)));
}
__global__ void __launch_bounds__(256) dbg_check_att(Args a) {
    __shared__ float pr[SEQ]; __shared__ float red[256]; __shared__ float qs[128]; __shared__ float o1[128];
    unsigned* ctl = (unsigned*)(a.ws + WS_CTL); unsigned char* ws = a.ws;
    const int tid = threadIdx.x;
    const unsigned hsh = hash_u32(blockIdx.x * 104729u + 71u);
    const int b = hsh & 3, h = (hsh >> 2) & 7; int pos = (hsh >> 5) % SEQ; if ((blockIdx.x & 3) == 1) pos = pos % 300;
    const int t = b * SEQ + pos;
    const bf16_t* KD = (const bf16_t*)(ws + WS_KD); const bf16_t* VD = (const bf16_t*)(ws + WS_VD);
    if (tid < 128) qs[tid] = dbg_inproj(a, t, 6144 + h * 128 + tid) * 0.125f;
    float lam; { float d1 = 0.f, d2 = 0.f; for (int i = 0; i < 64; ++i) { d1 += a.in[I_LQ1][i] * a.in[I_LK1][i]; d2 += a.in[I_LQ2][i] * a.in[I_LK2][i]; } lam = expf(d1) - expf(d2) + 0.2f; }
    __syncthreads();
    float ov = 0.f;
    for (int m = 0; m < 2; ++m) {
        float mx = -INFINITY;
        for (int s = tid; s <= pos; s += 256) { const bf16_t* kp = KD + (size_t)(b * SEQ + s) * 1024 + h * 128 + m * 64; float d = 0.f; for (int k = 0; k < 64; ++k) d += qs[m * 64 + k] * bf2f(kp[k]);
            const int n = pos - s; int bk; if (n < 16) bk = n; else { bk = 16 + (int)(logf((float)n / 16.f) / logf(8.f) * 16.f); if (bk > 31) bk = 31; }
            d += a.in[I_RELB][bk * 8 + h]; pr[s] = d; mx = fmaxf(mx, d); }
        red[tid] = mx; __syncthreads(); for (int st = 128; st > 0; st >>= 1) { if (tid < st) red[tid] = fmaxf(red[tid], red[tid + st]); __syncthreads(); }
        mx = red[0]; __syncthreads();
        float sm = 0.f; for (int s = tid; s <= pos; s += 256) { const float p = expf(pr[s] - mx); pr[s] = p; sm += p; }
        red[tid] = sm; __syncthreads(); for (int st = 128; st > 0; st >>= 1) { if (tid < st) red[tid] += red[tid + st]; __syncthreads(); }
        sm = red[0]; __syncthreads();
        if (tid < 128) { float acc = 0.f; for (int s = 0; s <= pos; ++s) acc += pr[s] * bf2f(VD[(size_t)(b * SEQ + s) * 1024 + h * 128 + tid]); acc /= sm;
            if (m == 0) o1[tid] = acc; else ov = o1[tid] - lam * acc; }
        __syncthreads();
    }
    red[tid] = tid < 128 ? ov * ov : 0.f; __syncthreads(); for (int st = 128; st > 0; st >>= 1) { if (tid < st) red[tid] += red[tid + st]; __syncthreads(); }
    const float rs = 1.f / sqrtf(red[0] / 128.f + LN_EPS);
    if (tid < 128) { const float e = ov * rs * a.in[I_SUBLN_G][tid] * 0.8f;
        const float got = bf2f(((const bf16_t*)(ws + WS_QD))[(size_t)t * 1024 + h * 128 + tid]);
        dbg_fail(ctl, 3, !(fabsf(got - e) <= 0.06f + 0.06f * fabsf(e))); }
}
__global__ void dbg_report(Args a, int nout) {
    unsigned* ctl = (unsigned*)(a.ws + WS_CTL);
    int first = 0;
    if (ctl[CW_TMO] != 0u || ctl[CW_BAR + XB_TMO] != 0u) first = 15;
    for (int s = 14; s >= 1; --s) if (ctl[CW_DBG + s] > (s == 1 ? 16u : 64u)) first = s;
    const float c = first ? (float)(1 << first) : 0.5f;
    for (size_t i = (size_t)blockIdx.x * blockDim.x + threadIdx.x; i < (size_t)nout; i += (size_t)gridDim.x * blockDim.x) a.out[i] = c;
}
#endif

extern "C" void kernel_launch(void* const* d_in, const int* in_sizes, int n_in, void* d_out, int out_size, void* d_ws, size_t ws_size, hipStream_t stream) {
    static int grid = 0;
    if (grid == 0) {
        if (n_in != 29 || in_sizes[0] != NTOK * DM || out_size != NTOK * DM || ws_size < WS_END) {
            fprintf(stderr, "kernel_launch: unexpected shapes: n_in %d in0 %d out %d ws %zu (need >= %zu)\n", n_in, n_in > 0 ? in_sizes[0] : -1, out_size, ws_size, (size_t)WS_END); grid = -1; return; }
        int dev = 0, cus = 0;
        if (hipGetDevice(&dev) != hipSuccess || hipDeviceGetAttribute(&cus, hipDeviceAttributeMultiprocessorCount, dev) != hipSuccess) { grid = -1; return; }
        if (hipFuncSetAttribute((const void*)mega_fwd, hipFuncAttributeMaxDynamicSharedMemorySize, LDS_BYTES) != hipSuccess) { fprintf(stderr, "kernel_launch: hipFuncSetAttribute failed\n"); grid = -1; return; }
        int per_cu = 0;
        if (hipOccupancyMaxActiveBlocksPerMultiprocessor(&per_cu, (const void*)mega_fwd, NWAVES * 64, LDS_BYTES) != hipSuccess || per_cu < 1)
            fprintf(stderr, "kernel_launch: occupancy query says %d\n", per_cu);
        (void)hipGetLastError();
        grid = cus;
        if (grid != 256) fprintf(stderr, "kernel_launch: %d CUs (expected 256)\n", grid);
    }
    if (grid < 0) return;
    (void)hipMemsetAsync((char*)d_ws + WS_CTL, 0, CTL_ZERO_BYTES, stream);
    Args a{};
    for (int i = 0; i < 29; ++i) a.in[i] = (const float*)d_in[i];
    a.out = (float*)d_out; a.ws = (unsigned char*)d_ws; a.ph_lo = 0; a.ph_hi = DEBUG_CHECK ? 4 : 100;
    hipLaunchKernelGGL(mega_fwd, dim3(grid), dim3(NWAVES * 64), LDS_BYTES, stream, a);
#if DEBUG_CHECK
    hipLaunchKernelGGL(dbg_check, dim3(256), dim3(256), 0, stream, a);
    hipLaunchKernelGGL(dbg_check_ret, dim3(512), dim3(256), 0, stream, a);
    hipLaunchKernelGGL(dbg_check_att, dim3(512), dim3(256), 0, stream, a);
    hipLaunchKernelGGL(dbg_report, dim3(1024), dim3(256), 0, stream, a, out_size);
#endif
}
```

```cpp
#include <hip/hip_runtime.h>
#include <hip/hip_bf16.h>
#include <cstdio>
#include <cstdint>

#ifndef DEBUG_CHECK
#define DEBUG_CHECK 0
#endif
#ifndef REP
#define REP 0
#endif
#ifndef TIMING
#define TIMING 0
#endif
#ifndef T_A0
#define T_A0 3
#define T_A1 4
#define T_SCALE 15
#endif

constexpr int NTOK = 32768, DM = 1024, SEQ = 8192, NBATCH = 4, PLE = 256;
constexpr int INCOLS = 11264;
constexpr int NEXP = 256, TOPK = 8, DEXP = 256;
constexpr float LN_EPS = 1e-5f;
constexpr float DN_ALPHA = 1.189207115002721f;
constexpr float LOG2E = 1.4426950408889634f;
constexpr float QD_SCALE = 0.125f * LOG2E;
constexpr float KR_SCALE = 0.08838834764831845f;

constexpr size_t MiB = 1u << 20;
constexpr size_t WS_CTL = 0, CTL_ZERO_BYTES = 1 * MiB;
constexpr size_t WS_WIN_T = 1 * MiB;
constexpr size_t WS_WRO_T = 23 * MiB;
constexpr size_t WS_WDO_T = 27 * MiB;
constexpr size_t WS_WO_T  = 29 * MiB;
constexpr size_t WS_ROUT_T = 31 * MiB;
constexpr size_t WS_PLEW_T = 31 * MiB + 512 * 1024;
constexpr size_t WS_PLEG_T = 32 * MiB;
constexpr size_t WS_SHGU_T = 34 * MiB;
constexpr size_t WS_SHD_T  = 35 * MiB;
constexpr size_t WS_XN   = 48 * MiB;
constexpr size_t WS_PB   = 112 * MiB;
constexpr size_t WS_QR   = 128 * MiB;
constexpr size_t WS_KR   = 192 * MiB;
constexpr size_t WS_VR   = 256 * MiB;
constexpr size_t WS_GR   = 384 * MiB;
constexpr size_t WS_QD   = 512 * MiB;
constexpr size_t WS_KD   = 576 * MiB;
constexpr size_t WS_VD   = 640 * MiB;
constexpr size_t WS_GT   = 704 * MiB;
constexpr size_t WS_M    = 192 * MiB;
constexpr size_t WS_GNST = 896 * MiB;
constexpr size_t WS_Z    = 256 * MiB;
constexpr size_t WS_H1   = 320 * MiB;
constexpr size_t WS_LOGIT = 48 * MiB;
constexpr size_t WS_META = 1008 * MiB;
constexpr size_t WS_EGU_T = 768 * MiB;
constexpr size_t WS_ED_A  = 448 * MiB, WS_ED_B = 912 * MiB;
constexpr size_t WS_ACT  = 112 * MiB;
constexpr size_t WS_BASE = 384 * MiB;
constexpr size_t WS_Y    = 512 * MiB;
constexpr size_t WS_END  = 1024 * MiB;
constexpr size_t WS_DBGV = 912 * MiB;
constexpr size_t WS_XN8 = 912 * MiB;
constexpr size_t WS_SXN = 944 * MiB;
constexpr size_t WS_SWIN = 36 * MiB;
constexpr size_t WS_SH1 = 37 * MiB;
constexpr size_t WS_SEGU = 38 * MiB;
constexpr size_t WS_SSHGU = 39 * MiB;
constexpr size_t WS_SPLEG = 39 * MiB + 4096;
constexpr size_t WS_SWRO = 39 * MiB + 16384;
constexpr size_t WS_H18 = 80 * MiB;
constexpr size_t WS_SAR = 40 * MiB;
constexpr size_t WS_SWDO = 39 * MiB + 32768;
constexpr size_t WS_AD8 = 976 * MiB;
constexpr size_t WS_AR8 = 128 * MiB;
constexpr int NROWS_MAX = 1280 * 256;
constexpr int SH_ACT_ROW0 = NROWS_MAX;
constexpr size_t M_IDX = WS_META, M_W = WS_META + 1 * MiB, M_RASSIGN = WS_META + 2 * MiB, M_RTOK = WS_META + 4 * MiB, M_RW = WS_META + 6 * MiB,
                 M_RS = WS_META + 10 * MiB, M_BLKE = WS_META + 8 * MiB, M_NBLK = WS_META + 8 * MiB + 65536, M_IDENT = WS_META + 9 * MiB;

constexpr int CW_TMO = 0, CW_CODE = 1;
constexpr int CW_TS = 512;
constexpr int CW_DBG = 64;
constexpr int CW_BAR = 4096;
constexpr int CW_STEAL = 480;
constexpr int CW_CNT = 16384;
constexpr int CW_CUR = 16384 + 256;

constexpr int RING_BYTES = 131072;
constexpr int LDSCTL_OFF = 147456 - 1024, MISC_OFF = LDSCTL_OFF + 320;
constexpr int LDS_BYTES = 147456;
constexpr int NWAVES = 8;
constexpr float F8_WSCALE = 64.f, F8_ASCALE = 16.f;

__host__ __device__ __forceinline__ size_t ed_off(int e) { return WS_ED_B + (size_t)e * (1024 * 256); }
constexpr size_t WS_V8 = WS_ED_A;
constexpr float V8_SCALE = 16.f;
constexpr size_t WS_M8 = 320 * MiB;
constexpr float M8_SCALE = 16.f, B8_SCALE = 16.f;
#define GAS __attribute__((address_space(1)))
#define LAS __attribute__((address_space(3)))
typedef unsigned short bf16_t;
typedef unsigned v4u __attribute__((ext_vector_type(4)));
typedef float f32x4 __attribute__((ext_vector_type(4)));
typedef float f32x2 __attribute__((ext_vector_type(2)));
typedef int i32x4 __attribute__((ext_vector_type(4)));
typedef int i32x8 __attribute__((ext_vector_type(8)));
typedef short bf16x8 __attribute__((ext_vector_type(8)));
typedef GAS unsigned gu32;
#define RLX_AGENT __ATOMIC_RELAXED, __HIP_MEMORY_SCOPE_AGENT
#define LDS_WAIT() asm volatile("s_waitcnt lgkmcnt(0)" ::: "memory")
#define VM_WAIT() asm volatile("s_waitcnt vmcnt(0)" ::: "memory")

__device__ __forceinline__ unsigned f2bf(float f) { unsigned u = __builtin_bit_cast(unsigned, f); return (u + 0x7fffu + ((u >> 16) & 1u)) >> 16; }
__device__ __forceinline__ unsigned pk2(float lo, float hi) { return f2bf(lo) | (f2bf(hi) << 16); }
__device__ __forceinline__ float bf2f(unsigned short b) { return __builtin_bit_cast(float, (unsigned)b << 16); }
__device__ __forceinline__ float bflo(unsigned w) { return __builtin_bit_cast(float, w << 16); }
__device__ __forceinline__ float bfhi(unsigned w) { return __builtin_bit_cast(float, w & 0xffff0000u); }
__device__ __forceinline__ unsigned cvt_pk_bf16(float lo, float hi) { unsigned r; asm volatile("v_cvt_pk_bf16_f32 %0, %1, %2" : "=v"(r) : "v"(lo), "v"(hi)); return r; }
__device__ __forceinline__ unsigned cvtpk_(float lo, float hi) { unsigned r; asm("v_cvt_pk_bf16_f32 %0, %1, %2" : "=v"(r) : "v"(lo), "v"(hi)); return r; }
__device__ __forceinline__ float fast_sigmoid(float x) { return __builtin_amdgcn_rcpf(1.f + __builtin_amdgcn_exp2f(-x * LOG2E)); }
__device__ __forceinline__ float fast_silu(float x) { return x * fast_sigmoid(x); }
__device__ __forceinline__ int lane_id() { int l; asm volatile("v_mbcnt_lo_u32_b32 %0, -1, 0\n\tv_mbcnt_hi_u32_b32 %0, -1, %0" : "=v"(l)); return l; }
__device__ __forceinline__ float wave_sum(float v) {
#pragma unroll
    for (int o = 1; o < 64; o <<= 1) v += __shfl_xor(v, o);
    return v;
}

namespace pg8 {
constexpr int BM = 256, BK = 64, HALF = 128, HTB = HALF * BK * 2, STAGE_BYTES = 8 * HTB, NXCD = 8, WGM = 8, SCL_OFF = 131072;
__host__ __device__ __forceinline__ int lds_byte(int r, int c) { const int st = (r >> 4) * 2 + (c >> 5), rr = r & 15, cc = c & 31, ob = rr * 64 + cc * 2; return st * 1024 + (ob ^ (((ob >> 9) & 1) << 5)); }
__host__ __device__ __forceinline__ void stage_rc(int b, int& R, int& C) { const int st = b / 1024, sb = b % 1024, swz = sb ^ (((sb >> 9) & 1) << 5); R = (st >> 1) * 16 + swz / 64; C = (st & 1) * 32 + (swz % 64) / 2; }
__host__ __device__ __forceinline__ int perm32(int rho) { const int n = rho >> 4, i = rho & 15; return 8 * (i >> 2) + 4 * n + (i & 3); }

struct Unit { int pm, pn, type, aux; const char* A; const char* B; int grow; const float* cs; };
__device__ __forceinline__ bool tile_order(long L, int nM, int nN, int& pm, int& pn) {
    const int nwg = nM * nN; if (L >= nwg) return false;
    int wgid = (int)L; { const int q = nwg / NXCD, r = nwg % NXCD, xcd = wgid % NXCD, off = wgid / NXCD; wgid = (xcd < r ? xcd * (q + 1) : r * (q + 1) + (xcd - r) * q) + off; }
    const int nig = WGM * nN, gid = wgid / nig, fm = gid * WGM, gsz = (nM - fm) < WGM ? (nM - fm) : WGM;
    pm = fm + ((wgid % nig) % gsz); pn = (wgid % nig) / gsz; return true;
}
struct DenseOrder {
    const char* A; const char* Bt; int nM, nN, G, c; size_t tstep; int type;
    __device__ void init(const void* A_, const void* Bt_, int M, int N, int K, int G_, int c_, int type_ = 0) { A = (const char*)A_; Bt = (const char*)Bt_; nM = M / BM; nN = N / BM; G = G_; c = c_; tstep = (size_t)BM * K * 2; type = type_; }
    __device__ __forceinline__ bool next(int i, Unit& u) const {
        int pm, pn; if (!tile_order((long)i * G + c, nM, nN, pm, pn)) return false;
        u.pm = pm; u.pn = pn; u.type = type; u.aux = 0; u.A = A + (size_t)pm * tstep; u.B = Bt + (size_t)pn * tstep; u.grow = -1; return true;
    }
};

template <class Epi, class Sched, bool GATHER, bool I8 = false, bool F8 = false>
__device__ __forceinline__ void gemm_phase(LAS unsigned char* lds, const int K, const Sched& S, const Epi& E, const int* __restrict__ rowtok, const int wave_) {
    const int wid = __builtin_amdgcn_readfirstlane(wave_), lane = lane_id(), tid = wid * 64 + lane, wr = wid >> 2, wc = wid & 3, fr = lane & 15, fq = lane >> 4;
    const int nt = K / BK;
    int RA[2], CA[2];
    unsigned voffB[2], voffAc[2][2], voffAn[2][2];
#pragma unroll
    for (int i = 0; i < 2; ++i) { int R, C; stage_rc(tid * 16 + i * 8192, R, C); const int Rb = Epi::WIDE ? (64 * (R >> 5) + perm32(R & 31)) : (Epi::PERM ? ((R & ~31) + perm32(R & 31)) : R);
        RA[i] = R; CA[i] = C; voffB[i] = (unsigned)(Rb * K + C) * 2u;
        voffAc[0][i] = voffAc[1][i] = voffAn[0][i] = voffAn[1][i] = (unsigned)(R * K + C) * 2u; }
    const size_t kstep = (size_t)(BK * 2);
    const size_t hstepB = Epi::WIDE ? (size_t)32 * K * 2 : (size_t)HALF * K * 2;
    const size_t hstepA = GATHER ? 0 : (size_t)HALF * K * 2;
    const unsigned ldsw = (unsigned)wid * 1024u;
    const int aoff = lds_byte(wr * 64 + fr, fq * 8), boff = lds_byte(wc * 32 + fr, fq * 8);
#define PG8_SA(b, h) (((b) * 2 + (h)) * HTB)
#define PG8_SB(b, h) ((4 + (b) * 2 + (h)) * HTB)
#define PG8_STAGE(bufoff, gbase, voff) do { _Pragma("unroll") for (int _i = 0; _i < 2; ++_i) \
        __builtin_amdgcn_global_load_lds((const unsigned*)((const char*)(gbase) + (voff)[_i]), (LAS unsigned*)(lds + (bufoff) + ldsw + _i * 8192), 16, 0, 0); } while (0)
#define PG8_LDA(dst, b, h) do { _Pragma("unroll") for (int m = 0; m < 4; ++m) _Pragma("unroll") for (int k = 0; k < 2; ++k) dst[m][k] = *(const LAS bf16x8*)(lds + PG8_SA(b, h) + aoff + m * 2048 + k * 1024); } while (0)
#define PG8_LDB(dst, b, h) do { _Pragma("unroll") for (int n = 0; n < 2; ++n) _Pragma("unroll") for (int k = 0; k < 2; ++k) dst[n][k] = *(const LAS bf16x8*)(lds + PG8_SB(b, h) + boff + n * 2048 + k * 1024); } while (0)
#define PG8_MMA(ai, bj, At, Bt) do { __builtin_amdgcn_s_setprio(1); _Pragma("unroll") for (int m = 0; m < 4; ++m) _Pragma("unroll") for (int n = 0; n < 2; ++n) _Pragma("unroll") for (int k = 0; k < 2; ++k) { \
        if constexpr (F8) {   \
          const i32x4 b_ = __builtin_bit_cast(i32x4, Bt[n][k]), a_ = __builtin_bit_cast(i32x4, At[m][k]); \
          acc[ai][bj][m][n] = __builtin_amdgcn_mfma_f32_16x16x32_fp8_fp8((long)(((unsigned long long)(unsigned)b_[1] << 32) | (unsigned)b_[0]), (long)(((unsigned long long)(unsigned)a_[1] << 32) | (unsigned)a_[0]), acc[ai][bj][m][n], 0, 0, 0); \
          acc[ai][bj][m][n] = __builtin_amdgcn_mfma_f32_16x16x32_fp8_fp8((long)(((unsigned long long)(unsigned)b_[3] << 32) | (unsigned)b_[2]), (long)(((unsigned long long)(unsigned)a_[3] << 32) | (unsigned)a_[2]), acc[ai][bj][m][n], 0, 0, 0); } \
        else if constexpr (I8) acc[ai][bj][m][n] = __builtin_bit_cast(f32x4, __builtin_amdgcn_mfma_i32_16x16x64_i8(__builtin_bit_cast(i32x4, Bt[n][k]), __builtin_bit_cast(i32x4, At[m][k]), __builtin_bit_cast(i32x4, acc[ai][bj][m][n]), 0, 0, 0)); \
        else acc[ai][bj][m][n] = __builtin_amdgcn_mfma_f32_16x16x32_bf16(Bt[n][k], At[m][k], acc[ai][bj][m][n], 0, 0, 0); } __builtin_amdgcn_s_setprio(0); } while (0)
#define PG8_WAIT_V(n) asm volatile("s_waitcnt vmcnt(" #n ")" ::: "memory")
#define PG8_WAIT_L(n) asm volatile("s_waitcnt lgkmcnt(" #n ")" ::: "memory")
#define PG8_BAR __builtin_amdgcn_s_barrier()
#define PG8_SCHED __builtin_amdgcn_sched_barrier(0)
#define PG8_GOFF(dst, u) do { if (GATHER) { _Pragma("unroll") for (int h = 0; h < 2; ++h) _Pragma("unroll") for (int i = 0; i < 2; ++i) { \
        const int tok = rowtok[(u).grow + h * HALF + RA[i]]; dst[h][i] = (unsigned)(tok * K + CA[i]) * 2u; } } } while (0)
    Unit cur, nxt; int ui = 0;
    if (!S.next(0, cur)) return;
    PG8_GOFF(voffAc, cur);
#define PG8_SCALES(u, buf) do { if constexpr (I8 || Epi::PRE) { const float* src_ = (wid < 4 ? E.rowscale_ptr(u) + wid * 64 : E.colscale(u) + (wid - 4) * 64) + lane; \
        __builtin_amdgcn_global_load_lds((const unsigned*)src_, (LAS unsigned*)(lds + SCL_OFF + (buf) * 2048 + wid * 256), 4, 0, 0); } } while (0)
    PG8_SCALES(cur, 0);
    f32x4 acc[2][2][4][2];
#pragma unroll
    for (int a = 0; a < 2; ++a)
#pragma unroll
        for (int b = 0; b < 2; ++b)
#pragma unroll
            for (int m = 0; m < 4; ++m)
#pragma unroll
                for (int n = 0; n < 2; ++n) acc[a][b][m][n] = (f32x4){0.f, 0.f, 0.f, 0.f};
    bf16x8 At[4][2], B0[2][2], B1[2][2];
    const char* cA = cur.A; const char* cB = cur.B;
    PG8_STAGE(PG8_SB(0, 0), cB, voffB); PG8_STAGE(PG8_SB(0, 1), cB + hstepB, voffB); PG8_STAGE(PG8_SA(0, 0), cA, voffAc[0]); PG8_STAGE(PG8_SA(0, 1), cA + hstepA, voffAc[1]);
    if (wr == 1) PG8_BAR;
    PG8_WAIT_V(2); PG8_BAR;
    PG8_STAGE(PG8_SB(1, 0), cB + kstep, voffB); PG8_STAGE(PG8_SA(1, 0), cA + kstep, voffAc[0]); PG8_STAGE(PG8_SB(1, 1), cB + hstepB + kstep, voffB);
    PG8_WAIT_V(6); PG8_BAR;
    for (;;) {
        const bool has_next = S.next(ui + 1, nxt);
        if (has_next) { PG8_GOFF(voffAn, nxt); }
        else { if (GATHER) { _Pragma("unroll") for (int h = 0; h < 2; ++h) _Pragma("unroll") for (int i = 0; i < 2; ++i) voffAn[h][i] = voffAc[h][i]; } }
        const char* nA = has_next ? nxt.A : cA; const char* nB = has_next ? nxt.B : cB;
        _Pragma("unroll 1") for (int t = 0; t < nt; t += 2) {
            const bool last = (t == nt - 2);
            const char* a1 = cA + (size_t)(t + 1) * kstep;
            const char* a2 = last ? nA : cA + (size_t)(t + 2) * kstep; const char* b2 = last ? nB : cB + (size_t)(t + 2) * kstep;
            const char* a3 = a2 + kstep; const char* b3 = b2 + kstep;
            unsigned va2[2][2];
#pragma unroll
            for (int h = 0; h < 2; ++h)
#pragma unroll
                for (int i = 0; i < 2; ++i) va2[h][i] = (GATHER && last) ? voffAn[h][i] : voffAc[h][i];
            PG8_LDB(B0, 0, 0); PG8_LDB(B1, 0, 1); PG8_SCHED; PG8_LDA(At, 0, 0); PG8_STAGE(PG8_SA(1, 1), a1 + hstepA, voffAc[1]);
            PG8_WAIT_V(8); PG8_WAIT_L(0); PG8_BAR; PG8_MMA(0, 0, At, B0); PG8_MMA(0, 1, At, B1); PG8_BAR; PG8_SCHED;
            PG8_LDA(At, 0, 1); PG8_STAGE(PG8_SB(0, 0), b2, voffB); PG8_STAGE(PG8_SB(0, 1), b2 + hstepB, voffB); PG8_STAGE(PG8_SA(0, 0), a2, va2[0]);
            PG8_WAIT_V(8); PG8_WAIT_L(0); PG8_BAR; PG8_MMA(1, 0, At, B0); PG8_MMA(1, 1, At, B1); PG8_BAR; PG8_SCHED;
            PG8_LDB(B0, 1, 0); PG8_LDB(B1, 1, 1); PG8_SCHED; PG8_LDA(At, 1, 0); PG8_STAGE(PG8_SA(0, 1), a2 + hstepA, va2[1]);
            PG8_WAIT_V(8); PG8_WAIT_L(0); PG8_BAR; PG8_MMA(0, 0, At, B0); PG8_MMA(0, 1, At, B1); PG8_BAR; PG8_SCHED;
            PG8_LDA(At, 1, 1); PG8_STAGE(PG8_SB(1, 0), b3, voffB); PG8_STAGE(PG8_SB(1, 1), b3 + hstepB, voffB); PG8_STAGE(PG8_SA(1, 0), a3, va2[0]);
            PG8_WAIT_V(8); PG8_WAIT_L(0); PG8_BAR; PG8_MMA(1, 0, At, B0); PG8_MMA(1, 1, At, B1); PG8_BAR; PG8_SCHED;
            if (t == 0 && has_next) PG8_SCALES(nxt, (ui + 1) & 1);
        }
        if (wr == 0) PG8_BAR;
        if constexpr (I8) {
            int lr0 = wr * 64 + fr, cw = wc * 32 + 8 * fq; asm volatile("" : "+v"(lr0), "+v"(cw));
            const LAS unsigned char* scl = lds + SCL_OFF + (ui & 1) * 2048;
            f32x4 csv[2][2];
#pragma unroll
            for (int bj = 0; bj < 2; ++bj)
#pragma unroll
                for (int n = 0; n < 2; ++n) csv[bj][n] = *(const LAS f32x4*)(scl + 1024 + 4 * ((Epi::WIDE ? 64 * wc + 32 * bj + 8 * fq : bj * 128 + cw) + 4 * n));
#pragma unroll
            for (int ai = 0; ai < 2; ++ai)
#pragma unroll
                for (int m = 0; m < 4; ++m) { const float rsv = E.fixed_rowscale() ? E.fixed_rs_value() : *(const LAS float*)(scl + 4 * (lr0 + ai * 128 + m * 16));
#pragma unroll
                    for (int bj = 0; bj < 2; ++bj)
#pragma unroll
                        for (int n = 0; n < 2; ++n) acc[ai][bj][m][n] = __builtin_convertvector(__builtin_bit_cast(i32x4, acc[ai][bj][m][n]), f32x4) * rsv * csv[bj][n]; }
        }
        if constexpr (Epi::PRE) E(acc, cur, wr, wc, fr, fq, lds + SCL_OFF + (ui & 1) * 2048); else E(acc, cur, wr, wc, fr, fq);
        if (!has_next) break;
#pragma unroll
        for (int a = 0; a < 2; ++a)
#pragma unroll
            for (int b = 0; b < 2; ++b)
#pragma unroll
                for (int m = 0; m < 4; ++m)
#pragma unroll
                    for (int n = 0; n < 2; ++n) acc[a][b][m][n] = (f32x4){0.f, 0.f, 0.f, 0.f};
        cur = nxt; cA = nA; cB = nB; ++ui;
        if (GATHER) { _Pragma("unroll") for (int h = 0; h < 2; ++h) _Pragma("unroll") for (int i = 0; i < 2; ++i) voffAc[h][i] = voffAn[h][i]; }
        if (wr == 1) PG8_BAR;
    }
    PG8_WAIT_V(0);
    PG8_BAR;
#undef PG8_SA
#undef PG8_SB
#undef PG8_STAGE
#undef PG8_LDA
#undef PG8_LDB
#undef PG8_MMA
#undef PG8_WAIT_V
#undef PG8_WAIT_L
#undef PG8_BAR
#undef PG8_SCHED
#undef PG8_GOFF
#undef PG8_SCALES
}
typedef f32x4 Acc[2][2][4][2];
}

#define XB_TMO      128
#define XB_XCNT(j)  (256  + 64 * (j))
#define XB_XSUB(j)  (1280 + 64 * (j))
#define XB_XGEN(j)  (2304 + 64 * (j))
#define XB_TOP      3328
#define XB_TOPGEN   3392
#define XCD_BAR_WORDS 3456
#define XB_SPIN_CAP (1u << 18)
__device__ __forceinline__ unsigned xb_ld(unsigned* p)              { return __hip_atomic_load(p, __ATOMIC_RELAXED, __HIP_MEMORY_SCOPE_AGENT); }
__device__ __forceinline__ unsigned xb_add(unsigned* p, unsigned v) { return __hip_atomic_fetch_add(p, v, __ATOMIC_RELAXED, __HIP_MEMORY_SCOPE_AGENT); }
__device__ __forceinline__ unsigned xb_xcc_id() { return (unsigned)__builtin_amdgcn_s_getreg((3 << 11) | 20) & 0xFu; }
#define XB_SPIN(cond, bar) do { unsigned _sp = 0; while (cond) { __builtin_amdgcn_s_sleep(1); \
    if ((++_sp & 255u) == 0u) { if (xb_ld(&(bar)[XB_TMO])) break; if (_sp > XB_SPIN_CAP) { atomicAdd(&(bar)[XB_TMO], 1u); break; } } } } while (0)
struct XcdBarrier { unsigned* bar; unsigned x; volatile LAS unsigned* st; };
__device__ __forceinline__ XcdBarrier xcd_barrier_post(unsigned* bar, volatile LAS unsigned* st) {
    XcdBarrier b; b.bar = bar; b.x = xb_xcc_id(); b.st = st;
    if (threadIdx.x == 0) (void)xb_add(&bar[XB_XCNT(b.x)], 1u);
    return b;
}
__device__ __forceinline__ void xcd_barrier_complete(unsigned* bar, unsigned x, unsigned& nloc, unsigned& nx) {
    const unsigned G = gridDim.x * gridDim.y * gridDim.z;
    unsigned sum, cnt, mine, sp = 0u;
    for (;;) {
        sum = 0u; cnt = 0u; mine = 0u;
#pragma unroll
        for (unsigned j = 0; j < 16; ++j) { const unsigned c = xb_ld(&bar[XB_XCNT(j)]); sum += c; cnt += (c > 0u) ? 1u : 0u; mine = (j == x) ? c : mine; }
        if (sum == G) break;
        __builtin_amdgcn_s_sleep(1);
        if ((++sp & 255u) == 0u) { if (xb_ld(&bar[XB_TMO])) break; if (sp > XB_SPIN_CAP) { atomicAdd(&bar[XB_TMO], 1u); break; } }
    }
    nloc = mine > 0u ? mine : 1u; nx = cnt > 0u ? cnt : 1u;
}
__device__ __forceinline__ void xcd_barrier(const XcdBarrier& b) {
    asm volatile("s_waitcnt vmcnt(0)" ::: "memory");
    __syncthreads();
    if (threadIdx.x == 0) {
        unsigned* bar = b.bar;
        __builtin_amdgcn_s_waitcnt(0);
        unsigned nloc = b.st[0], nx = b.st[1];
        if (nloc == 0u) { xcd_barrier_complete(bar, b.x, nloc, nx); b.st[0] = nloc; b.st[1] = nx; }
        const unsigned old = xb_add(&bar[XB_XSUB(b.x)], 1u);
        const unsigned gen = old / nloc;
        if (old + 1u == (gen + 1u) * nloc) {
            __builtin_amdgcn_fence(__ATOMIC_RELEASE, "agent");
            asm volatile("s_waitcnt vmcnt(0)" ::: "memory");
            const unsigned og = xb_add(&bar[XB_TOP], 1u);
            const unsigned tg = og / nx;
            if (og + 1u == (tg + 1u) * nx) xb_add(&bar[XB_TOPGEN], 1u);
            else XB_SPIN(xb_ld(&bar[XB_TOPGEN]) == tg, bar);
            __builtin_amdgcn_fence(__ATOMIC_ACQUIRE, "agent");
            xb_add(&bar[XB_XGEN(b.x)], 1u);
            asm volatile("s_waitcnt vmcnt(0)" ::: "memory");
        } else {
            XB_SPIN(xb_ld(&bar[XB_XGEN(b.x)]) == gen, bar);
            __builtin_amdgcn_fence(__ATOMIC_ACQUIRE, "agent");
            asm volatile("s_waitcnt vmcnt(0)" ::: "memory");
        }
    }
    __syncthreads();
}

struct Args { const float* in[29]; float* out; unsigned char* ws; int ph_lo, ph_hi; };
enum { I_X = 0, I_P, I_LNIN_G, I_LNIN_B, I_RELB, I_WIN, I_GN_G, I_LQ1, I_LK1, I_LQ2, I_LK2, I_SUBLN_G, I_WRO, I_WDO, I_WO, I_LN1_G, I_LN1_B,
       I_ROUT_W, I_ROUT_B, I_EG, I_EU, I_ED, I_SG, I_SU, I_SD, I_PLE_W, I_PLE_GW, I_LN2_G, I_LN2_B };

struct Frame {
    LAS unsigned char* lds;
    volatile LAS unsigned* MISC;
    gu32* ctl;
    int wave, vcu, G;
};
#define FTID (F.wave * 64 + lane_id())
#define FLANE (lane_id())

__device__ __forceinline__ void p0_transpose_item(const float* W, int K, int N, bf16_t* WT, int k0, int n0, int dstrow0, LAS float* scr, int lane) {
    const int cg = lane & 7, r = lane >> 3;
    f32x4 v[8];
#pragma unroll
    for (int i = 0; i < 8; ++i) v[i] = *(const f32x4*)(W + (size_t)(k0 + r + 8 * i) * N + n0 + 4 * cg);
#pragma unroll
    for (int i = 0; i < 8; ++i) { LAS float* d = scr + (r + 8 * i) * 33 + 4 * cg; d[0] = v[i].x; d[1] = v[i].y; d[2] = v[i].z; d[3] = v[i].w; }
    LDS_WAIT(); asm volatile("" ::: "memory");
    const int c = lane & 7;
#pragma unroll
    for (int j = 0; j < 4; ++j) { const int n = (lane >> 3) + 8 * j; const LAS float* s = scr + (8 * c) * 33 + n;
        v4u o; o.x = pk2(s[0 * 33], s[1 * 33]); o.y = pk2(s[2 * 33], s[3 * 33]); o.z = pk2(s[4 * 33], s[5 * 33]); o.w = pk2(s[6 * 33], s[7 * 33]);
        *(GAS v4u*)(WT + (size_t)(dstrow0 + n) * K + k0 + 8 * c) = o; }
    LDS_WAIT(); asm volatile("" ::: "memory");
}
__device__ __forceinline__ void p0_transpose_item_f8(const float* W, int K, int N, unsigned char* WT8, int k0, int n0, int dstrow0, LAS float* scr, int lane, const float scale) {
    const int cg = lane & 7, r = lane >> 3;
    f32x4 v[8];
#pragma unroll
    for (int i = 0; i < 8; ++i) v[i] = *(const f32x4*)(W + (size_t)(k0 + r + 8 * i) * N + n0 + 4 * cg);
#pragma unroll
    for (int i = 0; i < 8; ++i) { LAS float* d = scr + (r + 8 * i) * 33 + 4 * cg; d[0] = v[i].x * scale; d[1] = v[i].y * scale; d[2] = v[i].z * scale; d[3] = v[i].w * scale; }
    LDS_WAIT(); asm volatile("" ::: "memory");
    const int c = lane & 7;
#pragma unroll
    for (int j = 0; j < 4; ++j) { const int n = (lane >> 3) + 8 * j; const LAS float* s = scr + (8 * c) * 33 + n;
        int w0 = 0, w1 = 0;
        w0 = __builtin_amdgcn_cvt_pk_fp8_f32(s[0 * 33], s[1 * 33], w0, false); w0 = __builtin_amdgcn_cvt_pk_fp8_f32(s[2 * 33], s[3 * 33], w0, true);
        w1 = __builtin_amdgcn_cvt_pk_fp8_f32(s[4 * 33], s[5 * 33], w1, false); w1 = __builtin_amdgcn_cvt_pk_fp8_f32(s[6 * 33], s[7 * 33], w1, true);
        *(GAS unsigned long long*)(WT8 + (size_t)(dstrow0 + n) * K + k0 + 8 * c) = (unsigned long long)(unsigned)w0 | ((unsigned long long)(unsigned)w1 << 32); }
    LDS_WAIT(); asm volatile("" ::: "memory");
}
__host__ __device__ __forceinline__ int win_dst_row(int c) {
    if (c >= 2048) return c;
    const int sb = c & ~1023, cs = c & 1023, hd = cs >> 7, half = (cs >> 6) & 1, j = cs & 63;
    return sb + (hd >> 1) * 256 + 64 * (2 * (hd & 1) + (j >> 5)) + 32 * half + (j & 31);
}
__device__ __forceinline__ void ln_row_to_bf16(int lane, const float* xrow, const float* g, const float* b, bf16_t* orow) {
    const GAS f32x4* xr = (const GAS f32x4*)xrow + lane;
    f32x4 v[4]; float s = 0.f;
#pragma unroll
    for (int j = 0; j < 4; ++j) { v[j] = xr[64 * j]; s += (v[j].x + v[j].y) + (v[j].z + v[j].w); }
    const float mean = wave_sum(s) * (1.f / DM); float s2 = 0.f;
#pragma unroll
    for (int j = 0; j < 4; ++j) { v[j] = v[j] - mean; s2 += (v[j].x * v[j].x + v[j].y * v[j].y) + (v[j].z * v[j].z + v[j].w * v[j].w); }
    const float rstd = 1.f / sqrtf(wave_sum(s2) * (1.f / DM) + LN_EPS);
    GAS unsigned long long* o8 = (GAS unsigned long long*)orow + lane;
#pragma unroll
    for (int j = 0; j < 4; ++j) { const f32x4 gg = *((const GAS f32x4*)g + lane + 64 * j), bb = *((const GAS f32x4*)b + lane + 64 * j);
        const f32x4 y = v[j] * rstd * gg + bb;
        o8[64 * j] = (unsigned long long)pk2(y.x, y.y) | ((unsigned long long)pk2(y.z, y.w) << 32); }
}

template <bool BF16IN>
__device__ __forceinline__ void ln_row_to_bf16_i8(int lane, const void* xrow, const float* g, const float* b, bf16_t* orow, signed char* qrow, float* srow) {
    f32x4 v[4]; float s = 0.f;
#pragma unroll
    for (int j = 0; j < 4; ++j) {
        if constexpr (BF16IN) { const unsigned long long w = ((const GAS unsigned long long*)xrow)[lane + 64 * j]; v[j] = (f32x4){bflo((unsigned)w), bfhi((unsigned)w), bflo((unsigned)(w >> 32)), bfhi((unsigned)(w >> 32))}; }
        else v[j] = ((const GAS f32x4*)xrow)[lane + 64 * j];
        s += (v[j].x + v[j].y) + (v[j].z + v[j].w); }
    const float mean = wave_sum(s) * (1.f / DM); float s2 = 0.f;
#pragma unroll
    for (int j = 0; j < 4; ++j) { v[j] = v[j] - mean; s2 += (v[j].x * v[j].x + v[j].y * v[j].y) + (v[j].z * v[j].z + v[j].w * v[j].w); }
    const float rstd = 1.f / sqrtf(wave_sum(s2) * (1.f / DM) + LN_EPS);
    GAS unsigned long long* o8 = (GAS unsigned long long*)orow + lane;
    float mx = 0.f;
#pragma unroll
    for (int j = 0; j < 4; ++j) { const f32x4 gg = *((const GAS f32x4*)g + lane + 64 * j), bb = *((const GAS f32x4*)b + lane + 64 * j);
        v[j] = v[j] * rstd * gg + bb;
        o8[64 * j] = (unsigned long long)pk2(v[j].x, v[j].y) | ((unsigned long long)pk2(v[j].z, v[j].w) << 32);
        mx = fmaxf(mx, fmaxf(fmaxf(fabsf(v[j].x), fabsf(v[j].y)), fmaxf(fabsf(v[j].z), fabsf(v[j].w)))); }
#pragma unroll
    for (int o = 1; o < 64; o <<= 1) mx = fmaxf(mx, __shfl_xor(mx, o));
    const float sc = mx > 0.f ? mx * (1.f / 127.f) : 1.f, inv = 1.f / sc;
    GAS unsigned* q4 = (GAS unsigned*)qrow + lane;
#pragma unroll
    for (int j = 0; j < 4; ++j) { const int q0 = (int)rintf(v[j].x * inv), q1 = (int)rintf(v[j].y * inv), q2 = (int)rintf(v[j].z * inv), q3 = (int)rintf(v[j].w * inv);
        q4[64 * j] = (unsigned)(q0 & 255) | ((unsigned)(q1 & 255) << 8) | ((unsigned)(q2 & 255) << 16) | ((unsigned)(q3 & 255) << 24); }
    if (lane == 0) *srow = sc;
}
template <bool BF16IN>
__device__ __forceinline__ void ln_rows_bf16_i8(int lane, const void* X, const float* g, const float* b, bf16_t* O, signed char* Q, float* S, int m0, int mstep, int M) {
    f32x4 gg[4], bb[4];
#pragma unroll
    for (int j = 0; j < 4; ++j) { gg[j] = *((const GAS f32x4*)g + lane + 64 * j); bb[j] = *((const GAS f32x4*)b + lane + 64 * j); }
    f32x4 cv[4], nv[4]; unsigned long long cw[4], nw[4];
#define LN_LOAD(dv, dw, m_) do { _Pragma("unroll") for (int j = 0; j < 4; ++j) { \
        if constexpr (BF16IN) dw[j] = ((const GAS unsigned long long*)((const bf16_t*)X + (size_t)(m_) * DM))[lane + 64 * j]; \
        else dv[j] = ((const GAS f32x4*)((const float*)X + (size_t)(m_) * DM))[lane + 64 * j]; } } while (0)
    int m = m0;
    if (m < M) LN_LOAD(cv, cw, m);
    while (m < M) {
        const int mn = m + mstep;
        if (mn < M) LN_LOAD(nv, nw, mn);
        f32x4 v[4]; float s = 0.f;
#pragma unroll
        for (int j = 0; j < 4; ++j) {
            if constexpr (BF16IN) { const unsigned long long w = cw[j]; v[j] = (f32x4){bflo((unsigned)w), bfhi((unsigned)w), bflo((unsigned)(w >> 32)), bfhi((unsigned)(w >> 32))}; }
            else v[j] = cv[j];
            s += (v[j].x + v[j].y) + (v[j].z + v[j].w); }
        const float mean = wave_sum(s) * (1.f / DM); float s2 = 0.f;
#pragma unroll
        for (int j = 0; j < 4; ++j) { v[j] = v[j] - mean; s2 += (v[j].x * v[j].x + v[j].y * v[j].y) + (v[j].z * v[j].z + v[j].w * v[j].w); }
        const float rstd = 1.f / sqrtf(wave_sum(s2) * (1.f / DM) + LN_EPS);
        GAS unsigned long long* o8 = (GAS unsigned long long*)(O + (size_t)m * DM) + lane;
        float mx = 0.f;
#pragma unroll
        for (int j = 0; j < 4; ++j) {
            v[j] = v[j] * rstd * gg[j] + bb[j];
            o8[64 * j] = (unsigned long long)pk2(v[j].x, v[j].y) | ((unsigned long long)pk2(v[j].z, v[j].w) << 32);
            mx = fmaxf(mx, fmaxf(fmaxf(fabsf(v[j].x), fabsf(v[j].y)), fmaxf(fabsf(v[j].z), fabsf(v[j].w)))); }
#pragma unroll
        for (int o = 1; o < 64; o <<= 1) mx = fmaxf(mx, __shfl_xor(mx, o));
        const float sc = mx > 0.f ? mx * (1.f / 127.f) : 1.f, inv = 1.f / sc;
        GAS unsigned* q4 = (GAS unsigned*)(Q + (size_t)m * DM) + lane;
#pragma unroll
        for (int j = 0; j < 4; ++j) { const int q0 = (int)rintf(v[j].x * inv), q1 = (int)rintf(v[j].y * inv), q2 = (int)rintf(v[j].z * inv), q3 = (int)rintf(v[j].w * inv);
            q4[64 * j] = (unsigned)(q0 & 255) | ((unsigned)(q1 & 255) << 8) | ((unsigned)(q2 & 255) << 16) | ((unsigned)(q3 & 255) << 24); }
        if (lane == 0) S[m] = sc;
#pragma unroll
        for (int j = 0; j < 4; ++j) { if constexpr (BF16IN) cw[j] = nw[j]; else cv[j] = nv[j]; }
        m = mn;
    }
#undef LN_LOAD
}
template <int KP>
__device__ __forceinline__ void quant_cols32(LAS unsigned char* lds, const float* W, int N, int n0, signed char* WT, float* scl, int dst0, int wave, int lane) {
    const int t = wave * 64 + lane, cg = t & 7, rg = t >> 3;
    constexpr int PITCH = 1040, K = 1024 * KP;
    LAS float* red = (LAS float*)(lds + 32 * PITCH);
    const float* Wp = W + (size_t)(4 * rg) * N + n0 + 4 * cg;
    f32x4 v[4][4]; f32x4 mx = (f32x4){0.f, 0.f, 0.f, 0.f};
#pragma unroll 1
    for (int part = 0; part < KP; ++part) {
#pragma unroll
        for (int i = 0; i < 4; ++i)
#pragma unroll
            for (int j = 0; j < 4; ++j) v[i][j] = *(const f32x4*)(Wp + (size_t)(1024 * part + 256 * i + j) * N);
#pragma unroll
        for (int i = 0; i < 4; ++i)
#pragma unroll
            for (int j = 0; j < 4; ++j) mx = __builtin_elementwise_max(mx, __builtin_elementwise_abs(v[i][j]));
    }
#pragma unroll
    for (int off = 8; off < 64; off <<= 1)
#pragma unroll
        for (int c = 0; c < 4; ++c) mx[c] = fmaxf(mx[c], __shfl_xor(mx[c], off));
    if (lane < 8) *(LAS f32x4*)(red + wave * 32 + 4 * cg) = mx;
    __syncthreads();
    f32x4 cm = *(const LAS f32x4*)(red + 4 * cg);
#pragma unroll
    for (int w = 1; w < 8; ++w) cm = __builtin_elementwise_max(cm, *(const LAS f32x4*)(red + w * 32 + 4 * cg));
    f32x4 sc, inv;
#pragma unroll
    for (int c = 0; c < 4; ++c) { sc[c] = cm[c] > 0.f ? cm[c] * (1.f / 127.f) : 1.f; inv[c] = 1.f / sc[c]; }
    if (t < 8) *(f32x4*)(scl + dst0 + 4 * cg) = sc;
#pragma unroll 1
    for (int part = 0; part < KP; ++part) {
        if (KP > 1) {
#pragma unroll
            for (int i = 0; i < 4; ++i)
#pragma unroll
                for (int j = 0; j < 4; ++j) v[i][j] = *(const f32x4*)(Wp + (size_t)(1024 * part + 256 * i + j) * N);
        }
#pragma unroll
        for (int i = 0; i < 4; ++i)
#pragma unroll
            for (int c = 0; c < 4; ++c) { const int q0 = (int)rintf(v[i][0][c] * inv[c]), q1 = (int)rintf(v[i][1][c] * inv[c]), q2 = (int)rintf(v[i][2][c] * inv[c]), q3 = (int)rintf(v[i][3][c] * inv[c]);
                *(LAS unsigned*)(lds + (4 * cg + c) * PITCH + 256 * i + 4 * rg) = (unsigned)(q0 & 255) | ((unsigned)(q1 & 255) << 8) | ((unsigned)(q2 & 255) << 16) | ((unsigned)(q3 & 255) << 24); }
        __syncthreads();
        { const int row = t >> 4, ch = t & 15;
#pragma unroll
          for (int e = 0; e < 4; ++e) *(GAS v4u*)(WT + (size_t)(dst0 + row) * K + 1024 * part + ch * 64 + e * 16) = *(const LAS v4u*)(lds + row * PITCH + ch * 64 + e * 16); }
        __syncthreads();
    }
}
__device__ __forceinline__ void quant_cols32_k1024(LAS unsigned char* lds, const float* W, int N, int n0, signed char* WT, float* scl, int dst0, int wave, int lane) { quant_cols32<1>(lds, W, N, n0, WT, scl, dst0, wave, lane); }
__device__ __forceinline__ void p0_prologue(Frame& F, const Args& a) {
    LAS float* scr = (LAS float*)(F.lds + F.wave * 16384);
    const int gw = F.vcu * NWAVES + F.wave, NGW = F.G * NWAVES;
    unsigned char* ws = a.ws;
    constexpr int I_WINc = 0;
    constexpr int I_WROc = 0, I_WDOc = 0, I_WOc = 16 * 32, I_ROUTc = 16 * 8, I_PLEWc = 4 * 32, I_PLEGc = 0, I_SGc = 0, I_SUc = 0, I_SDc = 4 * 32;
    constexpr int NITEMS = I_WINc + I_WROc + I_WDOc + I_WOc + I_ROUTc + I_PLEWc + I_PLEGc + I_SGc + I_SUc + I_SDc;
    for (int it = gw; it < NITEMS; it += NGW) {
        int r = it; const float* W; int K, N; bf16_t* WT; int kind = 0;
        if (r < I_WINc) { W = a.in[I_WIN]; K = 1024; N = INCOLS; WT = (bf16_t*)(ws + WS_WIN_T); kind = 1; }
        else if ((r -= I_WINc) < I_WROc) { W = a.in[I_WRO]; K = 2048; N = 1024; WT = (bf16_t*)(ws + WS_WRO_T); }
        else if ((r -= I_WROc) < I_WDOc) { W = a.in[I_WDO]; K = 1024; N = 1024; WT = (bf16_t*)(ws + WS_WDO_T); }
        else if ((r -= I_WDOc) < I_WOc) { W = a.in[I_WO]; K = 1024; N = 1024; WT = (bf16_t*)(ws + WS_WO_T); }
        else if ((r -= I_WOc) < I_ROUTc) { W = a.in[I_ROUT_W]; K = 1024; N = 256; WT = (bf16_t*)(ws + WS_ROUT_T); }
        else if ((r -= I_ROUTc) < I_PLEWc) { W = a.in[I_PLE_W]; K = 256; N = 1024; WT = (bf16_t*)(ws + WS_PLEW_T); }
        else if ((r -= I_PLEWc) < I_PLEGc) { W = a.in[I_PLE_GW]; K = 1024; N = 1024; WT = (bf16_t*)(ws + WS_PLEG_T); }
        else if ((r -= I_PLEGc) < I_SGc) { W = a.in[I_SG]; K = 1024; N = 256; WT = (bf16_t*)(ws + WS_SHGU_T); kind = 2; }
        else if ((r -= I_SGc) < I_SUc) { W = a.in[I_SU]; K = 1024; N = 256; WT = (bf16_t*)(ws + WS_SHGU_T); kind = 3; }
        else { r -= I_SUc; W = a.in[I_SD]; K = 256; N = 1024; WT = (bf16_t*)(ws + WS_SHD_T); }
        const int nblk = N / 32, kb = r / nblk, nb = r % nblk, n0 = 32 * nb;
        int d0 = n0;
        if (kind == 1) d0 = win_dst_row(n0);
        else if (kind == 2) d0 = (n0 >> 7) * 256 + (n0 & 127);
        else if (kind == 3) d0 = (n0 >> 7) * 256 + 128 + (n0 & 127);
        if (W == a.in[I_SD] || W == a.in[I_WO]) p0_transpose_item_f8(W, K, N, (unsigned char*)WT, 64 * kb, n0, d0, scr, FLANE, F8_WSCALE);
        else p0_transpose_item(W, K, N, WT, 64 * kb, n0, d0, scr, FLANE);
    }
    __syncthreads();
    for (int it = F.vcu; it < 32 + INCOLS / 32 + 32 + 16 + 32; it += F.G) {
        int r = it;
        if (r < 32) { quant_cols32<2>(F.lds, a.in[I_WRO], 1024, 32 * r, (signed char*)(ws + WS_WRO_T), (float*)(ws + WS_SWRO), 32 * r, F.wave, FLANE); continue; } r -= 32;
        if (r < INCOLS / 32) { quant_cols32_k1024(F.lds, a.in[I_WIN], INCOLS, 32 * r, (signed char*)(ws + WS_WIN_T), (float*)(ws + WS_SWIN), win_dst_row(32 * r), F.wave, FLANE); continue; } r -= INCOLS / 32;
        if (r < 32) { quant_cols32_k1024(F.lds, a.in[I_WDO], 1024, 32 * r, (signed char*)(ws + WS_WDO_T), (float*)(ws + WS_SWDO), 32 * r, F.wave, FLANE); continue; } r -= 32;
        if (r < 16) { const int up = r >> 3, n0 = 32 * (r & 7); quant_cols32_k1024(F.lds, a.in[up ? I_SU : I_SG], 256, n0, (signed char*)(ws + WS_SHGU_T), (float*)(ws + WS_SSHGU), (n0 >> 7) * 256 + up * 128 + (n0 & 127), F.wave, FLANE); continue; } r -= 16;
        quant_cols32_k1024(F.lds, a.in[I_PLE_GW], 1024, 32 * r, (signed char*)(ws + WS_PLEG_T), (float*)(ws + WS_SPLEG), 32 * r, F.wave, FLANE);
    }
    ln_rows_bf16_i8<false>(FLANE, a.in[I_X], a.in[I_LNIN_G], a.in[I_LNIN_B], (bf16_t*)(ws + WS_XN), (signed char*)(ws + WS_XN8), (float*)(ws + WS_SXN), gw, NGW, NTOK);
    { const size_t n8 = (size_t)NTOK * PLE / 8; const GAS f32x4* src = (const GAS f32x4*)a.in[I_P]; GAS v4u* dst = (GAS v4u*)(ws + WS_PB);
      for (size_t i = (size_t)F.vcu * 512 + FTID; i < n8; i += (size_t)F.G * 512) { const f32x4 x0 = src[2 * i], x1 = src[2 * i + 1];
          v4u o; o.x = pk2(x0.x, x0.y); o.y = pk2(x0.z, x0.w); o.z = pk2(x1.x, x1.y); o.w = pk2(x1.z, x1.w); dst[i] = o; } }
}

__device__ __forceinline__ void unpack8(const v4u w, float* f) { f[0] = bflo(w.x); f[1] = bfhi(w.x); f[2] = bflo(w.y); f[3] = bfhi(w.y); f[4] = bflo(w.z); f[5] = bfhi(w.z); f[6] = bflo(w.w); f[7] = bfhi(w.w); }
__device__ __forceinline__ unsigned long long pack8_fp8(const float* f) { int w0 = 0, w1 = 0;
    w0 = __builtin_amdgcn_cvt_pk_fp8_f32(f[0], f[1], w0, false); w0 = __builtin_amdgcn_cvt_pk_fp8_f32(f[2], f[3], w0, true);
    w1 = __builtin_amdgcn_cvt_pk_fp8_f32(f[4], f[5], w1, false); w1 = __builtin_amdgcn_cvt_pk_fp8_f32(f[6], f[7], w1, true);
    return (unsigned long long)(unsigned)w0 | ((unsigned long long)(unsigned)w1 << 32); }
__device__ __forceinline__ void unpack8_fp8(const unsigned long long yw, float* f) { const int w0 = (int)(unsigned)yw, w1 = (int)(unsigned)(yw >> 32);
    const auto f0 = __builtin_amdgcn_cvt_pk_f32_fp8(w0, false), f1 = __builtin_amdgcn_cvt_pk_f32_fp8(w0, true), f2 = __builtin_amdgcn_cvt_pk_f32_fp8(w1, false), f3 = __builtin_amdgcn_cvt_pk_f32_fp8(w1, true);
    f[0] = f0[0]; f[1] = f0[1]; f[2] = f1[0]; f[3] = f1[1]; f[4] = f2[0]; f[5] = f2[1]; f[6] = f3[0]; f[7] = f3[1]; }
__device__ __forceinline__ v4u pack8(const float* f) { v4u w; w.x = cvt_pk_bf16(f[0], f[1]); w.y = cvt_pk_bf16(f[2], f[3]); w.z = cvt_pk_bf16(f[4], f[5]); w.w = cvt_pk_bf16(f[6], f[7]); return w; }
struct EpiInProj {
    static constexpr bool PERM = true, WIDE = true, PRE = false;
    unsigned char* ws;
    __device__ __forceinline__ const float* rowscale_ptr(const pg8::Unit& u) const { return (const float*)(ws + WS_SXN) + u.pm * 256; }
    __device__ __forceinline__ bool fixed_rowscale() const { return false; }
    __device__ __forceinline__ float fixed_rs_value() const { return 1.f; }
    __device__ __forceinline__ const float* colscale(const pg8::Unit& u) const { return (const float*)(ws + WS_SWIN) + u.pn * 256; }
    __device__ __forceinline__ void operator()(const pg8::Acc& acc, const pg8::Unit& u, int wr, int wc, int fr, int fq) const {
        const int pn = u.pn; int seg, t0, ld; size_t boff;
        if (pn < 4) { seg = 0; t0 = 0; boff = WS_QR; ld = 1024; } else if (pn < 8) { seg = 1; t0 = 4; boff = WS_KR; ld = 1024; }
        else if (pn < 16) { seg = 2; t0 = 8; boff = WS_V8; ld = 2048; } else if (pn < 24) { seg = 3; t0 = 16; boff = WS_GR; ld = 2048; }
        else if (pn < 28) { seg = 4; t0 = 24; boff = WS_QD; ld = 1024; } else if (pn < 32) { seg = 5; t0 = 28; boff = WS_KD; ld = 1024; }
        else if (pn < 36) { seg = 6; t0 = 32; boff = WS_VD; ld = 1024; } else { seg = 7; t0 = 36; boff = WS_GT; ld = 2048; }
        bf16_t* base = (bf16_t*)(ws + boff);
        const int tl = pn - t0;
        const int row0 = u.pm * 256 + wr * 64 + fr;
        if (seg <= 1) {
            const int hl = wc >> 1, j0 = 32 * (wc & 1) + 8 * fq, head = 2 * tl + hl;
            const float sc = seg == 1 ? KR_SCALE : 1.f;
            float th[8];
#pragma unroll
            for (int i = 0; i < 8; ++i) th[i] = exp2f(-(float)(j0 + i) * (13.287712379549449f / 63.f));
#pragma unroll
            for (int ai = 0; ai < 2; ++ai)
#pragma unroll
                for (int m = 0; m < 4; ++m) {
                    const int row = row0 + ai * 128 + m * 16; const float pos = (float)(row & (SEQ - 1));
                    float o1[8], o2[8];
#pragma unroll
                    for (int i = 0; i < 8; ++i) {
                        const float t1 = acc[ai][0][m][i >> 2][i & 3], t2 = acc[ai][1][m][i >> 2][i & 3];
                        const float ang = pos * th[i]; const float k = rintf(ang * 0.15915494309189535f);
                        float r = fmaf(-k, 6.2831855f, ang); r = fmaf(-k, -1.7484555e-7f, r);
                        const float rr = r * 0.15915494309189535f;
                        const float c = __builtin_amdgcn_cosf(rr), s = __builtin_amdgcn_sinf(rr);
                        o1[i] = (t1 * c - t2 * s) * sc; o2[i] = (t2 * c + t1 * s) * sc;
                    }
                    bf16_t* rp = base + (size_t)row * ld + head * 128 + j0;
                    v4u w; w.x = cvt_pk_bf16(o1[0], o1[1]); w.y = cvt_pk_bf16(o1[2], o1[3]); w.z = cvt_pk_bf16(o1[4], o1[5]); w.w = cvt_pk_bf16(o1[6], o1[7]);
                    *(v4u*)rp = w;
                    w.x = cvt_pk_bf16(o2[0], o2[1]); w.y = cvt_pk_bf16(o2[2], o2[3]); w.z = cvt_pk_bf16(o2[4], o2[5]); w.w = cvt_pk_bf16(o2[6], o2[7]);
                    *(v4u*)(rp + 64) = w;
                }
        } else {
            const bool lo = fr < 8; const int rl = fr & 7;
            const int colb = tl * 256 + 64 * wc + 8 * fq;
            const bool f8 = (seg == 2 || seg == 3 || seg == 7);
#pragma unroll
            for (int ai = 0; ai < 2; ++ai)
#pragma unroll
                for (int m = 0; m < 4; ++m) {
                    const int rbase = u.pm * 256 + wr * 64 + ai * 128 + m * 16;
                    float vv[2][8];
#pragma unroll
                    for (int bj = 0; bj < 2; ++bj) {
                        f32x4 v0 = acc[ai][bj][m][0], v1 = acc[ai][bj][m][1];
                        if (seg == 3) { for (int i = 0; i < 4; ++i) { v0[i] = fast_silu(v0[i]); v1[i] = fast_silu(v1[i]); } }
                        else if (seg == 7) { for (int i = 0; i < 4; ++i) { v0[i] = fast_sigmoid(v0[i]); v1[i] = fast_sigmoid(v1[i]); } }
                        else if (seg == 4) { v0 = v0 * QD_SCALE; v1 = v1 * QD_SCALE; }
                        else if (seg == 2) { v0 = v0 * V8_SCALE; v1 = v1 * V8_SCALE; }
#pragma unroll
                        for (int i = 0; i < 4; ++i) { vv[bj][i] = v0[i]; vv[bj][4 + i] = v1[i]; }
                    }
                    if (f8) {
                        const unsigned long long p0 = pack8_fp8(vv[0]), p1 = pack8_fp8(vv[1]);
                        const unsigned p1l = (unsigned)p1, p1h = (unsigned)(p1 >> 32);
                        const unsigned tl_ = (unsigned)__builtin_amdgcn_update_dpp(0, (int)p1l, 0x118, 0xf, 0xf, false), th_ = (unsigned)__builtin_amdgcn_update_dpp(0, (int)p1h, 0x118, 0xf, 0xf, false);
                        const unsigned ul_ = (unsigned)__builtin_amdgcn_update_dpp(0, (int)p1l, 0x108, 0xf, 0xf, false), uh_ = (unsigned)__builtin_amdgcn_update_dpp(0, (int)p1h, 0x108, 0xf, 0xf, false);
                        const unsigned long long tt = (unsigned long long)tl_ | ((unsigned long long)th_ << 32), uu = (unsigned long long)ul_ | ((unsigned long long)uh_ << 32);
                        unsigned char* bp = (unsigned char*)base + colb + (lo ? 0 : 32);
                        *(unsigned long long*)(bp + (size_t)(rbase + rl) * 2048) = lo ? p0 : tt;
                        bp = (unsigned char*)base + colb + (lo ? 32 : 0);
                        *(unsigned long long*)(bp + (size_t)(rbase + 8 + rl) * 2048) = lo ? uu : p0;
                    } else {
                        const v4u w0 = pack8(vv[0]), w1 = pack8(vv[1]); v4u tt, uu;
#pragma unroll
                        for (int k = 0; k < 4; ++k) { tt[k] = (unsigned)__builtin_amdgcn_update_dpp(0, (int)w1[k], 0x118, 0xf, 0xf, false); uu[k] = (unsigned)__builtin_amdgcn_update_dpp(0, (int)w1[k], 0x108, 0xf, 0xf, false); }
                        bf16_t* bp = base + colb + (lo ? 0 : 32);
                        *(v4u*)(bp + (size_t)(rbase + rl) * ld) = lo ? w0 : tt;
                        bp = base + colb + (lo ? 32 : 0);
                        *(v4u*)(bp + (size_t)(rbase + 8 + rl) * ld) = lo ? uu : w0;
                    }
                }
        }
    }
};

namespace att {
using f32x16 = __attribute__((ext_vector_type(16))) float;
using s16x4  = __attribute__((ext_vector_type(4))) short;
constexpr int SHM_V = 16384, SHM_K64 = 8192;
constexpr int A_V = 0, A_K = 49152, A_WS = 73728, A_TAB = 75776, A_ST = 77312;
constexpr int R_KS = 0, R_KI = 32768, R_VI = 65536, R_ST = 98304, R_STP = 272, R_OS = 107008;
#define KSWZ(row, colB) ((row) * 256 + ((colB) ^ (((row) & 7) << 4)))
#define KSWZ64(row, colB) ((row) * 128 + ((colB) ^ ((((row) >> 1) & 7) << 4)))
#define SBAR() __builtin_amdgcn_sched_barrier(0)
__device__ __forceinline__ int crow(int r, int hi) { return (r & 3) + 8 * (r >> 2) + 4 * hi; }
__device__ __forceinline__ int v_st(int k, int c) { const int kk = (k & ~0xC) | ((k & 4) << 1) | ((k & 8) >> 1); return ((kk >> 3) * 4 + (c >> 5)) * 512 + ((kk & 7) * 32 + (c & 31)) * 2; }
__device__ __forceinline__ int v_rd_base(int lane) { return ((lane & 3) << 3) | (((lane >> 2) & 3) << 6) | (((lane >> 4) & 1) << 5) | (((lane >> 5) & 1) << 8); }
constexpr int v_rd_off(int d0, int ks, int half) { return d0 * 512 + ks * 4096 + half * 2048; }
template <int OFF> __device__ __forceinline__ s16x4 tr_read(int vb) {
  s16x4 r; asm volatile("ds_read_b64_tr_b16 %0, %1 offset:%2" : "=&v"(r) : "v"(vb), "i"(OFF) : "memory"); return r;
}
#define PKF(L, H) (bf16x8){L[0], L[1], L[2], L[3], H[0], H[1], H[2], H[3]}
template <int D0> __device__ __forceinline__ void pv_one(f32x16& od, int vb, bf16x8 pa0, bf16x8 pa1, bf16x8 pa2, bf16x8 pa3) {
  const s16x4 l0 = tr_read<v_rd_off(D0, 0, 0)>(vb), h0 = tr_read<v_rd_off(D0, 0, 1)>(vb), l1 = tr_read<v_rd_off(D0, 1, 0)>(vb), h1 = tr_read<v_rd_off(D0, 1, 1)>(vb);
  const s16x4 l2 = tr_read<v_rd_off(D0, 2, 0)>(vb), h2 = tr_read<v_rd_off(D0, 2, 1)>(vb), l3 = tr_read<v_rd_off(D0, 3, 0)>(vb), h3 = tr_read<v_rd_off(D0, 3, 1)>(vb);
  asm volatile("s_waitcnt lgkmcnt(0)" ::: "memory"); SBAR();
  od = __builtin_amdgcn_mfma_f32_32x32x16_bf16(pa0, PKF(l0, h0), od, 0, 0, 0);
  od = __builtin_amdgcn_mfma_f32_32x32x16_bf16(pa1, PKF(l1, h1), od, 0, 0, 0);
  od = __builtin_amdgcn_mfma_f32_32x32x16_bf16(pa2, PKF(l2, h2), od, 0, 0, 0);
  od = __builtin_amdgcn_mfma_f32_32x32x16_bf16(pa3, PKF(l3, h3), od, 0, 0, 0);
}
__device__ __forceinline__ void pv_d0(f32x16* o, int vb, bf16x8 pa0, bf16x8 pa1, bf16x8 pa2, bf16x8 pa3) {
  pv_one<0>(o[0], vb, pa0, pa1, pa2, pa3); pv_one<1>(o[1], vb, pa0, pa1, pa2, pa3); pv_one<2>(o[2], vb, pa0, pa1, pa2, pa3); pv_one<3>(o[3], vb, pa0, pa1, pa2, pa3);
}
#define PK4(P, BASE, OUT) do { unsigned a0 = cvt_pk_bf16(P[BASE + 0], P[BASE + 1]), a1 = cvt_pk_bf16(P[BASE + 2], P[BASE + 3]);   \
    unsigned b0 = cvt_pk_bf16(P[BASE + 4], P[BASE + 5]), b1 = cvt_pk_bf16(P[BASE + 6], P[BASE + 7]);                              \
    auto r0 = __builtin_amdgcn_permlane32_swap(a0, b0, false, false); auto r1 = __builtin_amdgcn_permlane32_swap(a1, b1, false, false); \
    v4u w = {r0[0], r1[0], r0[1], r1[1]}; OUT = *reinterpret_cast<bf16x8*>(&w); } while (0)

__device__ __forceinline__ int t5_bucket(int n) {
  if (n < 16) return n;
  int b = 16;
  b += (n >= 19); b += (n >= 21); b += (n >= 24); b += (n >= 27); b += (n >= 31); b += (n >= 35); b += (n >= 40); b += (n >= 46);
  b += (n >= 52); b += (n >= 59); b += (n >= 67); b += (n >= 77); b += (n >= 87); b += (n >= 99); b += (n >= 113);
  return b;
}
constexpr float THR2 = 8.f;
template <bool FIRST>
__device__ __forceinline__ void partialSM(f32x16& p0, f32x16& p1, float& m_reg, float& alpha) {
  float pmax = p0[0];
#pragma unroll
  for (int r = 1; r < 16; ++r) pmax = fmaxf(pmax, p0[r]);
#pragma unroll
  for (int r = 0; r < 16; ++r) pmax = fmaxf(pmax, p1[r]);
  { auto rr = __builtin_amdgcn_permlane32_swap(__float_as_uint(pmax), __float_as_uint(pmax), false, false);
    pmax = fmaxf(__uint_as_float(rr[0]), __uint_as_float(rr[1])); }
  if (FIRST) { m_reg = pmax; alpha = 1.f;
#pragma unroll
    for (int r = 0; r < 16; ++r) { p0[r] = p0[r] - pmax; p1[r] = p1[r] - pmax; } }
  else if (__builtin_expect(__all(pmax <= THR2), 1)) { alpha = 1.f; }
  else { const float d = fmaxf(pmax, 0.f); alpha = __builtin_amdgcn_exp2f(-d); m_reg += d;
#pragma unroll
    for (int r = 0; r < 16; ++r) { p0[r] = p0[r] - d; p1[r] = p1[r] - d; } }
#pragma unroll
  for (int r = 0; r < 16; ++r) p0[r] = __builtin_amdgcn_exp2f(p0[r]);
}
__device__ __forceinline__ void finishSM(f32x16& p0, f32x16& p1, float alpha, float& l_reg, bf16x8& pa0, bf16x8& pa1, bf16x8& pa2, bf16x8& pa3) {
#pragma unroll
  for (int r = 0; r < 16; ++r) p1[r] = __builtin_amdgcn_exp2f(p1[r]);
  f32x2 ps2 = (f32x2){p0[0], p0[1]};
#pragma unroll
  for (int r = 2; r < 16; r += 2) ps2 += (f32x2){p0[r], p0[r + 1]};
#pragma unroll
  for (int r = 0; r < 16; r += 2) ps2 += (f32x2){p1[r], p1[r + 1]};
  float ps = ps2.x + ps2.y;
  { auto rr = __builtin_amdgcn_permlane32_swap(__float_as_uint(ps), __float_as_uint(ps), false, false);
    ps = __uint_as_float(rr[0]) + __uint_as_float(rr[1]); }
  l_reg = l_reg * alpha + ps;
  PK4(p0, 0, pa0); PK4(p0, 8, pa1); PK4(p1, 0, pa2); PK4(p1, 8, pa3);
}
__device__ __forceinline__ void qkt64(f32x16& p0, f32x16& p1, const char* Ks, const bf16x8* qr, int r32, int hi, float init) {
#pragma unroll
  for (int r = 0; r < 16; ++r) { p0[r] = init; p1[r] = init; }
#pragma unroll
  for (int d0 = 0; d0 < 4; ++d0) { const int cb = d0 * 32 + hi * 16;
    const bf16x8 b0 = *reinterpret_cast<const bf16x8*>(Ks + KSWZ64(r32, cb));
    const bf16x8 b1 = *reinterpret_cast<const bf16x8*>(Ks + KSWZ64(32 + r32, cb));
    p0 = __builtin_amdgcn_mfma_f32_32x32x16_bf16(b0, qr[d0], p0, 0, 0, 0);
    p1 = __builtin_amdgcn_mfma_f32_32x32x16_bf16(b1, qr[d0], p1, 0, 0, 0); }
}
__device__ __forceinline__ void bias_mask(f32x16& p0, f32x16& p1, const float* tab, int dbase) {
#pragma unroll
  for (int r = 0; r < 16; ++r) {
    const int d0 = dbase - ((r & 3) + 8 * (r >> 2)), d1 = d0 - 32;
    const float b0 = tab[min(max(d0, 0), 383)], b1 = tab[min(max(d1, 0), 383)];
    p0[r] = d0 >= 0 ? p0[r] + b0 : -INFINITY; p1[r] = d1 >= 0 ? p1[r] + b1 : -INFINITY;
  }
}

__device__ __forceinline__ void attn_unit(int b, int h, int qb, const bf16_t* QD, signed char* OD, const float ad_inv, const bf16_t* __restrict__ KD, const bf16_t* __restrict__ VD,
                                          const float* relb, const float* subg, float lam, char* lds, const int wave_, bf16x8& vs0, bf16x8& vs1, bf16x8& ks, const bool have0) {
  const int wid = __builtin_amdgcn_readfirstlane(wave_); int lane = lane_id(); asm volatile("" : "+v"(lane));
  const int tid = wid * 64 + lane, r32 = lane & 31, hi = lane >> 5;
  char* V_lds = lds + A_V; char* K_lds = lds + A_K;
  float* wsf = (float*)(lds + A_WS) + wid * 64; float* li_l = wsf; float* al_l = wsf + 32;
  float* tab = (float*)(lds + A_TAB);
  unsigned* stash = (unsigned*)(lds + A_ST) + wid * 2048;
  const int q0 = qb * 256; const long rowbase = (long)b * SEQ;
  if (tid < 384) tab[tid] = relb[t5_bucket(tid) * 8 + h] * LOG2E;
  const float c31 = relb[31 * 8 + h] * LOG2E;
  const int NT = 4 * (qb + 1);
  const int sr = tid >> 4, sc = (tid & 15) * 8, vst0 = v_st(sr, sc), vst1 = v_st(32 + sr, sc);
  const int kr = tid >> 3, kcb = (tid & 7) * 16, kst = KSWZ64(kr, kcb);
  const int vb0 = (int)(uintptr_t)V_lds + v_rd_base(lane);
  const int qw = q0 + wid * 32;
  f32x16 o[4];
  bf16x8 qr[4];
  for (int m = 0; m < 2; ++m) {
    const bf16_t* Kh = KD + rowbase * 1024 + h * 128 + m * 64; const bf16_t* Vh = VD + rowbase * 1024 + h * 128;
    const bf16_t* Qw = QD + (rowbase + qw + r32) * 1024 + h * 128 + m * 64 + hi * 8;
#pragma unroll
    for (int d0 = 0; d0 < 4; ++d0) qr[d0] = *reinterpret_cast<const bf16x8*>(Qw + d0 * 16);
    float m_reg = 0.f, l_reg = 0;
#pragma unroll
    for (int d = 0; d < 4; ++d)
#pragma unroll
      for (int r = 0; r < 16; ++r) o[d][r] = 0.f;
    const unsigned vo0 = (unsigned)(sr * 1024 + sc) * 2u, vo1 = vo0 + 32u * 2048u, ko = (unsigned)(kr * 1024 + (tid & 7) * 8) * 2u;
    const __amdgpu_buffer_rsrc_t rsV = __builtin_amdgcn_make_buffer_rsrc((void*)Vh, 0, SEQ * 2048, 0x00020000), rsK = __builtin_amdgcn_make_buffer_rsrc((void*)Kh, 0, SEQ * 2048, 0x00020000);
#define SLOAD(k0) do { const int so_ = (k0) * 2048; vs0 = __builtin_bit_cast(bf16x8, __builtin_amdgcn_raw_buffer_load_b128(rsV, vo0, so_, 0)); \
    vs1 = __builtin_bit_cast(bf16x8, __builtin_amdgcn_raw_buffer_load_b128(rsV, vo1, so_, 0)); ks = __builtin_bit_cast(bf16x8, __builtin_amdgcn_raw_buffer_load_b128(rsK, ko, so_, 0)); } while (0)
#define SWRITE(bb) do { *(bf16x8*)(V_lds + (bb) * SHM_V + vst0) = vs0; *(bf16x8*)(V_lds + (bb) * SHM_V + vst1) = vs1; \
    *(bf16x8*)(K_lds + (bb) * SHM_K64 + kst) = ks; } while (0)
    const int E = (qb >= 1) ? 4 * qb - 4 : -1;
    if (E >= 0) {
      f32x16 pA0, pA1, pB0, pB1; float alA, alB; bf16x8 pa0, pa1, pa2, pa3;
#define RESC(a) do { if (__any((a) < 1.f)) { if (hi == 0) al_l[r32] = (a); asm volatile("s_waitcnt lgkmcnt(0)" ::: "memory"); \
    _Pragma("unroll") for (int d = 0; d < 4; ++d) _Pragma("unroll") for (int r = 0; r < 16; ++r) o[d][r] *= al_l[crow(r, hi)]; } } while (0)
      if (m == 0 && !have0) SLOAD(0);
      SWRITE(0); SLOAD(64); __syncthreads();
      qkt64(pA0, pA1, K_lds, qr, r32, hi, c31); partialSM<true>(pA0, pA1, m_reg, alA);
      SWRITE(1); SLOAD(2 * 64); __syncthreads();
      int sK = SHM_K64, sV = 0, sW = 2;
      for (int j = 1; j + 1 <= E; j += 2) {
        SBAR(); qkt64(pB0, pB1, K_lds + sK, qr, r32, hi, c31 - m_reg);
        finishSM(pA0, pA1, alA, l_reg, pa0, pa1, pa2, pa3); SBAR();
        SWRITE(sW); SLOAD((j + 2) * 64); SBAR();
        pv_d0(o, vb0 + sV, pa0, pa1, pa2, pa3); partialSM<false>(pB0, pB1, m_reg, alB);
        RESC(alB); __syncthreads();
        sK = (sK == 2 * SHM_K64) ? 0 : sK + SHM_K64; sV = (sV == 2 * SHM_V) ? 0 : sV + SHM_V; sW = (sW == 2) ? 0 : sW + 1;
        SBAR(); qkt64(pA0, pA1, K_lds + sK, qr, r32, hi, c31 - m_reg);
        finishSM(pB0, pB1, alB, l_reg, pa0, pa1, pa2, pa3); SBAR();
        SWRITE(sW); SLOAD((j + 3) * 64); SBAR();
        pv_d0(o, vb0 + sV, pa0, pa1, pa2, pa3); partialSM<false>(pA0, pA1, m_reg, alA);
        RESC(alA); __syncthreads();
        sK = (sK == 2 * SHM_K64) ? 0 : sK + SHM_K64; sV = (sV == 2 * SHM_V) ? 0 : sV + SHM_V; sW = (sW == 2) ? 0 : sW + 1;
      }
      finishSM(pA0, pA1, alA, l_reg, pa0, pa1, pa2, pa3); SBAR();
      pv_d0(o, vb0 + sV, pa0, pa1, pa2, pa3);
      __syncthreads();
#undef RESC
    } else {
      if (m == 0 && !have0) SLOAD(0);
      SWRITE(0); SLOAD(64); __syncthreads();
    }
    for (int t = E + 1; t < NT; ++t) {
      const int bb = t % 3, bn = (t + 1) % 3;
      const bool far = (qw - 64 * t - 63) >= 128;
      if (64 * t <= qw + 31) {
      f32x16 p0, p1; float al; bf16x8 pa0, pa1, pa2, pa3;
      const bool first = (E < 0) && (t == 0);
      qkt64(p0, p1, K_lds + bb * SHM_K64, qr, r32, hi, (far ? c31 : 0.f) - (first ? 0.f : m_reg));
      if (!far) bias_mask(p0, p1, tab, qw + r32 - 64 * t - 4 * hi);
      if (first) partialSM<true>(p0, p1, m_reg, al); else partialSM<false>(p0, p1, m_reg, al);
      if (__any(al < 1.f)) { if (hi == 0) al_l[r32] = al; asm volatile("s_waitcnt lgkmcnt(0)" ::: "memory");
#pragma unroll
        for (int d = 0; d < 4; ++d)
#pragma unroll
          for (int r = 0; r < 16; ++r) o[d][r] *= al_l[crow(r, hi)]; }
      finishSM(p0, p1, al, l_reg, pa0, pa1, pa2, pa3); SBAR();
      pv_d0(o, vb0 + bb * SHM_V, pa0, pa1, pa2, pa3);
      }
      if (t + 1 < NT) { SWRITE(bn); if (t + 2 < NT) SLOAD((t + 2) * 64); }
      __syncthreads();
    }
    {
      const __amdgpu_buffer_rsrc_t rsKn = __builtin_amdgcn_make_buffer_rsrc((void*)(m == 0 ? Kh + 64 : Kh - 64), 0, SEQ * 2048, 0x00020000);
      vs0 = __builtin_bit_cast(bf16x8, __builtin_amdgcn_raw_buffer_load_b128(rsV, vo0, 0, 0)); vs1 = __builtin_bit_cast(bf16x8, __builtin_amdgcn_raw_buffer_load_b128(rsV, vo1, 0, 0));
      ks = __builtin_bit_cast(bf16x8, __builtin_amdgcn_raw_buffer_load_b128(rsKn, ko, 0, 0)); }
#undef SLOAD
#undef SWRITE
    if (hi == 0) li_l[r32] = l_reg; asm volatile("s_waitcnt lgkmcnt(0)" ::: "memory");
    float rli[16];
#pragma unroll
    for (int r = 0; r < 16; ++r) rli[r] = __builtin_amdgcn_rcpf(li_l[crow(r, hi)]);
    if (m == 0) {
#pragma unroll
      for (int d = 0; d < 4; ++d)
#pragma unroll
        for (int r = 0; r < 16; r += 2) stash[(d * 8 + (r >> 1)) * 64 + lane] = pk2(o[d][r] * rli[r], o[d][r + 1] * rli[r + 1]);
    } else {
      float ss[16];
#pragma unroll
      for (int r = 0; r < 16; ++r) ss[r] = 0.f;
#pragma unroll
      for (int d = 0; d < 4; ++d)
#pragma unroll
        for (int r = 0; r < 16; r += 2) { const unsigned w = stash[(d * 8 + (r >> 1)) * 64 + lane];
          o[d][r] = bflo(w) - lam * o[d][r] * rli[r]; o[d][r + 1] = bfhi(w) - lam * o[d][r + 1] * rli[r + 1];
          ss[r] += o[d][r] * o[d][r]; ss[r + 1] += o[d][r + 1] * o[d][r + 1]; }
#pragma unroll
      for (int off = 1; off < 32; off <<= 1)
#pragma unroll
        for (int r = 0; r < 16; ++r) ss[r] += __shfl_xor(ss[r], off);
      float gv[4];
#pragma unroll
      for (int d = 0; d < 4; ++d) gv[d] = subg[d * 32 + r32] * 0.8f;
      char* stg = (char*)stash;
#pragma unroll
      for (int r = 0; r < 16; ++r) { const float rs = 1.f / sqrtf(ss[r] * (1.f / 128.f) + LN_EPS); const int orow = crow(r, hi);
#pragma unroll
        for (int d = 0; d < 4; ++d) *(signed char*)(stg + orow * 128 + d * 32 + r32) = (signed char)(int)rintf(fminf(fmaxf(o[d][r] * rs * gv[d] * ad_inv, -127.f), 127.f)); }
      asm volatile("s_waitcnt lgkmcnt(0)" ::: "memory");
      char* Ob = (char*)OD + ((size_t)(rowbase + qw) * 1024 + h * 128) + (size_t)(lane >> 3) * 1024 + (lane & 7) * 16;
#pragma unroll
      for (int i = 0; i < 4; ++i) { const v4u v = *(const v4u*)(stg + (i * 8 + (lane >> 3)) * 128 + (lane & 7) * 16); *(v4u*)(Ob + (size_t)i * 8192) = v; }
    }
    __syncthreads();
  }
}

__device__ __forceinline__ void ret_chain(int b, int h, int j, const bf16_t* __restrict__ QR, const bf16_t* __restrict__ KR, const bf16_t* VR, bf16_t* VRo, const long omask, f32x2* gnst, char* lds, const int wave_) {
  const int wid = __builtin_amdgcn_readfirstlane(wave_); int lane = lane_id(); asm volatile("" : "+v"(lane));
  const int tid = wid * 64 + lane, r32 = lane & 31, hi = lane >> 5;
  char* KS = lds + R_KS; char* KI = lds + R_KI; char* VI = lds + R_VI; char* ST = lds + R_ST;
  const float lg = log2f(1.f - exp2f(-5.f - (float)h));
  const float c_dec = exp2f(128.f * lg);
  const long rowbase = (long)b * SEQ;
  for (int i = tid; i < 32 * R_STP / 4; i += 512) ((unsigned*)ST)[i] = 0u;
  const int sr = tid >> 4, sc = (tid & 15) * 8;
  const int vt = tid >> 2, vc = (tid & 3) * 8;
  const bf16_t* Kg = KR + rowbase * 1024 + h * 128 + sc;
  const bf16_t* Vg = VR + rowbase * 2048 + h * 256 + j * 32 + vc;
  const bf16_t* Qg = QR + (rowbase + (wid & 3) * 32 + r32) * 1024 + h * 128 + hi * 8;
  const int vbV = (int)(uintptr_t)VI + v_rd_base(lane);
  const int vbK = (int)(uintptr_t)KI + v_rd_base(lane) + (wid & 3) * 512;
  const float kd = exp2f((float)(127 - vt) * lg);
  bf16x8 kreg[4], vreg;
#pragma unroll
  for (int i = 0; i < 4; ++i) kreg[i] = *reinterpret_cast<const bf16x8*>(Kg + (long)(sr + 32 * i) * 1024);
  vreg = *reinterpret_cast<const bf16x8*>(Vg + (long)vt * 2048);
  f32x16 sacc;
#pragma unroll
  for (int r = 0; r < 16; ++r) sacc[r] = 0.f;
  bf16x8 qr[8];
#pragma unroll
  for (int d0 = 0; d0 < 8; ++d0) qr[d0] = *reinterpret_cast<const bf16x8*>(Qg + d0 * 16);
  for (int n = 0; n < SEQ / 128; ++n) {
    const long t0 = (long)n * 128;
    float lgv = lg; asm volatile("" : "+v"(lgv));
#pragma unroll
    for (int i = 0; i < 4; ++i) { const int tok = sr + 32 * i;
      *(bf16x8*)(KS + KSWZ(tok, sc * 2)) = kreg[i];
      *(bf16x8*)(KI + (i >> 1) * SHM_V + v_st(tok & 63, sc)) = kreg[i]; }
    { *(bf16x8*)(VI + (vt >> 6) * SHM_V + v_st(vt & 63, vc)) = vreg;
      bf16x8 vd;
#pragma unroll
      for (int e = 0; e < 8; ++e) vd[e] = (short)f2bf(bf2f((unsigned short)vreg[e]) * kd);
      *(bf16x8*)(VI + (vt >> 6) * SHM_V + v_st(vt & 63, 32 + vc)) = vd; }
    if (n + 1 < SEQ / 128) {
#pragma unroll
      for (int i = 0; i < 4; ++i) kreg[i] = *reinterpret_cast<const bf16x8*>(Kg + (t0 + 128 + sr + 32 * i) * 1024);
      vreg = *reinterpret_cast<const bf16x8*>(Vg + (t0 + 128 + vt) * 2048);
    }
    __syncthreads();
    if (wid < 4) {
      f32x16 acc;
#pragma unroll
      for (int r = 0; r < 16; ++r) acc[r] = 0.f;
#pragma unroll
      for (int d0 = 0; d0 < 8; ++d0) { const bf16x8 bs = *reinterpret_cast<const bf16x8*>(ST + r32 * R_STP + (16 * d0 + 8 * hi) * 2);
        acc = __builtin_amdgcn_mfma_f32_32x32x16_bf16(qr[d0], bs, acc, 0, 0, 0); }
#pragma unroll
      for (int r = 0; r < 16; ++r) acc[r] *= __builtin_amdgcn_exp2f((float)(32 * wid + crow(r, hi) + 1) * lgv);
#define RET_KB(kb) if ((kb) <= wid) { f32x16 p; _Pragma("unroll") for (int r = 0; r < 16; ++r) p[r] = 0.f; \
        _Pragma("unroll") for (int d0 = 0; d0 < 8; ++d0) { const bf16x8 kf = *reinterpret_cast<const bf16x8*>(KS + KSWZ(32 * (kb) + r32, (16 * d0 + 8 * hi) * 2)); \
          p = __builtin_amdgcn_mfma_f32_32x32x16_bf16(kf, qr[d0], p, 0, 0, 0); } \
        _Pragma("unroll") for (int r = 0; r < 16; ++r) { const int rel = 32 * (wid - (kb)) + r32 - crow(r, hi); p[r] = rel >= 0 ? p[r] * __builtin_amdgcn_exp2f((float)rel * lgv) : 0.f; } \
        bf16x8 pa0, pa1; PK4(p, 0, pa0); PK4(p, 8, pa1); \
        const s16x4 l0 = tr_read<v_rd_off(0, ((kb) & 1) * 2 + 0, 0) + ((kb) >> 1) * SHM_V>(vbV), h0 = tr_read<v_rd_off(0, ((kb) & 1) * 2 + 0, 1) + ((kb) >> 1) * SHM_V>(vbV); \
        const s16x4 l1 = tr_read<v_rd_off(0, ((kb) & 1) * 2 + 1, 0) + ((kb) >> 1) * SHM_V>(vbV), h1 = tr_read<v_rd_off(0, ((kb) & 1) * 2 + 1, 1) + ((kb) >> 1) * SHM_V>(vbV); \
        asm volatile("s_waitcnt lgkmcnt(0)" ::: "memory"); SBAR(); \
        acc = __builtin_amdgcn_mfma_f32_32x32x16_bf16(pa0, PKF(l0, h0), acc, 0, 0, 0); \
        acc = __builtin_amdgcn_mfma_f32_32x32x16_bf16(pa1, PKF(l1, h1), acc, 0, 0, 0); }
      RET_KB(0) RET_KB(1) RET_KB(2) RET_KB(3)
#undef RET_KB
      if (n + 1 < SEQ / 128) {
#pragma unroll
        for (int d0 = 0; d0 < 8; ++d0) qr[d0] = *reinterpret_cast<const bf16x8*>(Qg + (t0 + 128) * 1024 + d0 * 16);
      }
      char* stg = lds + R_OS + wid * 2048;
#pragma unroll
      for (int r = 0; r < 16; ++r) *(bf16_t*)(stg + crow(r, hi) * 64 + r32 * 2) = (bf16_t)f2bf(acc[r]);
      asm volatile("s_waitcnt lgkmcnt(0)" ::: "memory");
      { const v4u v0 = *(const v4u*)(stg + (lane >> 1) * 64 + (lane & 1) * 32), v1 = *(const v4u*)(stg + (lane >> 1) * 64 + (lane & 1) * 32 + 16);
        const long orow = rowbase + t0 + 32 * wid + (lane >> 1);
        char* Ob = (char*)(VRo + (orow & omask) * 2048 + h * 256 + j * 32) + (lane & 1) * 32;
        *(v4u*)Ob = v0; *(v4u*)(Ob + 16) = v1;
        float s1 = 0.f, s2 = 0.f;
#pragma unroll
        for (int e = 0; e < 4; ++e) { const float a0 = bflo(v0[e]), a1 = bfhi(v0[e]), a2 = bflo(v1[e]), a3 = bfhi(v1[e]);
          s1 += (a0 + a1) + (a2 + a3); s2 += (a0 * a0 + a1 * a1) + (a2 * a2 + a3 * a3); }
        s1 += __shfl_xor(s1, 1); s2 += __shfl_xor(s2, 1);
        if ((lane & 1) == 0) gnst[((size_t)j * NTOK + orow) * 8 + h] = (f32x2){s1, s2}; }
    } else {
#pragma unroll
      for (int r = 0; r < 16; ++r) sacc[r] *= c_dec;
#define RET_KS(im, ks) { const s16x4 al = tr_read<v_rd_off(1, ks, 0) + (im) * SHM_V>(vbV), ah = tr_read<v_rd_off(1, ks, 1) + (im) * SHM_V>(vbV); \
        const s16x4 bl = tr_read<v_rd_off(0, ks, 0) + (im) * SHM_V>(vbK), bh = tr_read<v_rd_off(0, ks, 1) + (im) * SHM_V>(vbK); \
        asm volatile("s_waitcnt lgkmcnt(0)" ::: "memory"); SBAR(); \
        sacc = __builtin_amdgcn_mfma_f32_32x32x16_bf16(PKF(al, ah), PKF(bl, bh), sacc, 0, 0, 0); }
      RET_KS(0, 0) RET_KS(0, 1) RET_KS(0, 2) RET_KS(0, 3) RET_KS(1, 0) RET_KS(1, 1) RET_KS(1, 2) RET_KS(1, 3)
#undef RET_KS
    }
    __syncthreads();
    if (wid >= 4) {
#pragma unroll
      for (int r = 0; r < 16; ++r) *(bf16_t*)(ST + crow(r, hi) * R_STP + (32 * (wid - 4) + r32) * 2) = (bf16_t)f2bf(sacc[r]);
    }
  }
  __syncthreads();
}
__device__ __forceinline__ bf16x8 f8_to_bf8(const unsigned long long w) { float f[8]; unpack8_fp8(w, f); v4u o;
#pragma unroll
  for (int k = 0; k < 4; ++k) o[k] = cvtpk_(f[2 * k] * (1.f / V8_SCALE), f[2 * k + 1] * (1.f / V8_SCALE));
  return __builtin_bit_cast(bf16x8, o); }
constexpr int R2_KS = 0, R2_KI = 32768, R2_VI = 65536, R2_ST = 98304, R2_OS = R2_ST + 4 * 32 * R_STP;
constexpr int RA_KI = 0, RA_VI = 32768;
__device__ __forceinline__ bf16x8 scale8(bf16x8 v, float f) { bf16x8 o;
#pragma unroll
  for (int e = 0; e < 8; ++e) o[e] = (short)f2bf(bf2f((unsigned short)v[e]) * f);
  return o; }
#define RET_KS2(sa, S, im, ks) { const s16x4 al = tr_read<v_rd_off(S, ks, 0) + (im) * SHM_V>(vbV), ah = tr_read<v_rd_off(S, ks, 1) + (im) * SHM_V>(vbV); \
        const s16x4 bl = tr_read<v_rd_off(0, ks, 0) + (im) * SHM_V>(vbK), bh = tr_read<v_rd_off(0, ks, 1) + (im) * SHM_V>(vbK); \
        asm volatile("s_waitcnt lgkmcnt(0)" ::: "memory"); SBAR(); \
        sa = __builtin_amdgcn_mfma_f32_32x32x16_bf16(PKF(al, ah), PKF(bl, bh), sa, 0, 0, 0); }
template <int S> __device__ __forceinline__ void ret_state_slice(f32x16& sa, const float c_dec, const int vbV, const int vbK) {
#pragma unroll
  for (int r = 0; r < 16; ++r) sa[r] *= c_dec;
  RET_KS2(sa, S, 0, 0) RET_KS2(sa, S, 0, 1) RET_KS2(sa, S, 0, 2) RET_KS2(sa, S, 0, 3) RET_KS2(sa, S, 1, 0) RET_KS2(sa, S, 1, 1) RET_KS2(sa, S, 1, 2) RET_KS2(sa, S, 1, 3)
}
__device__ __forceinline__ void ret_passA(int b, int h, int seg, const bf16_t* __restrict__ KR, const unsigned char* __restrict__ V8, bf16_t* Sloc, char* lds, const int wave_) {
  const int wid = __builtin_amdgcn_readfirstlane(wave_); int lane = lane_id(); asm volatile("" : "+v"(lane));
  const int tid = wid * 64 + lane;
  char* KI = lds + RA_KI; char* VI = lds + RA_VI;
  const float lg = log2f(1.f - exp2f(-5.f - (float)h));
  const float c_dec = exp2f(128.f * lg);
  const long rowbase = (long)b * SEQ + (long)seg * 1024;
  const int sr = tid >> 4, sc = (tid & 15) * 8;
  const int vtk = tid >> 5, vcl = (tid & 31) * 8;
  const bf16_t* Kg = KR + rowbase * 1024 + h * 128 + sc;
  const unsigned char* Vg = V8 + (rowbase + vtk) * 2048 + h * 256 + vcl;
  const int vbV = (int)(uintptr_t)VI + v_rd_base(lane) + (wid >> 2) * 2 * SHM_V;
  const int vbK = (int)(uintptr_t)KI + v_rd_base(lane) + (wid & 3) * 512;
  bf16x8 kreg[4]; unsigned long long vreg[8];
#pragma unroll
  for (int i = 0; i < 4; ++i) kreg[i] = *reinterpret_cast<const bf16x8*>(Kg + (long)(sr + 32 * i) * 1024);
#pragma unroll
  for (int e = 0; e < 8; ++e) vreg[e] = *reinterpret_cast<const unsigned long long*>(Vg + (long)(16 * e) * 2048);
  f32x16 sacc[4];
#pragma unroll
  for (int s = 0; s < 4; ++s)
#pragma unroll
    for (int r = 0; r < 16; ++r) sacc[s][r] = 0.f;
  for (int n = 0; n < 8; ++n) {
    const long t0 = (long)n * 128;
    float lgv = lg; asm volatile("" : "+v"(lgv));
#pragma unroll
    for (int i = 0; i < 4; ++i) { const int tok = sr + 32 * i;
      *(bf16x8*)(KI + (i >> 1) * SHM_V + v_st(tok & 63, sc)) = scale8(kreg[i], __builtin_amdgcn_exp2f((float)(127 - tok) * lgv)); }
#pragma unroll
    for (int e = 0; e < 8; ++e) { const int tok = vtk + 16 * e;
      *(bf16x8*)(VI + ((vcl >> 7) * 2 + (tok >> 6)) * SHM_V + v_st(tok & 63, vcl & 127)) = f8_to_bf8(vreg[e]); }
    if (n + 1 < 8) {
#pragma unroll
      for (int i = 0; i < 4; ++i) kreg[i] = *reinterpret_cast<const bf16x8*>(Kg + (t0 + 128 + sr + 32 * i) * 1024);
#pragma unroll
      for (int e = 0; e < 8; ++e) vreg[e] = *reinterpret_cast<const unsigned long long*>(Vg + (t0 + 128 + 16 * e) * 2048);
    }
    __syncthreads();
    ret_state_slice<0>(sacc[0], c_dec, vbV, vbK); ret_state_slice<1>(sacc[1], c_dec, vbV, vbK); ret_state_slice<2>(sacc[2], c_dec, vbV, vbK); ret_state_slice<3>(sacc[3], c_dec, vbV, vbK);
    __syncthreads();
  }
#pragma unroll
  for (int s = 0; s < 4; ++s) { const int tile = (4 * (wid >> 2) + s) * 4 + (wid & 3); v4u o0, o1;
    o0.x = pk2(sacc[s][0], sacc[s][1]); o0.y = pk2(sacc[s][2], sacc[s][3]); o0.z = pk2(sacc[s][4], sacc[s][5]); o0.w = pk2(sacc[s][6], sacc[s][7]);
    o1.x = pk2(sacc[s][8], sacc[s][9]); o1.y = pk2(sacc[s][10], sacc[s][11]); o1.z = pk2(sacc[s][12], sacc[s][13]); o1.w = pk2(sacc[s][14], sacc[s][15]);
    v4u* dst = (v4u*)(Sloc + ((size_t)tile * 64 + lane) * 16); dst[0] = o0; dst[1] = o1; }
}
template <int S> __device__ __forceinline__ void ret_out_slice(const bf16x8* qr, const bf16x8 (&pa)[4][2], const float* qdv, const char* ST, const int vbV, char* stg, bf16_t* Orow, f32x2* gn, const int wid, int lane) {
  asm volatile("" : "+v"(lane));
  const int r32 = lane & 31, hi = lane >> 5;
  f32x16 acc;
#pragma unroll
  for (int r = 0; r < 16; ++r) acc[r] = 0.f;
#pragma unroll
  for (int d0 = 0; d0 < 8; ++d0) { const bf16x8 bs = *reinterpret_cast<const bf16x8*>(ST + (32 * S + r32) * R_STP + (16 * d0 + 8 * hi) * 2);
    acc = __builtin_amdgcn_mfma_f32_32x32x16_bf16(qr[d0], bs, acc, 0, 0, 0); }
#pragma unroll
  for (int r = 0; r < 16; ++r) acc[r] *= qdv[r];
#define RET_PV2(kb) if ((kb) <= wid) { \
    const s16x4 l0 = tr_read<v_rd_off(S, ((kb) & 1) * 2 + 0, 0) + ((kb) >> 1) * SHM_V>(vbV), h0 = tr_read<v_rd_off(S, ((kb) & 1) * 2 + 0, 1) + ((kb) >> 1) * SHM_V>(vbV); \
    const s16x4 l1 = tr_read<v_rd_off(S, ((kb) & 1) * 2 + 1, 0) + ((kb) >> 1) * SHM_V>(vbV), h1 = tr_read<v_rd_off(S, ((kb) & 1) * 2 + 1, 1) + ((kb) >> 1) * SHM_V>(vbV); \
    asm volatile("s_waitcnt lgkmcnt(0)" ::: "memory"); SBAR(); \
    acc = __builtin_amdgcn_mfma_f32_32x32x16_bf16(pa[kb][0], PKF(l0, h0), acc, 0, 0, 0); \
    acc = __builtin_amdgcn_mfma_f32_32x32x16_bf16(pa[kb][1], PKF(l1, h1), acc, 0, 0, 0); }
  RET_PV2(0) RET_PV2(1) RET_PV2(2) RET_PV2(3)
#undef RET_PV2
#pragma unroll
  for (int r = 0; r < 16; ++r) *(bf16_t*)(stg + crow(r, hi) * 64 + r32 * 2) = (bf16_t)f2bf(acc[r]);
  asm volatile("s_waitcnt lgkmcnt(0)" ::: "memory");
  { const v4u v0 = *(const v4u*)(stg + (lane >> 1) * 64 + (lane & 1) * 32), v1 = *(const v4u*)(stg + (lane >> 1) * 64 + (lane & 1) * 32 + 16);
    char* Ob = (char*)(Orow + (size_t)(lane >> 1) * 2048) + (lane & 1) * 32;
    *(v4u*)Ob = v0; *(v4u*)(Ob + 16) = v1;
    float s1 = 0.f, s2 = 0.f;
#pragma unroll
    for (int e = 0; e < 4; ++e) { const float a0 = bflo(v0[e]), a1 = bfhi(v0[e]), a2 = bflo(v1[e]), a3 = bfhi(v1[e]);
      s1 += (a0 + a1) + (a2 + a3); s2 += (a0 * a0 + a1 * a1) + (a2 * a2 + a3 * a3); }
    s1 += __shfl_xor(s1, 1); s2 += __shfl_xor(s2, 1);
    if ((lane & 1) == 0) gn[(size_t)(lane >> 1) * 8] = (f32x2){s1, s2}; }
  asm volatile("s_waitcnt lgkmcnt(0)" ::: "memory");
}
__device__ __forceinline__ void ret_passB(int b, int h, int seg, const bf16_t* __restrict__ QR, const bf16_t* __restrict__ KR, const unsigned char* __restrict__ V8, bf16_t* VR, const bf16_t* Sall, f32x2* gnst, char* lds, const int wave_) {
  const int wid = __builtin_amdgcn_readfirstlane(wave_);
  char* KS = lds + R2_KS; char* KI = lds + R2_KI; char* VI = lds + R2_VI; char* ST = lds + R2_ST;
  const float lg = log2f(1.f - exp2f(-5.f - (float)h));
  const float c_dec = exp2f(128.f * lg);
  const long rowbase = (long)b * SEQ + (long)seg * 1024;
#define R2_LANE() int lane = lane_id(); asm volatile("" : "+v"(lane)); const int tid = wid * 64 + lane, r32 = lane & 31, hi = lane >> 5; (void)r32; (void)hi; \
  const int sr = tid >> 4, sc = (tid & 15) * 8, vtk = tid >> 4, vcl = (tid & 15) * 8; \
  const bf16_t* Kg = KR + rowbase * 1024 + h * 128 + sc; const unsigned char* Vg = V8 + (rowbase + vtk) * 2048 + h * 256 + vcl; \
  const int vbV = (int)(uintptr_t)VI + v_rd_base(lane); const int vbK = (int)(uintptr_t)KI + v_rd_base(lane) + (wid & 3) * 512; (void)vbK;
  bf16x8 kreg[4]; unsigned long long vreg[4];
  { R2_LANE();
#pragma unroll
    for (int i = 0; i < 4; ++i) kreg[i] = *reinterpret_cast<const bf16x8*>(Kg + (long)(sr + 32 * i) * 1024);
#pragma unroll
    for (int e = 0; e < 4; ++e) vreg[e] = *reinterpret_cast<const unsigned long long*>(Vg + (long)(32 * e) * 2048); }
#define R2_STAGE_A() do { _Pragma("unroll") for (int i = 0; i < 4; ++i) { const int tok = sr + 32 * i; \
      *(bf16x8*)(KS + KSWZ(tok, sc * 2)) = kreg[i]; \
      *(bf16x8*)(KI + (i >> 1) * SHM_V + v_st(tok & 63, sc)) = scale8(kreg[i], __builtin_amdgcn_exp2f((float)(127 - tok) * lgv)); } \
    _Pragma("unroll") for (int e = 0; e < 4; ++e) { const int tok = vtk + 32 * e; *(bf16x8*)(VI + (tok >> 6) * SHM_V + v_st(tok & 63, vcl)) = f8_to_bf8(vreg[e]); } } while (0)
#define R2_STAGE_B() do { _Pragma("unroll") for (int e = 0; e < 4; ++e) { const int tok = vtk + 32 * e; *(bf16x8*)(VI + (tok >> 6) * SHM_V + v_st(tok & 63, vcl)) = f8_to_bf8(vreg[e]); } } while (0)
#define R2_PREF_A() do { if (n + 1 < 8) { _Pragma("unroll") for (int i = 0; i < 4; ++i) kreg[i] = *reinterpret_cast<const bf16x8*>(Kg + (t0 + 128 + sr + 32 * i) * 1024); } \
      _Pragma("unroll") for (int e = 0; e < 4; ++e) vreg[e] = *reinterpret_cast<const unsigned long long*>(Vg + (t0 + 32 * e) * 2048 + 128); } while (0)
#define R2_PREF_B() do { if (n + 1 < 8) { _Pragma("unroll") for (int e = 0; e < 4; ++e) vreg[e] = *reinterpret_cast<const unsigned long long*>(Vg + (t0 + 128 + 32 * e) * 2048); } } while (0)
  if (wid < 4) {
    bf16x8 qr[8];
    { R2_LANE(); const bf16_t* Qg = QR + (rowbase + wid * 32 + r32) * 1024 + h * 128 + hi * 8;
#pragma unroll
      for (int d0 = 0; d0 < 8; ++d0) qr[d0] = *reinterpret_cast<const bf16x8*>(Qg + d0 * 16); }
    char* stg = lds + R2_OS + wid * 2048;
    for (int n = 0; n < 8; ++n) {
      const long t0 = (long)n * 128;
      float lgv = lg; asm volatile("" : "+v"(lgv));
      R2_LANE();
      R2_STAGE_A(); R2_PREF_A();
      __syncthreads();
      bf16x8 pa[4][2]; float qdv[16];
      bf16_t* Orow = VR + (rowbase + t0 + 32 * wid) * 2048 + h * 256;
      f32x2* gn = gnst + ((size_t)(rowbase + t0 + 32 * wid)) * 8 + h;
#define RET_SC2(kb) if ((kb) <= wid) { f32x16 p; _Pragma("unroll") for (int r = 0; r < 16; ++r) p[r] = 0.f; \
        _Pragma("unroll") for (int d0 = 0; d0 < 8; ++d0) { const bf16x8 kf = *reinterpret_cast<const bf16x8*>(KS + KSWZ(32 * (kb) + r32, (16 * d0 + 8 * hi) * 2)); \
          p = __builtin_amdgcn_mfma_f32_32x32x16_bf16(kf, qr[d0], p, 0, 0, 0); } \
        _Pragma("unroll") for (int r = 0; r < 16; ++r) { const int rel = 32 * (wid - (kb)) + r32 - crow(r, hi); p[r] = rel >= 0 ? p[r] * __builtin_amdgcn_exp2f((float)rel * lgv) : 0.f; } \
        PK4(p, 0, pa[kb][0]); PK4(p, 8, pa[kb][1]); }
      RET_SC2(0) RET_SC2(1) RET_SC2(2) RET_SC2(3)
#undef RET_SC2
#pragma unroll
      for (int r = 0; r < 16; ++r) qdv[r] = __builtin_amdgcn_exp2f((float)(32 * wid + crow(r, hi) + 1) * lgv);
      ret_out_slice<0>(qr, pa, qdv, ST, vbV, stg, Orow + 0 * 32, gn + (size_t)0 * NTOK * 8, wid, lane);
      ret_out_slice<1>(qr, pa, qdv, ST, vbV, stg, Orow + 1 * 32, gn + (size_t)1 * NTOK * 8, wid, lane);
      ret_out_slice<2>(qr, pa, qdv, ST, vbV, stg, Orow + 2 * 32, gn + (size_t)2 * NTOK * 8, wid, lane);
      ret_out_slice<3>(qr, pa, qdv, ST, vbV, stg, Orow + 3 * 32, gn + (size_t)3 * NTOK * 8, wid, lane);
      __syncthreads();
      R2_STAGE_B(); R2_PREF_B();
      __syncthreads();
      ret_out_slice<0>(qr, pa, qdv, ST, vbV, stg, Orow + 4 * 32, gn + (size_t)4 * NTOK * 8, wid, lane);
      ret_out_slice<1>(qr, pa, qdv, ST, vbV, stg, Orow + 5 * 32, gn + (size_t)5 * NTOK * 8, wid, lane);
      ret_out_slice<2>(qr, pa, qdv, ST, vbV, stg, Orow + 6 * 32, gn + (size_t)6 * NTOK * 8, wid, lane);
      ret_out_slice<3>(qr, pa, qdv, ST, vbV, stg, Orow + 7 * 32, gn + (size_t)7 * NTOK * 8, wid, lane);
      if (n + 1 < 8) { const bf16_t* Qg = QR + (rowbase + wid * 32 + r32) * 1024 + h * 128 + hi * 8;
#pragma unroll
        for (int d0 = 0; d0 < 8; ++d0) qr[d0] = *reinterpret_cast<const bf16x8*>(Qg + (t0 + 128) * 1024 + d0 * 16);
      }
      __syncthreads();
    }
  } else {
    f32x16 sacc[8];
#pragma unroll
    for (int s = 0; s < 8; ++s)
#pragma unroll
      for (int r = 0; r < 16; ++r) sacc[s][r] = 0.f;
    for (int sp = 0; sp < seg; ++sp) {
      int lane = lane_id(); asm volatile("" : "+v"(lane));
      const float f = exp2f(1024.f * lg * (float)(seg - 1 - sp));
      const bf16_t* Sp = Sall + (size_t)sp * (256 * 128);
#pragma unroll
      for (int s = 0; s < 8; ++s) { const int tile = s * 4 + (wid - 4);
        const v4u* src = (const v4u*)(Sp + ((size_t)tile * 64 + lane) * 16); const v4u a0 = src[0], a1 = src[1];
#pragma unroll
        for (int k = 0; k < 4; ++k) { sacc[s][2 * k] += f * bflo(a0[k]); sacc[s][2 * k + 1] += f * bfhi(a0[k]); sacc[s][8 + 2 * k] += f * bflo(a1[k]); sacc[s][8 + 2 * k + 1] += f * bfhi(a1[k]); } }
    }
#define R2_ST_WRITE(base) do { _Pragma("unroll") for (int s = 0; s < 4; ++s) _Pragma("unroll") for (int r = 0; r < 16; ++r) \
      *(bf16_t*)(ST + (32 * s + crow(r, hi)) * R_STP + (32 * (wid - 4) + r32) * 2) = (bf16_t)f2bf(sacc[(base) + s][r]); } while (0)
    for (int n = 0; n < 8; ++n) {
      const long t0 = (long)n * 128;
      float lgv = lg; asm volatile("" : "+v"(lgv));
      R2_LANE();
      R2_STAGE_A(); R2_ST_WRITE(0); R2_PREF_A();
      __syncthreads();
      ret_state_slice<0>(sacc[0], c_dec, vbV, vbK); ret_state_slice<1>(sacc[1], c_dec, vbV, vbK); ret_state_slice<2>(sacc[2], c_dec, vbV, vbK); ret_state_slice<3>(sacc[3], c_dec, vbV, vbK);
      __syncthreads();
      R2_STAGE_B(); R2_ST_WRITE(4); R2_PREF_B();
      __syncthreads();
      ret_state_slice<0>(sacc[4], c_dec, vbV, vbK); ret_state_slice<1>(sacc[5], c_dec, vbV, vbK); ret_state_slice<2>(sacc[6], c_dec, vbV, vbK); ret_state_slice<3>(sacc[7], c_dec, vbV, vbK);
      __syncthreads();
    }
#undef R2_ST_WRITE
  }
#undef R2_LANE
#undef R2_STAGE_A
#undef R2_STAGE_B
#undef R2_PREF_A
#undef R2_PREF_B
}
#undef RET_KS2
#undef SBAR
}

__device__ __forceinline__ void gn_pass(Frame& F, unsigned char* ws, const float* gn_g, const bool dummy) {
    const int gw = F.vcu * NWAVES + F.wave, NGW = F.G * NWAVES, lane = FLANE;
    const f32x2* gnst = (const f32x2*)(ws + WS_GNST);
    f32x4 w0[4], w1[4];
#pragma unroll
    for (int i = 0; i < 4; ++i) { const int c8 = i * 64 + lane; w0[i] = *((const GAS f32x4*)gn_g + 2 * c8); w1[i] = *((const GAS f32x4*)gn_g + 2 * c8 + 1); }
    v4u co[4], no[4]; unsigned long long cg[4], ng[4]; f32x2 cs[8], ns[8];
#define GN_LOAD(o_, g_, s_, t_) do { const GAS v4u* o4 = (const GAS v4u*)(ws + WS_VR + (size_t)(t_) * 4096); const GAS unsigned long long* g4 = (const GAS unsigned long long*)(ws + WS_GR + (size_t)(t_) * 2048); \
        _Pragma("unroll") for (int i = 0; i < 4; ++i) { o_[i] = o4[i * 64 + lane]; g_[i] = g4[i * 64 + lane]; } \
        _Pragma("unroll") for (int j = 0; j < 8; ++j) s_[j] = gnst[((size_t)j * NTOK + (t_)) * 8 + (lane & 7)]; } while (0)
    int t = gw;
    if (t < NTOK) GN_LOAD(co, cg, cs, t);
    while (t < NTOK) {
        const int tn = t + NGW;
        if (tn < NTOK) GN_LOAD(no, ng, ns, tn);
        float mean, rstd;
        { float s = 0.f, q = 0.f;
#pragma unroll
          for (int j = 0; j < 8; ++j) { s += cs[j].x; q += cs[j].y; }
          mean = s * (1.f / 256.f); rstd = 1.f / sqrtf(fmaxf(q * (1.f / 256.f) - mean * mean, 0.f) + LN_EPS); }
        float y[4][8]; float mx = 0.f;
#pragma unroll
        for (int i = 0; i < 4; ++i) { const int c8 = i * 64 + lane, hd = c8 >> 5;
            const float mu = __shfl(mean, hd), rs = __shfl(rstd, hd);
            float of[8], gf[8]; unpack8(co[i], of); unpack8_fp8(cg[i], gf);
            const float wv[8] = {w0[i].x, w0[i].y, w0[i].z, w0[i].w, w1[i].x, w1[i].y, w1[i].z, w1[i].w};
#pragma unroll
            for (int e = 0; e < 8; ++e) { y[i][e] = gf[e] * wv[e] * (of[e] - mu) * rs; mx = fmaxf(mx, fabsf(y[i][e])); } }
#pragma unroll
        for (int o = 1; o < 64; o <<= 1) mx = fmaxf(mx, __shfl_xor(mx, o));
        const float sc = mx > 0.f ? mx * (1.f / 127.f) : 1.f, inv = 1.f / sc;
        if (!dummy) {
            GAS unsigned long long* q8 = (GAS unsigned long long*)(ws + WS_AR8 + (size_t)t * 2048);
#pragma unroll
            for (int i = 0; i < 4; ++i) { unsigned long long w = 0;
#pragma unroll
                for (int e = 0; e < 8; ++e) w |= (unsigned long long)((unsigned)((int)rintf(y[i][e] * inv) & 255)) << (8 * e);
                q8[i * 64 + lane] = w; }
            if (lane == 0) ((float*)(ws + WS_SAR))[t] = sc;
        }
#pragma unroll
        for (int i = 0; i < 4; ++i) { co[i] = no[i]; cg[i] = ng[i]; }
#pragma unroll
        for (int j = 0; j < 8; ++j) cs[j] = ns[j];
        t = tn;
    }
#undef GN_LOAD
}

#define EPI_ROWS_BEGIN const int row0 = u.pm * 256 + wr * 64 + fr; const int colw = wc * 32 + 8 * fq; \
    _Pragma("unroll") for (int ai = 0; ai < 2; ++ai) _Pragma("unroll") for (int m = 0; m < 4; ++m) { const int row = row0 + ai * 128 + m * 16; (void)row; \
    _Pragma("unroll") for (int bj = 0; bj < 2; ++bj) { float v[8]; _Pragma("unroll") for (int i = 0; i < 8; ++i) v[i] = acc[ai][bj][m][i >> 2][i & 3]; const int colt = bj * 128 + colw; (void)colt;
#define EPI_ROWS_END } }
struct EpiM { static constexpr bool PERM = true, WIDE = false, PRE = false; unsigned char* ws; int which; int dummy; float fixed_rs;
    __device__ __forceinline__ const float* rowscale_ptr(const pg8::Unit& u) const { return (const float*)(ws + WS_SAR) + u.pm * 256; }
    __device__ __forceinline__ bool fixed_rowscale() const { return which != 0; }
    __device__ __forceinline__ float fixed_rs_value() const { return fixed_rs; }
    __device__ __forceinline__ const float* colscale(const pg8::Unit& u) const { return (const float*)(ws + (which ? WS_SWDO : WS_SWRO)) + u.pn * 256; }
    __device__ __forceinline__ void operator()(const pg8::Acc& acc, const pg8::Unit& u, int wr, int wc, int fr, int fq) const {
        EPI_ROWS_BEGIN
            const int col = u.pn * 256 + colt; float g[8]; unpack8_fp8(*(const unsigned long long*)(ws + WS_GT + (size_t)row * 2048 + which * 1024 + col), g);
            bf16_t* mp = (bf16_t*)(ws + WS_M) + (size_t)row * 1024 + col;
            if (which) { float o[8]; unpack8(*(const v4u*)mp, o);
#pragma unroll
                for (int i = 0; i < 8; ++i) v[i] = o[i] + g[i] * v[i]; }
            else {
#pragma unroll
                for (int i = 0; i < 8; ++i) v[i] = g[i] * v[i]; }
            if (!dummy) { if (which) {
#pragma unroll
                    for (int i = 0; i < 8; ++i) v[i] *= M8_SCALE;
                    *(unsigned long long*)(ws + WS_M8 + (size_t)row * 1024 + col) = pack8_fp8(v); }
                else *(v4u*)mp = pack8(v); }
        EPI_ROWS_END
    } };
struct EpiZ { static constexpr bool PERM = true, WIDE = false, PRE = false; unsigned char* ws;
    __device__ __forceinline__ void operator()(const pg8::Acc& acc, const pg8::Unit& u, int wr, int wc, int fr, int fq) const {
        EPI_ROWS_BEGIN
            const int col = u.pn * 256 + colt; float x[8]; unpack8(*(const v4u*)((const bf16_t*)(ws + WS_XN) + (size_t)row * 1024 + col), x);
#pragma unroll
            for (int i = 0; i < 8; ++i) v[i] = DN_ALPHA * x[i] + v[i] * (1.f / (M8_SCALE * F8_WSCALE));
            *(v4u*)((bf16_t*)(ws + WS_Z) + (size_t)row * 1024 + col) = pack8(v);
        EPI_ROWS_END
    } };
struct EpiP5 { static constexpr bool PERM = true, WIDE = false, PRE = false; unsigned char* ws;
    __device__ __forceinline__ void operator()(const pg8::Acc& acc, const pg8::Unit& u, int wr, int wc, int fr, int fq) const {
        EPI_ROWS_BEGIN
            const int col = u.pn * 256 + colt;
            if (u.type == 0) { float* zp = (float*)(ws + WS_LOGIT) + (size_t)row * 256 + col; *(f32x4*)zp = (f32x4){v[0], v[1], v[2], v[3]}; *(f32x4*)(zp + 4) = (f32x4){v[4], v[5], v[6], v[7]}; }
            else {
#pragma unroll
                for (int i = 0; i < 8; ++i) v[i] *= B8_SCALE;
                *(unsigned long long*)(ws + WS_BASE + (size_t)row * 1024 + col) = pack8_fp8(v); }
        EPI_ROWS_END
    } };
struct EpiP8 { static constexpr bool PERM = true, WIDE = false, PRE = false; unsigned char* ws; int dummy;
    __device__ __forceinline__ const float* rowscale_ptr(const pg8::Unit& u) const { return (const float*)(ws + M_RS) + u.grow; }
    __device__ __forceinline__ bool fixed_rowscale() const { return false; }
    __device__ __forceinline__ float fixed_rs_value() const { return 1.f; }
    __device__ __forceinline__ const float* colscale(const pg8::Unit& u) const { return u.cs; }
    __device__ __forceinline__ void operator()(const pg8::Acc& acc, const pg8::Unit& u, int wr, int wc, int fr, int fq) const {
        const int lrow0 = wr * 64 + fr, colw = wc * 32 + 8 * fq;
        if (u.type == 0) {
#pragma unroll
            for (int ai = 0; ai < 2; ++ai)
#pragma unroll
                for (int m = 0; m < 4; ++m) { const int lrow = lrow0 + ai * 128 + m * 16; float v[8];
#pragma unroll
                    for (int i = 0; i < 8; ++i) v[i] = fast_silu(acc[ai][0][m][i >> 2][i & 3]) * acc[ai][1][m][i >> 2][i & 3];
#pragma unroll
                    for (int i = 0; i < 8; ++i) v[i] *= F8_ASCALE;
                    *(unsigned long long*)(ws + WS_ACT + (size_t)(u.aux + lrow) * 256 + u.pn * 128 + colw) = pack8_fp8(v); }
        } else {
#pragma unroll
            for (int ai = 0; ai < 2; ++ai)
#pragma unroll
                for (int m = 0; m < 4; ++m)
#pragma unroll
                    for (int bj = 0; bj < 2; ++bj) { const int row = u.pm * 256 + lrow0 + ai * 128 + m * 16, col = u.pn * 256 + bj * 128 + colw;
                        unsigned char* bp = ws + WS_BASE + (size_t)row * 1024 + col; float o[8]; unpack8_fp8(*(const unsigned long long*)bp, o);
#pragma unroll
                        for (int i = 0; i < 8; ++i) o[i] *= fast_sigmoid(acc[ai][bj][m][i >> 2][i & 3]);
                        if (!dummy) *(unsigned long long*)bp = pack8_fp8(o); }
        }
    } };
struct EpiP9 { static constexpr bool PERM = true, WIDE = false, PRE = true; unsigned char* ws; int dummy;
    __device__ __forceinline__ const float* rowscale_ptr(const pg8::Unit& u) const { return (const float*)(ws + M_RASSIGN) + u.aux; }
    __device__ __forceinline__ const float* colscale(const pg8::Unit& u) const { return (const float*)(ws + M_RW) + u.aux; }
    __device__ __forceinline__ void operator()(const pg8::Acc& acc, const pg8::Unit& u, int wr, int wc, int fr, int fq, const LAS unsigned char* scl) const {
        int lrow0 = wr * 64 + fr, colw = wc * 32 + 8 * fq; asm volatile("" : "+v"(lrow0), "+v"(colw));
        if (u.type == 0) {
            int av[8]; float wv[8];
#pragma unroll
            for (int q = 0; q < 8; ++q) { const int lrow = lrow0 + (q >> 2) * 128 + (q & 3) * 16; av[q] = *(const LAS int*)(scl + 4 * lrow); wv[q] = *(const LAS float*)(scl + 1024 + 4 * lrow); }
#pragma unroll
            for (int q = 0; q < 8; ++q) { int a = av[q]; asm volatile("" : "+v"(a) :: "memory");
                if (a >= 0) { unsigned char* yp = ws + WS_Y + (size_t)a * 1024 + u.pn * 256 + colw * 2;
                    const float w16 = wv[q] * (16.f / (F8_WSCALE * F8_ASCALE)); v4u o;
#pragma unroll
                    for (int bj = 0; bj < 2; ++bj) { float v[8];
#pragma unroll
                        for (int i = 0; i < 8; ++i) v[i] = w16 * acc[q >> 2][bj][q & 3][i >> 2][i & 3];
                        int w0 = 0, w1 = 0;
                        w0 = __builtin_amdgcn_cvt_pk_fp8_f32(v[0], v[1], w0, false); w0 = __builtin_amdgcn_cvt_pk_fp8_f32(v[2], v[3], w0, true);
                        w1 = __builtin_amdgcn_cvt_pk_fp8_f32(v[4], v[5], w1, false); w1 = __builtin_amdgcn_cvt_pk_fp8_f32(v[6], v[7], w1, true);
                        o[2 * bj] = (unsigned)w0; o[2 * bj + 1] = (unsigned)w1; }
                    *(v4u*)yp = o; } }
        } else {
#pragma unroll
            for (int q = 0; q < 8; ++q) { int lrow = lrow0 + (q >> 2) * 128 + (q & 3) * 16; asm volatile("" : "+v"(lrow) :: "memory");
                unsigned char* bp = ws + WS_BASE + (size_t)(u.pm * 256 + lrow) * 1024 + u.pn * 256 + colw;
#pragma unroll
                for (int bj = 0; bj < 2; ++bj) { float o[8]; unpack8_fp8(*(const unsigned long long*)(bp + bj * 128), o);
#pragma unroll
                    for (int i = 0; i < 8; ++i) o[i] += acc[q >> 2][bj][q & 3][i >> 2][i & 3] * (B8_SCALE / (F8_WSCALE * F8_ASCALE));
                    if (!dummy) *(unsigned long long*)(bp + bj * 128) = pack8_fp8(o); } }
        }
    } };

struct P5Order {
    unsigned char* ws; int G, c, which;
    __device__ __forceinline__ bool next(int i, pg8::Unit& u) const {
        int idx = i * G + c;
        if (which == 1 && G == 256) { if (c < 128 || i >= 4) return false; idx = i * 128 + (c - 128); }
        if (which == 0) { if (idx >= 128) return false; u.pm = idx; u.pn = 0; u.type = 0; u.aux = 0; u.A = (const char*)(ws + WS_H1) + (size_t)idx * 256 * 1024 * 2; u.B = (const char*)(ws + WS_ROUT_T); u.grow = -1; return true; }
        if (idx >= 512) return false; u.pm = idx >> 2; u.pn = idx & 3; u.type = 1; u.aux = 0; u.A = (const char*)(ws + WS_PB) + (size_t)u.pm * 256 * 256 * 2; u.B = (const char*)(ws + WS_PLEW_T) + (size_t)u.pn * 256 * 256 * 2; u.grow = -1; return true;
    } };
struct P8Order {
    unsigned char* ws; int G, c, nblk;
    __device__ __forceinline__ bool next(int i, pg8::Unit& u) const {
        int idx = i * G + c; u.A = (const char*)(ws + WS_H18);
        if (idx < 2 * nblk) { const int blk = idx >> 1, e = __builtin_amdgcn_readfirstlane(((const volatile int*)(ws + M_BLKE))[blk]); u.pm = blk; u.pn = idx & 1; u.type = 0; u.aux = blk * 256; u.grow = blk * 256;
            u.B = (const char*)(ws + WS_EGU_T) + (size_t)e * (512 * 1024) + (size_t)u.pn * (256 * 1024); u.cs = (const float*)(ws + WS_SEGU) + e * 512 + u.pn * 256; return true; }
        idx -= 2 * nblk;
        if (idx < 256) { u.pm = idx >> 1; u.pn = idx & 1; u.type = 0; u.aux = SH_ACT_ROW0 + u.pm * 256; u.grow = NROWS_MAX + u.pm * 256;
            u.B = (const char*)(ws + WS_SHGU_T) + (size_t)u.pn * (256 * 1024); u.cs = (const float*)(ws + WS_SSHGU) + u.pn * 256; return true; }
        idx -= 256;
        if (idx < 512) { u.pm = idx >> 2; u.pn = idx & 3; u.type = 2; u.aux = 0; u.grow = NROWS_MAX + u.pm * 256;
            u.B = (const char*)(ws + WS_PLEG_T) + (size_t)u.pn * (256 * 1024); u.cs = (const float*)(ws + WS_SPLEG) + u.pn * 256; return true; }
        return false;
    } };
struct P9Order {
    unsigned char* ws; int G, c, nblk;
    __device__ __forceinline__ bool next(int i, pg8::Unit& u) const {
        int idx = i * G + c; u.grow = -1;
        if (idx < 4 * nblk) { const int blk = idx >> 2, e = __builtin_amdgcn_readfirstlane(((const volatile int*)(ws + M_BLKE))[blk]); u.pm = blk; u.pn = idx & 3; u.type = 0; u.aux = blk * 256;
            u.A = (const char*)(ws + WS_ACT) + (size_t)blk * (256 * 256); u.B = (const char*)(ws + ed_off(e)) + (size_t)u.pn * (256 * 256); return true; }
        idx -= 4 * nblk;
        if (idx < 512) { u.pm = idx >> 2; u.pn = idx & 3; u.type = 1; u.aux = 0;
            u.A = (const char*)(ws + WS_ACT) + (size_t)(SH_ACT_ROW0 + u.pm * 256) * 256; u.B = (const char*)(ws + WS_SHD_T) + (size_t)u.pn * (256 * 256); return true; }
        return false;
    } };

__device__ __forceinline__ void px_convert(Frame& F, const Args& a) {
    LAS float* scr = (LAS float*)(F.lds + F.wave * 16384);
    const int gw = F.vcu * NWAVES + F.wave, NGW = F.G * NWAVES; unsigned char* ws = a.ws;
    for (int it = gw; it < 256 * 128; it += NGW) { const int e = it >> 7, q = it & 127, kb = q >> 5, nb = q & 31, n0 = 32 * nb;
        p0_transpose_item_f8(a.in[I_ED] + (size_t)e * 256 * 1024, 256, 1024, ws + ed_off(e), 64 * kb, n0, n0, scr, FLANE, F8_WSCALE); }
    __syncthreads();
}
__device__ __forceinline__ void px_convert_dyn(Frame& F, const Args& a) {
    unsigned char* ws = a.ws;
    unsigned nx = 0u; if (FTID == 0) nx = __hip_atomic_fetch_add(F.ctl + CW_STEAL, 1u, RLX_AGENT);
    for (;;) {
        if (FTID == 0) F.MISC[4] = nx;
        __syncthreads();
        const int it = __builtin_amdgcn_readfirstlane((int)F.MISC[4]);
        if (it >= 256 * 16) break;
        if (FTID == 0) nx = __hip_atomic_fetch_add(F.ctl + CW_STEAL, 1u, RLX_AGENT);
        const int e = it >> 4, up = (it >> 3) & 1, n0 = 32 * (it & 7);
        quant_cols32_k1024(F.lds, a.in[up ? I_EU : I_EG] + (size_t)e * 1024 * 256, 256, n0, (signed char*)(ws + WS_EGU_T) + (size_t)e * 512 * 1024, (float*)(ws + WS_SEGU) + e * 512,
                           (n0 >> 7) * 256 + up * 128 + (n0 & 127), F.wave, FLANE);
    }
    __syncthreads();
}

__device__ __forceinline__ void route_pass(Frame& F, const Args& a, const bool dummy) {
    unsigned char* ws = a.ws; const int lane = FLANE;
    LAS unsigned* hist = (LAS unsigned*)F.lds;
    if (FTID < 256) hist[FTID] = 0u;
    __syncthreads();
    const int gw = F.vcu * NWAVES + F.wave, NGW = F.G * NWAVES;
    const f32x4 bb = ((const GAS f32x4*)a.in[I_ROUT_B])[lane];
    constexpr int U = 4;
    for (int t0 = gw; t0 < NTOK; t0 += U * NGW) {
        f32x4 x[U];
#pragma unroll
        for (int u = 0; u < U; ++u) { const int t = t0 + u * NGW; x[u] = (t < NTOK) ? ((const GAS f32x4*)(ws + WS_LOGIT + (size_t)t * 1024))[lane] : (f32x4){0.f, 0.f, 0.f, 0.f}; }
        float sc[U][4], c[U][4], a1[U], a2[U];
#pragma unroll
        for (int u = 0; u < U; ++u) {
#pragma unroll
            for (int i = 0; i < 4; ++i) { sc[u][i] = 1.f / (1.f + expf(-x[u][i])); c[u][i] = sc[u][i] + bb[i]; }
            a1[u] = fmaxf(c[u][0], c[u][1]); a2[u] = fminf(c[u][0], c[u][1]);
#pragma unroll
            for (int i = 2; i < 4; ++i) { if (c[u][i] > a1[u]) { a2[u] = a1[u]; a1[u] = c[u][i]; } else if (c[u][i] > a2[u]) a2[u] = c[u][i]; } }
#pragma unroll
        for (int off = 1; off < 8; off <<= 1) {
#pragma unroll
            for (int u = 0; u < U; ++u) { const float b1 = __shfl_xor(a1[u], off), b2 = __shfl_xor(a2[u], off); const float n1 = fmaxf(a1[u], b1), n2 = fmaxf(fminf(a1[u], b1), fmaxf(a2[u], b2)); a1[u] = n1; a2[u] = n2; } }
        const int g = lane >> 3;
#pragma unroll
        for (int u = 0; u < U; ++u) { const float gs = a1[u] + a2[u]; int rank = 0;
#pragma unroll
            for (int g2 = 0; g2 < 8; ++g2) { const float o = __shfl(gs, g2 * 8); rank += (o > gs || (o == gs && g2 < g)) ? 1 : 0; }
            if (rank >= 4) { c[u][0] = c[u][1] = c[u][2] = c[u][3] = -INFINITY; } }
        float sel_s[U]; int sel_e[U];
#pragma unroll
        for (int u = 0; u < U; ++u) { sel_s[u] = 0.f; sel_e[u] = 0; }
#pragma unroll
        for (int k = 0; k < 8; ++k) {
            float bv[U]; int be[U];
#pragma unroll
            for (int u = 0; u < U; ++u) { bv[u] = c[u][0]; int bi = 0;
#pragma unroll
                for (int i = 1; i < 4; ++i) if (c[u][i] > bv[u]) { bv[u] = c[u][i]; bi = i; }
                be[u] = lane * 4 + bi; }
#pragma unroll
            for (int off = 1; off < 64; off <<= 1) {
#pragma unroll
                for (int u = 0; u < U; ++u) { const float ov = __shfl_xor(bv[u], off); const int oe = __shfl_xor(be[u], off); if (ov > bv[u] || (ov == bv[u] && oe < be[u])) { bv[u] = ov; be[u] = oe; } } }
#pragma unroll
            for (int u = 0; u < U; ++u) { const int owner = be[u] >> 2, wi = be[u] & 3;
                float sv = wi == 0 ? sc[u][0] : wi == 1 ? sc[u][1] : wi == 2 ? sc[u][2] : sc[u][3];
                sv = __shfl(sv, owner);
                if (lane == owner) {
#pragma unroll
                    for (int i = 0; i < 4; ++i) if (wi == i) c[u][i] = -INFINITY; }
                if (lane == k) { sel_s[u] = sv; sel_e[u] = be[u]; } }
        }
        float tot[U];
#pragma unroll
        for (int u = 0; u < U; ++u) tot[u] = lane < 8 ? sel_s[u] : 0.f;
#pragma unroll
        for (int o = 1; o < 64; o <<= 1) {
#pragma unroll
            for (int u = 0; u < U; ++u) tot[u] += __shfl_xor(tot[u], o); }
#pragma unroll
        for (int u = 0; u < U; ++u) { const int t = t0 + u * NGW;
            if (t < NTOK && lane < 8) { ((int*)(ws + M_IDX))[(size_t)t * 8 + lane] = sel_e[u]; ((float*)(ws + M_W))[(size_t)t * 8 + lane] = sel_s[u] / tot[u] * 2.5f; atomicAdd((unsigned*)&hist[sel_e[u]], 1u); } }
    }
    __syncthreads();
    if (!dummy && FTID < 256 && hist[FTID]) __hip_atomic_fetch_add(F.ctl + CW_CNT + FTID, hist[FTID], RLX_AGENT);
    __syncthreads();
    for (int i = blockIdx.x * 512 + FTID; i < NROWS_MAX; i += F.G * 512) { ((int*)(ws + M_RASSIGN))[i] = -1; ((int*)(ws + M_RTOK))[i] = 0; ((float*)(ws + M_RW))[i] = 0.f; ((float*)(ws + M_RS))[i] = 0.f; }
    for (int i = blockIdx.x * 512 + FTID; i < NTOK; i += F.G * 512) { ((int*)(ws + M_RTOK))[NROWS_MAX + i] = i; ((float*)(ws + M_RS))[NROWS_MAX + i] = ((const float*)(ws + WS_SH1))[i]; }
}
__device__ __forceinline__ void scatter_pass(Frame& F, const Args& a) {
    unsigned char* ws = a.ws;
    LAS int* bst = (LAS int*)F.lds;
    LAS int* nbk = bst + 320;
    { const int t = FTID; if (t < NEXP) nbk[t] = (int)((__hip_atomic_load(F.ctl + CW_CNT + t, RLX_AGENT) + 255u) >> 8); }
    __syncthreads();
    if (F.wave == 0) {
        const int l = lane_id(); const int c0 = nbk[4 * l], c1 = nbk[4 * l + 1], c2 = nbk[4 * l + 2], c3 = nbk[4 * l + 3];
        int tot = c0 + c1 + c2 + c3, inc = tot;
#pragma unroll
        for (int off = 1; off < 64; off <<= 1) { const int o = __shfl_up(inc, off); if (l >= off) inc += o; }
        const int ex = inc - tot;
        bst[4 * l] = ex; bst[4 * l + 1] = ex + c0; bst[4 * l + 2] = ex + c0 + c1; bst[4 * l + 3] = ex + c0 + c1 + c2;
        if (l == 63) bst[NEXP] = inc;
    }
    __syncthreads();
    if (blockIdx.x == 0) { if (FTID < NEXP) { for (int b = bst[FTID]; b < bst[FTID + 1]; ++b) ((int*)(ws + M_BLKE))[b] = FTID; } if (FTID == 0) *(int*)(ws + M_NBLK) = bst[NEXP]; }
    for (int i = blockIdx.x * 512 + FTID; i < NTOK * 8; i += F.G * 512) {
        const int e = ((const int*)(ws + M_IDX))[i]; const unsigned rank = __hip_atomic_fetch_add(F.ctl + CW_CUR + e, 1u, RLX_AGENT);
        const int row = bst[e] * 256 + (int)rank;
        ((int*)(ws + M_RASSIGN))[row] = i; ((int*)(ws + M_RTOK))[row] = i >> 3; ((float*)(ws + M_RW))[row] = ((const float*)(ws + M_W))[i]; ((float*)(ws + M_RS))[row] = ((const float*)(ws + WS_SH1))[i >> 3];
    }
}
__device__ __forceinline__ void final_pass(Frame& F, const Args& a) {
    unsigned char* ws = a.ws; const int lane = FLANE; const int gw = F.vcu * NWAVES + F.wave, NGW = F.G * NWAVES;
    for (int t = gw; t < NTOK; t += NGW) {
        float v[16];
#pragma unroll
        for (int i = 0; i < 2; ++i) { const int c8 = lane + 64 * i; float hh[8], bs[8];
            unpack8(((const GAS v4u*)(ws + WS_H1 + (size_t)t * 2048))[c8], hh); unpack8_fp8(((const GAS unsigned long long*)(ws + WS_BASE + (size_t)t * 1024))[c8], bs);
#pragma unroll
            for (int e = 0; e < 8; ++e) v[i * 8 + e] = DN_ALPHA * hh[e] + bs[e] * (1.f / B8_SCALE);
            float ys[8] = {0.f, 0.f, 0.f, 0.f, 0.f, 0.f, 0.f, 0.f};
            const int p8 = (c8 & ~31) | ((c8 & 15) << 1) | ((c8 >> 4) & 1);
#pragma unroll
            for (int k = 0; k < 8; ++k) { const unsigned long long yw = ((const GAS unsigned long long*)(ws + WS_Y + ((size_t)t * 8 + k) * 1024))[p8];
                const int w0 = (int)(unsigned)yw, w1 = (int)(unsigned)(yw >> 32);
                const auto f0 = __builtin_amdgcn_cvt_pk_f32_fp8(w0, false), f1 = __builtin_amdgcn_cvt_pk_f32_fp8(w0, true), f2 = __builtin_amdgcn_cvt_pk_f32_fp8(w1, false), f3 = __builtin_amdgcn_cvt_pk_f32_fp8(w1, true);
                ys[0] += f0[0]; ys[1] += f0[1]; ys[2] += f1[0]; ys[3] += f1[1]; ys[4] += f2[0]; ys[5] += f2[1]; ys[6] += f3[0]; ys[7] += f3[1]; }
#pragma unroll
            for (int e = 0; e < 8; ++e) v[i * 8 + e] += ys[e] * (1.f / 16.f); }
        float s = 0.f;
#pragma unroll
        for (int e = 0; e < 16; ++e) s += v[e];
        const float mean = wave_sum(s) * (1.f / DM); float q = 0.f;
#pragma unroll
        for (int e = 0; e < 16; ++e) { v[e] -= mean; q += v[e] * v[e]; }
        const float rstd = 1.f / sqrtf(wave_sum(q) * (1.f / DM) + LN_EPS);
#pragma unroll
        for (int i = 0; i < 2; ++i) { const int c8 = lane + 64 * i;
#pragma unroll
            for (int hlf = 0; hlf < 2; ++hlf) { const f32x4 gg = ((const GAS f32x4*)a.in[I_LN2_G])[c8 * 2 + hlf], bb = ((const GAS f32x4*)a.in[I_LN2_B])[c8 * 2 + hlf];
                f32x4 o; o.x = v[i * 8 + hlf * 4 + 0] * rstd * gg.x + bb.x; o.y = v[i * 8 + hlf * 4 + 1] * rstd * gg.y + bb.y; o.z = v[i * 8 + hlf * 4 + 2] * rstd * gg.z + bb.z; o.w = v[i * 8 + hlf * 4 + 3] * rstd * gg.w + bb.w;
                ((GAS f32x4*)(a.out + (size_t)t * DM))[c8 * 2 + hlf] = o; } }
    }
}

__global__ void __launch_bounds__(NWAVES * 64, 2) mega_fwd(Args args) {
    extern __shared__ __attribute__((aligned(16))) unsigned char lds[];
    Frame F;
    F.lds = (LAS unsigned char*)lds;
    F.MISC = (volatile LAS unsigned*)(F.lds + MISC_OFF);
    F.wave = __builtin_amdgcn_readfirstlane((int)threadIdx.x >> 6);
    F.G = gridDim.x; { const int bx = blockIdx.x; F.vcu = (F.G % 8 == 0) ? (bx % 8) * (F.G / 8) + bx / 8 : bx; }
    unsigned char* ws = args.ws;
    F.ctl = (gu32*)(ws + WS_CTL);
    for (int u = FTID; u < (LDS_BYTES - LDSCTL_OFF) / 4; u += NWAVES * 64) ((LAS unsigned*)(F.lds + LDSCTL_OFF))[u] = 0u;
    __syncthreads();
    XcdBarrier bar = xcd_barrier_post((unsigned*)(F.ctl + CW_BAR), F.MISC + 8);
    const int lo = args.ph_lo, hi = args.ph_hi;
#define STAMP(k) do { if (TIMING && F.wave == 0) { const unsigned long long t_ = __builtin_amdgcn_s_memrealtime(); F.MISC[16 + 2 * (k)] = (unsigned)t_; F.MISC[17 + 2 * (k)] = (unsigned)(t_ >> 32); } } while (0)
    STAMP(0);
#define IN(k) (lo <= (k) && (k) < hi)
#define GRID_BAR() xcd_barrier(bar)

    if (IN(0)) { p0_prologue(F, args); if (REP & 1) p0_prologue(F, args); GRID_BAR(); }
    STAMP(1);
    if (IN(1)) {
        pg8::DenseOrder S; S.init(ws + WS_XN8, ws + WS_WIN_T, NTOK, INCOLS, 512, F.G, (int)blockIdx.x);
        EpiInProj E{ws};
        pg8::gemm_phase<EpiInProj, pg8::DenseOrder, false, true>(F.lds, 512, S, E, nullptr, F.wave);
        if (REP & 2) pg8::gemm_phase<EpiInProj, pg8::DenseOrder, false, true>(F.lds, 512, S, E, nullptr, F.wave);
        GRID_BAR();
    }
    STAMP(2);
#if DEBUG_CHECK
    if (IN(2)) {
        const GAS v4u* src = (const GAS v4u*)(ws + WS_VR); GAS v4u* dst = (GAS v4u*)(ws + WS_DBGV);
        for (size_t i = (size_t)blockIdx.x * 512 + FTID; i < (size_t)64 * MiB / 16; i += (size_t)F.G * 512) dst[i] = src[i];
        GRID_BAR();
    }
#endif
    if (IN(2)) {
        const int bh = F.vcu >> 3, s = F.vcu & 7, b = bh >> 3, h = bh & 7;
        if (REP & 8) att::ret_chain(b, h, s, (const bf16_t*)(ws + WS_QR), (const bf16_t*)(ws + WS_KR), (const bf16_t*)(ws + WS_VR), (bf16_t*)(ws + WS_DBGV), 16383L, (f32x2*)(ws + WS_GNST), (char*)lds, F.wave);
        if (s < 7) att::ret_passA(b, h, s, (const bf16_t*)(ws + WS_KR), (const unsigned char*)(ws + WS_V8), (bf16_t*)(ws + WS_META) + (size_t)F.vcu * (256 * 128), (char*)lds, F.wave);
        GRID_BAR();
        att::ret_passB(b, h, s, (const bf16_t*)(ws + WS_QR), (const bf16_t*)(ws + WS_KR), (const unsigned char*)(ws + WS_V8), (bf16_t*)(ws + WS_VR), (const bf16_t*)(ws + WS_META) + (size_t)(bh * 8) * (256 * 128), (f32x2*)(ws + WS_GNST), (char*)lds, F.wave);
        STAMP(3);
        float lam;
        { float d1 = 0.f, d2 = 0.f; for (int i = 0; i < 64; ++i) { d1 += args.in[I_LQ1][i] * args.in[I_LK1][i]; d2 += args.in[I_LQ2][i] * args.in[I_LK2][i]; }
          lam = expf(d1) - expf(d2) + 0.2f; }
        float gmax = 0.f; for (int i = 0; i < 128; ++i) gmax = fmaxf(gmax, fabsf(args.in[I_SUBLN_G][i]));
        const float ad_scale = fmaxf(gmax, 1e-20f) * (0.8f * 11.313708499f / 127.f), ad_inv = 1.f / ad_scale;
        bf16x8 avs0, avs1, aks;
        if (REP & 4) for (int i = 0; i < 4; ++i) {
            const int qb = (i == 0) ? 31 - s : (i == 1) ? 16 + s : (i == 2) ? 15 - s : s;
            att::attn_unit(b, h, qb, (const bf16_t*)(ws + WS_QD), (signed char*)(ws + WS_DBGV), ad_inv, (const bf16_t*)(ws + WS_KD), (const bf16_t*)(ws + WS_VD), args.in[I_RELB], args.in[I_SUBLN_G], lam, (char*)lds, F.wave, avs0, avs1, aks, i > 0);
        }
        for (int i = 0; i < 4; ++i) {
            const int qb = (i == 0) ? 31 - s : (i == 1) ? 16 + s : (i == 2) ? 15 - s : s;
            att::attn_unit(b, h, qb, (const bf16_t*)(ws + WS_QD), (signed char*)(ws + WS_AD8), ad_inv, (const bf16_t*)(ws + WS_KD), (const bf16_t*)(ws + WS_VD), args.in[I_RELB], args.in[I_SUBLN_G], lam, (char*)lds, F.wave, avs0, avs1, aks, i > 0);
            if (i == (bh & 3)) { px_convert(F, args); if (REP & 128) px_convert(F, args); }
        }
        px_convert_dyn(F, args);
        GRID_BAR();
    }
    STAMP(4);
    if (IN(3)) { if (REP & 256) gn_pass(F, ws, args.in[I_GN_G], true); gn_pass(F, ws, args.in[I_GN_G], false); GRID_BAR(); }
    STAMP(5);
    if (IN(4)) {
        pg8::DenseOrder S; S.init(ws + WS_AR8, ws + WS_WRO_T, NTOK, 1024, 1024, F.G, (int)blockIdx.x);
        EpiM E{ws, 0, 0, 0.f}; pg8::gemm_phase<EpiM, pg8::DenseOrder, false, true>(F.lds, 1024, S, E, nullptr, F.wave);
        __syncthreads();
    }
    STAMP(6);
    if (IN(5)) {
        pg8::DenseOrder S; S.init(ws + WS_AD8, ws + WS_WDO_T, NTOK, 1024, 512, F.G, (int)blockIdx.x);
        float gmax = 0.f; for (int i = 0; i < 128; ++i) gmax = fmaxf(gmax, fabsf(args.in[I_SUBLN_G][i]));
        EpiM E{ws, 1, 0, fmaxf(gmax, 1e-20f) * (0.8f * 11.313708499f / 127.f)}; pg8::gemm_phase<EpiM, pg8::DenseOrder, false, true>(F.lds, 512, S, E, nullptr, F.wave); GRID_BAR();
    }
    STAMP(7);
    if (IN(6)) {
        pg8::DenseOrder S; S.init(ws + WS_M8, ws + WS_WO_T, NTOK, 1024, 512, F.G, (int)blockIdx.x);
        EpiZ E{ws}; pg8::gemm_phase<EpiZ, pg8::DenseOrder, false, false, true>(F.lds, 512, S, E, nullptr, F.wave); GRID_BAR();
    }
    STAMP(8);
    if (IN(7)) {
        const int gw = F.vcu * NWAVES + F.wave, NGW = F.G * NWAVES;
        ln_rows_bf16_i8<true>(FLANE, ws + WS_Z, args.in[I_LN1_G], args.in[I_LN1_B], (bf16_t*)(ws + WS_H1), (signed char*)(ws + WS_H18), (float*)(ws + WS_SH1), gw, NGW, NTOK);
        GRID_BAR();
    }
    STAMP(9);
    if (IN(8)) {
        EpiP5 E{ws};
        { P5Order S{ws, F.G, F.vcu, 0}; pg8::gemm_phase<EpiP5, P5Order, false>(F.lds, 1024, S, E, nullptr, F.wave); }
        { P5Order S{ws, F.G, F.vcu, 1}; pg8::gemm_phase<EpiP5, P5Order, false>(F.lds, 256, S, E, nullptr, F.wave); }
        if (REP & 1024) { { P5Order S{ws, F.G, F.vcu, 0}; pg8::gemm_phase<EpiP5, P5Order, false>(F.lds, 1024, S, E, nullptr, F.wave); }
          { P5Order S{ws, F.G, F.vcu, 1}; pg8::gemm_phase<EpiP5, P5Order, false>(F.lds, 256, S, E, nullptr, F.wave); } }
        GRID_BAR();
    }
    STAMP(10);
    if (IN(9)) { if (REP & 16384) route_pass(F, args, true); route_pass(F, args, false); GRID_BAR(); }
    STAMP(11);
    if (IN(10)) { scatter_pass(F, args); GRID_BAR(); }
    STAMP(12);
    if (IN(11)) {
        const int nblk = __builtin_amdgcn_readfirstlane(*(const volatile int*)(ws + M_NBLK));
        P8Order S{ws, F.G, F.vcu  , nblk}; EpiP8 E{ws, 0};
        if (REP & 2048) { EpiP8 E2{ws, 1}; pg8::gemm_phase<EpiP8, P8Order, true, true>(F.lds, 512, S, E2, (const int*)(ws + M_RTOK), F.wave); }
        pg8::gemm_phase<EpiP8, P8Order, true, true>(F.lds, 512, S, E, (const int*)(ws + M_RTOK), F.wave); GRID_BAR();
    }
    STAMP(13);
    if (IN(12)) {
        const int nblk = __builtin_amdgcn_readfirstlane(*(const volatile int*)(ws + M_NBLK));
        P9Order S{ws, F.G, F.vcu, nblk}; EpiP9 E{ws, 0};
        if (REP & 4096) { EpiP9 E2{ws, 1}; pg8::gemm_phase<EpiP9, P9Order, false, false, true>(F.lds, 128, S, E2, nullptr, F.wave); }
        pg8::gemm_phase<EpiP9, P9Order, false, false, true>(F.lds, 128, S, E, nullptr, F.wave); GRID_BAR();
    }
    STAMP(14);
    if (REP & 32768) { for (int i = 0; i < 20; ++i) GRID_BAR(); }
    if (IN(13)) { final_pass(F, args); if (REP & 8192) final_pass(F, args); }
#if TIMING
    GRID_BAR(); STAMP(15);
    if (blockIdx.x == 0 && FTID == 0) {
      const unsigned long long t1 = ((unsigned long long)F.MISC[17 + 2 * T_A1] << 32) | F.MISC[16 + 2 * T_A1], t0 = ((unsigned long long)F.MISC[17 + 2 * T_A0] << 32) | F.MISC[16 + 2 * T_A0];
      args.out[0] = 10.f + (float)(t1 - t0) * 0.01f / (float)(T_SCALE); }
#endif
#undef IN
#undef GRID_BAR
}

#if DEBUG_CHECK
__device__ __forceinline__ unsigned hash_u32(unsigned x) { x ^= x >> 16; x *= 0x7feb352du; x ^= x >> 15; x *= 0x846ca68bu; x ^= x >> 16; return x; }
__device__ __forceinline__ void dbg_fail(unsigned* ctl, int stage, bool bad) { if (bad) atomicAdd(&ctl[CW_DBG + stage], 1u); }
__device__ float ref_ln_dot(const float* xrow, const float* g, const float* b, const float* W, int N, int col) {
    float s = 0.f; for (int k = 0; k < DM; ++k) s += xrow[k]; const float mean = s / DM;
    float q = 0.f; for (int k = 0; k < DM; ++k) { const float d = xrow[k] - mean; q += d * d; } const float rstd = 1.f / sqrtf(q / DM + LN_EPS);
    float acc = 0.f; for (int k = 0; k < DM; ++k) acc += ((xrow[k] - mean) * rstd * g[k] + b[k]) * W[(size_t)k * N + col];
    return acc;
}
__global__ void dbg_check(Args a) {
    unsigned* ctl = (unsigned*)(a.ws + WS_CTL); unsigned char* ws = a.ws;
    const unsigned gid = blockIdx.x * blockDim.x + threadIdx.x;
    {
        const unsigned h = hash_u32(gid * 2654435761u + 17u);
        const int row = h % NTOK; int col = (h >> 15) % INCOLS;
        const float* xrow = a.in[I_X] + (size_t)row * DM;
        int seg; int cs; size_t boff; int ld;
        if (col < 1024) { seg = 0; cs = col; boff = WS_QR; ld = 1024; } else if (col < 2048) { seg = 1; cs = col - 1024; boff = WS_KR; ld = 1024; }
        else if (col < 4096) { seg = 2; cs = col - 2048; boff = WS_VR; ld = 2048; } else if (col < 6144) { seg = 3; cs = col - 4096; boff = WS_GR; ld = 2048; }
        else if (col < 7168) { seg = 4; cs = col - 6144; boff = WS_QD; ld = 1024; } else if (col < 8192) { seg = 5; cs = col - 7168; boff = WS_KD; ld = 1024; }
        else if (col < 9216) { seg = 6; cs = col - 8192; boff = WS_VD; ld = 1024; } else { seg = 7; cs = col - 9216; boff = WS_GT; ld = 2048; }
        float e;
        if (seg <= 1) {
            const int j = cs & 63, half = (cs >> 6) & 1; const int c1 = col - half * 64, c2 = c1 + 64;
            const float t1 = ref_ln_dot(xrow, a.in[I_LNIN_G], a.in[I_LNIN_B], a.in[I_WIN], INCOLS, c1);
            const float t2 = ref_ln_dot(xrow, a.in[I_LNIN_G], a.in[I_LNIN_B], a.in[I_WIN], INCOLS, c2);
            const double theta = 1.0 / pow(10000.0, (double)j / 63.0); const double ang = (double)(row % SEQ) * theta;
            const float c = (float)cos(ang), s = (float)sin(ang);
            e = half ? (t2 * c + t1 * s) : (t1 * c - t2 * s);
            if (seg == 1) e *= KR_SCALE;
        } else {
            e = ref_ln_dot(xrow, a.in[I_LNIN_G], a.in[I_LNIN_B], a.in[I_WIN], INCOLS, col);
            if (seg == 3) e = e / (1.f + expf(-e)); else if (seg == 7) e = 1.f / (1.f + expf(-e)); else if (seg == 4) e *= QD_SCALE;
        }
        const float got = bf2f(((const bf16_t*)(ws + boff))[(size_t)row * ld + cs]);
        if (seg != 2 && seg != 3 && seg != 4)
            dbg_fail(ctl, 1, !(fabsf(got - e) <= 0.08f + 0.05f * fabsf(e)));
    }
}
__device__ float dbg_inproj(const Args& a, int row, int col) { return ref_ln_dot(a.in[I_X] + (size_t)row * DM, a.in[I_LNIN_G], a.in[I_LNIN_B], a.in[I_WIN], INCOLS, col); }
__global__ void __launch_bounds__(256) dbg_check_ret(Args a) {
    __shared__ float sc[256]; __shared__ float red[256]; __shared__ float qs[128];
    unsigned* ctl = (unsigned*)(a.ws + WS_CTL); unsigned char* ws = a.ws;
    const int tid = threadIdx.x;
    const unsigned hsh = hash_u32(blockIdx.x * 7919u + 13u);
    const int b = hsh & 1, h = (hsh >> 1) & 7; int pos = (hsh >> 4) % SEQ; if (blockIdx.x & 1) pos = pos % 700;
    const int t = b * SEQ + pos;
    const bf16_t* QR = (const bf16_t*)(ws + WS_QR); const bf16_t* KR = (const bf16_t*)(ws + WS_KR); const bf16_t* VV = (const bf16_t*)(ws + WS_DBGV);
    if (tid < 128) qs[tid] = bf2f(QR[(size_t)t * 1024 + h * 128 + tid]);
    __syncthreads();
    const float lgam = logf(1.f - exp2f(-5.f - (float)h));
    float o = 0.f;
    for (int s0 = 0; s0 <= pos; s0 += 256) {
        const int s = s0 + tid; float v = 0.f;
        if (s <= pos) { const bf16_t* kp = KR + (size_t)(b * SEQ + s) * 1024 + h * 128; float d = 0.f; for (int k = 0; k < 128; ++k) d += qs[k] * bf2f(kp[k]); v = d * expf((float)(pos - s) * lgam); }
        sc[tid] = v; __syncthreads();
        const int n = min(256, pos + 1 - s0);
        for (int i = 0; i < n; ++i) o += sc[i] * bf2f(VV[(size_t)(b * SEQ + s0 + i) * 2048 + h * 256 + tid]);
        __syncthreads();
    }
    red[tid] = o; __syncthreads(); for (int st = 128; st > 0; st >>= 1) { if (tid < st) red[tid] += red[tid + st]; __syncthreads(); }
    const float mu = red[0] / 256.f; __syncthreads();
    red[tid] = (o - mu) * (o - mu); __syncthreads(); for (int st = 128; st > 0; st >>= 1) { if (tid < st) red[tid] += red[tid + st]; __syncthreads(); }
    const float rstd = 1.f / sqrtf(red[0] / 256.f + LN_EPS);
    const float g = dbg_inproj(a, t, 4096 + h * 256 + tid);
    const float e = g / (1.f + expf(-g)) * (o - mu) * rstd * a.in[I_GN_G][h * 256 + tid];
    const float got = bf2f(((const bf16_t*)(ws + WS_GR))[(size_t)t * 2048 + h * 256 + tid]);
    dbg_fail(ctl, 2, !(fabsf(got - e) <= 0.06f + 0.06f * fabsf(e)));
}
__global__ void __launch_bounds__(256) dbg_check_att(Args a) {
    __shared__ float pr[SEQ]; __shared__ float red[256]; __shared__ float qs[128]; __shared__ float o1[128];
    unsigned* ctl = (unsigned*)(a.ws + WS_CTL); unsigned char* ws = a.ws;
    const int tid = threadIdx.x;
    const unsigned hsh = hash_u32(blockIdx.x * 104729u + 71u);
    const int b = hsh & 3, h = (hsh >> 2) & 7; int pos = (hsh >> 5) % SEQ; if ((blockIdx.x & 3) == 1) pos = pos % 300;
    const int t = b * SEQ + pos;
    const bf16_t* KD = (const bf16_t*)(ws + WS_KD); const bf16_t* VD = (const bf16_t*)(ws + WS_VD);
    if (tid < 128) qs[tid] = dbg_inproj(a, t, 6144 + h * 128 + tid) * 0.125f;
    float lam; { float d1 = 0.f, d2 = 0.f; for (int i = 0; i < 64; ++i) { d1 += a.in[I_LQ1][i] * a.in[I_LK1][i]; d2 += a.in[I_LQ2][i] * a.in[I_LK2][i]; } lam = expf(d1) - expf(d2) + 0.2f; }
    __syncthreads();
    float ov = 0.f;
    for (int m = 0; m < 2; ++m) {
        float mx = -INFINITY;
        for (int s = tid; s <= pos; s += 256) { const bf16_t* kp = KD + (size_t)(b * SEQ + s) * 1024 + h * 128 + m * 64; float d = 0.f; for (int k = 0; k < 64; ++k) d += qs[m * 64 + k] * bf2f(kp[k]);
            const int n = pos - s; int bk; if (n < 16) bk = n; else { bk = 16 + (int)(logf((float)n / 16.f) / logf(8.f) * 16.f); if (bk > 31) bk = 31; }
            d += a.in[I_RELB][bk * 8 + h]; pr[s] = d; mx = fmaxf(mx, d); }
        red[tid] = mx; __syncthreads(); for (int st = 128; st > 0; st >>= 1) { if (tid < st) red[tid] = fmaxf(red[tid], red[tid + st]); __syncthreads(); }
        mx = red[0]; __syncthreads();
        float sm = 0.f; for (int s = tid; s <= pos; s += 256) { const float p = expf(pr[s] - mx); pr[s] = p; sm += p; }
        red[tid] = sm; __syncthreads(); for (int st = 128; st > 0; st >>= 1) { if (tid < st) red[tid] += red[tid + st]; __syncthreads(); }
        sm = red[0]; __syncthreads();
        if (tid < 128) { float acc = 0.f; for (int s = 0; s <= pos; ++s) acc += pr[s] * bf2f(VD[(size_t)(b * SEQ + s) * 1024 + h * 128 + tid]); acc /= sm;
            if (m == 0) o1[tid] = acc; else ov = o1[tid] - lam * acc; }
        __syncthreads();
    }
    red[tid] = tid < 128 ? ov * ov : 0.f; __syncthreads(); for (int st = 128; st > 0; st >>= 1) { if (tid < st) red[tid] += red[tid + st]; __syncthreads(); }
    const float rs = 1.f / sqrtf(red[0] / 128.f + LN_EPS);
    if (tid < 128) { const float e = ov * rs * a.in[I_SUBLN_G][tid] * 0.8f;
        const float got = bf2f(((const bf16_t*)(ws + WS_QD))[(size_t)t * 1024 + h * 128 + tid]);
        dbg_fail(ctl, 3, !(fabsf(got - e) <= 0.06f + 0.06f * fabsf(e))); }
}
__global__ void dbg_report(Args a, int nout) {
    unsigned* ctl = (unsigned*)(a.ws + WS_CTL);
    int first = 0;
    if (ctl[CW_TMO] != 0u || ctl[CW_BAR + XB_TMO] != 0u) first = 15;
    for (int s = 14; s >= 1; --s) if (ctl[CW_DBG + s] > (s == 1 ? 16u : 64u)) first = s;
    const float c = first ? (float)(1 << first) : 0.5f;
    for (size_t i = (size_t)blockIdx.x * blockDim.x + threadIdx.x; i < (size_t)nout; i += (size_t)gridDim.x * blockDim.x) a.out[i] = c;
}
#endif

extern "C" void kernel_launch(void* const* d_in, const int* in_sizes, int n_in, void* d_out, int out_size, void* d_ws, size_t ws_size, hipStream_t stream) {
    static int grid = 0;
    if (grid == 0) {
        if (n_in != 29 || in_sizes[0] != NTOK * DM || out_size != NTOK * DM || ws_size < WS_END) {
            fprintf(stderr, "kernel_launch: unexpected shapes: n_in %d in0 %d out %d ws %zu (need >= %zu)\n", n_in, n_in > 0 ? in_sizes[0] : -1, out_size, ws_size, (size_t)WS_END); grid = -1; return; }
        int dev = 0, cus = 0;
        if (hipGetDevice(&dev) != hipSuccess || hipDeviceGetAttribute(&cus, hipDeviceAttributeMultiprocessorCount, dev) != hipSuccess) { grid = -1; return; }
        if (hipFuncSetAttribute((const void*)mega_fwd, hipFuncAttributeMaxDynamicSharedMemorySize, LDS_BYTES) != hipSuccess) { fprintf(stderr, "kernel_launch: hipFuncSetAttribute failed\n"); grid = -1; return; }
        int per_cu = 0;
        if (hipOccupancyMaxActiveBlocksPerMultiprocessor(&per_cu, (const void*)mega_fwd, NWAVES * 64, LDS_BYTES) != hipSuccess || per_cu < 1)
            fprintf(stderr, "kernel_launch: occupancy query says %d\n", per_cu);
        (void)hipGetLastError();
        grid = cus;
        if (grid != 256) fprintf(stderr, "kernel_launch: %d CUs (expected 256)\n", grid);
    }
    if (grid < 0) return;
    (void)hipMemsetAsync((char*)d_ws + WS_CTL, 0, CTL_ZERO_BYTES, stream);
    Args a{};
    for (int i = 0; i < 29; ++i) a.in[i] = (const float*)d_in[i];
    a.out = (float*)d_out; a.ws = (unsigned char*)d_ws; a.ph_lo = 0; a.ph_hi = DEBUG_CHECK ? 4 : 100;
    hipLaunchKernelGGL(mega_fwd, dim3(grid), dim3(NWAVES * 64), LDS_BYTES, stream, a);
#if DEBUG_CHECK
    hipLaunchKernelGGL(dbg_check, dim3(256), dim3(256), 0, stream, a);
    hipLaunchKernelGGL(dbg_check_ret, dim3(512), dim3(256), 0, stream, a);
    hipLaunchKernelGGL(dbg_check_att, dim3(512), dim3(256), 0, stream, a);
    hipLaunchKernelGGL(dbg_report, dim3(1024), dim3(256), 0, stream, a, out_size);
#endif
}
```

```cpp
#include <hip/hip_runtime.h>
#include <hip/hip_bf16.h>
#include <cstdio>
#include <cstdint>

#ifndef DEBUG_CHECK
#define DEBUG_CHECK 0
#endif
#ifndef REP
#define REP 0
#endif
#ifndef TIMING
#define TIMING 0
#endif
#ifndef T_A0
#define T_A0 3
#define T_A1 4
#define T_SCALE 15
#endif

constexpr int NTOK = 32768, DM = 1024, SEQ = 8192, NBATCH = 4, PLE = 256;
constexpr int INCOLS = 11264;
constexpr int NEXP = 256, TOPK = 8, DEXP = 256;
constexpr float LN_EPS = 1e-5f;
constexpr float DN_ALPHA = 1.189207115002721f;
constexpr float LOG2E = 1.4426950408889634f;
constexpr float QD_SCALE = 0.125f * LOG2E;
constexpr float KR_SCALE = 0.08838834764831845f;

constexpr size_t MiB = 1u << 20;
constexpr size_t WS_CTL = 0, CTL_ZERO_BYTES = 1 * MiB;
constexpr size_t WS_WIN_T = 1 * MiB;
constexpr size_t WS_WRO_T = 23 * MiB;
constexpr size_t WS_WDO_T = 27 * MiB;
constexpr size_t WS_WO_T  = 29 * MiB;
constexpr size_t WS_ROUT_T = 31 * MiB;
constexpr size_t WS_PLEW_T = 31 * MiB + 512 * 1024;
constexpr size_t WS_PLEG_T = 32 * MiB;
constexpr size_t WS_SHGU_T = 34 * MiB;
constexpr size_t WS_SHD_T  = 35 * MiB;
constexpr size_t WS_XN   = 48 * MiB;
constexpr size_t WS_PB   = 112 * MiB;
constexpr size_t WS_QR   = 128 * MiB;
constexpr size_t WS_KR   = 192 * MiB;
constexpr size_t WS_VR   = 256 * MiB;
constexpr size_t WS_GR   = 384 * MiB;
constexpr size_t WS_QD   = 512 * MiB;
constexpr size_t WS_KD   = 576 * MiB;
constexpr size_t WS_VD   = 640 * MiB;
constexpr size_t WS_GT   = 704 * MiB;
constexpr size_t WS_M    = 192 * MiB;
constexpr size_t WS_GNST = 896 * MiB;
constexpr size_t WS_Z    = 256 * MiB;
constexpr size_t WS_H1   = 320 * MiB;
constexpr size_t WS_LOGIT = 48 * MiB;
constexpr size_t WS_META = 1008 * MiB;
constexpr size_t WS_EGU_T = 768 * MiB;
constexpr size_t WS_ED_A  = 448 * MiB, WS_ED_B = 912 * MiB;
constexpr size_t WS_ACT  = 112 * MiB;
constexpr size_t WS_BASE = 384 * MiB;
constexpr size_t WS_Y    = 512 * MiB;
constexpr size_t WS_END  = 1024 * MiB;
constexpr size_t WS_DBGV = 912 * MiB;
constexpr size_t WS_XN8 = 912 * MiB;
constexpr size_t WS_SXN = 944 * MiB;
constexpr size_t WS_SWIN = 36 * MiB;
constexpr size_t WS_SH1 = 37 * MiB;
constexpr size_t WS_SEGU = 38 * MiB;
constexpr size_t WS_SSHGU = 39 * MiB;
constexpr size_t WS_SPLEG = 39 * MiB + 4096;
constexpr size_t WS_SWRO = 39 * MiB + 16384;
constexpr size_t WS_H18 = 80 * MiB;
constexpr size_t WS_SAR = 40 * MiB;
constexpr size_t WS_SWDO = 39 * MiB + 32768;
constexpr size_t WS_AD8 = 976 * MiB;
constexpr size_t WS_AR8 = 128 * MiB;
constexpr int NROWS_MAX = 1280 * 256;
constexpr int SH_ACT_ROW0 = NROWS_MAX;
constexpr size_t M_IDX = WS_META, M_W = WS_META + 1 * MiB, M_RASSIGN = WS_META + 2 * MiB, M_RTOK = WS_META + 4 * MiB, M_RW = WS_META + 6 * MiB,
                 M_RS = WS_META + 10 * MiB, M_BLKE = WS_META + 8 * MiB, M_NBLK = WS_META + 8 * MiB + 65536, M_IDENT = WS_META + 9 * MiB;

constexpr int CW_TMO = 0, CW_CODE = 1;
constexpr int CW_TS = 512;
constexpr int CW_DBG = 64;
constexpr int CW_BAR = 4096;
constexpr int CW_STEAL = 480;
constexpr int CW_PAD = 32;
constexpr int CW_CNT = 16384;
constexpr int CW_CUR = 16384 + 256 * CW_PAD;

constexpr int RING_BYTES = 131072;
constexpr int LDSCTL_OFF = 147456 - 1024, MISC_OFF = LDSCTL_OFF + 320;
constexpr int LDS_BYTES = 147456;
constexpr int NWAVES = 8;
constexpr float F8_WSCALE = 64.f, F8_ASCALE = 16.f;

__host__ __device__ __forceinline__ size_t ed_off(int e) { return WS_ED_B + (size_t)e * (1024 * 256); }
constexpr size_t WS_V8 = WS_ED_A;
constexpr float V8_SCALE = 16.f;
constexpr size_t WS_M8 = 320 * MiB;
constexpr float M8_SCALE = 16.f, B8_SCALE = 16.f;
#define GAS __attribute__((address_space(1)))
#define LAS __attribute__((address_space(3)))
typedef unsigned short bf16_t;
typedef unsigned v4u __attribute__((ext_vector_type(4)));
typedef float f32x4 __attribute__((ext_vector_type(4)));
typedef float f32x2 __attribute__((ext_vector_type(2)));
typedef int i32x4 __attribute__((ext_vector_type(4)));
typedef int i32x8 __attribute__((ext_vector_type(8)));
typedef short bf16x8 __attribute__((ext_vector_type(8)));
typedef GAS unsigned gu32;
#define RLX_AGENT __ATOMIC_RELAXED, __HIP_MEMORY_SCOPE_AGENT
#define LDS_WAIT() asm volatile("s_waitcnt lgkmcnt(0)" ::: "memory")
#define VM_WAIT() asm volatile("s_waitcnt vmcnt(0)" ::: "memory")

__device__ __forceinline__ unsigned f2bf(float f) { unsigned u = __builtin_bit_cast(unsigned, f); return (u + 0x7fffu + ((u >> 16) & 1u)) >> 16; }
__device__ __forceinline__ unsigned pk2(float lo, float hi) { return f2bf(lo) | (f2bf(hi) << 16); }
__device__ __forceinline__ float bf2f(unsigned short b) { return __builtin_bit_cast(float, (unsigned)b << 16); }
__device__ __forceinline__ float bflo(unsigned w) { return __builtin_bit_cast(float, w << 16); }
__device__ __forceinline__ float bfhi(unsigned w) { return __builtin_bit_cast(float, w & 0xffff0000u); }
__device__ __forceinline__ unsigned cvt_pk_bf16(float lo, float hi) { unsigned r; asm volatile("v_cvt_pk_bf16_f32 %0, %1, %2" : "=v"(r) : "v"(lo), "v"(hi)); return r; }
__device__ __forceinline__ unsigned cvtpk_(float lo, float hi) { unsigned r; asm("v_cvt_pk_bf16_f32 %0, %1, %2" : "=v"(r) : "v"(lo), "v"(hi)); return r; }
__device__ __forceinline__ float fast_sigmoid(float x) { return __builtin_amdgcn_rcpf(1.f + __builtin_amdgcn_exp2f(-x * LOG2E)); }
__device__ __forceinline__ float fast_silu(float x) { return x * fast_sigmoid(x); }
__device__ __forceinline__ int lane_id() { int l; asm volatile("v_mbcnt_lo_u32_b32 %0, -1, 0\n\tv_mbcnt_hi_u32_b32 %0, -1, %0" : "=v"(l)); return l; }
__device__ __forceinline__ float wave_sum(float v) {
#pragma unroll
    for (int o = 1; o < 64; o <<= 1) v += __shfl_xor(v, o);
    return v;
}

namespace pg8 {
constexpr int BM = 256, BK = 64, HALF = 128, HTB = HALF * BK * 2, STAGE_BYTES = 8 * HTB, NXCD = 8, WGM = 8, SCL_OFF = 131072;
__host__ __device__ __forceinline__ int lds_byte(int r, int c) { const int st = (r >> 4) * 2 + (c >> 5), rr = r & 15, cc = c & 31, ob = rr * 64 + cc * 2; return st * 1024 + (ob ^ (((ob >> 9) & 1) << 5)); }
__host__ __device__ __forceinline__ void stage_rc(int b, int& R, int& C) { const int st = b / 1024, sb = b % 1024, swz = sb ^ (((sb >> 9) & 1) << 5); R = (st >> 1) * 16 + swz / 64; C = (st & 1) * 32 + (swz % 64) / 2; }
__host__ __device__ __forceinline__ int perm32(int rho) { const int n = rho >> 4, i = rho & 15; return 8 * (i >> 2) + 4 * n + (i & 3); }

struct Unit { int pm, pn, type, aux; const char* A; const char* B; int grow; const float* cs; };
__device__ __forceinline__ bool tile_order(long L, int nM, int nN, int& pm, int& pn) {
    const int nwg = nM * nN; if (L >= nwg) return false;
    int wgid = (int)L; { const int q = nwg / NXCD, r = nwg % NXCD, xcd = wgid % NXCD, off = wgid / NXCD; wgid = (xcd < r ? xcd * (q + 1) : r * (q + 1) + (xcd - r) * q) + off; }
    const int nig = WGM * nN, gid = wgid / nig, fm = gid * WGM, gsz = (nM - fm) < WGM ? (nM - fm) : WGM;
    pm = fm + ((wgid % nig) % gsz); pn = (wgid % nig) / gsz; return true;
}
struct DenseOrder {
    const char* A; const char* Bt; int nM, nN, G, c; size_t tstep; int type;
    __device__ void init(const void* A_, const void* Bt_, int M, int N, int K, int G_, int c_, int type_ = 0) { A = (const char*)A_; Bt = (const char*)Bt_; nM = M / BM; nN = N / BM; G = G_; c = c_; tstep = (size_t)BM * K * 2; type = type_; }
    __device__ __forceinline__ bool next(int i, Unit& u) const {
        int pm, pn; if (!tile_order((long)i * G + c, nM, nN, pm, pn)) return false;
        u.pm = pm; u.pn = pn; u.type = type; u.aux = 0; u.A = A + (size_t)pm * tstep; u.B = Bt + (size_t)pn * tstep; u.grow = -1; return true;
    }
};

template <class Epi, class Sched, bool GATHER, bool I8 = false, bool F8 = false>
__device__ __forceinline__ void gemm_phase(LAS unsigned char* lds, const int K, const Sched& S, const Epi& E, const int* __restrict__ rowtok, const int wave_) {
    const int wid = __builtin_amdgcn_readfirstlane(wave_), lane = lane_id(), tid = wid * 64 + lane, wr = wid >> 2, wc = wid & 3, fr = lane & 15, fq = lane >> 4;
    const int nt = K / BK;
    int RA[2], CA[2];
    unsigned voffB[2], voffAc[2][2], voffAn[2][2];
#pragma unroll
    for (int i = 0; i < 2; ++i) { int R, C; stage_rc(tid * 16 + i * 8192, R, C); const int Rb = Epi::WIDE ? (64 * (R >> 5) + perm32(R & 31)) : (Epi::PERM ? ((R & ~31) + perm32(R & 31)) : R);
        RA[i] = R; CA[i] = C; voffB[i] = (unsigned)(Rb * K + C) * 2u;
        voffAc[0][i] = voffAc[1][i] = voffAn[0][i] = voffAn[1][i] = (unsigned)(R * K + C) * 2u; }
    const size_t kstep = (size_t)(BK * 2);
    const size_t hstepB = Epi::WIDE ? (size_t)32 * K * 2 : (size_t)HALF * K * 2;
    const size_t hstepA = GATHER ? 0 : (size_t)HALF * K * 2;
    const unsigned ldsw = (unsigned)wid * 1024u;
    const int aoff = lds_byte(wr * 64 + fr, fq * 8), boff = lds_byte(wc * 32 + fr, fq * 8);
#define PG8_SA(b, h) (((b) * 2 + (h)) * HTB)
#define PG8_SB(b, h) ((4 + (b) * 2 + (h)) * HTB)
#define PG8_STAGE(bufoff, gbase, voff) do { _Pragma("unroll") for (int _i = 0; _i < 2; ++_i) \
        __builtin_amdgcn_global_load_lds((const unsigned*)((const char*)(gbase) + (voff)[_i]), (LAS unsigned*)(lds + (bufoff) + ldsw + _i * 8192), 16, 0, 0); } while (0)
#define PG8_LDA(dst, b, h) do { _Pragma("unroll") for (int m = 0; m < 4; ++m) _Pragma("unroll") for (int k = 0; k < 2; ++k) dst[m][k] = *(const LAS bf16x8*)(lds + PG8_SA(b, h) + aoff + m * 2048 + k * 1024); } while (0)
#define PG8_LDB(dst, b, h) do { _Pragma("unroll") for (int n = 0; n < 2; ++n) _Pragma("unroll") for (int k = 0; k < 2; ++k) dst[n][k] = *(const LAS bf16x8*)(lds + PG8_SB(b, h) + boff + n * 2048 + k * 1024); } while (0)
#define PG8_MMA(ai, bj, At, Bt) do { __builtin_amdgcn_s_setprio(1); _Pragma("unroll") for (int m = 0; m < 4; ++m) _Pragma("unroll") for (int n = 0; n < 2; ++n) _Pragma("unroll") for (int k = 0; k < 2; ++k) { \
        if constexpr (F8) {   \
          const i32x4 b_ = __builtin_bit_cast(i32x4, Bt[n][k]), a_ = __builtin_bit_cast(i32x4, At[m][k]); \
          acc[ai][bj][m][n] = __builtin_amdgcn_mfma_f32_16x16x32_fp8_fp8((long)(((unsigned long long)(unsigned)b_[1] << 32) | (unsigned)b_[0]), (long)(((unsigned long long)(unsigned)a_[1] << 32) | (unsigned)a_[0]), acc[ai][bj][m][n], 0, 0, 0); \
          acc[ai][bj][m][n] = __builtin_amdgcn_mfma_f32_16x16x32_fp8_fp8((long)(((unsigned long long)(unsigned)b_[3] << 32) | (unsigned)b_[2]), (long)(((unsigned long long)(unsigned)a_[3] << 32) | (unsigned)a_[2]), acc[ai][bj][m][n], 0, 0, 0); } \
        else if constexpr (I8) acc[ai][bj][m][n] = __builtin_bit_cast(f32x4, __builtin_amdgcn_mfma_i32_16x16x64_i8(__builtin_bit_cast(i32x4, Bt[n][k]), __builtin_bit_cast(i32x4, At[m][k]), __builtin_bit_cast(i32x4, acc[ai][bj][m][n]), 0, 0, 0)); \
        else acc[ai][bj][m][n] = __builtin_amdgcn_mfma_f32_16x16x32_bf16(Bt[n][k], At[m][k], acc[ai][bj][m][n], 0, 0, 0); } __builtin_amdgcn_s_setprio(0); } while (0)
#define PG8_WAIT_V(n) asm volatile("s_waitcnt vmcnt(" #n ")" ::: "memory")
#define PG8_WAIT_L(n) asm volatile("s_waitcnt lgkmcnt(" #n ")" ::: "memory")
#define PG8_BAR __builtin_amdgcn_s_barrier()
#define PG8_SCHED __builtin_amdgcn_sched_barrier(0)
#define PG8_GOFF(dst, u) do { if (GATHER) { _Pragma("unroll") for (int h = 0; h < 2; ++h) _Pragma("unroll") for (int i = 0; i < 2; ++i) { \
        const int tok = rowtok[(u).grow + h * HALF + RA[i]]; dst[h][i] = (unsigned)(tok * K + CA[i]) * 2u; } } } while (0)
    Unit cur, nxt; int ui = 0;
    if (!S.next(0, cur)) return;
    PG8_GOFF(voffAc, cur);
#define PG8_SCALES(u, buf) do { if constexpr (I8 || Epi::PRE) { const float* src_ = (wid < 4 ? E.rowscale_ptr(u) + wid * 64 : E.colscale(u) + (wid - 4) * 64) + lane; \
        __builtin_amdgcn_global_load_lds((const unsigned*)src_, (LAS unsigned*)(lds + SCL_OFF + (buf) * 2048 + wid * 256), 4, 0, 0); } } while (0)
    PG8_SCALES(cur, 0);
    f32x4 acc[2][2][4][2];
#pragma unroll
    for (int a = 0; a < 2; ++a)
#pragma unroll
        for (int b = 0; b < 2; ++b)
#pragma unroll
            for (int m = 0; m < 4; ++m)
#pragma unroll
                for (int n = 0; n < 2; ++n) acc[a][b][m][n] = (f32x4){0.f, 0.f, 0.f, 0.f};
    bf16x8 At[4][2], B0[2][2], B1[2][2];
    const char* cA = cur.A; const char* cB = cur.B;
    PG8_STAGE(PG8_SB(0, 0), cB, voffB); PG8_STAGE(PG8_SB(0, 1), cB + hstepB, voffB); PG8_STAGE(PG8_SA(0, 0), cA, voffAc[0]); PG8_STAGE(PG8_SA(0, 1), cA + hstepA, voffAc[1]);
    if (wr == 1) PG8_BAR;
    PG8_WAIT_V(2); PG8_BAR;
    PG8_STAGE(PG8_SB(1, 0), cB + kstep, voffB); PG8_STAGE(PG8_SA(1, 0), cA + kstep, voffAc[0]); PG8_STAGE(PG8_SB(1, 1), cB + hstepB + kstep, voffB);
    PG8_WAIT_V(6); PG8_BAR;
    for (;;) {
        const bool has_next = S.next(ui + 1, nxt);
        if (has_next) { PG8_GOFF(voffAn, nxt); }
        else { if (GATHER) { _Pragma("unroll") for (int h = 0; h < 2; ++h) _Pragma("unroll") for (int i = 0; i < 2; ++i) voffAn[h][i] = voffAc[h][i]; } }
        const char* nA = has_next ? nxt.A : cA; const char* nB = has_next ? nxt.B : cB;
        _Pragma("unroll 1") for (int t = 0; t < nt; t += 2) {
            const bool last = (t == nt - 2);
            const char* a1 = cA + (size_t)(t + 1) * kstep;
            const char* a2 = last ? nA : cA + (size_t)(t + 2) * kstep; const char* b2 = last ? nB : cB + (size_t)(t + 2) * kstep;
            const char* a3 = a2 + kstep; const char* b3 = b2 + kstep;
            unsigned va2[2][2];
#pragma unroll
            for (int h = 0; h < 2; ++h)
#pragma unroll
                for (int i = 0; i < 2; ++i) va2[h][i] = (GATHER && last) ? voffAn[h][i] : voffAc[h][i];
            PG8_LDB(B0, 0, 0); PG8_LDB(B1, 0, 1); PG8_SCHED; PG8_LDA(At, 0, 0); PG8_STAGE(PG8_SA(1, 1), a1 + hstepA, voffAc[1]);
            PG8_WAIT_V(8); PG8_WAIT_L(0); PG8_BAR; PG8_MMA(0, 0, At, B0); PG8_MMA(0, 1, At, B1); PG8_BAR; PG8_SCHED;
            PG8_LDA(At, 0, 1); PG8_STAGE(PG8_SB(0, 0), b2, voffB); PG8_STAGE(PG8_SB(0, 1), b2 + hstepB, voffB); PG8_STAGE(PG8_SA(0, 0), a2, va2[0]);
            PG8_WAIT_V(8); PG8_WAIT_L(0); PG8_BAR; PG8_MMA(1, 0, At, B0); PG8_MMA(1, 1, At, B1); PG8_BAR; PG8_SCHED;
            PG8_LDB(B0, 1, 0); PG8_LDB(B1, 1, 1); PG8_SCHED; PG8_LDA(At, 1, 0); PG8_STAGE(PG8_SA(0, 1), a2 + hstepA, va2[1]);
            PG8_WAIT_V(8); PG8_WAIT_L(0); PG8_BAR; PG8_MMA(0, 0, At, B0); PG8_MMA(0, 1, At, B1); PG8_BAR; PG8_SCHED;
            PG8_LDA(At, 1, 1); PG8_STAGE(PG8_SB(1, 0), b3, voffB); PG8_STAGE(PG8_SB(1, 1), b3 + hstepB, voffB); PG8_STAGE(PG8_SA(1, 0), a3, va2[0]);
            PG8_WAIT_V(8); PG8_WAIT_L(0); PG8_BAR; PG8_MMA(1, 0, At, B0); PG8_MMA(1, 1, At, B1); PG8_BAR; PG8_SCHED;
            if (t == 0 && has_next) PG8_SCALES(nxt, (ui + 1) & 1);
        }
        if (wr == 0) PG8_BAR;
        if constexpr (I8) {
            int lr0 = wr * 64 + fr, cw = wc * 32 + 8 * fq; asm volatile("" : "+v"(lr0), "+v"(cw));
            const LAS unsigned char* scl = lds + SCL_OFF + (ui & 1) * 2048;
            f32x4 csv[2][2];
#pragma unroll
            for (int bj = 0; bj < 2; ++bj)
#pragma unroll
                for (int n = 0; n < 2; ++n) csv[bj][n] = *(const LAS f32x4*)(scl + 1024 + 4 * ((Epi::WIDE ? 64 * wc + 32 * bj + 8 * fq : bj * 128 + cw) + 4 * n));
#pragma unroll
            for (int ai = 0; ai < 2; ++ai)
#pragma unroll
                for (int m = 0; m < 4; ++m) { const float rsv = E.fixed_rowscale() ? E.fixed_rs_value() : *(const LAS float*)(scl + 4 * (lr0 + ai * 128 + m * 16));
#pragma unroll
                    for (int bj = 0; bj < 2; ++bj)
#pragma unroll
                        for (int n = 0; n < 2; ++n) acc[ai][bj][m][n] = __builtin_convertvector(__builtin_bit_cast(i32x4, acc[ai][bj][m][n]), f32x4) * rsv * csv[bj][n]; }
        }
        if constexpr (Epi::PRE) E(acc, cur, wr, wc, fr, fq, lds + SCL_OFF + (ui & 1) * 2048); else E(acc, cur, wr, wc, fr, fq);
        if (!has_next) break;
#pragma unroll
        for (int a = 0; a < 2; ++a)
#pragma unroll
            for (int b = 0; b < 2; ++b)
#pragma unroll
                for (int m = 0; m < 4; ++m)
#pragma unroll
                    for (int n = 0; n < 2; ++n) acc[a][b][m][n] = (f32x4){0.f, 0.f, 0.f, 0.f};
        cur = nxt; cA = nA; cB = nB; ++ui;
        if (GATHER) { _Pragma("unroll") for (int h = 0; h < 2; ++h) _Pragma("unroll") for (int i = 0; i < 2; ++i) voffAc[h][i] = voffAn[h][i]; }
        if (wr == 1) PG8_BAR;
    }
    PG8_WAIT_V(0);
    PG8_BAR;
#undef PG8_SA
#undef PG8_SB
#undef PG8_STAGE
#undef PG8_LDA
#undef PG8_LDB
#undef PG8_MMA
#undef PG8_WAIT_V
#undef PG8_WAIT_L
#undef PG8_BAR
#undef PG8_SCHED
#undef PG8_GOFF
#undef PG8_SCALES
}
typedef f32x4 Acc[2][2][4][2];
}

#define XB_TMO      128
#define XB_XCNT(j)  (256  + 64 * (j))
#define XB_XSUB(j)  (1280 + 64 * (j))
#define XB_XGEN(j)  (2304 + 64 * (j))
#define XB_TOP      3328
#define XB_TOPGEN   3392
#define XCD_BAR_WORDS 3456
#define XB_SPIN_CAP (1u << 18)
__device__ __forceinline__ unsigned xb_ld(unsigned* p)              { return __hip_atomic_load(p, __ATOMIC_RELAXED, __HIP_MEMORY_SCOPE_AGENT); }
__device__ __forceinline__ unsigned xb_add(unsigned* p, unsigned v) { return __hip_atomic_fetch_add(p, v, __ATOMIC_RELAXED, __HIP_MEMORY_SCOPE_AGENT); }
__device__ __forceinline__ unsigned xb_xcc_id() { return (unsigned)__builtin_amdgcn_s_getreg((3 << 11) | 20) & 0xFu; }
#define XB_SPIN(cond, bar) do { unsigned _sp = 0; while (cond) { __builtin_amdgcn_s_sleep(1); \
    if ((++_sp & 255u) == 0u) { if (xb_ld(&(bar)[XB_TMO])) break; if (_sp > XB_SPIN_CAP) { atomicAdd(&(bar)[XB_TMO], 1u); break; } } } } while (0)
struct XcdBarrier { unsigned* bar; unsigned x; volatile LAS unsigned* st; };
__device__ __forceinline__ XcdBarrier xcd_barrier_post(unsigned* bar, volatile LAS unsigned* st) {
    XcdBarrier b; b.bar = bar; b.x = xb_xcc_id(); b.st = st;
    if (threadIdx.x == 0) (void)xb_add(&bar[XB_XCNT(b.x)], 1u);
    return b;
}
__device__ __forceinline__ void xcd_barrier_complete(unsigned* bar, unsigned x, unsigned& nloc, unsigned& nx) {
    const unsigned G = gridDim.x * gridDim.y * gridDim.z;
    unsigned sum, cnt, mine, sp = 0u;
    for (;;) {
        sum = 0u; cnt = 0u; mine = 0u;
#pragma unroll
        for (unsigned j = 0; j < 16; ++j) { const unsigned c = xb_ld(&bar[XB_XCNT(j)]); sum += c; cnt += (c > 0u) ? 1u : 0u; mine = (j == x) ? c : mine; }
        if (sum == G) break;
        __builtin_amdgcn_s_sleep(1);
        if ((++sp & 255u) == 0u) { if (xb_ld(&bar[XB_TMO])) break; if (sp > XB_SPIN_CAP) { atomicAdd(&bar[XB_TMO], 1u); break; } }
    }
    nloc = mine > 0u ? mine : 1u; nx = cnt > 0u ? cnt : 1u;
}
__device__ __forceinline__ void xcd_barrier(const XcdBarrier& b) {
    asm volatile("s_waitcnt vmcnt(0)" ::: "memory");
    __syncthreads();
    if (threadIdx.x == 0) {
        unsigned* bar = b.bar;
        __builtin_amdgcn_s_waitcnt(0);
        unsigned nloc = b.st[0], nx = b.st[1];
        if (nloc == 0u) { xcd_barrier_complete(bar, b.x, nloc, nx); b.st[0] = nloc; b.st[1] = nx; }
        const unsigned old = xb_add(&bar[XB_XSUB(b.x)], 1u);
        const unsigned gen = old / nloc;
        if (old + 1u == (gen + 1u) * nloc) {
            __builtin_amdgcn_fence(__ATOMIC_RELEASE, "agent");
            asm volatile("s_waitcnt vmcnt(0)" ::: "memory");
            const unsigned og = xb_add(&bar[XB_TOP], 1u);
            const unsigned tg = og / nx;
            if (og + 1u == (tg + 1u) * nx) xb_add(&bar[XB_TOPGEN], 1u);
            else XB_SPIN(xb_ld(&bar[XB_TOPGEN]) == tg, bar);
            __builtin_amdgcn_fence(__ATOMIC_ACQUIRE, "agent");
            xb_add(&bar[XB_XGEN(b.x)], 1u);
            asm volatile("s_waitcnt vmcnt(0)" ::: "memory");
        } else {
            XB_SPIN(xb_ld(&bar[XB_XGEN(b.x)]) == gen, bar);
            __builtin_amdgcn_fence(__ATOMIC_ACQUIRE, "agent");
            asm volatile("s_waitcnt vmcnt(0)" ::: "memory");
        }
    }
    __syncthreads();
}

struct Args { const float* in[29]; float* out; unsigned char* ws; int ph_lo, ph_hi; };
enum { I_X = 0, I_P, I_LNIN_G, I_LNIN_B, I_RELB, I_WIN, I_GN_G, I_LQ1, I_LK1, I_LQ2, I_LK2, I_SUBLN_G, I_WRO, I_WDO, I_WO, I_LN1_G, I_LN1_B,
       I_ROUT_W, I_ROUT_B, I_EG, I_EU, I_ED, I_SG, I_SU, I_SD, I_PLE_W, I_PLE_GW, I_LN2_G, I_LN2_B };

struct Frame {
    LAS unsigned char* lds;
    volatile LAS unsigned* MISC;
    gu32* ctl;
    int wave, vcu, G;
};
#define FTID (F.wave * 64 + lane_id())
#define FLANE (lane_id())

__device__ __forceinline__ void p0_transpose_item(const float* W, int K, int N, bf16_t* WT, int k0, int n0, int dstrow0, LAS float* scr, int lane) {
    const int cg = lane & 7, r = lane >> 3;
    f32x4 v[8];
#pragma unroll
    for (int i = 0; i < 8; ++i) v[i] = *(const f32x4*)(W + (size_t)(k0 + r + 8 * i) * N + n0 + 4 * cg);
#pragma unroll
    for (int i = 0; i < 8; ++i) { LAS float* d = scr + (r + 8 * i) * 33 + 4 * cg; d[0] = v[i].x; d[1] = v[i].y; d[2] = v[i].z; d[3] = v[i].w; }
    LDS_WAIT(); asm volatile("" ::: "memory");
    const int c = lane & 7;
#pragma unroll
    for (int j = 0; j < 4; ++j) { const int n = (lane >> 3) + 8 * j; const LAS float* s = scr + (8 * c) * 33 + n;
        v4u o; o.x = pk2(s[0 * 33], s[1 * 33]); o.y = pk2(s[2 * 33], s[3 * 33]); o.z = pk2(s[4 * 33], s[5 * 33]); o.w = pk2(s[6 * 33], s[7 * 33]);
        *(GAS v4u*)(WT + (size_t)(dstrow0 + n) * K + k0 + 8 * c) = o; }
    LDS_WAIT(); asm volatile("" ::: "memory");
}
__device__ __forceinline__ void p0_transpose_item_f8(const float* W, int K, int N, unsigned char* WT8, int k0, int n0, int dstrow0, LAS float* scr, int lane, const float scale) {
    const int cg = lane & 7, r = lane >> 3;
    f32x4 v[8];
#pragma unroll
    for (int i = 0; i < 8; ++i) v[i] = *(const f32x4*)(W + (size_t)(k0 + r + 8 * i) * N + n0 + 4 * cg);
#pragma unroll
    for (int i = 0; i < 8; ++i) { LAS float* d = scr + (r + 8 * i) * 33 + 4 * cg; d[0] = v[i].x * scale; d[1] = v[i].y * scale; d[2] = v[i].z * scale; d[3] = v[i].w * scale; }
    LDS_WAIT(); asm volatile("" ::: "memory");
    const int c = lane & 7;
#pragma unroll
    for (int j = 0; j < 4; ++j) { const int n = (lane >> 3) + 8 * j; const LAS float* s = scr + (8 * c) * 33 + n;
        int w0 = 0, w1 = 0;
        w0 = __builtin_amdgcn_cvt_pk_fp8_f32(s[0 * 33], s[1 * 33], w0, false); w0 = __builtin_amdgcn_cvt_pk_fp8_f32(s[2 * 33], s[3 * 33], w0, true);
        w1 = __builtin_amdgcn_cvt_pk_fp8_f32(s[4 * 33], s[5 * 33], w1, false); w1 = __builtin_amdgcn_cvt_pk_fp8_f32(s[6 * 33], s[7 * 33], w1, true);
        *(GAS unsigned long long*)(WT8 + (size_t)(dstrow0 + n) * K + k0 + 8 * c) = (unsigned long long)(unsigned)w0 | ((unsigned long long)(unsigned)w1 << 32); }
    LDS_WAIT(); asm volatile("" ::: "memory");
}
__host__ __device__ __forceinline__ int win_dst_row(int c) {
    if (c >= 2048) return c;
    const int sb = c & ~1023, cs = c & 1023, hd = cs >> 7, half = (cs >> 6) & 1, j = cs & 63;
    return sb + (hd >> 1) * 256 + 64 * (2 * (hd & 1) + (j >> 5)) + 32 * half + (j & 31);
}
__device__ __forceinline__ void ln_row_to_bf16(int lane, const float* xrow, const float* g, const float* b, bf16_t* orow) {
    const GAS f32x4* xr = (const GAS f32x4*)xrow + lane;
    f32x4 v[4]; float s = 0.f;
#pragma unroll
    for (int j = 0; j < 4; ++j) { v[j] = xr[64 * j]; s += (v[j].x + v[j].y) + (v[j].z + v[j].w); }
    const float mean = wave_sum(s) * (1.f / DM); float s2 = 0.f;
#pragma unroll
    for (int j = 0; j < 4; ++j) { v[j] = v[j] - mean; s2 += (v[j].x * v[j].x + v[j].y * v[j].y) + (v[j].z * v[j].z + v[j].w * v[j].w); }
    const float rstd = 1.f / sqrtf(wave_sum(s2) * (1.f / DM) + LN_EPS);
    GAS unsigned long long* o8 = (GAS unsigned long long*)orow + lane;
#pragma unroll
    for (int j = 0; j < 4; ++j) { const f32x4 gg = *((const GAS f32x4*)g + lane + 64 * j), bb = *((const GAS f32x4*)b + lane + 64 * j);
        const f32x4 y = v[j] * rstd * gg + bb;
        o8[64 * j] = (unsigned long long)pk2(y.x, y.y) | ((unsigned long long)pk2(y.z, y.w) << 32); }
}

template <bool BF16IN>
__device__ __forceinline__ void ln_row_to_bf16_i8(int lane, const void* xrow, const float* g, const float* b, bf16_t* orow, signed char* qrow, float* srow) {
    f32x4 v[4]; float s = 0.f;
#pragma unroll
    for (int j = 0; j < 4; ++j) {
        if constexpr (BF16IN) { const unsigned long long w = ((const GAS unsigned long long*)xrow)[lane + 64 * j]; v[j] = (f32x4){bflo((unsigned)w), bfhi((unsigned)w), bflo((unsigned)(w >> 32)), bfhi((unsigned)(w >> 32))}; }
        else v[j] = ((const GAS f32x4*)xrow)[lane + 64 * j];
        s += (v[j].x + v[j].y) + (v[j].z + v[j].w); }
    const float mean = wave_sum(s) * (1.f / DM); float s2 = 0.f;
#pragma unroll
    for (int j = 0; j < 4; ++j) { v[j] = v[j] - mean; s2 += (v[j].x * v[j].x + v[j].y * v[j].y) + (v[j].z * v[j].z + v[j].w * v[j].w); }
    const float rstd = 1.f / sqrtf(wave_sum(s2) * (1.f / DM) + LN_EPS);
    GAS unsigned long long* o8 = (GAS unsigned long long*)orow + lane;
    float mx = 0.f;
#pragma unroll
    for (int j = 0; j < 4; ++j) { const f32x4 gg = *((const GAS f32x4*)g + lane + 64 * j), bb = *((const GAS f32x4*)b + lane + 64 * j);
        v[j] = v[j] * rstd * gg + bb;
        o8[64 * j] = (unsigned long long)pk2(v[j].x, v[j].y) | ((unsigned long long)pk2(v[j].z, v[j].w) << 32);
        mx = fmaxf(mx, fmaxf(fmaxf(fabsf(v[j].x), fabsf(v[j].y)), fmaxf(fabsf(v[j].z), fabsf(v[j].w)))); }
#pragma unroll
    for (int o = 1; o < 64; o <<= 1) mx = fmaxf(mx, __shfl_xor(mx, o));
    const float sc = mx > 0.f ? mx * (1.f / 127.f) : 1.f, inv = 1.f / sc;
    GAS unsigned* q4 = (GAS unsigned*)qrow + lane;
#pragma unroll
    for (int j = 0; j < 4; ++j) { const int q0 = (int)rintf(v[j].x * inv), q1 = (int)rintf(v[j].y * inv), q2 = (int)rintf(v[j].z * inv), q3 = (int)rintf(v[j].w * inv);
        q4[64 * j] = (unsigned)(q0 & 255) | ((unsigned)(q1 & 255) << 8) | ((unsigned)(q2 & 255) << 16) | ((unsigned)(q3 & 255) << 24); }
    if (lane == 0) *srow = sc;
}
template <bool BF16IN>
__device__ __forceinline__ void ln_rows_bf16_i8(int lane, const void* X, const float* g, const float* b, bf16_t* O, signed char* Q, float* S, int m0, int mstep, int M) {
    f32x4 gg[4], bb[4];
#pragma unroll
    for (int j = 0; j < 4; ++j) { gg[j] = *((const GAS f32x4*)g + lane + 64 * j); bb[j] = *((const GAS f32x4*)b + lane + 64 * j); }
    f32x4 cv[4], nv[4]; unsigned long long cw[4], nw[4];
#define LN_LOAD(dv, dw, m_) do { _Pragma("unroll") for (int j = 0; j < 4; ++j) { \
        if constexpr (BF16IN) dw[j] = ((const GAS unsigned long long*)((const bf16_t*)X + (size_t)(m_) * DM))[lane + 64 * j]; \
        else dv[j] = ((const GAS f32x4*)((const float*)X + (size_t)(m_) * DM))[lane + 64 * j]; } } while (0)
    int m = m0;
    if (m < M) LN_LOAD(cv, cw, m);
    while (m < M) {
        const int mn = m + mstep;
        if (mn < M) LN_LOAD(nv, nw, mn);
        f32x4 v[4]; float s = 0.f;
#pragma unroll
        for (int j = 0; j < 4; ++j) {
            if constexpr (BF16IN) { const unsigned long long w = cw[j]; v[j] = (f32x4){bflo((unsigned)w), bfhi((unsigned)w), bflo((unsigned)(w >> 32)), bfhi((unsigned)(w >> 32))}; }
            else v[j] = cv[j];
            s += (v[j].x + v[j].y) + (v[j].z + v[j].w); }
        const float mean = wave_sum(s) * (1.f / DM); float s2 = 0.f;
#pragma unroll
        for (int j = 0; j < 4; ++j) { v[j] = v[j] - mean; s2 += (v[j].x * v[j].x + v[j].y * v[j].y) + (v[j].z * v[j].z + v[j].w * v[j].w); }
        const float rstd = 1.f / sqrtf(wave_sum(s2) * (1.f / DM) + LN_EPS);
        GAS unsigned long long* o8 = (GAS unsigned long long*)(O + (size_t)m * DM) + lane;
        float mx = 0.f;
#pragma unroll
        for (int j = 0; j < 4; ++j) {
            v[j] = v[j] * rstd * gg[j] + bb[j];
            o8[64 * j] = (unsigned long long)pk2(v[j].x, v[j].y) | ((unsigned long long)pk2(v[j].z, v[j].w) << 32);
            mx = fmaxf(mx, fmaxf(fmaxf(fabsf(v[j].x), fabsf(v[j].y)), fmaxf(fabsf(v[j].z), fabsf(v[j].w)))); }
#pragma unroll
        for (int o = 1; o < 64; o <<= 1) mx = fmaxf(mx, __shfl_xor(mx, o));
        const float sc = mx > 0.f ? mx * (1.f / 127.f) : 1.f, inv = 1.f / sc;
        GAS unsigned* q4 = (GAS unsigned*)(Q + (size_t)m * DM) + lane;
#pragma unroll
        for (int j = 0; j < 4; ++j) { const int q0 = (int)rintf(v[j].x * inv), q1 = (int)rintf(v[j].y * inv), q2 = (int)rintf(v[j].z * inv), q3 = (int)rintf(v[j].w * inv);
            q4[64 * j] = (unsigned)(q0 & 255) | ((unsigned)(q1 & 255) << 8) | ((unsigned)(q2 & 255) << 16) | ((unsigned)(q3 & 255) << 24); }
        if (lane == 0) S[m] = sc;
#pragma unroll
        for (int j = 0; j < 4; ++j) { if constexpr (BF16IN) cw[j] = nw[j]; else cv[j] = nv[j]; }
        m = mn;
    }
#undef LN_LOAD
}
template <int KP>
__device__ __forceinline__ void quant_cols32(LAS unsigned char* lds, const float* W, int N, int n0, signed char* WT, float* scl, int dst0, int wave, int lane) {
    const int t = wave * 64 + lane, cg = t & 7, rg = t >> 3;
    constexpr int PITCH = 1040, K = 1024 * KP;
    LAS float* red = (LAS float*)(lds + 32 * PITCH);
    const float* Wp = W + (size_t)(4 * rg) * N + n0 + 4 * cg;
    f32x4 v[4][4]; f32x4 mx = (f32x4){0.f, 0.f, 0.f, 0.f};
#pragma unroll 1
    for (int part = 0; part < KP; ++part) {
#pragma unroll
        for (int i = 0; i < 4; ++i)
#pragma unroll
            for (int j = 0; j < 4; ++j) v[i][j] = *(const f32x4*)(Wp + (size_t)(1024 * part + 256 * i + j) * N);
#pragma unroll
        for (int i = 0; i < 4; ++i)
#pragma unroll
            for (int j = 0; j < 4; ++j) mx = __builtin_elementwise_max(mx, __builtin_elementwise_abs(v[i][j]));
    }
#pragma unroll
    for (int off = 8; off < 64; off <<= 1)
#pragma unroll
        for (int c = 0; c < 4; ++c) mx[c] = fmaxf(mx[c], __shfl_xor(mx[c], off));
    if (lane < 8) *(LAS f32x4*)(red + wave * 32 + 4 * cg) = mx;
    __syncthreads();
    f32x4 cm = *(const LAS f32x4*)(red + 4 * cg);
#pragma unroll
    for (int w = 1; w < 8; ++w) cm = __builtin_elementwise_max(cm, *(const LAS f32x4*)(red + w * 32 + 4 * cg));
    f32x4 sc, inv;
#pragma unroll
    for (int c = 0; c < 4; ++c) { sc[c] = cm[c] > 0.f ? cm[c] * (1.f / 127.f) : 1.f; inv[c] = 1.f / sc[c]; }
    if (t < 8) *(f32x4*)(scl + dst0 + 4 * cg) = sc;
#pragma unroll 1
    for (int part = 0; part < KP; ++part) {
        if (KP > 1) {
#pragma unroll
            for (int i = 0; i < 4; ++i)
#pragma unroll
                for (int j = 0; j < 4; ++j) v[i][j] = *(const f32x4*)(Wp + (size_t)(1024 * part + 256 * i + j) * N);
        }
#pragma unroll
        for (int i = 0; i < 4; ++i)
#pragma unroll
            for (int c = 0; c < 4; ++c) { const int q0 = (int)rintf(v[i][0][c] * inv[c]), q1 = (int)rintf(v[i][1][c] * inv[c]), q2 = (int)rintf(v[i][2][c] * inv[c]), q3 = (int)rintf(v[i][3][c] * inv[c]);
                *(LAS unsigned*)(lds + (4 * cg + c) * PITCH + 256 * i + 4 * rg) = (unsigned)(q0 & 255) | ((unsigned)(q1 & 255) << 8) | ((unsigned)(q2 & 255) << 16) | ((unsigned)(q3 & 255) << 24); }
        __syncthreads();
        { const int row = t >> 4, ch = t & 15;
#pragma unroll
          for (int e = 0; e < 4; ++e) *(GAS v4u*)(WT + (size_t)(dst0 + row) * K + 1024 * part + ch * 64 + e * 16) = *(const LAS v4u*)(lds + row * PITCH + ch * 64 + e * 16); }
        __syncthreads();
    }
}
__device__ __forceinline__ void quant_cols32_k1024(LAS unsigned char* lds, const float* W, int N, int n0, signed char* WT, float* scl, int dst0, int wave, int lane) { quant_cols32<1>(lds, W, N, n0, WT, scl, dst0, wave, lane); }
__device__ __forceinline__ void p0_prologue(Frame& F, const Args& a) {
    LAS float* scr = (LAS float*)(F.lds + F.wave * 16384);
    const int gw = F.vcu * NWAVES + F.wave, NGW = F.G * NWAVES;
    unsigned char* ws = a.ws;
    constexpr int I_WINc = 0;
    constexpr int I_WROc = 0, I_WDOc = 0, I_WOc = 16 * 32, I_ROUTc = 16 * 8, I_PLEWc = 4 * 32, I_PLEGc = 0, I_SGc = 0, I_SUc = 0, I_SDc = 4 * 32;
    constexpr int NITEMS = I_WINc + I_WROc + I_WDOc + I_WOc + I_ROUTc + I_PLEWc + I_PLEGc + I_SGc + I_SUc + I_SDc;
    for (int it = gw; it < NITEMS; it += NGW) {
        int r = it; const float* W; int K, N; bf16_t* WT; int kind = 0;
        if (r < I_WINc) { W = a.in[I_WIN]; K = 1024; N = INCOLS; WT = (bf16_t*)(ws + WS_WIN_T); kind = 1; }
        else if ((r -= I_WINc) < I_WROc) { W = a.in[I_WRO]; K = 2048; N = 1024; WT = (bf16_t*)(ws + WS_WRO_T); }
        else if ((r -= I_WROc) < I_WDOc) { W = a.in[I_WDO]; K = 1024; N = 1024; WT = (bf16_t*)(ws + WS_WDO_T); }
        else if ((r -= I_WDOc) < I_WOc) { W = a.in[I_WO]; K = 1024; N = 1024; WT = (bf16_t*)(ws + WS_WO_T); }
        else if ((r -= I_WOc) < I_ROUTc) { W = a.in[I_ROUT_W]; K = 1024; N = 256; WT = (bf16_t*)(ws + WS_ROUT_T); }
        else if ((r -= I_ROUTc) < I_PLEWc) { W = a.in[I_PLE_W]; K = 256; N = 1024; WT = (bf16_t*)(ws + WS_PLEW_T); }
        else if ((r -= I_PLEWc) < I_PLEGc) { W = a.in[I_PLE_GW]; K = 1024; N = 1024; WT = (bf16_t*)(ws + WS_PLEG_T); }
        else if ((r -= I_PLEGc) < I_SGc) { W = a.in[I_SG]; K = 1024; N = 256; WT = (bf16_t*)(ws + WS_SHGU_T); kind = 2; }
        else if ((r -= I_SGc) < I_SUc) { W = a.in[I_SU]; K = 1024; N = 256; WT = (bf16_t*)(ws + WS_SHGU_T); kind = 3; }
        else { r -= I_SUc; W = a.in[I_SD]; K = 256; N = 1024; WT = (bf16_t*)(ws + WS_SHD_T); }
        const int nblk = N / 32, kb = r / nblk, nb = r % nblk, n0 = 32 * nb;
        int d0 = n0;
        if (kind == 1) d0 = win_dst_row(n0);
        else if (kind == 2) d0 = (n0 >> 7) * 256 + (n0 & 127);
        else if (kind == 3) d0 = (n0 >> 7) * 256 + 128 + (n0 & 127);
        if (W == a.in[I_SD] || W == a.in[I_WO]) p0_transpose_item_f8(W, K, N, (unsigned char*)WT, 64 * kb, n0, d0, scr, FLANE, F8_WSCALE);
        else p0_transpose_item(W, K, N, WT, 64 * kb, n0, d0, scr, FLANE);
    }
    __syncthreads();
    for (int it = F.vcu; it < 32 + INCOLS / 32 + 32 + 16 + 32; it += F.G) {
        int r = it;
        if (r < 32) { quant_cols32<2>(F.lds, a.in[I_WRO], 1024, 32 * r, (signed char*)(ws + WS_WRO_T), (float*)(ws + WS_SWRO), 32 * r, F.wave, FLANE); continue; } r -= 32;
        if (r < INCOLS / 32) { quant_cols32_k1024(F.lds, a.in[I_WIN], INCOLS, 32 * r, (signed char*)(ws + WS_WIN_T), (float*)(ws + WS_SWIN), win_dst_row(32 * r), F.wave, FLANE); continue; } r -= INCOLS / 32;
        if (r < 32) { quant_cols32_k1024(F.lds, a.in[I_WDO], 1024, 32 * r, (signed char*)(ws + WS_WDO_T), (float*)(ws + WS_SWDO), 32 * r, F.wave, FLANE); continue; } r -= 32;
        if (r < 16) { const int up = r >> 3, n0 = 32 * (r & 7); quant_cols32_k1024(F.lds, a.in[up ? I_SU : I_SG], 256, n0, (signed char*)(ws + WS_SHGU_T), (float*)(ws + WS_SSHGU), (n0 >> 7) * 256 + up * 128 + (n0 & 127), F.wave, FLANE); continue; } r -= 16;
        quant_cols32_k1024(F.lds, a.in[I_PLE_GW], 1024, 32 * r, (signed char*)(ws + WS_PLEG_T), (float*)(ws + WS_SPLEG), 32 * r, F.wave, FLANE);
    }
    ln_rows_bf16_i8<false>(FLANE, a.in[I_X], a.in[I_LNIN_G], a.in[I_LNIN_B], (bf16_t*)(ws + WS_XN), (signed char*)(ws + WS_XN8), (float*)(ws + WS_SXN), gw, NGW, NTOK);
    { const size_t n8 = (size_t)NTOK * PLE / 8; const GAS f32x4* src = (const GAS f32x4*)a.in[I_P]; GAS v4u* dst = (GAS v4u*)(ws + WS_PB);
      for (size_t i = (size_t)F.vcu * 512 + FTID; i < n8; i += (size_t)F.G * 512) { const f32x4 x0 = src[2 * i], x1 = src[2 * i + 1];
          v4u o; o.x = pk2(x0.x, x0.y); o.y = pk2(x0.z, x0.w); o.z = pk2(x1.x, x1.y); o.w = pk2(x1.z, x1.w); dst[i] = o; } }
}

__device__ __forceinline__ void unpack8(const v4u w, float* f) { f[0] = bflo(w.x); f[1] = bfhi(w.x); f[2] = bflo(w.y); f[3] = bfhi(w.y); f[4] = bflo(w.z); f[5] = bfhi(w.z); f[6] = bflo(w.w); f[7] = bfhi(w.w); }
__device__ __forceinline__ unsigned long long pack8_fp8(const float* f) { int w0 = 0, w1 = 0;
    w0 = __builtin_amdgcn_cvt_pk_fp8_f32(f[0], f[1], w0, false); w0 = __builtin_amdgcn_cvt_pk_fp8_f32(f[2], f[3], w0, true);
    w1 = __builtin_amdgcn_cvt_pk_fp8_f32(f[4], f[5], w1, false); w1 = __builtin_amdgcn_cvt_pk_fp8_f32(f[6], f[7], w1, true);
    return (unsigned long long)(unsigned)w0 | ((unsigned long long)(unsigned)w1 << 32); }
__device__ __forceinline__ void unpack8_fp8(const unsigned long long yw, float* f) { const int w0 = (int)(unsigned)yw, w1 = (int)(unsigned)(yw >> 32);
    const auto f0 = __builtin_amdgcn_cvt_pk_f32_fp8(w0, false), f1 = __builtin_amdgcn_cvt_pk_f32_fp8(w0, true), f2 = __builtin_amdgcn_cvt_pk_f32_fp8(w1, false), f3 = __builtin_amdgcn_cvt_pk_f32_fp8(w1, true);
    f[0] = f0[0]; f[1] = f0[1]; f[2] = f1[0]; f[3] = f1[1]; f[4] = f2[0]; f[5] = f2[1]; f[6] = f3[0]; f[7] = f3[1]; }
__device__ __forceinline__ v4u pack8(const float* f) { v4u w; w.x = cvt_pk_bf16(f[0], f[1]); w.y = cvt_pk_bf16(f[2], f[3]); w.z = cvt_pk_bf16(f[4], f[5]); w.w = cvt_pk_bf16(f[6], f[7]); return w; }
struct EpiInProj {
    static constexpr bool PERM = true, WIDE = true, PRE = false;
    unsigned char* ws;
    __device__ __forceinline__ const float* rowscale_ptr(const pg8::Unit& u) const { return (const float*)(ws + WS_SXN) + u.pm * 256; }
    __device__ __forceinline__ bool fixed_rowscale() const { return false; }
    __device__ __forceinline__ float fixed_rs_value() const { return 1.f; }
    __device__ __forceinline__ const float* colscale(const pg8::Unit& u) const { return (const float*)(ws + WS_SWIN) + u.pn * 256; }
    __device__ __forceinline__ void operator()(const pg8::Acc& acc, const pg8::Unit& u, int wr, int wc, int fr, int fq) const {
        const int pn = u.pn; int seg, t0, ld; size_t boff;
        if (pn < 4) { seg = 0; t0 = 0; boff = WS_QR; ld = 1024; } else if (pn < 8) { seg = 1; t0 = 4; boff = WS_KR; ld = 1024; }
        else if (pn < 16) { seg = 2; t0 = 8; boff = WS_V8; ld = 2048; } else if (pn < 24) { seg = 3; t0 = 16; boff = WS_GR; ld = 2048; }
        else if (pn < 28) { seg = 4; t0 = 24; boff = WS_QD; ld = 1024; } else if (pn < 32) { seg = 5; t0 = 28; boff = WS_KD; ld = 1024; }
        else if (pn < 36) { seg = 6; t0 = 32; boff = WS_VD; ld = 1024; } else { seg = 7; t0 = 36; boff = WS_GT; ld = 2048; }
        bf16_t* base = (bf16_t*)(ws + boff);
        const int tl = pn - t0;
        const int row0 = u.pm * 256 + wr * 64 + fr;
        if (seg <= 1) {
            const int hl = wc >> 1, j0 = 32 * (wc & 1) + 8 * fq, head = 2 * tl + hl;
            const float sc = seg == 1 ? KR_SCALE : 1.f;
            float th[8];
#pragma unroll
            for (int i = 0; i < 8; ++i) th[i] = exp2f(-(float)(j0 + i) * (13.287712379549449f / 63.f));
#pragma unroll
            for (int ai = 0; ai < 2; ++ai)
#pragma unroll
                for (int m = 0; m < 4; ++m) {
                    const int row = row0 + ai * 128 + m * 16; const float pos = (float)(row & (SEQ - 1));
                    float o1[8], o2[8];
#pragma unroll
                    for (int i = 0; i < 8; ++i) {
                        const float t1 = acc[ai][0][m][i >> 2][i & 3], t2 = acc[ai][1][m][i >> 2][i & 3];
                        const float ang = pos * th[i]; const float k = rintf(ang * 0.15915494309189535f);
                        float r = fmaf(-k, 6.2831855f, ang); r = fmaf(-k, -1.7484555e-7f, r);
                        const float rr = r * 0.15915494309189535f;
                        const float c = __builtin_amdgcn_cosf(rr), s = __builtin_amdgcn_sinf(rr);
                        o1[i] = (t1 * c - t2 * s) * sc; o2[i] = (t2 * c + t1 * s) * sc;
                    }
                    bf16_t* rp = base + (size_t)row * ld + head * 128 + j0;
                    v4u w; w.x = cvt_pk_bf16(o1[0], o1[1]); w.y = cvt_pk_bf16(o1[2], o1[3]); w.z = cvt_pk_bf16(o1[4], o1[5]); w.w = cvt_pk_bf16(o1[6], o1[7]);
                    *(v4u*)rp = w;
                    w.x = cvt_pk_bf16(o2[0], o2[1]); w.y = cvt_pk_bf16(o2[2], o2[3]); w.z = cvt_pk_bf16(o2[4], o2[5]); w.w = cvt_pk_bf16(o2[6], o2[7]);
                    *(v4u*)(rp + 64) = w;
                }
        } else {
            const bool lo = fr < 8; const int rl = fr & 7;
            const int colb = tl * 256 + 64 * wc + 8 * fq;
            const bool f8 = (seg == 2 || seg == 3 || seg == 7);
#pragma unroll
            for (int ai = 0; ai < 2; ++ai)
#pragma unroll
                for (int m = 0; m < 4; ++m) {
                    const int rbase = u.pm * 256 + wr * 64 + ai * 128 + m * 16;
                    float vv[2][8];
#pragma unroll
                    for (int bj = 0; bj < 2; ++bj) {
                        f32x4 v0 = acc[ai][bj][m][0], v1 = acc[ai][bj][m][1];
                        if (seg == 3) { for (int i = 0; i < 4; ++i) { v0[i] = fast_silu(v0[i]); v1[i] = fast_silu(v1[i]); } }
                        else if (seg == 7) { for (int i = 0; i < 4; ++i) { v0[i] = fast_sigmoid(v0[i]); v1[i] = fast_sigmoid(v1[i]); } }
                        else if (seg == 4) { v0 = v0 * QD_SCALE; v1 = v1 * QD_SCALE; }
                        else if (seg == 2) { v0 = v0 * V8_SCALE; v1 = v1 * V8_SCALE; }
#pragma unroll
                        for (int i = 0; i < 4; ++i) { vv[bj][i] = v0[i]; vv[bj][4 + i] = v1[i]; }
                    }
                    if (f8) {
                        const unsigned long long p0 = pack8_fp8(vv[0]), p1 = pack8_fp8(vv[1]);
                        const unsigned p1l = (unsigned)p1, p1h = (unsigned)(p1 >> 32);
                        const unsigned tl_ = (unsigned)__builtin_amdgcn_update_dpp(0, (int)p1l, 0x118, 0xf, 0xf, false), th_ = (unsigned)__builtin_amdgcn_update_dpp(0, (int)p1h, 0x118, 0xf, 0xf, false);
                        const unsigned ul_ = (unsigned)__builtin_amdgcn_update_dpp(0, (int)p1l, 0x108, 0xf, 0xf, false), uh_ = (unsigned)__builtin_amdgcn_update_dpp(0, (int)p1h, 0x108, 0xf, 0xf, false);
                        const unsigned long long tt = (unsigned long long)tl_ | ((unsigned long long)th_ << 32), uu = (unsigned long long)ul_ | ((unsigned long long)uh_ << 32);
                        unsigned char* bp = (unsigned char*)base + colb + (lo ? 0 : 32);
                        *(unsigned long long*)(bp + (size_t)(rbase + rl) * 2048) = lo ? p0 : tt;
                        bp = (unsigned char*)base + colb + (lo ? 32 : 0);
                        *(unsigned long long*)(bp + (size_t)(rbase + 8 + rl) * 2048) = lo ? uu : p0;
                    } else {
                        const v4u w0 = pack8(vv[0]), w1 = pack8(vv[1]); v4u tt, uu;
#pragma unroll
                        for (int k = 0; k < 4; ++k) { tt[k] = (unsigned)__builtin_amdgcn_update_dpp(0, (int)w1[k], 0x118, 0xf, 0xf, false); uu[k] = (unsigned)__builtin_amdgcn_update_dpp(0, (int)w1[k], 0x108, 0xf, 0xf, false); }
                        bf16_t* bp = base + colb + (lo ? 0 : 32);
                        *(v4u*)(bp + (size_t)(rbase + rl) * ld) = lo ? w0 : tt;
                        bp = base + colb + (lo ? 32 : 0);
                        *(v4u*)(bp + (size_t)(rbase + 8 + rl) * ld) = lo ? uu : w0;
                    }
                }
        }
    }
};

namespace att {
using f32x16 = __attribute__((ext_vector_type(16))) float;
using s16x4  = __attribute__((ext_vector_type(4))) short;
constexpr int SHM_V = 16384, SHM_K64 = 8192;
constexpr int A_V = 0, A_K = 49152, A_WS = 73728, A_TAB = 75776, A_ST = 77312;
constexpr int R_KS = 0, R_KI = 32768, R_VI = 65536, R_ST = 98304, R_STP = 272, R_OS = 107008;
#define KSWZ(row, colB) ((row) * 256 + ((colB) ^ (((row) & 7) << 4)))
#define KSWZ64(row, colB) ((row) * 128 + ((colB) ^ ((((row) >> 1) & 7) << 4)))
#define SBAR() __builtin_amdgcn_sched_barrier(0)
__device__ __forceinline__ int crow(int r, int hi) { return (r & 3) + 8 * (r >> 2) + 4 * hi; }
__device__ __forceinline__ int v_st(int k, int c) { const int kk = (k & ~0xC) | ((k & 4) << 1) | ((k & 8) >> 1); return ((kk >> 3) * 4 + (c >> 5)) * 512 + ((kk & 7) * 32 + (c & 31)) * 2; }
__device__ __forceinline__ int v_rd_base(int lane) { return ((lane & 3) << 3) | (((lane >> 2) & 3) << 6) | (((lane >> 4) & 1) << 5) | (((lane >> 5) & 1) << 8); }
constexpr int v_rd_off(int d0, int ks, int half) { return d0 * 512 + ks * 4096 + half * 2048; }
template <int OFF> __device__ __forceinline__ s16x4 tr_read(int vb) {
  s16x4 r; asm volatile("ds_read_b64_tr_b16 %0, %1 offset:%2" : "=&v"(r) : "v"(vb), "i"(OFF) : "memory"); return r;
}
#define PKF(L, H) (bf16x8){L[0], L[1], L[2], L[3], H[0], H[1], H[2], H[3]}
template <int D0> __device__ __forceinline__ void pv_one(f32x16& od, int vb, bf16x8 pa0, bf16x8 pa1, bf16x8 pa2, bf16x8 pa3) {
  const s16x4 l0 = tr_read<v_rd_off(D0, 0, 0)>(vb), h0 = tr_read<v_rd_off(D0, 0, 1)>(vb), l1 = tr_read<v_rd_off(D0, 1, 0)>(vb), h1 = tr_read<v_rd_off(D0, 1, 1)>(vb);
  const s16x4 l2 = tr_read<v_rd_off(D0, 2, 0)>(vb), h2 = tr_read<v_rd_off(D0, 2, 1)>(vb), l3 = tr_read<v_rd_off(D0, 3, 0)>(vb), h3 = tr_read<v_rd_off(D0, 3, 1)>(vb);
  asm volatile("s_waitcnt lgkmcnt(0)" ::: "memory"); SBAR();
  od = __builtin_amdgcn_mfma_f32_32x32x16_bf16(pa0, PKF(l0, h0), od, 0, 0, 0);
  od = __builtin_amdgcn_mfma_f32_32x32x16_bf16(pa1, PKF(l1, h1), od, 0, 0, 0);
  od = __builtin_amdgcn_mfma_f32_32x32x16_bf16(pa2, PKF(l2, h2), od, 0, 0, 0);
  od = __builtin_amdgcn_mfma_f32_32x32x16_bf16(pa3, PKF(l3, h3), od, 0, 0, 0);
}
__device__ __forceinline__ void pv_d0(f32x16* o, int vb, bf16x8 pa0, bf16x8 pa1, bf16x8 pa2, bf16x8 pa3) {
  pv_one<0>(o[0], vb, pa0, pa1, pa2, pa3); pv_one<1>(o[1], vb, pa0, pa1, pa2, pa3); pv_one<2>(o[2], vb, pa0, pa1, pa2, pa3); pv_one<3>(o[3], vb, pa0, pa1, pa2, pa3);
}
#define PK4(P, BASE, OUT) do { unsigned a0 = cvt_pk_bf16(P[BASE + 0], P[BASE + 1]), a1 = cvt_pk_bf16(P[BASE + 2], P[BASE + 3]);   \
    unsigned b0 = cvt_pk_bf16(P[BASE + 4], P[BASE + 5]), b1 = cvt_pk_bf16(P[BASE + 6], P[BASE + 7]);                              \
    auto r0 = __builtin_amdgcn_permlane32_swap(a0, b0, false, false); auto r1 = __builtin_amdgcn_permlane32_swap(a1, b1, false, false); \
    v4u w = {r0[0], r1[0], r0[1], r1[1]}; OUT = *reinterpret_cast<bf16x8*>(&w); } while (0)

__device__ __forceinline__ int t5_bucket(int n) {
  if (n < 16) return n;
  int b = 16;
  b += (n >= 19); b += (n >= 21); b += (n >= 24); b += (n >= 27); b += (n >= 31); b += (n >= 35); b += (n >= 40); b += (n >= 46);
  b += (n >= 52); b += (n >= 59); b += (n >= 67); b += (n >= 77); b += (n >= 87); b += (n >= 99); b += (n >= 113);
  return b;
}
constexpr float THR2 = 8.f;
template <bool FIRST>
__device__ __forceinline__ void partialSM(f32x16& p0, f32x16& p1, float& m_reg, float& alpha) {
  float pmax = p0[0];
#pragma unroll
  for (int r = 1; r < 16; ++r) pmax = fmaxf(pmax, p0[r]);
#pragma unroll
  for (int r = 0; r < 16; ++r) pmax = fmaxf(pmax, p1[r]);
  { auto rr = __builtin_amdgcn_permlane32_swap(__float_as_uint(pmax), __float_as_uint(pmax), false, false);
    pmax = fmaxf(__uint_as_float(rr[0]), __uint_as_float(rr[1])); }
  if (FIRST) { m_reg = pmax; alpha = 1.f;
#pragma unroll
    for (int r = 0; r < 16; ++r) { p0[r] = p0[r] - pmax; p1[r] = p1[r] - pmax; } }
  else if (__builtin_expect(__all(pmax <= THR2), 1)) { alpha = 1.f; }
  else { const float d = fmaxf(pmax, 0.f); alpha = __builtin_amdgcn_exp2f(-d); m_reg += d;
#pragma unroll
    for (int r = 0; r < 16; ++r) { p0[r] = p0[r] - d; p1[r] = p1[r] - d; } }
#pragma unroll
  for (int r = 0; r < 16; ++r) p0[r] = __builtin_amdgcn_exp2f(p0[r]);
}
__device__ __forceinline__ void finishSM(f32x16& p0, f32x16& p1, float alpha, float& l_reg, bf16x8& pa0, bf16x8& pa1, bf16x8& pa2, bf16x8& pa3) {
#pragma unroll
  for (int r = 0; r < 16; ++r) p1[r] = __builtin_amdgcn_exp2f(p1[r]);
  f32x2 ps2 = (f32x2){p0[0], p0[1]};
#pragma unroll
  for (int r = 2; r < 16; r += 2) ps2 += (f32x2){p0[r], p0[r + 1]};
#pragma unroll
  for (int r = 0; r < 16; r += 2) ps2 += (f32x2){p1[r], p1[r + 1]};
  float ps = ps2.x + ps2.y;
  { auto rr = __builtin_amdgcn_permlane32_swap(__float_as_uint(ps), __float_as_uint(ps), false, false);
    ps = __uint_as_float(rr[0]) + __uint_as_float(rr[1]); }
  l_reg = l_reg * alpha + ps;
  PK4(p0, 0, pa0); PK4(p0, 8, pa1); PK4(p1, 0, pa2); PK4(p1, 8, pa3);
}
__device__ __forceinline__ void qkt64(f32x16& p0, f32x16& p1, const char* Ks, const bf16x8* qr, int r32, int hi, float init) {
#pragma unroll
  for (int r = 0; r < 16; ++r) { p0[r] = init; p1[r] = init; }
#pragma unroll
  for (int d0 = 0; d0 < 4; ++d0) { const int cb = d0 * 32 + hi * 16;
    const bf16x8 b0 = *reinterpret_cast<const bf16x8*>(Ks + KSWZ64(r32, cb));
    const bf16x8 b1 = *reinterpret_cast<const bf16x8*>(Ks + KSWZ64(32 + r32, cb));
    p0 = __builtin_amdgcn_mfma_f32_32x32x16_bf16(b0, qr[d0], p0, 0, 0, 0);
    p1 = __builtin_amdgcn_mfma_f32_32x32x16_bf16(b1, qr[d0], p1, 0, 0, 0); }
}
__device__ __forceinline__ void bias_mask(f32x16& p0, f32x16& p1, const float* tab, int dbase) {
#pragma unroll
  for (int r = 0; r < 16; ++r) {
    const int d0 = dbase - ((r & 3) + 8 * (r >> 2)), d1 = d0 - 32;
    const float b0 = tab[min(max(d0, 0), 383)], b1 = tab[min(max(d1, 0), 383)];
    p0[r] = d0 >= 0 ? p0[r] + b0 : -INFINITY; p1[r] = d1 >= 0 ? p1[r] + b1 : -INFINITY;
  }
}

__device__ __forceinline__ void attn_unit(int b, int h, int qb, const bf16_t* QD, signed char* OD, const float ad_inv, const bf16_t* __restrict__ KD, const bf16_t* __restrict__ VD,
                                          const float* relb, const float* subg, float lam, char* lds, const int wave_, bf16x8& vs0, bf16x8& vs1, bf16x8& ks, const bool have0) {
  const int wid = __builtin_amdgcn_readfirstlane(wave_); int lane = lane_id(); asm volatile("" : "+v"(lane));
  const int tid = wid * 64 + lane, r32 = lane & 31, hi = lane >> 5;
  char* V_lds = lds + A_V; char* K_lds = lds + A_K;
  float* wsf = (float*)(lds + A_WS) + wid * 64; float* li_l = wsf; float* al_l = wsf + 32;
  float* tab = (float*)(lds + A_TAB);
  unsigned* stash = (unsigned*)(lds + A_ST) + wid * 2048;
  const int q0 = qb * 256; const long rowbase = (long)b * SEQ;
  if (tid < 384) tab[tid] = relb[t5_bucket(tid) * 8 + h] * LOG2E;
  const float c31 = relb[31 * 8 + h] * LOG2E;
  const int NT = 4 * (qb + 1);
  const int sr = tid >> 4, sc = (tid & 15) * 8, vst0 = v_st(sr, sc), vst1 = v_st(32 + sr, sc);
  const int kr = tid >> 3, kcb = (tid & 7) * 16, kst = KSWZ64(kr, kcb);
  const int vb0 = (int)(uintptr_t)V_lds + v_rd_base(lane);
  const int qw = q0 + wid * 32;
  f32x16 o[4];
  bf16x8 qr[4];
  for (int m = 0; m < 2; ++m) {
    const bf16_t* Kh = KD + rowbase * 1024 + h * 128 + m * 64; const bf16_t* Vh = VD + rowbase * 1024 + h * 128;
    const bf16_t* Qw = QD + (rowbase + qw + r32) * 1024 + h * 128 + m * 64 + hi * 8;
#pragma unroll
    for (int d0 = 0; d0 < 4; ++d0) qr[d0] = *reinterpret_cast<const bf16x8*>(Qw + d0 * 16);
    float m_reg = 0.f, l_reg = 0;
#pragma unroll
    for (int d = 0; d < 4; ++d)
#pragma unroll
      for (int r = 0; r < 16; ++r) o[d][r] = 0.f;
    const unsigned vo0 = (unsigned)(sr * 1024 + sc) * 2u, vo1 = vo0 + 32u * 2048u, ko = (unsigned)(kr * 1024 + (tid & 7) * 8) * 2u;
    const __amdgpu_buffer_rsrc_t rsV = __builtin_amdgcn_make_buffer_rsrc((void*)Vh, 0, SEQ * 2048, 0x00020000), rsK = __builtin_amdgcn_make_buffer_rsrc((void*)Kh, 0, SEQ * 2048, 0x00020000);
#define SLOAD(k0) do { const int so_ = (k0) * 2048; vs0 = __builtin_bit_cast(bf16x8, __builtin_amdgcn_raw_buffer_load_b128(rsV, vo0, so_, 0)); \
    vs1 = __builtin_bit_cast(bf16x8, __builtin_amdgcn_raw_buffer_load_b128(rsV, vo1, so_, 0)); ks = __builtin_bit_cast(bf16x8, __builtin_amdgcn_raw_buffer_load_b128(rsK, ko, so_, 0)); } while (0)
#define SWRITE(bb) do { *(bf16x8*)(V_lds + (bb) * SHM_V + vst0) = vs0; *(bf16x8*)(V_lds + (bb) * SHM_V + vst1) = vs1; \
    *(bf16x8*)(K_lds + (bb) * SHM_K64 + kst) = ks; } while (0)
    const int E = (qb >= 1) ? 4 * qb - 4 : -1;
    if (E >= 0) {
      f32x16 pA0, pA1, pB0, pB1; float alA, alB; bf16x8 pa0, pa1, pa2, pa3;
#define RESC(a) do { if (__any((a) < 1.f)) { if (hi == 0) al_l[r32] = (a); asm volatile("s_waitcnt lgkmcnt(0)" ::: "memory"); \
    _Pragma("unroll") for (int d = 0; d < 4; ++d) _Pragma("unroll") for (int r = 0; r < 16; ++r) o[d][r] *= al_l[crow(r, hi)]; } } while (0)
      if (m == 0 && !have0) SLOAD(0);
      SWRITE(0); SLOAD(64); __syncthreads();
      qkt64(pA0, pA1, K_lds, qr, r32, hi, c31); partialSM<true>(pA0, pA1, m_reg, alA);
      SWRITE(1); SLOAD(2 * 64); __syncthreads();
      int sK = SHM_K64, sV = 0, sW = 2;
      for (int j = 1; j + 1 <= E; j += 2) {
        SBAR(); qkt64(pB0, pB1, K_lds + sK, qr, r32, hi, c31 - m_reg);
        finishSM(pA0, pA1, alA, l_reg, pa0, pa1, pa2, pa3); SBAR();
        SWRITE(sW); SLOAD((j + 2) * 64); SBAR();
        pv_d0(o, vb0 + sV, pa0, pa1, pa2, pa3); partialSM<false>(pB0, pB1, m_reg, alB);
        RESC(alB); __syncthreads();
        sK = (sK == 2 * SHM_K64) ? 0 : sK + SHM_K64; sV = (sV == 2 * SHM_V) ? 0 : sV + SHM_V; sW = (sW == 2) ? 0 : sW + 1;
        SBAR(); qkt64(pA0, pA1, K_lds + sK, qr, r32, hi, c31 - m_reg);
        finishSM(pB0, pB1, alB, l_reg, pa0, pa1, pa2, pa3); SBAR();
        SWRITE(sW); SLOAD((j + 3) * 64); SBAR();
        pv_d0(o, vb0 + sV, pa0, pa1, pa2, pa3); partialSM<false>(pA0, pA1, m_reg, alA);
        RESC(alA); __syncthreads();
        sK = (sK == 2 * SHM_K64) ? 0 : sK + SHM_K64; sV = (sV == 2 * SHM_V) ? 0 : sV + SHM_V; sW = (sW == 2) ? 0 : sW + 1;
      }
      finishSM(pA0, pA1, alA, l_reg, pa0, pa1, pa2, pa3); SBAR();
      pv_d0(o, vb0 + sV, pa0, pa1, pa2, pa3);
      __syncthreads();
#undef RESC
    } else {
      if (m == 0 && !have0) SLOAD(0);
      SWRITE(0); SLOAD(64); __syncthreads();
    }
    for (int t = E + 1; t < NT; ++t) {
      const int bb = t % 3, bn = (t + 1) % 3;
      const bool far = (qw - 64 * t - 63) >= 128;
      if (64 * t <= qw + 31) {
      f32x16 p0, p1; float al; bf16x8 pa0, pa1, pa2, pa3;
      const bool first = (E < 0) && (t == 0);
      qkt64(p0, p1, K_lds + bb * SHM_K64, qr, r32, hi, (far ? c31 : 0.f) - (first ? 0.f : m_reg));
      if (!far) bias_mask(p0, p1, tab, qw + r32 - 64 * t - 4 * hi);
      if (first) partialSM<true>(p0, p1, m_reg, al); else partialSM<false>(p0, p1, m_reg, al);
      if (__any(al < 1.f)) { if (hi == 0) al_l[r32] = al; asm volatile("s_waitcnt lgkmcnt(0)" ::: "memory");
#pragma unroll
        for (int d = 0; d < 4; ++d)
#pragma unroll
          for (int r = 0; r < 16; ++r) o[d][r] *= al_l[crow(r, hi)]; }
      finishSM(p0, p1, al, l_reg, pa0, pa1, pa2, pa3); SBAR();
      pv_d0(o, vb0 + bb * SHM_V, pa0, pa1, pa2, pa3);
      }
      if (t + 1 < NT) { SWRITE(bn); if (t + 2 < NT) SLOAD((t + 2) * 64); }
      __syncthreads();
    }
    {
      const __amdgpu_buffer_rsrc_t rsKn = __builtin_amdgcn_make_buffer_rsrc((void*)(m == 0 ? Kh + 64 : Kh - 64), 0, SEQ * 2048, 0x00020000);
      vs0 = __builtin_bit_cast(bf16x8, __builtin_amdgcn_raw_buffer_load_b128(rsV, vo0, 0, 0)); vs1 = __builtin_bit_cast(bf16x8, __builtin_amdgcn_raw_buffer_load_b128(rsV, vo1, 0, 0));
      ks = __builtin_bit_cast(bf16x8, __builtin_amdgcn_raw_buffer_load_b128(rsKn, ko, 0, 0)); }
#undef SLOAD
#undef SWRITE
    if (hi == 0) li_l[r32] = l_reg; asm volatile("s_waitcnt lgkmcnt(0)" ::: "memory");
    float rli[16];
#pragma unroll
    for (int r = 0; r < 16; ++r) rli[r] = __builtin_amdgcn_rcpf(li_l[crow(r, hi)]);
    if (m == 0) {
#pragma unroll
      for (int d = 0; d < 4; ++d)
#pragma unroll
        for (int r = 0; r < 16; r += 2) stash[(d * 8 + (r >> 1)) * 64 + lane] = pk2(o[d][r] * rli[r], o[d][r + 1] * rli[r + 1]);
    } else {
      float ss[16];
#pragma unroll
      for (int r = 0; r < 16; ++r) ss[r] = 0.f;
#pragma unroll
      for (int d = 0; d < 4; ++d)
#pragma unroll
        for (int r = 0; r < 16; r += 2) { const unsigned w = stash[(d * 8 + (r >> 1)) * 64 + lane];
          o[d][r] = bflo(w) - lam * o[d][r] * rli[r]; o[d][r + 1] = bfhi(w) - lam * o[d][r + 1] * rli[r + 1];
          ss[r] += o[d][r] * o[d][r]; ss[r + 1] += o[d][r + 1] * o[d][r + 1]; }
#pragma unroll
      for (int off = 1; off < 32; off <<= 1)
#pragma unroll
        for (int r = 0; r < 16; ++r) ss[r] += __shfl_xor(ss[r], off);
      float gv[4];
#pragma unroll
      for (int d = 0; d < 4; ++d) gv[d] = subg[d * 32 + r32] * 0.8f;
      char* stg = (char*)stash;
#pragma unroll
      for (int r = 0; r < 16; ++r) { const float rs = 1.f / sqrtf(ss[r] * (1.f / 128.f) + LN_EPS); const int orow = crow(r, hi);
#pragma unroll
        for (int d = 0; d < 4; ++d) *(signed char*)(stg + orow * 128 + d * 32 + r32) = (signed char)(int)rintf(fminf(fmaxf(o[d][r] * rs * gv[d] * ad_inv, -127.f), 127.f)); }
      asm volatile("s_waitcnt lgkmcnt(0)" ::: "memory");
      char* Ob = (char*)OD + ((size_t)(rowbase + qw) * 1024 + h * 128) + (size_t)(lane >> 3) * 1024 + (lane & 7) * 16;
#pragma unroll
      for (int i = 0; i < 4; ++i) { const v4u v = *(const v4u*)(stg + (i * 8 + (lane >> 3)) * 128 + (lane & 7) * 16); *(v4u*)(Ob + (size_t)i * 8192) = v; }
    }
    __syncthreads();
  }
}

__device__ __forceinline__ void ret_chain(int b, int h, int j, const bf16_t* __restrict__ QR, const bf16_t* __restrict__ KR, const bf16_t* VR, bf16_t* VRo, const long omask, f32x2* gnst, char* lds, const int wave_) {
  const int wid = __builtin_amdgcn_readfirstlane(wave_); int lane = lane_id(); asm volatile("" : "+v"(lane));
  const int tid = wid * 64 + lane, r32 = lane & 31, hi = lane >> 5;
  char* KS = lds + R_KS; char* KI = lds + R_KI; char* VI = lds + R_VI; char* ST = lds + R_ST;
  const float lg = log2f(1.f - exp2f(-5.f - (float)h));
  const float c_dec = exp2f(128.f * lg);
  const long rowbase = (long)b * SEQ;
  for (int i = tid; i < 32 * R_STP / 4; i += 512) ((unsigned*)ST)[i] = 0u;
  const int sr = tid >> 4, sc = (tid & 15) * 8;
  const int vt = tid >> 2, vc = (tid & 3) * 8;
  const bf16_t* Kg = KR + rowbase * 1024 + h * 128 + sc;
  const bf16_t* Vg = VR + rowbase * 2048 + h * 256 + j * 32 + vc;
  const bf16_t* Qg = QR + (rowbase + (wid & 3) * 32 + r32) * 1024 + h * 128 + hi * 8;
  const int vbV = (int)(uintptr_t)VI + v_rd_base(lane);
  const int vbK = (int)(uintptr_t)KI + v_rd_base(lane) + (wid & 3) * 512;
  const float kd = exp2f((float)(127 - vt) * lg);
  bf16x8 kreg[4], vreg;
#pragma unroll
  for (int i = 0; i < 4; ++i) kreg[i] = *reinterpret_cast<const bf16x8*>(Kg + (long)(sr + 32 * i) * 1024);
  vreg = *reinterpret_cast<const bf16x8*>(Vg + (long)vt * 2048);
  f32x16 sacc;
#pragma unroll
  for (int r = 0; r < 16; ++r) sacc[r] = 0.f;
  bf16x8 qr[8];
#pragma unroll
  for (int d0 = 0; d0 < 8; ++d0) qr[d0] = *reinterpret_cast<const bf16x8*>(Qg + d0 * 16);
  for (int n = 0; n < SEQ / 128; ++n) {
    const long t0 = (long)n * 128;
    float lgv = lg; asm volatile("" : "+v"(lgv));
#pragma unroll
    for (int i = 0; i < 4; ++i) { const int tok = sr + 32 * i;
      *(bf16x8*)(KS + KSWZ(tok, sc * 2)) = kreg[i];
      *(bf16x8*)(KI + (i >> 1) * SHM_V + v_st(tok & 63, sc)) = kreg[i]; }
    { *(bf16x8*)(VI + (vt >> 6) * SHM_V + v_st(vt & 63, vc)) = vreg;
      bf16x8 vd;
#pragma unroll
      for (int e = 0; e < 8; ++e) vd[e] = (short)f2bf(bf2f((unsigned short)vreg[e]) * kd);
      *(bf16x8*)(VI + (vt >> 6) * SHM_V + v_st(vt & 63, 32 + vc)) = vd; }
    if (n + 1 < SEQ / 128) {
#pragma unroll
      for (int i = 0; i < 4; ++i) kreg[i] = *reinterpret_cast<const bf16x8*>(Kg + (t0 + 128 + sr + 32 * i) * 1024);
      vreg = *reinterpret_cast<const bf16x8*>(Vg + (t0 + 128 + vt) * 2048);
    }
    __syncthreads();
    if (wid < 4) {
      f32x16 acc;
#pragma unroll
      for (int r = 0; r < 16; ++r) acc[r] = 0.f;
#pragma unroll
      for (int d0 = 0; d0 < 8; ++d0) { const bf16x8 bs = *reinterpret_cast<const bf16x8*>(ST + r32 * R_STP + (16 * d0 + 8 * hi) * 2);
        acc = __builtin_amdgcn_mfma_f32_32x32x16_bf16(qr[d0], bs, acc, 0, 0, 0); }
#pragma unroll
      for (int r = 0; r < 16; ++r) acc[r] *= __builtin_amdgcn_exp2f((float)(32 * wid + crow(r, hi) + 1) * lgv);
#define RET_KB(kb) if ((kb) <= wid) { f32x16 p; _Pragma("unroll") for (int r = 0; r < 16; ++r) p[r] = 0.f; \
        _Pragma("unroll") for (int d0 = 0; d0 < 8; ++d0) { const bf16x8 kf = *reinterpret_cast<const bf16x8*>(KS + KSWZ(32 * (kb) + r32, (16 * d0 + 8 * hi) * 2)); \
          p = __builtin_amdgcn_mfma_f32_32x32x16_bf16(kf, qr[d0], p, 0, 0, 0); } \
        _Pragma("unroll") for (int r = 0; r < 16; ++r) { const int rel = 32 * (wid - (kb)) + r32 - crow(r, hi); p[r] = rel >= 0 ? p[r] * __builtin_amdgcn_exp2f((float)rel * lgv) : 0.f; } \
        bf16x8 pa0, pa1; PK4(p, 0, pa0); PK4(p, 8, pa1); \
        const s16x4 l0 = tr_read<v_rd_off(0, ((kb) & 1) * 2 + 0, 0) + ((kb) >> 1) * SHM_V>(vbV), h0 = tr_read<v_rd_off(0, ((kb) & 1) * 2 + 0, 1) + ((kb) >> 1) * SHM_V>(vbV); \
        const s16x4 l1 = tr_read<v_rd_off(0, ((kb) & 1) * 2 + 1, 0) + ((kb) >> 1) * SHM_V>(vbV), h1 = tr_read<v_rd_off(0, ((kb) & 1) * 2 + 1, 1) + ((kb) >> 1) * SHM_V>(vbV); \
        asm volatile("s_waitcnt lgkmcnt(0)" ::: "memory"); SBAR(); \
        acc = __builtin_amdgcn_mfma_f32_32x32x16_bf16(pa0, PKF(l0, h0), acc, 0, 0, 0); \
        acc = __builtin_amdgcn_mfma_f32_32x32x16_bf16(pa1, PKF(l1, h1), acc, 0, 0, 0); }
      RET_KB(0) RET_KB(1) RET_KB(2) RET_KB(3)
#undef RET_KB
      if (n + 1 < SEQ / 128) {
#pragma unroll
        for (int d0 = 0; d0 < 8; ++d0) qr[d0] = *reinterpret_cast<const bf16x8*>(Qg + (t0 + 128) * 1024 + d0 * 16);
      }
      char* stg = lds + R_OS + wid * 2048;
#pragma unroll
      for (int r = 0; r < 16; ++r) *(bf16_t*)(stg + crow(r, hi) * 64 + r32 * 2) = (bf16_t)f2bf(acc[r]);
      asm volatile("s_waitcnt lgkmcnt(0)" ::: "memory");
      { const v4u v0 = *(const v4u*)(stg + (lane >> 1) * 64 + (lane & 1) * 32), v1 = *(const v4u*)(stg + (lane >> 1) * 64 + (lane & 1) * 32 + 16);
        const long orow = rowbase + t0 + 32 * wid + (lane >> 1);
        char* Ob = (char*)(VRo + (orow & omask) * 2048 + h * 256 + j * 32) + (lane & 1) * 32;
        *(v4u*)Ob = v0; *(v4u*)(Ob + 16) = v1;
        float s1 = 0.f, s2 = 0.f;
#pragma unroll
        for (int e = 0; e < 4; ++e) { const float a0 = bflo(v0[e]), a1 = bfhi(v0[e]), a2 = bflo(v1[e]), a3 = bfhi(v1[e]);
          s1 += (a0 + a1) + (a2 + a3); s2 += (a0 * a0 + a1 * a1) + (a2 * a2 + a3 * a3); }
        s1 += __shfl_xor(s1, 1); s2 += __shfl_xor(s2, 1);
        if ((lane & 1) == 0) gnst[((size_t)j * NTOK + orow) * 8 + h] = (f32x2){s1, s2}; }
    } else {
#pragma unroll
      for (int r = 0; r < 16; ++r) sacc[r] *= c_dec;
#define RET_KS(im, ks) { const s16x4 al = tr_read<v_rd_off(1, ks, 0) + (im) * SHM_V>(vbV), ah = tr_read<v_rd_off(1, ks, 1) + (im) * SHM_V>(vbV); \
        const s16x4 bl = tr_read<v_rd_off(0, ks, 0) + (im) * SHM_V>(vbK), bh = tr_read<v_rd_off(0, ks, 1) + (im) * SHM_V>(vbK); \
        asm volatile("s_waitcnt lgkmcnt(0)" ::: "memory"); SBAR(); \
        sacc = __builtin_amdgcn_mfma_f32_32x32x16_bf16(PKF(al, ah), PKF(bl, bh), sacc, 0, 0, 0); }
      RET_KS(0, 0) RET_KS(0, 1) RET_KS(0, 2) RET_KS(0, 3) RET_KS(1, 0) RET_KS(1, 1) RET_KS(1, 2) RET_KS(1, 3)
#undef RET_KS
    }
    __syncthreads();
    if (wid >= 4) {
#pragma unroll
      for (int r = 0; r < 16; ++r) *(bf16_t*)(ST + crow(r, hi) * R_STP + (32 * (wid - 4) + r32) * 2) = (bf16_t)f2bf(sacc[r]);
    }
  }
  __syncthreads();
}
__device__ __forceinline__ bf16x8 f8_to_bf8(const unsigned long long w) { float f[8]; unpack8_fp8(w, f); v4u o;
#pragma unroll
  for (int k = 0; k < 4; ++k) o[k] = cvtpk_(f[2 * k] * (1.f / V8_SCALE), f[2 * k + 1] * (1.f / V8_SCALE));
  return __builtin_bit_cast(bf16x8, o); }
constexpr int R2_KS = 0, R2_KI = 32768, R2_VI = 65536, R2_ST = 98304, R2_OS = R2_ST + 4 * 32 * R_STP;
constexpr int RA_KI = 0, RA_VI = 32768;
__device__ __forceinline__ bf16x8 scale8(bf16x8 v, float f) { bf16x8 o;
#pragma unroll
  for (int e = 0; e < 8; ++e) o[e] = (short)f2bf(bf2f((unsigned short)v[e]) * f);
  return o; }
#define RET_KS2(sa, S, im, ks) { const s16x4 al = tr_read<v_rd_off(S, ks, 0) + (im) * SHM_V>(vbV), ah = tr_read<v_rd_off(S, ks, 1) + (im) * SHM_V>(vbV); \
        const s16x4 bl = tr_read<v_rd_off(0, ks, 0) + (im) * SHM_V>(vbK), bh = tr_read<v_rd_off(0, ks, 1) + (im) * SHM_V>(vbK); \
        asm volatile("s_waitcnt lgkmcnt(0)" ::: "memory"); SBAR(); \
        sa = __builtin_amdgcn_mfma_f32_32x32x16_bf16(PKF(al, ah), PKF(bl, bh), sa, 0, 0, 0); }
template <int S> __device__ __forceinline__ void ret_state_slice(f32x16& sa, const float c_dec, const int vbV, const int vbK) {
#pragma unroll
  for (int r = 0; r < 16; ++r) sa[r] *= c_dec;
  RET_KS2(sa, S, 0, 0) RET_KS2(sa, S, 0, 1) RET_KS2(sa, S, 0, 2) RET_KS2(sa, S, 0, 3) RET_KS2(sa, S, 1, 0) RET_KS2(sa, S, 1, 1) RET_KS2(sa, S, 1, 2) RET_KS2(sa, S, 1, 3)
}
__device__ __forceinline__ void ret_passA(int b, int h, int seg, const bf16_t* __restrict__ KR, const unsigned char* __restrict__ V8, bf16_t* Sloc, char* lds, const int wave_) {
  const int wid = __builtin_amdgcn_readfirstlane(wave_); int lane = lane_id(); asm volatile("" : "+v"(lane));
  const int tid = wid * 64 + lane;
  char* KI = lds + RA_KI; char* VI = lds + RA_VI;
  const float lg = log2f(1.f - exp2f(-5.f - (float)h));
  const float c_dec = exp2f(128.f * lg);
  const long rowbase = (long)b * SEQ + (long)seg * 1024;
  const int sr = tid >> 4, sc = (tid & 15) * 8;
  const int vtk = tid >> 5, vcl = (tid & 31) * 8;
  const bf16_t* Kg = KR + rowbase * 1024 + h * 128 + sc;
  const unsigned char* Vg = V8 + (rowbase + vtk) * 2048 + h * 256 + vcl;
  const int vbV = (int)(uintptr_t)VI + v_rd_base(lane) + (wid >> 2) * 2 * SHM_V;
  const int vbK = (int)(uintptr_t)KI + v_rd_base(lane) + (wid & 3) * 512;
  bf16x8 kreg[4]; unsigned long long vreg[8];
#pragma unroll
  for (int i = 0; i < 4; ++i) kreg[i] = *reinterpret_cast<const bf16x8*>(Kg + (long)(sr + 32 * i) * 1024);
#pragma unroll
  for (int e = 0; e < 8; ++e) vreg[e] = *reinterpret_cast<const unsigned long long*>(Vg + (long)(16 * e) * 2048);
  f32x16 sacc[4];
#pragma unroll
  for (int s = 0; s < 4; ++s)
#pragma unroll
    for (int r = 0; r < 16; ++r) sacc[s][r] = 0.f;
  for (int n = 0; n < 8; ++n) {
    const long t0 = (long)n * 128;
    float lgv = lg; asm volatile("" : "+v"(lgv));
#pragma unroll
    for (int i = 0; i < 4; ++i) { const int tok = sr + 32 * i;
      *(bf16x8*)(KI + (i >> 1) * SHM_V + v_st(tok & 63, sc)) = scale8(kreg[i], __builtin_amdgcn_exp2f((float)(127 - tok) * lgv)); }
#pragma unroll
    for (int e = 0; e < 8; ++e) { const int tok = vtk + 16 * e;
      *(bf16x8*)(VI + ((vcl >> 7) * 2 + (tok >> 6)) * SHM_V + v_st(tok & 63, vcl & 127)) = f8_to_bf8(vreg[e]); }
    if (n + 1 < 8) {
#pragma unroll
      for (int i = 0; i < 4; ++i) kreg[i] = *reinterpret_cast<const bf16x8*>(Kg + (t0 + 128 + sr + 32 * i) * 1024);
#pragma unroll
      for (int e = 0; e < 8; ++e) vreg[e] = *reinterpret_cast<const unsigned long long*>(Vg + (t0 + 128 + 16 * e) * 2048);
    }
    __syncthreads();
    ret_state_slice<0>(sacc[0], c_dec, vbV, vbK); ret_state_slice<1>(sacc[1], c_dec, vbV, vbK); ret_state_slice<2>(sacc[2], c_dec, vbV, vbK); ret_state_slice<3>(sacc[3], c_dec, vbV, vbK);
    __syncthreads();
  }
#pragma unroll
  for (int s = 0; s < 4; ++s) { const int tile = (4 * (wid >> 2) + s) * 4 + (wid & 3); v4u o0, o1;
    o0.x = pk2(sacc[s][0], sacc[s][1]); o0.y = pk2(sacc[s][2], sacc[s][3]); o0.z = pk2(sacc[s][4], sacc[s][5]); o0.w = pk2(sacc[s][6], sacc[s][7]);
    o1.x = pk2(sacc[s][8], sacc[s][9]); o1.y = pk2(sacc[s][10], sacc[s][11]); o1.z = pk2(sacc[s][12], sacc[s][13]); o1.w = pk2(sacc[s][14], sacc[s][15]);
    v4u* dst = (v4u*)(Sloc + ((size_t)tile * 64 + lane) * 16); dst[0] = o0; dst[1] = o1; }
}
template <int S> __device__ __forceinline__ void ret_out_slice(const bf16x8* qr, const bf16x8 (&pa)[4][2], const float* qdv, const char* ST, const int vbV, char* stg, bf16_t* Orow, f32x2* gn, const int wid, int lane) {
  asm volatile("" : "+v"(lane));
  const int r32 = lane & 31, hi = lane >> 5;
  f32x16 acc;
#pragma unroll
  for (int r = 0; r < 16; ++r) acc[r] = 0.f;
#pragma unroll
  for (int d0 = 0; d0 < 8; ++d0) { const bf16x8 bs = *reinterpret_cast<const bf16x8*>(ST + (32 * S + r32) * R_STP + (16 * d0 + 8 * hi) * 2);
    acc = __builtin_amdgcn_mfma_f32_32x32x16_bf16(qr[d0], bs, acc, 0, 0, 0); }
#pragma unroll
  for (int r = 0; r < 16; ++r) acc[r] *= qdv[r];
#define RET_PV2(kb) if ((kb) <= wid) { \
    const s16x4 l0 = tr_read<v_rd_off(S, ((kb) & 1) * 2 + 0, 0) + ((kb) >> 1) * SHM_V>(vbV), h0 = tr_read<v_rd_off(S, ((kb) & 1) * 2 + 0, 1) + ((kb) >> 1) * SHM_V>(vbV); \
    const s16x4 l1 = tr_read<v_rd_off(S, ((kb) & 1) * 2 + 1, 0) + ((kb) >> 1) * SHM_V>(vbV), h1 = tr_read<v_rd_off(S, ((kb) & 1) * 2 + 1, 1) + ((kb) >> 1) * SHM_V>(vbV); \
    asm volatile("s_waitcnt lgkmcnt(0)" ::: "memory"); SBAR(); \
    acc = __builtin_amdgcn_mfma_f32_32x32x16_bf16(pa[kb][0], PKF(l0, h0), acc, 0, 0, 0); \
    acc = __builtin_amdgcn_mfma_f32_32x32x16_bf16(pa[kb][1], PKF(l1, h1), acc, 0, 0, 0); }
  RET_PV2(0) RET_PV2(1) RET_PV2(2) RET_PV2(3)
#undef RET_PV2
#pragma unroll
  for (int r = 0; r < 16; ++r) *(bf16_t*)(stg + crow(r, hi) * 64 + r32 * 2) = (bf16_t)f2bf(acc[r]);
  asm volatile("s_waitcnt lgkmcnt(0)" ::: "memory");
  { const v4u v0 = *(const v4u*)(stg + (lane >> 1) * 64 + (lane & 1) * 32), v1 = *(const v4u*)(stg + (lane >> 1) * 64 + (lane & 1) * 32 + 16);
    char* Ob = (char*)(Orow + (size_t)(lane >> 1) * 2048) + (lane & 1) * 32;
    *(v4u*)Ob = v0; *(v4u*)(Ob + 16) = v1;
    float s1 = 0.f, s2 = 0.f;
#pragma unroll
    for (int e = 0; e < 4; ++e) { const float a0 = bflo(v0[e]), a1 = bfhi(v0[e]), a2 = bflo(v1[e]), a3 = bfhi(v1[e]);
      s1 += (a0 + a1) + (a2 + a3); s2 += (a0 * a0 + a1 * a1) + (a2 * a2 + a3 * a3); }
    s1 += __shfl_xor(s1, 1); s2 += __shfl_xor(s2, 1);
    if ((lane & 1) == 0) gn[(size_t)(lane >> 1) * 8] = (f32x2){s1, s2}; }
  asm volatile("s_waitcnt lgkmcnt(0)" ::: "memory");
}
__device__ __forceinline__ void ret_passB(int b, int h, int seg, const bf16_t* __restrict__ QR, const bf16_t* __restrict__ KR, const unsigned char* __restrict__ V8, bf16_t* VR, const bf16_t* Sall, f32x2* gnst, char* lds, const int wave_) {
  const int wid = __builtin_amdgcn_readfirstlane(wave_);
  char* KS = lds + R2_KS; char* KI = lds + R2_KI; char* VI = lds + R2_VI; char* ST = lds + R2_ST;
  const float lg = log2f(1.f - exp2f(-5.f - (float)h));
  const float c_dec = exp2f(128.f * lg);
  const long rowbase = (long)b * SEQ + (long)seg * 1024;
#define R2_LANE() int lane = lane_id(); asm volatile("" : "+v"(lane)); const int tid = wid * 64 + lane, r32 = lane & 31, hi = lane >> 5; (void)r32; (void)hi; \
  const int sr = tid >> 4, sc = (tid & 15) * 8, vtk = tid >> 4, vcl = (tid & 15) * 8; \
  const bf16_t* Kg = KR + rowbase * 1024 + h * 128 + sc; const unsigned char* Vg = V8 + (rowbase + vtk) * 2048 + h * 256 + vcl; \
  const int vbV = (int)(uintptr_t)VI + v_rd_base(lane); const int vbK = (int)(uintptr_t)KI + v_rd_base(lane) + (wid & 3) * 512; (void)vbK;
  bf16x8 kreg[4]; unsigned long long vreg[4];
  { R2_LANE();
#pragma unroll
    for (int i = 0; i < 4; ++i) kreg[i] = *reinterpret_cast<const bf16x8*>(Kg + (long)(sr + 32 * i) * 1024);
#pragma unroll
    for (int e = 0; e < 4; ++e) vreg[e] = *reinterpret_cast<const unsigned long long*>(Vg + (long)(32 * e) * 2048); }
#define R2_STAGE_A() do { _Pragma("unroll") for (int i = 0; i < 4; ++i) { const int tok = sr + 32 * i; \
      *(bf16x8*)(KS + KSWZ(tok, sc * 2)) = kreg[i]; \
      *(bf16x8*)(KI + (i >> 1) * SHM_V + v_st(tok & 63, sc)) = scale8(kreg[i], __builtin_amdgcn_exp2f((float)(127 - tok) * lgv)); } \
    _Pragma("unroll") for (int e = 0; e < 4; ++e) { const int tok = vtk + 32 * e; *(bf16x8*)(VI + (tok >> 6) * SHM_V + v_st(tok & 63, vcl)) = f8_to_bf8(vreg[e]); } } while (0)
#define R2_STAGE_B() do { _Pragma("unroll") for (int e = 0; e < 4; ++e) { const int tok = vtk + 32 * e; *(bf16x8*)(VI + (tok >> 6) * SHM_V + v_st(tok & 63, vcl)) = f8_to_bf8(vreg[e]); } } while (0)
#define R2_PREF_A() do { if (n + 1 < 8) { _Pragma("unroll") for (int i = 0; i < 4; ++i) kreg[i] = *reinterpret_cast<const bf16x8*>(Kg + (t0 + 128 + sr + 32 * i) * 1024); } \
      _Pragma("unroll") for (int e = 0; e < 4; ++e) vreg[e] = *reinterpret_cast<const unsigned long long*>(Vg + (t0 + 32 * e) * 2048 + 128); } while (0)
#define R2_PREF_B() do { if (n + 1 < 8) { _Pragma("unroll") for (int e = 0; e < 4; ++e) vreg[e] = *reinterpret_cast<const unsigned long long*>(Vg + (t0 + 128 + 32 * e) * 2048); } } while (0)
  if (wid < 4) {
    bf16x8 qr[8];
    { R2_LANE(); const bf16_t* Qg = QR + (rowbase + wid * 32 + r32) * 1024 + h * 128 + hi * 8;
#pragma unroll
      for (int d0 = 0; d0 < 8; ++d0) qr[d0] = *reinterpret_cast<const bf16x8*>(Qg + d0 * 16); }
    char* stg = lds + R2_OS + wid * 2048;
    for (int n = 0; n < 8; ++n) {
      const long t0 = (long)n * 128;
      float lgv = lg; asm volatile("" : "+v"(lgv));
      R2_LANE();
      R2_STAGE_A(); R2_PREF_A();
      __syncthreads();
      bf16x8 pa[4][2]; float qdv[16];
      bf16_t* Orow = VR + (rowbase + t0 + 32 * wid) * 2048 + h * 256;
      f32x2* gn = gnst + ((size_t)(rowbase + t0 + 32 * wid)) * 8 + h;
#define RET_SC2(kb) if ((kb) <= wid) { f32x16 p; _Pragma("unroll") for (int r = 0; r < 16; ++r) p[r] = 0.f; \
        _Pragma("unroll") for (int d0 = 0; d0 < 8; ++d0) { const bf16x8 kf = *reinterpret_cast<const bf16x8*>(KS + KSWZ(32 * (kb) + r32, (16 * d0 + 8 * hi) * 2)); \
          p = __builtin_amdgcn_mfma_f32_32x32x16_bf16(kf, qr[d0], p, 0, 0, 0); } \
        _Pragma("unroll") for (int r = 0; r < 16; ++r) { const int rel = 32 * (wid - (kb)) + r32 - crow(r, hi); p[r] = rel >= 0 ? p[r] * __builtin_amdgcn_exp2f((float)rel * lgv) : 0.f; } \
        PK4(p, 0, pa[kb][0]); PK4(p, 8, pa[kb][1]); }
      RET_SC2(0) RET_SC2(1) RET_SC2(2) RET_SC2(3)
#undef RET_SC2
#pragma unroll
      for (int r = 0; r < 16; ++r) qdv[r] = __builtin_amdgcn_exp2f((float)(32 * wid + crow(r, hi) + 1) * lgv);
      ret_out_slice<0>(qr, pa, qdv, ST, vbV, stg, Orow + 0 * 32, gn + (size_t)0 * NTOK * 8, wid, lane);
      ret_out_slice<1>(qr, pa, qdv, ST, vbV, stg, Orow + 1 * 32, gn + (size_t)1 * NTOK * 8, wid, lane);
      ret_out_slice<2>(qr, pa, qdv, ST, vbV, stg, Orow + 2 * 32, gn + (size_t)2 * NTOK * 8, wid, lane);
      ret_out_slice<3>(qr, pa, qdv, ST, vbV, stg, Orow + 3 * 32, gn + (size_t)3 * NTOK * 8, wid, lane);
      __syncthreads();
      R2_STAGE_B(); R2_PREF_B();
      __syncthreads();
      ret_out_slice<0>(qr, pa, qdv, ST, vbV, stg, Orow + 4 * 32, gn + (size_t)4 * NTOK * 8, wid, lane);
      ret_out_slice<1>(qr, pa, qdv, ST, vbV, stg, Orow + 5 * 32, gn + (size_t)5 * NTOK * 8, wid, lane);
      ret_out_slice<2>(qr, pa, qdv, ST, vbV, stg, Orow + 6 * 32, gn + (size_t)6 * NTOK * 8, wid, lane);
      ret_out_slice<3>(qr, pa, qdv, ST, vbV, stg, Orow + 7 * 32, gn + (size_t)7 * NTOK * 8, wid, lane);
      if (n + 1 < 8) { const bf16_t* Qg = QR + (rowbase + wid * 32 + r32) * 1024 + h * 128 + hi * 8;
#pragma unroll
        for (int d0 = 0; d0 < 8; ++d0) qr[d0] = *reinterpret_cast<const bf16x8*>(Qg + (t0 + 128) * 1024 + d0 * 16);
      }
      __syncthreads();
    }
  } else {
    f32x16 sacc[8];
#pragma unroll
    for (int s = 0; s < 8; ++s)
#pragma unroll
      for (int r = 0; r < 16; ++r) sacc[s][r] = 0.f;
    for (int sp = 0; sp < seg; ++sp) {
      int lane = lane_id(); asm volatile("" : "+v"(lane));
      const float f = exp2f(1024.f * lg * (float)(seg - 1 - sp));
      const bf16_t* Sp = Sall + (size_t)sp * (256 * 128);
#pragma unroll
      for (int s = 0; s < 8; ++s) { const int tile = s * 4 + (wid - 4);
        const v4u* src = (const v4u*)(Sp + ((size_t)tile * 64 + lane) * 16); const v4u a0 = src[0], a1 = src[1];
#pragma unroll
        for (int k = 0; k < 4; ++k) { sacc[s][2 * k] += f * bflo(a0[k]); sacc[s][2 * k + 1] += f * bfhi(a0[k]); sacc[s][8 + 2 * k] += f * bflo(a1[k]); sacc[s][8 + 2 * k + 1] += f * bfhi(a1[k]); } }
    }
#define R2_ST_WRITE(base) do { _Pragma("unroll") for (int s = 0; s < 4; ++s) _Pragma("unroll") for (int r = 0; r < 16; ++r) \
      *(bf16_t*)(ST + (32 * s + crow(r, hi)) * R_STP + (32 * (wid - 4) + r32) * 2) = (bf16_t)f2bf(sacc[(base) + s][r]); } while (0)
    for (int n = 0; n < 8; ++n) {
      const long t0 = (long)n * 128;
      float lgv = lg; asm volatile("" : "+v"(lgv));
      R2_LANE();
      R2_STAGE_A(); R2_ST_WRITE(0); R2_PREF_A();
      __syncthreads();
      ret_state_slice<0>(sacc[0], c_dec, vbV, vbK); ret_state_slice<1>(sacc[1], c_dec, vbV, vbK); ret_state_slice<2>(sacc[2], c_dec, vbV, vbK); ret_state_slice<3>(sacc[3], c_dec, vbV, vbK);
      __syncthreads();
      R2_STAGE_B(); R2_ST_WRITE(4); R2_PREF_B();
      __syncthreads();
      ret_state_slice<0>(sacc[4], c_dec, vbV, vbK); ret_state_slice<1>(sacc[5], c_dec, vbV, vbK); ret_state_slice<2>(sacc[6], c_dec, vbV, vbK); ret_state_slice<3>(sacc[7], c_dec, vbV, vbK);
      __syncthreads();
    }
#undef R2_ST_WRITE
  }
#undef R2_LANE
#undef R2_STAGE_A
#undef R2_STAGE_B
#undef R2_PREF_A
#undef R2_PREF_B
}
#undef RET_KS2
#undef SBAR
}

__device__ __forceinline__ void gn_pass(Frame& F, unsigned char* ws, const float* gn_g, const bool dummy) {
    const int gw = F.vcu * NWAVES + F.wave, NGW = F.G * NWAVES, lane = FLANE;
    const f32x2* gnst = (const f32x2*)(ws + WS_GNST);
    f32x4 w0[4], w1[4];
#pragma unroll
    for (int i = 0; i < 4; ++i) { const int c8 = i * 64 + lane; w0[i] = *((const GAS f32x4*)gn_g + 2 * c8); w1[i] = *((const GAS f32x4*)gn_g + 2 * c8 + 1); }
    v4u co[4], no[4]; unsigned long long cg[4], ng[4]; f32x2 cs[8], ns[8];
#define GN_LOAD(o_, g_, s_, t_) do { const GAS v4u* o4 = (const GAS v4u*)(ws + WS_VR + (size_t)(t_) * 4096); const GAS unsigned long long* g4 = (const GAS unsigned long long*)(ws + WS_GR + (size_t)(t_) * 2048); \
        _Pragma("unroll") for (int i = 0; i < 4; ++i) { o_[i] = o4[i * 64 + lane]; g_[i] = g4[i * 64 + lane]; } \
        _Pragma("unroll") for (int j = 0; j < 8; ++j) s_[j] = gnst[((size_t)j * NTOK + (t_)) * 8 + (lane & 7)]; } while (0)
    int t = gw;
    if (t < NTOK) GN_LOAD(co, cg, cs, t);
    while (t < NTOK) {
        const int tn = t + NGW;
        if (tn < NTOK) GN_LOAD(no, ng, ns, tn);
        float mean, rstd;
        { float s = 0.f, q = 0.f;
#pragma unroll
          for (int j = 0; j < 8; ++j) { s += cs[j].x; q += cs[j].y; }
          mean = s * (1.f / 256.f); rstd = 1.f / sqrtf(fmaxf(q * (1.f / 256.f) - mean * mean, 0.f) + LN_EPS); }
        float y[4][8]; float mx = 0.f;
#pragma unroll
        for (int i = 0; i < 4; ++i) { const int c8 = i * 64 + lane, hd = c8 >> 5;
            const float mu = __shfl(mean, hd), rs = __shfl(rstd, hd);
            float of[8], gf[8]; unpack8(co[i], of); unpack8_fp8(cg[i], gf);
            const float wv[8] = {w0[i].x, w0[i].y, w0[i].z, w0[i].w, w1[i].x, w1[i].y, w1[i].z, w1[i].w};
#pragma unroll
            for (int e = 0; e < 8; ++e) { y[i][e] = gf[e] * wv[e] * (of[e] - mu) * rs; mx = fmaxf(mx, fabsf(y[i][e])); } }
#pragma unroll
        for (int o = 1; o < 64; o <<= 1) mx = fmaxf(mx, __shfl_xor(mx, o));
        const float sc = mx > 0.f ? mx * (1.f / 127.f) : 1.f, inv = 1.f / sc;
        if (!dummy) {
            GAS unsigned long long* q8 = (GAS unsigned long long*)(ws + WS_AR8 + (size_t)t * 2048);
#pragma unroll
            for (int i = 0; i < 4; ++i) { unsigned long long w = 0;
#pragma unroll
                for (int e = 0; e < 8; ++e) w |= (unsigned long long)((unsigned)((int)rintf(y[i][e] * inv) & 255)) << (8 * e);
                q8[i * 64 + lane] = w; }
            if (lane == 0) ((float*)(ws + WS_SAR))[t] = sc;
        }
#pragma unroll
        for (int i = 0; i < 4; ++i) { co[i] = no[i]; cg[i] = ng[i]; }
#pragma unroll
        for (int j = 0; j < 8; ++j) cs[j] = ns[j];
        t = tn;
    }
#undef GN_LOAD
}

#define EPI_ROWS_BEGIN const int row0 = u.pm * 256 + wr * 64 + fr; const int colw = wc * 32 + 8 * fq; \
    _Pragma("unroll") for (int ai = 0; ai < 2; ++ai) _Pragma("unroll") for (int m = 0; m < 4; ++m) { const int row = row0 + ai * 128 + m * 16; (void)row; \
    _Pragma("unroll") for (int bj = 0; bj < 2; ++bj) { float v[8]; _Pragma("unroll") for (int i = 0; i < 8; ++i) v[i] = acc[ai][bj][m][i >> 2][i & 3]; const int colt = bj * 128 + colw; (void)colt;
#define EPI_ROWS_END } }
struct EpiM { static constexpr bool PERM = true, WIDE = false, PRE = false; unsigned char* ws; int which; int dummy; float fixed_rs;
    __device__ __forceinline__ const float* rowscale_ptr(const pg8::Unit& u) const { return (const float*)(ws + WS_SAR) + u.pm * 256; }
    __device__ __forceinline__ bool fixed_rowscale() const { return which != 0; }
    __device__ __forceinline__ float fixed_rs_value() const { return fixed_rs; }
    __device__ __forceinline__ const float* colscale(const pg8::Unit& u) const { return (const float*)(ws + (which ? WS_SWDO : WS_SWRO)) + u.pn * 256; }
    __device__ __forceinline__ void operator()(const pg8::Acc& acc, const pg8::Unit& u, int wr, int wc, int fr, int fq) const {
        EPI_ROWS_BEGIN
            const int col = u.pn * 256 + colt; float g[8]; unpack8_fp8(*(const unsigned long long*)(ws + WS_GT + (size_t)row * 2048 + which * 1024 + col), g);
            bf16_t* mp = (bf16_t*)(ws + WS_M) + (size_t)row * 1024 + col;
            if (which) { float o[8]; unpack8(*(const v4u*)mp, o);
#pragma unroll
                for (int i = 0; i < 8; ++i) v[i] = o[i] + g[i] * v[i]; }
            else {
#pragma unroll
                for (int i = 0; i < 8; ++i) v[i] = g[i] * v[i]; }
            if (!dummy) { if (which) {
#pragma unroll
                    for (int i = 0; i < 8; ++i) v[i] *= M8_SCALE;
                    *(unsigned long long*)(ws + WS_M8 + (size_t)row * 1024 + col) = pack8_fp8(v); }
                else *(v4u*)mp = pack8(v); }
        EPI_ROWS_END
    } };
struct EpiZ { static constexpr bool PERM = true, WIDE = false, PRE = false; unsigned char* ws;
    __device__ __forceinline__ void operator()(const pg8::Acc& acc, const pg8::Unit& u, int wr, int wc, int fr, int fq) const {
        EPI_ROWS_BEGIN
            const int col = u.pn * 256 + colt; float x[8]; unpack8(*(const v4u*)((const bf16_t*)(ws + WS_XN) + (size_t)row * 1024 + col), x);
#pragma unroll
            for (int i = 0; i < 8; ++i) v[i] = DN_ALPHA * x[i] + v[i] * (1.f / (M8_SCALE * F8_WSCALE));
            *(v4u*)((bf16_t*)(ws + WS_Z) + (size_t)row * 1024 + col) = pack8(v);
        EPI_ROWS_END
    } };
struct EpiP5 { static constexpr bool PERM = true, WIDE = false, PRE = false; unsigned char* ws;
    __device__ __forceinline__ void operator()(const pg8::Acc& acc, const pg8::Unit& u, int wr, int wc, int fr, int fq) const {
        EPI_ROWS_BEGIN
            const int col = u.pn * 256 + colt;
            if (u.type == 0) { float* zp = (float*)(ws + WS_LOGIT) + (size_t)row * 256 + col; *(f32x4*)zp = (f32x4){v[0], v[1], v[2], v[3]}; *(f32x4*)(zp + 4) = (f32x4){v[4], v[5], v[6], v[7]}; }
            else {
#pragma unroll
                for (int i = 0; i < 8; ++i) v[i] *= B8_SCALE;
                *(unsigned long long*)(ws + WS_BASE + (size_t)row * 1024 + col) = pack8_fp8(v); }
        EPI_ROWS_END
    } };
struct EpiP8 { static constexpr bool PERM = true, WIDE = false, PRE = false; unsigned char* ws; int dummy;
    __device__ __forceinline__ const float* rowscale_ptr(const pg8::Unit& u) const { return (const float*)(ws + M_RS) + u.grow; }
    __device__ __forceinline__ bool fixed_rowscale() const { return false; }
    __device__ __forceinline__ float fixed_rs_value() const { return 1.f; }
    __device__ __forceinline__ const float* colscale(const pg8::Unit& u) const { return u.cs; }
    __device__ __forceinline__ void operator()(const pg8::Acc& acc, const pg8::Unit& u, int wr, int wc, int fr, int fq) const {
        const int lrow0 = wr * 64 + fr, colw = wc * 32 + 8 * fq;
        if (u.type == 0) {
#pragma unroll
            for (int ai = 0; ai < 2; ++ai)
#pragma unroll
                for (int m = 0; m < 4; ++m) { const int lrow = lrow0 + ai * 128 + m * 16; float v[8];
#pragma unroll
                    for (int i = 0; i < 8; ++i) v[i] = fast_silu(acc[ai][0][m][i >> 2][i & 3]) * acc[ai][1][m][i >> 2][i & 3];
#pragma unroll
                    for (int i = 0; i < 8; ++i) v[i] *= F8_ASCALE;
                    *(unsigned long long*)(ws + WS_ACT + (size_t)(u.aux + lrow) * 256 + u.pn * 128 + colw) = pack8_fp8(v); }
        } else {
#pragma unroll
            for (int ai = 0; ai < 2; ++ai)
#pragma unroll
                for (int m = 0; m < 4; ++m)
#pragma unroll
                    for (int bj = 0; bj < 2; ++bj) { const int row = u.pm * 256 + lrow0 + ai * 128 + m * 16, col = u.pn * 256 + bj * 128 + colw;
                        unsigned char* bp = ws + WS_BASE + (size_t)row * 1024 + col; float o[8]; unpack8_fp8(*(const unsigned long long*)bp, o);
#pragma unroll
                        for (int i = 0; i < 8; ++i) o[i] *= fast_sigmoid(acc[ai][bj][m][i >> 2][i & 3]);
                        if (!dummy) *(unsigned long long*)bp = pack8_fp8(o); }
        }
    } };
struct EpiP9 { static constexpr bool PERM = true, WIDE = false, PRE = true; unsigned char* ws; int dummy;
    __device__ __forceinline__ const float* rowscale_ptr(const pg8::Unit& u) const { return (const float*)(ws + M_RASSIGN) + u.aux; }
    __device__ __forceinline__ const float* colscale(const pg8::Unit& u) const { return (const float*)(ws + M_RW) + u.aux; }
    __device__ __forceinline__ void operator()(const pg8::Acc& acc, const pg8::Unit& u, int wr, int wc, int fr, int fq, const LAS unsigned char* scl) const {
        int lrow0 = wr * 64 + fr, colw = wc * 32 + 8 * fq; asm volatile("" : "+v"(lrow0), "+v"(colw));
        if (u.type == 0) {
            int av[8]; float wv[8];
#pragma unroll
            for (int q = 0; q < 8; ++q) { const int lrow = lrow0 + (q >> 2) * 128 + (q & 3) * 16; av[q] = *(const LAS int*)(scl + 4 * lrow); wv[q] = *(const LAS float*)(scl + 1024 + 4 * lrow); }
#pragma unroll
            for (int q = 0; q < 8; ++q) { int a = av[q]; asm volatile("" : "+v"(a) :: "memory");
                if (a >= 0) { unsigned char* yp = ws + WS_Y + (size_t)a * 1024 + u.pn * 256 + colw * 2;
                    const float w16 = wv[q] * (16.f / (F8_WSCALE * F8_ASCALE)); v4u o;
#pragma unroll
                    for (int bj = 0; bj < 2; ++bj) { float v[8];
#pragma unroll
                        for (int i = 0; i < 8; ++i) v[i] = w16 * acc[q >> 2][bj][q & 3][i >> 2][i & 3];
                        int w0 = 0, w1 = 0;
                        w0 = __builtin_amdgcn_cvt_pk_fp8_f32(v[0], v[1], w0, false); w0 = __builtin_amdgcn_cvt_pk_fp8_f32(v[2], v[3], w0, true);
                        w1 = __builtin_amdgcn_cvt_pk_fp8_f32(v[4], v[5], w1, false); w1 = __builtin_amdgcn_cvt_pk_fp8_f32(v[6], v[7], w1, true);
                        o[2 * bj] = (unsigned)w0; o[2 * bj + 1] = (unsigned)w1; }
                    *(v4u*)yp = o; } }
        } else {
#pragma unroll
            for (int q = 0; q < 8; ++q) { int lrow = lrow0 + (q >> 2) * 128 + (q & 3) * 16; asm volatile("" : "+v"(lrow) :: "memory");
                unsigned char* bp = ws + WS_BASE + (size_t)(u.pm * 256 + lrow) * 1024 + u.pn * 256 + colw;
#pragma unroll
                for (int bj = 0; bj < 2; ++bj) { float o[8]; unpack8_fp8(*(const unsigned long long*)(bp + bj * 128), o);
#pragma unroll
                    for (int i = 0; i < 8; ++i) o[i] += acc[q >> 2][bj][q & 3][i >> 2][i & 3] * (B8_SCALE / (F8_WSCALE * F8_ASCALE));
                    if (!dummy) *(unsigned long long*)(bp + bj * 128) = pack8_fp8(o); } }
        }
    } };

struct P5Order {
    unsigned char* ws; int G, c, which;
    __device__ __forceinline__ bool next(int i, pg8::Unit& u) const {
        int idx = i * G + c;
        if (which == 1 && G == 256) { if (c < 128 || i >= 4) return false; idx = i * 128 + (c - 128); }
        if (which == 0) { if (idx >= 128) return false; u.pm = idx; u.pn = 0; u.type = 0; u.aux = 0; u.A = (const char*)(ws + WS_H1) + (size_t)idx * 256 * 1024 * 2; u.B = (const char*)(ws + WS_ROUT_T); u.grow = -1; return true; }
        if (idx >= 512) return false; u.pm = idx >> 2; u.pn = idx & 3; u.type = 1; u.aux = 0; u.A = (const char*)(ws + WS_PB) + (size_t)u.pm * 256 * 256 * 2; u.B = (const char*)(ws + WS_PLEW_T) + (size_t)u.pn * 256 * 256 * 2; u.grow = -1; return true;
    } };
struct P8Order {
    unsigned char* ws; int G, c, nblk;
    __device__ __forceinline__ bool next(int i, pg8::Unit& u) const {
        int idx = i * G + c; u.A = (const char*)(ws + WS_H18);
        if (idx < 2 * nblk) { const int blk = idx >> 1, e = __builtin_amdgcn_readfirstlane(((const volatile int*)(ws + M_BLKE))[blk]); u.pm = blk; u.pn = idx & 1; u.type = 0; u.aux = blk * 256; u.grow = blk * 256;
            u.B = (const char*)(ws + WS_EGU_T) + (size_t)e * (512 * 1024) + (size_t)u.pn * (256 * 1024); u.cs = (const float*)(ws + WS_SEGU) + e * 512 + u.pn * 256; return true; }
        idx -= 2 * nblk;
        if (idx < 256) { u.pm = idx >> 1; u.pn = idx & 1; u.type = 0; u.aux = SH_ACT_ROW0 + u.pm * 256; u.grow = NROWS_MAX + u.pm * 256;
            u.B = (const char*)(ws + WS_SHGU_T) + (size_t)u.pn * (256 * 1024); u.cs = (const float*)(ws + WS_SSHGU) + u.pn * 256; return true; }
        idx -= 256;
        if (idx < 512) { u.pm = idx >> 2; u.pn = idx & 3; u.type = 2; u.aux = 0; u.grow = NROWS_MAX + u.pm * 256;
            u.B = (const char*)(ws + WS_PLEG_T) + (size_t)u.pn * (256 * 1024); u.cs = (const float*)(ws + WS_SPLEG) + u.pn * 256; return true; }
        return false;
    } };
struct P9Order {
    unsigned char* ws; int G, c, nblk;
    __device__ __forceinline__ bool next(int i, pg8::Unit& u) const {
        int idx = i * G + c; u.grow = -1;
        if (idx < 4 * nblk) { const int blk = idx >> 2, e = __builtin_amdgcn_readfirstlane(((const volatile int*)(ws + M_BLKE))[blk]); u.pm = blk; u.pn = idx & 3; u.type = 0; u.aux = blk * 256;
            u.A = (const char*)(ws + WS_ACT) + (size_t)blk * (256 * 256); u.B = (const char*)(ws + ed_off(e)) + (size_t)u.pn * (256 * 256); return true; }
        idx -= 4 * nblk;
        if (idx < 512) { u.pm = idx >> 2; u.pn = idx & 3; u.type = 1; u.aux = 0;
            u.A = (const char*)(ws + WS_ACT) + (size_t)(SH_ACT_ROW0 + u.pm * 256) * 256; u.B = (const char*)(ws + WS_SHD_T) + (size_t)u.pn * (256 * 256); return true; }
        return false;
    } };

__device__ __forceinline__ void px_convert(Frame& F, const Args& a) {
    LAS float* scr = (LAS float*)(F.lds + F.wave * 16384);
    const int gw = F.vcu * NWAVES + F.wave, NGW = F.G * NWAVES; unsigned char* ws = a.ws;
    for (int it = gw; it < 256 * 128; it += NGW) { const int e = it >> 7, q = it & 127, kb = q >> 5, nb = q & 31, n0 = 32 * nb;
        p0_transpose_item_f8(a.in[I_ED] + (size_t)e * 256 * 1024, 256, 1024, ws + ed_off(e), 64 * kb, n0, n0, scr, FLANE, F8_WSCALE); }
    __syncthreads();
}
__device__ __forceinline__ void px_convert_dyn(Frame& F, const Args& a) {
    unsigned char* ws = a.ws;
    unsigned nx = 0u; if (FTID == 0) nx = __hip_atomic_fetch_add(F.ctl + CW_STEAL, 1u, RLX_AGENT);
    for (;;) {
        if (FTID == 0) F.MISC[4] = nx;
        __syncthreads();
        const int it = __builtin_amdgcn_readfirstlane((int)F.MISC[4]);
        if (it >= 256 * 16) break;
        if (FTID == 0) nx = __hip_atomic_fetch_add(F.ctl + CW_STEAL, 1u, RLX_AGENT);
        const int e = it >> 4, up = (it >> 3) & 1, n0 = 32 * (it & 7);
        quant_cols32_k1024(F.lds, a.in[up ? I_EU : I_EG] + (size_t)e * 1024 * 256, 256, n0, (signed char*)(ws + WS_EGU_T) + (size_t)e * 512 * 1024, (float*)(ws + WS_SEGU) + e * 512,
                           (n0 >> 7) * 256 + up * 128 + (n0 & 127), F.wave, FLANE);
    }
    __syncthreads();
}

__device__ __forceinline__ void route_pass(Frame& F, const Args& a, const bool dummy) {
    unsigned char* ws = a.ws; const int lane = FLANE;
    LAS unsigned* hist = (LAS unsigned*)F.lds;
    if (FTID < 256) hist[FTID] = 0u;
    __syncthreads();
    const int gw = F.vcu * NWAVES + F.wave, NGW = F.G * NWAVES;
    const f32x4 bb = ((const GAS f32x4*)a.in[I_ROUT_B])[lane];
    constexpr int U = 4;
    for (int t0 = gw; t0 < NTOK; t0 += U * NGW) {
        f32x4 x[U];
#pragma unroll
        for (int u = 0; u < U; ++u) { const int t = t0 + u * NGW; x[u] = (t < NTOK) ? ((const GAS f32x4*)(ws + WS_LOGIT + (size_t)t * 1024))[lane] : (f32x4){0.f, 0.f, 0.f, 0.f}; }
        float sc[U][4], c[U][4], a1[U], a2[U];
#pragma unroll
        for (int u = 0; u < U; ++u) {
#pragma unroll
            for (int i = 0; i < 4; ++i) { sc[u][i] = 1.f / (1.f + expf(-x[u][i])); c[u][i] = sc[u][i] + bb[i]; }
            a1[u] = fmaxf(c[u][0], c[u][1]); a2[u] = fminf(c[u][0], c[u][1]);
#pragma unroll
            for (int i = 2; i < 4; ++i) { if (c[u][i] > a1[u]) { a2[u] = a1[u]; a1[u] = c[u][i]; } else if (c[u][i] > a2[u]) a2[u] = c[u][i]; } }
#pragma unroll
        for (int off = 1; off < 8; off <<= 1) {
#pragma unroll
            for (int u = 0; u < U; ++u) { const float b1 = __shfl_xor(a1[u], off), b2 = __shfl_xor(a2[u], off); const float n1 = fmaxf(a1[u], b1), n2 = fmaxf(fminf(a1[u], b1), fmaxf(a2[u], b2)); a1[u] = n1; a2[u] = n2; } }
        const int g = lane >> 3;
#pragma unroll
        for (int u = 0; u < U; ++u) { const float gs = a1[u] + a2[u]; int rank = 0;
#pragma unroll
            for (int g2 = 0; g2 < 8; ++g2) { const float o = __shfl(gs, g2 * 8); rank += (o > gs || (o == gs && g2 < g)) ? 1 : 0; }
            if (rank >= 4) { c[u][0] = c[u][1] = c[u][2] = c[u][3] = -INFINITY; } }
        float sel_s[U]; int sel_e[U];
#pragma unroll
        for (int u = 0; u < U; ++u) { sel_s[u] = 0.f; sel_e[u] = 0; }
#pragma unroll
        for (int k = 0; k < 8; ++k) {
            float bv[U]; int be[U];
#pragma unroll
            for (int u = 0; u < U; ++u) { bv[u] = c[u][0]; int bi = 0;
#pragma unroll
                for (int i = 1; i < 4; ++i) if (c[u][i] > bv[u]) { bv[u] = c[u][i]; bi = i; }
                be[u] = lane * 4 + bi; }
#pragma unroll
            for (int off = 1; off < 64; off <<= 1) {
#pragma unroll
                for (int u = 0; u < U; ++u) { const float ov = __shfl_xor(bv[u], off); const int oe = __shfl_xor(be[u], off); if (ov > bv[u] || (ov == bv[u] && oe < be[u])) { bv[u] = ov; be[u] = oe; } } }
#pragma unroll
            for (int u = 0; u < U; ++u) { const int owner = be[u] >> 2, wi = be[u] & 3;
                float sv = wi == 0 ? sc[u][0] : wi == 1 ? sc[u][1] : wi == 2 ? sc[u][2] : sc[u][3];
                sv = __shfl(sv, owner);
                if (lane == owner) {
#pragma unroll
                    for (int i = 0; i < 4; ++i) if (wi == i) c[u][i] = -INFINITY; }
                if (lane == k) { sel_s[u] = sv; sel_e[u] = be[u]; } }
        }
        float tot[U];
#pragma unroll
        for (int u = 0; u < U; ++u) tot[u] = lane < 8 ? sel_s[u] : 0.f;
#pragma unroll
        for (int o = 1; o < 64; o <<= 1) {
#pragma unroll
            for (int u = 0; u < U; ++u) tot[u] += __shfl_xor(tot[u], o); }
#pragma unroll
        for (int u = 0; u < U; ++u) { const int t = t0 + u * NGW;
            if (t < NTOK && lane < 8) { ((int*)(ws + M_IDX))[(size_t)t * 8 + lane] = sel_e[u]; ((float*)(ws + M_W))[(size_t)t * 8 + lane] = sel_s[u] / tot[u] * 2.5f; atomicAdd((unsigned*)&hist[sel_e[u]], 1u); } }
    }
    __syncthreads();
    if (!dummy && FTID < 256 && hist[FTID]) __hip_atomic_fetch_add(F.ctl + CW_CNT + FTID * CW_PAD, hist[FTID], RLX_AGENT);
    __syncthreads();
    for (int i = blockIdx.x * 512 + FTID; i < NROWS_MAX; i += F.G * 512) { ((int*)(ws + M_RASSIGN))[i] = -1; ((int*)(ws + M_RTOK))[i] = 0; ((float*)(ws + M_RW))[i] = 0.f; ((float*)(ws + M_RS))[i] = 0.f; }
    for (int i = blockIdx.x * 512 + FTID; i < NTOK; i += F.G * 512) { ((int*)(ws + M_RTOK))[NROWS_MAX + i] = i; ((float*)(ws + M_RS))[NROWS_MAX + i] = ((const float*)(ws + WS_SH1))[i]; }
}
__device__ __forceinline__ void scatter_pass(Frame& F, const Args& a) {
    unsigned char* ws = a.ws;
    LAS int* bst = (LAS int*)F.lds;
    LAS int* nbk = bst + 320;
    { const int t = FTID; if (t < NEXP) nbk[t] = (int)((__hip_atomic_load(F.ctl + CW_CNT + t * CW_PAD, RLX_AGENT) + 255u) >> 8); }
    __syncthreads();
    if (F.wave == 0) {
        const int l = lane_id(); const int c0 = nbk[4 * l], c1 = nbk[4 * l + 1], c2 = nbk[4 * l + 2], c3 = nbk[4 * l + 3];
        int tot = c0 + c1 + c2 + c3, inc = tot;
#pragma unroll
        for (int off = 1; off < 64; off <<= 1) { const int o = __shfl_up(inc, off); if (l >= off) inc += o; }
        const int ex = inc - tot;
        bst[4 * l] = ex; bst[4 * l + 1] = ex + c0; bst[4 * l + 2] = ex + c0 + c1; bst[4 * l + 3] = ex + c0 + c1 + c2;
        if (l == 63) bst[NEXP] = inc;
    }
    __syncthreads();
    if (blockIdx.x == 0) { if (FTID < NEXP) { for (int b = bst[FTID]; b < bst[FTID + 1]; ++b) ((int*)(ws + M_BLKE))[b] = FTID; } if (FTID == 0) *(int*)(ws + M_NBLK) = bst[NEXP]; }
    for (int i = blockIdx.x * 512 + FTID; i < NTOK * 8; i += F.G * 512) {
        const int e = ((const int*)(ws + M_IDX))[i]; const unsigned rank = __hip_atomic_fetch_add(F.ctl + CW_CUR + e * CW_PAD, 1u, RLX_AGENT);
        const int row = bst[e] * 256 + (int)rank;
        ((int*)(ws + M_RASSIGN))[row] = i; ((int*)(ws + M_RTOK))[row] = i >> 3; ((float*)(ws + M_RW))[row] = ((const float*)(ws + M_W))[i]; ((float*)(ws + M_RS))[row] = ((const float*)(ws + WS_SH1))[i >> 3];
    }
}
__device__ __forceinline__ void final_pass(Frame& F, const Args& a) {
    unsigned char* ws = a.ws; const int lane = FLANE; const int gw = F.vcu * NWAVES + F.wave, NGW = F.G * NWAVES;
    for (int t = gw; t < NTOK; t += NGW) {
        float v[16];
#pragma unroll
        for (int i = 0; i < 2; ++i) { const int c8 = lane + 64 * i; float hh[8], bs[8];
            unpack8(((const GAS v4u*)(ws + WS_H1 + (size_t)t * 2048))[c8], hh); unpack8_fp8(((const GAS unsigned long long*)(ws + WS_BASE + (size_t)t * 1024))[c8], bs);
#pragma unroll
            for (int e = 0; e < 8; ++e) v[i * 8 + e] = DN_ALPHA * hh[e] + bs[e] * (1.f / B8_SCALE);
            float ys[8] = {0.f, 0.f, 0.f, 0.f, 0.f, 0.f, 0.f, 0.f};
            const int p8 = (c8 & ~31) | ((c8 & 15) << 1) | ((c8 >> 4) & 1);
#pragma unroll
            for (int k = 0; k < 8; ++k) { const unsigned long long yw = ((const GAS unsigned long long*)(ws + WS_Y + ((size_t)t * 8 + k) * 1024))[p8];
                const int w0 = (int)(unsigned)yw, w1 = (int)(unsigned)(yw >> 32);
                const auto f0 = __builtin_amdgcn_cvt_pk_f32_fp8(w0, false), f1 = __builtin_amdgcn_cvt_pk_f32_fp8(w0, true), f2 = __builtin_amdgcn_cvt_pk_f32_fp8(w1, false), f3 = __builtin_amdgcn_cvt_pk_f32_fp8(w1, true);
                ys[0] += f0[0]; ys[1] += f0[1]; ys[2] += f1[0]; ys[3] += f1[1]; ys[4] += f2[0]; ys[5] += f2[1]; ys[6] += f3[0]; ys[7] += f3[1]; }
#pragma unroll
            for (int e = 0; e < 8; ++e) v[i * 8 + e] += ys[e] * (1.f / 16.f); }
        float s = 0.f;
#pragma unroll
        for (int e = 0; e < 16; ++e) s += v[e];
        const float mean = wave_sum(s) * (1.f / DM); float q = 0.f;
#pragma unroll
        for (int e = 0; e < 16; ++e) { v[e] -= mean; q += v[e] * v[e]; }
        const float rstd = 1.f / sqrtf(wave_sum(q) * (1.f / DM) + LN_EPS);
#pragma unroll
        for (int i = 0; i < 2; ++i) { const int c8 = lane + 64 * i;
#pragma unroll
            for (int hlf = 0; hlf < 2; ++hlf) { const f32x4 gg = ((const GAS f32x4*)a.in[I_LN2_G])[c8 * 2 + hlf], bb = ((const GAS f32x4*)a.in[I_LN2_B])[c8 * 2 + hlf];
                f32x4 o; o.x = v[i * 8 + hlf * 4 + 0] * rstd * gg.x + bb.x; o.y = v[i * 8 + hlf * 4 + 1] * rstd * gg.y + bb.y; o.z = v[i * 8 + hlf * 4 + 2] * rstd * gg.z + bb.z; o.w = v[i * 8 + hlf * 4 + 3] * rstd * gg.w + bb.w;
                ((GAS f32x4*)(a.out + (size_t)t * DM))[c8 * 2 + hlf] = o; } }
    }
}

__global__ void __launch_bounds__(NWAVES * 64, 2) mega_fwd(Args args) {
    extern __shared__ __attribute__((aligned(16))) unsigned char lds[];
    Frame F;
    F.lds = (LAS unsigned char*)lds;
    F.MISC = (volatile LAS unsigned*)(F.lds + MISC_OFF);
    F.wave = __builtin_amdgcn_readfirstlane((int)threadIdx.x >> 6);
    F.G = gridDim.x; { const int bx = blockIdx.x; F.vcu = (F.G % 8 == 0) ? (bx % 8) * (F.G / 8) + bx / 8 : bx; }
    unsigned char* ws = args.ws;
    F.ctl = (gu32*)(ws + WS_CTL);
    for (int u = FTID; u < (LDS_BYTES - LDSCTL_OFF) / 4; u += NWAVES * 64) ((LAS unsigned*)(F.lds + LDSCTL_OFF))[u] = 0u;
    __syncthreads();
    XcdBarrier bar = xcd_barrier_post((unsigned*)(F.ctl + CW_BAR), F.MISC + 8);
    const int lo = args.ph_lo, hi = args.ph_hi;
#define STAMP(k) do { if (TIMING && F.wave == 0) { const unsigned long long t_ = __builtin_amdgcn_s_memrealtime(); F.MISC[16 + 2 * (k)] = (unsigned)t_; F.MISC[17 + 2 * (k)] = (unsigned)(t_ >> 32); } } while (0)
    STAMP(0);
#define IN(k) (lo <= (k) && (k) < hi)
#define GRID_BAR() xcd_barrier(bar)

    if (IN(0)) { p0_prologue(F, args); if (REP & 1) p0_prologue(F, args); GRID_BAR(); }
    STAMP(1);
    if (IN(1)) {
        pg8::DenseOrder S; S.init(ws + WS_XN8, ws + WS_WIN_T, NTOK, INCOLS, 512, F.G, (int)blockIdx.x);
        EpiInProj E{ws};
        pg8::gemm_phase<EpiInProj, pg8::DenseOrder, false, true>(F.lds, 512, S, E, nullptr, F.wave);
        if (REP & 2) pg8::gemm_phase<EpiInProj, pg8::DenseOrder, false, true>(F.lds, 512, S, E, nullptr, F.wave);
        GRID_BAR();
    }
    STAMP(2);
#if DEBUG_CHECK
    if (IN(2)) {
        const GAS v4u* src = (const GAS v4u*)(ws + WS_VR); GAS v4u* dst = (GAS v4u*)(ws + WS_DBGV);
        for (size_t i = (size_t)blockIdx.x * 512 + FTID; i < (size_t)64 * MiB / 16; i += (size_t)F.G * 512) dst[i] = src[i];
        GRID_BAR();
    }
#endif
    if (IN(2)) {
        const int bh = F.vcu >> 3, s = F.vcu & 7, b = bh >> 3, h = bh & 7;
        if (REP & 8) att::ret_chain(b, h, s, (const bf16_t*)(ws + WS_QR), (const bf16_t*)(ws + WS_KR), (const bf16_t*)(ws + WS_VR), (bf16_t*)(ws + WS_DBGV), 16383L, (f32x2*)(ws + WS_GNST), (char*)lds, F.wave);
        if (s < 7) att::ret_passA(b, h, s, (const bf16_t*)(ws + WS_KR), (const unsigned char*)(ws + WS_V8), (bf16_t*)(ws + WS_META) + (size_t)F.vcu * (256 * 128), (char*)lds, F.wave);
        GRID_BAR();
        att::ret_passB(b, h, s, (const bf16_t*)(ws + WS_QR), (const bf16_t*)(ws + WS_KR), (const unsigned char*)(ws + WS_V8), (bf16_t*)(ws + WS_VR), (const bf16_t*)(ws + WS_META) + (size_t)(bh * 8) * (256 * 128), (f32x2*)(ws + WS_GNST), (char*)lds, F.wave);
        STAMP(3);
        float lam;
        { float d1 = 0.f, d2 = 0.f; for (int i = 0; i < 64; ++i) { d1 += args.in[I_LQ1][i] * args.in[I_LK1][i]; d2 += args.in[I_LQ2][i] * args.in[I_LK2][i]; }
          lam = expf(d1) - expf(d2) + 0.2f; }
        float gmax = 0.f; for (int i = 0; i < 128; ++i) gmax = fmaxf(gmax, fabsf(args.in[I_SUBLN_G][i]));
        const float ad_scale = fmaxf(gmax, 1e-20f) * (0.8f * 11.313708499f / 127.f), ad_inv = 1.f / ad_scale;
        bf16x8 avs0, avs1, aks;
        if (REP & 4) for (int i = 0; i < 4; ++i) {
            const int qb = (i == 0) ? 31 - s : (i == 1) ? 16 + s : (i == 2) ? 15 - s : s;
            att::attn_unit(b, h, qb, (const bf16_t*)(ws + WS_QD), (signed char*)(ws + WS_DBGV), ad_inv, (const bf16_t*)(ws + WS_KD), (const bf16_t*)(ws + WS_VD), args.in[I_RELB], args.in[I_SUBLN_G], lam, (char*)lds, F.wave, avs0, avs1, aks, i > 0);
        }
        for (int i = 0; i < 4; ++i) {
            const int qb = (i == 0) ? 31 - s : (i == 1) ? 16 + s : (i == 2) ? 15 - s : s;
            att::attn_unit(b, h, qb, (const bf16_t*)(ws + WS_QD), (signed char*)(ws + WS_AD8), ad_inv, (const bf16_t*)(ws + WS_KD), (const bf16_t*)(ws + WS_VD), args.in[I_RELB], args.in[I_SUBLN_G], lam, (char*)lds, F.wave, avs0, avs1, aks, i > 0);
            if (i == (bh & 3)) { px_convert(F, args); if (REP & 128) px_convert(F, args); }
        }
        px_convert_dyn(F, args);
        GRID_BAR();
    }
    STAMP(4);
    if (IN(3)) { if (REP & 256) gn_pass(F, ws, args.in[I_GN_G], true); gn_pass(F, ws, args.in[I_GN_G], false); GRID_BAR(); }
    STAMP(5);
    if (IN(4)) {
        pg8::DenseOrder S; S.init(ws + WS_AR8, ws + WS_WRO_T, NTOK, 1024, 1024, F.G, (int)blockIdx.x);
        EpiM E{ws, 0, 0, 0.f}; pg8::gemm_phase<EpiM, pg8::DenseOrder, false, true>(F.lds, 1024, S, E, nullptr, F.wave);
        __syncthreads();
    }
    STAMP(6);
    if (IN(5)) {
        pg8::DenseOrder S; S.init(ws + WS_AD8, ws + WS_WDO_T, NTOK, 1024, 512, F.G, (int)blockIdx.x);
        float gmax = 0.f; for (int i = 0; i < 128; ++i) gmax = fmaxf(gmax, fabsf(args.in[I_SUBLN_G][i]));
        EpiM E{ws, 1, 0, fmaxf(gmax, 1e-20f) * (0.8f * 11.313708499f / 127.f)}; pg8::gemm_phase<EpiM, pg8::DenseOrder, false, true>(F.lds, 512, S, E, nullptr, F.wave); GRID_BAR();
    }
    STAMP(7);
    if (IN(6)) {
        pg8::DenseOrder S; S.init(ws + WS_M8, ws + WS_WO_T, NTOK, 1024, 512, F.G, (int)blockIdx.x);
        EpiZ E{ws}; pg8::gemm_phase<EpiZ, pg8::DenseOrder, false, false, true>(F.lds, 512, S, E, nullptr, F.wave); GRID_BAR();
    }
    STAMP(8);
    if (IN(7)) {
        const int gw = F.vcu * NWAVES + F.wave, NGW = F.G * NWAVES;
        ln_rows_bf16_i8<true>(FLANE, ws + WS_Z, args.in[I_LN1_G], args.in[I_LN1_B], (bf16_t*)(ws + WS_H1), (signed char*)(ws + WS_H18), (float*)(ws + WS_SH1), gw, NGW, NTOK);
        GRID_BAR();
    }
    STAMP(9);
    if (IN(8)) {
        EpiP5 E{ws};
        { P5Order S{ws, F.G, F.vcu, 0}; pg8::gemm_phase<EpiP5, P5Order, false>(F.lds, 1024, S, E, nullptr, F.wave); }
        { P5Order S{ws, F.G, F.vcu, 1}; pg8::gemm_phase<EpiP5, P5Order, false>(F.lds, 256, S, E, nullptr, F.wave); }
        if (REP & 1024) { { P5Order S{ws, F.G, F.vcu, 0}; pg8::gemm_phase<EpiP5, P5Order, false>(F.lds, 1024, S, E, nullptr, F.wave); }
          { P5Order S{ws, F.G, F.vcu, 1}; pg8::gemm_phase<EpiP5, P5Order, false>(F.lds, 256, S, E, nullptr, F.wave); } }
        GRID_BAR();
    }
    STAMP(10);
    if (IN(9)) { if (REP & 16384) route_pass(F, args, true); route_pass(F, args, false); GRID_BAR(); }
    STAMP(11);
    if (IN(10)) { scatter_pass(F, args); GRID_BAR(); }
    STAMP(12);
    if (IN(11)) {
        const int nblk = __builtin_amdgcn_readfirstlane(*(const volatile int*)(ws + M_NBLK));
        P8Order S{ws, F.G, F.vcu  , nblk}; EpiP8 E{ws, 0};
        if (REP & 2048) { EpiP8 E2{ws, 1}; pg8::gemm_phase<EpiP8, P8Order, true, true>(F.lds, 512, S, E2, (const int*)(ws + M_RTOK), F.wave); }
        pg8::gemm_phase<EpiP8, P8Order, true, true>(F.lds, 512, S, E, (const int*)(ws + M_RTOK), F.wave); GRID_BAR();
    }
    STAMP(13);
    if (IN(12)) {
        const int nblk = __builtin_amdgcn_readfirstlane(*(const volatile int*)(ws + M_NBLK));
        P9Order S{ws, F.G, F.vcu, nblk}; EpiP9 E{ws, 0};
        if (REP & 4096) { EpiP9 E2{ws, 1}; pg8::gemm_phase<EpiP9, P9Order, false, false, true>(F.lds, 128, S, E2, nullptr, F.wave); }
        pg8::gemm_phase<EpiP9, P9Order, false, false, true>(F.lds, 128, S, E, nullptr, F.wave); GRID_BAR();
    }
    STAMP(14);
    if (REP & 32768) { for (int i = 0; i < 20; ++i) GRID_BAR(); }
    if (IN(13)) { final_pass(F, args); if (REP & 8192) final_pass(F, args); }
#if TIMING
    GRID_BAR(); STAMP(15);
    if (blockIdx.x == 0 && FTID == 0) {
      const unsigned long long t1 = ((unsigned long long)F.MISC[17 + 2 * T_A1] << 32) | F.MISC[16 + 2 * T_A1], t0 = ((unsigned long long)F.MISC[17 + 2 * T_A0] << 32) | F.MISC[16 + 2 * T_A0];
      args.out[0] = 10.f + (float)(t1 - t0) * 0.01f / (float)(T_SCALE); }
#endif
#undef IN
#undef GRID_BAR
}

#if DEBUG_CHECK
__device__ __forceinline__ unsigned hash_u32(unsigned x) { x ^= x >> 16; x *= 0x7feb352du; x ^= x >> 15; x *= 0x846ca68bu; x ^= x >> 16; return x; }
__device__ __forceinline__ void dbg_fail(unsigned* ctl, int stage, bool bad) { if (bad) atomicAdd(&ctl[CW_DBG + stage], 1u); }
__device__ float ref_ln_dot(const float* xrow, const float* g, const float* b, const float* W, int N, int col) {
    float s = 0.f; for (int k = 0; k < DM; ++k) s += xrow[k]; const float mean = s / DM;
    float q = 0.f; for (int k = 0; k < DM; ++k) { const float d = xrow[k] - mean; q += d * d; } const float rstd = 1.f / sqrtf(q / DM + LN_EPS);
    float acc = 0.f; for (int k = 0; k < DM; ++k) acc += ((xrow[k] - mean) * rstd * g[k] + b[k]) * W[(size_t)k * N + col];
    return acc;
}
__global__ void dbg_check(Args a) {
    unsigned* ctl = (unsigned*)(a.ws + WS_CTL); unsigned char* ws = a.ws;
    const unsigned gid = blockIdx.x * blockDim.x + threadIdx.x;
    {
        const unsigned h = hash_u32(gid * 2654435761u + 17u);
        const int row = h % NTOK; int col = (h >> 15) % INCOLS;
        const float* xrow = a.in[I_X] + (size_t)row * DM;
        int seg; int cs; size_t boff; int ld;
        if (col < 1024) { seg = 0; cs = col; boff = WS_QR; ld = 1024; } else if (col < 2048) { seg = 1; cs = col - 1024; boff = WS_KR; ld = 1024; }
        else if (col < 4096) { seg = 2; cs = col - 2048; boff = WS_VR; ld = 2048; } else if (col < 6144) { seg = 3; cs = col - 4096; boff = WS_GR; ld = 2048; }
        else if (col < 7168) { seg = 4; cs = col - 6144; boff = WS_QD; ld = 1024; } else if (col < 8192) { seg = 5; cs = col - 7168; boff = WS_KD; ld = 1024; }
        else if (col < 9216) { seg = 6; cs = col - 8192; boff = WS_VD; ld = 1024; } else { seg = 7; cs = col - 9216; boff = WS_GT; ld = 2048; }
        float e;
        if (seg <= 1) {
            const int j = cs & 63, half = (cs >> 6) & 1; const int c1 = col - half * 64, c2 = c1 + 64;
            const float t1 = ref_ln_dot(xrow, a.in[I_LNIN_G], a.in[I_LNIN_B], a.in[I_WIN], INCOLS, c1);
            const float t2 = ref_ln_dot(xrow, a.in[I_LNIN_G], a.in[I_LNIN_B], a.in[I_WIN], INCOLS, c2);
            const double theta = 1.0 / pow(10000.0, (double)j / 63.0); const double ang = (double)(row % SEQ) * theta;
            const float c = (float)cos(ang), s = (float)sin(ang);
            e = half ? (t2 * c + t1 * s) : (t1 * c - t2 * s);
            if (seg == 1) e *= KR_SCALE;
        } else {
            e = ref_ln_dot(xrow, a.in[I_LNIN_G], a.in[I_LNIN_B], a.in[I_WIN], INCOLS, col);
            if (seg == 3) e = e / (1.f + expf(-e)); else if (seg == 7) e = 1.f / (1.f + expf(-e)); else if (seg == 4) e *= QD_SCALE;
        }
        const float got = bf2f(((const bf16_t*)(ws + boff))[(size_t)row * ld + cs]);
        if (seg != 2 && seg != 3 && seg != 4)
            dbg_fail(ctl, 1, !(fabsf(got - e) <= 0.08f + 0.05f * fabsf(e)));
    }
}
__device__ float dbg_inproj(const Args& a, int row, int col) { return ref_ln_dot(a.in[I_X] + (size_t)row * DM, a.in[I_LNIN_G], a.in[I_LNIN_B], a.in[I_WIN], INCOLS, col); }
__global__ void __launch_bounds__(256) dbg_check_ret(Args a) {
    __shared__ float sc[256]; __shared__ float red[256]; __shared__ float qs[128];
    unsigned* ctl = (unsigned*)(a.ws + WS_CTL); unsigned char* ws = a.ws;
    const int tid = threadIdx.x;
    const unsigned hsh = hash_u32(blockIdx.x * 7919u + 13u);
    const int b = hsh & 1, h = (hsh >> 1) & 7; int pos = (hsh >> 4) % SEQ; if (blockIdx.x & 1) pos = pos % 700;
    const int t = b * SEQ + pos;
    const bf16_t* QR = (const bf16_t*)(ws + WS_QR); const bf16_t* KR = (const bf16_t*)(ws + WS_KR); const bf16_t* VV = (const bf16_t*)(ws + WS_DBGV);
    if (tid < 128) qs[tid] = bf2f(QR[(size_t)t * 1024 + h * 128 + tid]);
    __syncthreads();
    const float lgam = logf(1.f - exp2f(-5.f - (float)h));
    float o = 0.f;
    for (int s0 = 0; s0 <= pos; s0 += 256) {
        const int s = s0 + tid; float v = 0.f;
        if (s <= pos) { const bf16_t* kp = KR + (size_t)(b * SEQ + s) * 1024 + h * 128; float d = 0.f; for (int k = 0; k < 128; ++k) d += qs[k] * bf2f(kp[k]); v = d * expf((float)(pos - s) * lgam); }
        sc[tid] = v; __syncthreads();
        const int n = min(256, pos + 1 - s0);
        for (int i = 0; i < n; ++i) o += sc[i] * bf2f(VV[(size_t)(b * SEQ + s0 + i) * 2048 + h * 256 + tid]);
        __syncthreads();
    }
    red[tid] = o; __syncthreads(); for (int st = 128; st > 0; st >>= 1) { if (tid < st) red[tid] += red[tid + st]; __syncthreads(); }
    const float mu = red[0] / 256.f; __syncthreads();
    red[tid] = (o - mu) * (o - mu); __syncthreads(); for (int st = 128; st > 0; st >>= 1) { if (tid < st) red[tid] += red[tid + st]; __syncthreads(); }
    const float rstd = 1.f / sqrtf(red[0] / 256.f + LN_EPS);
    const float g = dbg_inproj(a, t, 4096 + h * 256 + tid);
    const float e = g / (1.f + expf(-g)) * (o - mu) * rstd * a.in[I_GN_G][h * 256 + tid];
    const float got = bf2f(((const bf16_t*)(ws + WS_GR))[(size_t)t * 2048 + h * 256 + tid]);
    dbg_fail(ctl, 2, !(fabsf(got - e) <= 0.06f + 0.06f * fabsf(e)));
}
__global__ void __launch_bounds__(256) dbg_check_att(Args a) {
    __shared__ float pr[SEQ]; __shared__ float red[256]; __shared__ float qs[128]; __shared__ float o1[128];
    unsigned* ctl = (unsigned*)(a.ws + WS_CTL); unsigned char* ws = a.ws;
    const int tid = threadIdx.x;
    const unsigned hsh = hash_u32(blockIdx.x * 104729u + 71u);
    const int b = hsh & 3, h = (hsh >> 2) & 7; int pos = (hsh >> 5) % SEQ; if ((blockIdx.x & 3) == 1) pos = pos % 300;
    const int t = b * SEQ + pos;
    const bf16_t* KD = (const bf16_t*)(ws + WS_KD); const bf16_t* VD = (const bf16_t*)(ws + WS_VD);
    if (tid < 128) qs[tid] = dbg_inproj(a, t, 6144 + h * 128 + tid) * 0.125f;
    float lam; { float d1 = 0.f, d2 = 0.f; for (int i = 0; i < 64; ++i) { d1 += a.in[I_LQ1][i] * a.in[I_LK1][i]; d2 += a.in[I_LQ2][i] * a.in[I_LK2][i]; } lam = expf(d1) - expf(d2) + 0.2f; }
    __syncthreads();
    float ov = 0.f;
    for (int m = 0; m < 2; ++m) {
        float mx = -INFINITY;
        for (int s = tid; s <= pos; s += 256) { const bf16_t* kp = KD + (size_t)(b * SEQ + s) * 1024 + h * 128 + m * 64; float d = 0.f; for (int k = 0; k < 64; ++k) d += qs[m * 64 + k] * bf2f(kp[k]);
            const int n = pos - s; int bk; if (n < 16) bk = n; else { bk = 16 + (int)(logf((float)n / 16.f) / logf(8.f) * 16.f); if (bk > 31) bk = 31; }
            d += a.in[I_RELB][bk * 8 + h]; pr[s] = d; mx = fmaxf(mx, d); }
        red[tid] = mx; __syncthreads(); for (int st = 128; st > 0; st >>= 1) { if (tid < st) red[tid] = fmaxf(red[tid], red[tid + st]); __syncthreads(); }
        mx = red[0]; __syncthreads();
        float sm = 0.f; for (int s = tid; s <= pos; s += 256) { const float p = expf(pr[s] - mx); pr[s] = p; sm += p; }
        red[tid] = sm; __syncthreads(); for (int st = 128; st > 0; st >>= 1) { if (tid < st) red[tid] += red[tid + st]; __syncthreads(); }
        sm = red[0]; __syncthreads();
        if (tid < 128) { float acc = 0.f; for (int s = 0; s <= pos; ++s) acc += pr[s] * bf2f(VD[(size_t)(b * SEQ + s) * 1024 + h * 128 + tid]); acc /= sm;
            if (m == 0) o1[tid] = acc; else ov = o1[tid] - lam * acc; }
        __syncthreads();
    }
    red[tid] = tid < 128 ? ov * ov : 0.f; __syncthreads(); for (int st = 128; st > 0; st >>= 1) { if (tid < st) red[tid] += red[tid + st]; __syncthreads(); }
    const float rs = 1.f / sqrtf(red[0] / 128.f + LN_EPS);
    if (tid < 128) { const float e = ov * rs * a.in[I_SUBLN_G][tid] * 0.8f;
        const float got = bf2f(((const bf16_t*)(ws + WS_QD))[(size_t)t * 1024 + h * 128 + tid]);
        dbg_fail(ctl, 3, !(fabsf(got - e) <= 0.06f + 0.06f * fabsf(e))); }
}
__global__ void dbg_report(Args a, int nout) {
    unsigned* ctl = (unsigned*)(a.ws + WS_CTL);
    int first = 0;
    if (ctl[CW_TMO] != 0u || ctl[CW_BAR + XB_TMO] != 0u) first = 15;
    for (int s = 14; s >= 1; --s) if (ctl[CW_DBG + s] > (s == 1 ? 16u : 64u)) first = s;
    const float c = first ? (float)(1 << first) : 0.5f;
    for (size_t i = (size_t)blockIdx.x * blockDim.x + threadIdx.x; i < (size_t)nout; i += (size_t)gridDim.x * blockDim.x) a.out[i] = c;
}
#endif

extern "C" void kernel_launch(void* const* d_in, const int* in_sizes, int n_in, void* d_out, int out_size, void* d_ws, size_t ws_size, hipStream_t stream) {
    static int grid = 0;
    if (grid == 0) {
        if (n_in != 29 || in_sizes[0] != NTOK * DM || out_size != NTOK * DM || ws_size < WS_END) {
            fprintf(stderr, "kernel_launch: unexpected shapes: n_in %d in0 %d out %d ws %zu (need >= %zu)\n", n_in, n_in > 0 ? in_sizes[0] : -1, out_size, ws_size, (size_t)WS_END); grid = -1; return; }
        int dev = 0, cus = 0;
        if (hipGetDevice(&dev) != hipSuccess || hipDeviceGetAttribute(&cus, hipDeviceAttributeMultiprocessorCount, dev) != hipSuccess) { grid = -1; return; }
        if (hipFuncSetAttribute((const void*)mega_fwd, hipFuncAttributeMaxDynamicSharedMemorySize, LDS_BYTES) != hipSuccess) { fprintf(stderr, "kernel_launch: hipFuncSetAttribute failed\n"); grid = -1; return; }
        int per_cu = 0;
        if (hipOccupancyMaxActiveBlocksPerMultiprocessor(&per_cu, (const void*)mega_fwd, NWAVES * 64, LDS_BYTES) != hipSuccess || per_cu < 1)
            fprintf(stderr, "kernel_launch: occupancy query says %d\n", per_cu);
        (void)hipGetLastError();
        grid = cus;
        if (grid != 256) fprintf(stderr, "kernel_launch: %d CUs (expected 256)\n", grid);
    }
    if (grid < 0) return;
    (void)hipMemsetAsync((char*)d_ws + WS_CTL, 0, CTL_ZERO_BYTES, stream);
    Args a{};
    for (int i = 0; i < 29; ++i) a.in[i] = (const float*)d_in[i];
    a.out = (float*)d_out; a.ws = (unsigned char*)d_ws; a.ph_lo = 0; a.ph_hi = DEBUG_CHECK ? 4 : 100;
    hipLaunchKernelGGL(mega_fwd, dim3(grid), dim3(NWAVES * 64), LDS_BYTES, stream, a);
#if DEBUG_CHECK
    hipLaunchKernelGGL(dbg_check, dim3(256), dim3(256), 0, stream, a);
    hipLaunchKernelGGL(dbg_check_ret, dim3(512), dim3(256), 0, stream, a);
    hipLaunchKernelGGL(dbg_check_att, dim3(512), dim3(256), 0, stream, a);
    hipLaunchKernelGGL(dbg_report, dim3(1024), dim3(256), 0, stream, a, out_size);
#endif
}
```

```cpp
#include <hip/hip_runtime.h>
#include <hip/hip_bf16.h>
#include <cstdio>
#include <cstdint>

#ifndef DEBUG_CHECK
#define DEBUG_CHECK 0
#endif
#ifndef REP
#define REP 0
#endif
#ifndef TIMING
#define TIMING 0
#endif
#ifndef T_A0
#define T_A0 3
#define T_A1 4
#define T_SCALE 15
#endif

constexpr int NTOK = 32768, DM = 1024, SEQ = 8192, NBATCH = 4, PLE = 256;
constexpr int INCOLS = 11264;
constexpr int NEXP = 256, TOPK = 8, DEXP = 256;
constexpr float LN_EPS = 1e-5f;
constexpr float DN_ALPHA = 1.189207115002721f;
constexpr float LOG2E = 1.4426950408889634f;
constexpr float QD_SCALE = 0.125f * LOG2E;
constexpr float KR_SCALE = 0.08838834764831845f;

constexpr size_t MiB = 1u << 20;
constexpr size_t WS_CTL = 0, CTL_ZERO_BYTES = 1 * MiB;
constexpr size_t WS_WIN_T = 1 * MiB;
constexpr size_t WS_WRO_T = 23 * MiB;
constexpr size_t WS_WDO_T = 27 * MiB;
constexpr size_t WS_WO_T  = 29 * MiB;
constexpr size_t WS_ROUT_T = 31 * MiB;
constexpr size_t WS_PLEW_T = 31 * MiB + 512 * 1024;
constexpr size_t WS_PLEG_T = 32 * MiB;
constexpr size_t WS_SHGU_T = 34 * MiB;
constexpr size_t WS_SHD_T  = 35 * MiB;
constexpr size_t WS_XN   = 48 * MiB;
constexpr size_t WS_PB   = 112 * MiB;
constexpr size_t WS_QR   = 128 * MiB;
constexpr size_t WS_KR   = 192 * MiB;
constexpr size_t WS_VR   = 256 * MiB;
constexpr size_t WS_GR   = 384 * MiB;
constexpr size_t WS_QD   = 512 * MiB;
constexpr size_t WS_KD   = 576 * MiB;
constexpr size_t WS_VD   = 640 * MiB;
constexpr size_t WS_GT   = 704 * MiB;
constexpr size_t WS_M    = 192 * MiB;
constexpr size_t WS_GNST = 896 * MiB;
constexpr size_t WS_Z    = 256 * MiB;
constexpr size_t WS_H1   = 320 * MiB;
constexpr size_t WS_LOGIT = 48 * MiB;
constexpr size_t WS_META = 1008 * MiB;
constexpr size_t WS_EGU_T = 768 * MiB;
constexpr size_t WS_ED_A  = 448 * MiB, WS_ED_B = 912 * MiB;
constexpr size_t WS_ACT  = 112 * MiB;
constexpr size_t WS_BASE = 384 * MiB;
constexpr size_t WS_Y    = 512 * MiB;
constexpr size_t WS_END  = 1024 * MiB;
constexpr size_t WS_DBGV = 912 * MiB;
constexpr size_t WS_XN8 = 912 * MiB;
constexpr size_t WS_SXN = 944 * MiB;
constexpr size_t WS_SWIN = 36 * MiB;
constexpr size_t WS_SH1 = 37 * MiB;
constexpr size_t WS_SEGU = 38 * MiB;
constexpr size_t WS_SSHGU = 39 * MiB;
constexpr size_t WS_SPLEG = 39 * MiB + 4096;
constexpr size_t WS_SWRO = 39 * MiB + 16384;
constexpr size_t WS_H18 = 80 * MiB;
constexpr size_t WS_SAR = 40 * MiB;
constexpr size_t WS_SWDO = 39 * MiB + 32768;
constexpr size_t WS_AD8 = 976 * MiB;
constexpr size_t WS_AR8 = 128 * MiB;
constexpr int NROWS_MAX = 1280 * 256;
constexpr int SH_ACT_ROW0 = NROWS_MAX;
constexpr size_t M_IDX = WS_META, M_W = WS_META + 1 * MiB, M_RASSIGN = WS_META + 2 * MiB, M_RTOK = WS_META + 4 * MiB, M_RW = WS_META + 6 * MiB,
                 M_RS = WS_META + 10 * MiB, M_BLKE = WS_META + 8 * MiB, M_NBLK = WS_META + 8 * MiB + 65536, M_IDENT = WS_META + 9 * MiB;

constexpr int CW_TMO = 0, CW_CODE = 1;
constexpr int CW_TS = 512;
constexpr int CW_DBG = 64;
constexpr int CW_BAR = 4096;
constexpr int CW_STEAL = 480;
constexpr int CW_PAD = 32;
constexpr int CW_CNT = 16384;
constexpr int CW_CUR = 16384 + 256 * CW_PAD;

constexpr int RING_BYTES = 131072;
constexpr int LDSCTL_OFF = 147456 - 1024, MISC_OFF = LDSCTL_OFF + 320;
constexpr int LDS_BYTES = 147456;
constexpr int NWAVES = 8;
constexpr float F8_WSCALE = 64.f, F8_ASCALE = 16.f;

__host__ __device__ __forceinline__ size_t ed_off(int e) { return WS_ED_B + (size_t)e * (1024 * 256); }
constexpr size_t WS_V8 = WS_ED_A;
constexpr float V8_SCALE = 16.f;
constexpr size_t WS_M8 = 320 * MiB;
constexpr float M8_SCALE = 16.f, B8_SCALE = 16.f;
#define GAS __attribute__((address_space(1)))
#define LAS __attribute__((address_space(3)))
typedef unsigned short bf16_t;
typedef unsigned v4u __attribute__((ext_vector_type(4)));
typedef float f32x4 __attribute__((ext_vector_type(4)));
typedef float f32x2 __attribute__((ext_vector_type(2)));
typedef int i32x4 __attribute__((ext_vector_type(4)));
typedef int i32x8 __attribute__((ext_vector_type(8)));
typedef short bf16x8 __attribute__((ext_vector_type(8)));
typedef GAS unsigned gu32;
#define RLX_AGENT __ATOMIC_RELAXED, __HIP_MEMORY_SCOPE_AGENT
#define LDS_WAIT() asm volatile("s_waitcnt lgkmcnt(0)" ::: "memory")
#define VM_WAIT() asm volatile("s_waitcnt vmcnt(0)" ::: "memory")

__device__ __forceinline__ unsigned f2bf(float f) { unsigned u = __builtin_bit_cast(unsigned, f); return (u + 0x7fffu + ((u >> 16) & 1u)) >> 16; }
__device__ __forceinline__ unsigned pk2(float lo, float hi) { return f2bf(lo) | (f2bf(hi) << 16); }
__device__ __forceinline__ float bf2f(unsigned short b) { return __builtin_bit_cast(float, (unsigned)b << 16); }
__device__ __forceinline__ float bflo(unsigned w) { return __builtin_bit_cast(float, w << 16); }
__device__ __forceinline__ float bfhi(unsigned w) { return __builtin_bit_cast(float, w & 0xffff0000u); }
__device__ __forceinline__ unsigned cvt_pk_bf16(float lo, float hi) { unsigned r; asm volatile("v_cvt_pk_bf16_f32 %0, %1, %2" : "=v"(r) : "v"(lo), "v"(hi)); return r; }
__device__ __forceinline__ unsigned cvtpk_(float lo, float hi) { unsigned r; asm("v_cvt_pk_bf16_f32 %0, %1, %2" : "=v"(r) : "v"(lo), "v"(hi)); return r; }
__device__ __forceinline__ float fast_sigmoid(float x) { return __builtin_amdgcn_rcpf(1.f + __builtin_amdgcn_exp2f(-x * LOG2E)); }
__device__ __forceinline__ float fast_silu(float x) { return x * fast_sigmoid(x); }
__device__ __forceinline__ int lane_id() { int l; asm volatile("v_mbcnt_lo_u32_b32 %0, -1, 0\n\tv_mbcnt_hi_u32_b32 %0, -1, %0" : "=v"(l)); return l; }
__device__ __forceinline__ float wave_sum(float v) {
#pragma unroll
    for (int o = 1; o < 64; o <<= 1) v += __shfl_xor(v, o);
    return v;
}

namespace pg8 {
constexpr int BM = 256, BK = 64, HALF = 128, HTB = HALF * BK * 2, STAGE_BYTES = 8 * HTB, NXCD = 8, WGM = 8, SCL_OFF = 131072;
__host__ __device__ __forceinline__ int lds_byte(int r, int c) { const int st = (r >> 4) * 2 + (c >> 5), rr = r & 15, cc = c & 31, ob = rr * 64 + cc * 2; return st * 1024 + (ob ^ (((ob >> 9) & 1) << 5)); }
__host__ __device__ __forceinline__ void stage_rc(int b, int& R, int& C) { const int st = b / 1024, sb = b % 1024, swz = sb ^ (((sb >> 9) & 1) << 5); R = (st >> 1) * 16 + swz / 64; C = (st & 1) * 32 + (swz % 64) / 2; }
__host__ __device__ __forceinline__ int perm32(int rho) { const int n = rho >> 4, i = rho & 15; return 8 * (i >> 2) + 4 * n + (i & 3); }

struct Unit { int pm, pn, type, aux; const char* A; const char* B; int grow; const float* cs; };
__device__ __forceinline__ bool tile_order(long L, int nM, int nN, int& pm, int& pn) {
    const int nwg = nM * nN; if (L >= nwg) return false;
    int wgid = (int)L; { const int q = nwg / NXCD, r = nwg % NXCD, xcd = wgid % NXCD, off = wgid / NXCD; wgid = (xcd < r ? xcd * (q + 1) : r * (q + 1) + (xcd - r) * q) + off; }
    const int nig = WGM * nN, gid = wgid / nig, fm = gid * WGM, gsz = (nM - fm) < WGM ? (nM - fm) : WGM;
    pm = fm + ((wgid % nig) % gsz); pn = (wgid % nig) / gsz; return true;
}
struct DenseOrder {
    const char* A; const char* Bt; int nM, nN, G, c; size_t tstep; int type;
    __device__ void init(const void* A_, const void* Bt_, int M, int N, int K, int G_, int c_, int type_ = 0) { A = (const char*)A_; Bt = (const char*)Bt_; nM = M / BM; nN = N / BM; G = G_; c = c_; tstep = (size_t)BM * K * 2; type = type_; }
    __device__ __forceinline__ bool next(int i, Unit& u) const {
        int pm, pn; if (!tile_order((long)i * G + c, nM, nN, pm, pn)) return false;
        u.pm = pm; u.pn = pn; u.type = type; u.aux = 0; u.A = A + (size_t)pm * tstep; u.B = Bt + (size_t)pn * tstep; u.grow = -1; return true;
    }
};

template <class Epi, class Sched, bool GATHER, bool I8 = false, bool F8 = false>
__device__ __forceinline__ void gemm_phase(LAS unsigned char* lds, const int K, const Sched& S, const Epi& E, const int* __restrict__ rowtok, const int wave_) {
    const int wid = __builtin_amdgcn_readfirstlane(wave_), lane = lane_id(), tid = wid * 64 + lane, wr = wid >> 2, wc = wid & 3, fr = lane & 15, fq = lane >> 4;
    const int nt = K / BK;
    int RA[2], CA[2];
    unsigned voffB[2], voffAc[2][2], voffAn[2][2];
#pragma unroll
    for (int i = 0; i < 2; ++i) { int R, C; stage_rc(tid * 16 + i * 8192, R, C); const int Rb = Epi::WIDE ? (64 * (R >> 5) + perm32(R & 31)) : (Epi::PERM ? ((R & ~31) + perm32(R & 31)) : R);
        RA[i] = R; CA[i] = C; voffB[i] = (unsigned)(Rb * K + C) * 2u;
        voffAc[0][i] = voffAc[1][i] = voffAn[0][i] = voffAn[1][i] = (unsigned)(R * K + C) * 2u; }
    const size_t kstep = (size_t)(BK * 2);
    const size_t hstepB = Epi::WIDE ? (size_t)32 * K * 2 : (size_t)HALF * K * 2;
    const size_t hstepA = GATHER ? 0 : (size_t)HALF * K * 2;
    const unsigned ldsw = (unsigned)wid * 1024u;
    const int aoff = lds_byte(wr * 64 + fr, fq * 8), boff = lds_byte(wc * 32 + fr, fq * 8);
#define PG8_SA(b, h) (((b) * 2 + (h)) * HTB)
#define PG8_SB(b, h) ((4 + (b) * 2 + (h)) * HTB)
#define PG8_STAGE(bufoff, gbase, voff) do { _Pragma("unroll") for (int _i = 0; _i < 2; ++_i) \
        __builtin_amdgcn_global_load_lds((const unsigned*)((const char*)(gbase) + (voff)[_i]), (LAS unsigned*)(lds + (bufoff) + ldsw + _i * 8192), 16, 0, 0); } while (0)
#define PG8_LDA(dst, b, h) do { _Pragma("unroll") for (int m = 0; m < 4; ++m) _Pragma("unroll") for (int k = 0; k < 2; ++k) dst[m][k] = *(const LAS bf16x8*)(lds + PG8_SA(b, h) + aoff + m * 2048 + k * 1024); } while (0)
#define PG8_LDB(dst, b, h) do { _Pragma("unroll") for (int n = 0; n < 2; ++n) _Pragma("unroll") for (int k = 0; k < 2; ++k) dst[n][k] = *(const LAS bf16x8*)(lds + PG8_SB(b, h) + boff + n * 2048 + k * 1024); } while (0)
#define PG8_MMA(ai, bj, At, Bt) do { __builtin_amdgcn_s_setprio(1); _Pragma("unroll") for (int m = 0; m < 4; ++m) _Pragma("unroll") for (int n = 0; n < 2; ++n) _Pragma("unroll") for (int k = 0; k < 2; ++k) { \
        if constexpr (F8) {   \
          const i32x4 b_ = __builtin_bit_cast(i32x4, Bt[n][k]), a_ = __builtin_bit_cast(i32x4, At[m][k]); \
          acc[ai][bj][m][n] = __builtin_amdgcn_mfma_f32_16x16x32_fp8_fp8((long)(((unsigned long long)(unsigned)b_[1] << 32) | (unsigned)b_[0]), (long)(((unsigned long long)(unsigned)a_[1] << 32) | (unsigned)a_[0]), acc[ai][bj][m][n], 0, 0, 0); \
          acc[ai][bj][m][n] = __builtin_amdgcn_mfma_f32_16x16x32_fp8_fp8((long)(((unsigned long long)(unsigned)b_[3] << 32) | (unsigned)b_[2]), (long)(((unsigned long long)(unsigned)a_[3] << 32) | (unsigned)a_[2]), acc[ai][bj][m][n], 0, 0, 0); } \
        else if constexpr (I8) acc[ai][bj][m][n] = __builtin_bit_cast(f32x4, __builtin_amdgcn_mfma_i32_16x16x64_i8(__builtin_bit_cast(i32x4, Bt[n][k]), __builtin_bit_cast(i32x4, At[m][k]), __builtin_bit_cast(i32x4, acc[ai][bj][m][n]), 0, 0, 0)); \
        else acc[ai][bj][m][n] = __builtin_amdgcn_mfma_f32_16x16x32_bf16(Bt[n][k], At[m][k], acc[ai][bj][m][n], 0, 0, 0); } __builtin_amdgcn_s_setprio(0); } while (0)
#define PG8_WAIT_V(n) asm volatile("s_waitcnt vmcnt(" #n ")" ::: "memory")
#define PG8_WAIT_L(n) asm volatile("s_waitcnt lgkmcnt(" #n ")" ::: "memory")
#define PG8_BAR __builtin_amdgcn_s_barrier()
#define PG8_SCHED __builtin_amdgcn_sched_barrier(0)
#define PG8_GOFF(dst, u) do { if (GATHER) { _Pragma("unroll") for (int h = 0; h < 2; ++h) _Pragma("unroll") for (int i = 0; i < 2; ++i) { \
        const int tok = rowtok[(u).grow + h * HALF + RA[i]]; dst[h][i] = (unsigned)(tok * K + CA[i]) * 2u; } } } while (0)
    Unit cur, nxt; int ui = 0;
    if (!S.next(0, cur)) return;
    PG8_GOFF(voffAc, cur);
#define PG8_SCALES(u, buf) do { if constexpr (I8 || Epi::PRE) { const float* src_ = (wid < 4 ? E.rowscale_ptr(u) + wid * 64 : E.colscale(u) + (wid - 4) * 64) + lane; \
        __builtin_amdgcn_global_load_lds((const unsigned*)src_, (LAS unsigned*)(lds + SCL_OFF + (buf) * 2048 + wid * 256), 4, 0, 0); } } while (0)
    PG8_SCALES(cur, 0);
    f32x4 acc[2][2][4][2];
#pragma unroll
    for (int a = 0; a < 2; ++a)
#pragma unroll
        for (int b = 0; b < 2; ++b)
#pragma unroll
            for (int m = 0; m < 4; ++m)
#pragma unroll
                for (int n = 0; n < 2; ++n) acc[a][b][m][n] = (f32x4){0.f, 0.f, 0.f, 0.f};
    bf16x8 At[4][2], B0[2][2], B1[2][2];
    const char* cA = cur.A; const char* cB = cur.B;
    PG8_STAGE(PG8_SB(0, 0), cB, voffB); PG8_STAGE(PG8_SB(0, 1), cB + hstepB, voffB); PG8_STAGE(PG8_SA(0, 0), cA, voffAc[0]); PG8_STAGE(PG8_SA(0, 1), cA + hstepA, voffAc[1]);
    if (wr == 1) PG8_BAR;
    PG8_WAIT_V(2); PG8_BAR;
    PG8_STAGE(PG8_SB(1, 0), cB + kstep, voffB); PG8_STAGE(PG8_SA(1, 0), cA + kstep, voffAc[0]); PG8_STAGE(PG8_SB(1, 1), cB + hstepB + kstep, voffB);
    PG8_WAIT_V(6); PG8_BAR;
    for (;;) {
        const bool has_next = S.next(ui + 1, nxt);
        if (has_next) { PG8_GOFF(voffAn, nxt); }
        else { if (GATHER) { _Pragma("unroll") for (int h = 0; h < 2; ++h) _Pragma("unroll") for (int i = 0; i < 2; ++i) voffAn[h][i] = voffAc[h][i]; } }
        const char* nA = has_next ? nxt.A : cA; const char* nB = has_next ? nxt.B : cB;
        _Pragma("unroll 1") for (int t = 0; t < nt; t += 2) {
            const bool last = (t == nt - 2);
            const char* a1 = cA + (size_t)(t + 1) * kstep;
            const char* a2 = last ? nA : cA + (size_t)(t + 2) * kstep; const char* b2 = last ? nB : cB + (size_t)(t + 2) * kstep;
            const char* a3 = a2 + kstep; const char* b3 = b2 + kstep;
            unsigned va2[2][2];
#pragma unroll
            for (int h = 0; h < 2; ++h)
#pragma unroll
                for (int i = 0; i < 2; ++i) va2[h][i] = (GATHER && last) ? voffAn[h][i] : voffAc[h][i];
            PG8_LDB(B0, 0, 0); PG8_LDB(B1, 0, 1); PG8_SCHED; PG8_LDA(At, 0, 0); PG8_STAGE(PG8_SA(1, 1), a1 + hstepA, voffAc[1]);
            PG8_WAIT_V(8); PG8_WAIT_L(0); PG8_BAR; PG8_MMA(0, 0, At, B0); PG8_MMA(0, 1, At, B1); PG8_BAR; PG8_SCHED;
            PG8_LDA(At, 0, 1); PG8_STAGE(PG8_SB(0, 0), b2, voffB); PG8_STAGE(PG8_SB(0, 1), b2 + hstepB, voffB); PG8_STAGE(PG8_SA(0, 0), a2, va2[0]);
            PG8_WAIT_V(8); PG8_WAIT_L(0); PG8_BAR; PG8_MMA(1, 0, At, B0); PG8_MMA(1, 1, At, B1); PG8_BAR; PG8_SCHED;
            PG8_LDB(B0, 1, 0); PG8_LDB(B1, 1, 1); PG8_SCHED; PG8_LDA(At, 1, 0); PG8_STAGE(PG8_SA(0, 1), a2 + hstepA, va2[1]);
            PG8_WAIT_V(8); PG8_WAIT_L(0); PG8_BAR; PG8_MMA(0, 0, At, B0); PG8_MMA(0, 1, At, B1); PG8_BAR; PG8_SCHED;
            PG8_LDA(At, 1, 1); PG8_STAGE(PG8_SB(1, 0), b3, voffB); PG8_STAGE(PG8_SB(1, 1), b3 + hstepB, voffB); PG8_STAGE(PG8_SA(1, 0), a3, va2[0]);
            PG8_WAIT_V(8); PG8_WAIT_L(0); PG8_BAR; PG8_MMA(1, 0, At, B0); PG8_MMA(1, 1, At, B1); PG8_BAR; PG8_SCHED;
            if (t == 0 && has_next) PG8_SCALES(nxt, (ui + 1) & 1);
        }
        if (wr == 0) PG8_BAR;
        if constexpr (I8) {
            int lr0 = wr * 64 + fr, cw = wc * 32 + 8 * fq; asm volatile("" : "+v"(lr0), "+v"(cw));
            const LAS unsigned char* scl = lds + SCL_OFF + (ui & 1) * 2048;
            f32x4 csv[2][2];
#pragma unroll
            for (int bj = 0; bj < 2; ++bj)
#pragma unroll
                for (int n = 0; n < 2; ++n) csv[bj][n] = *(const LAS f32x4*)(scl + 1024 + 4 * ((Epi::WIDE ? 64 * wc + 32 * bj + 8 * fq : bj * 128 + cw) + 4 * n));
#pragma unroll
            for (int ai = 0; ai < 2; ++ai)
#pragma unroll
                for (int m = 0; m < 4; ++m) { const float rsv = E.fixed_rowscale() ? E.fixed_rs_value() : *(const LAS float*)(scl + 4 * (lr0 + ai * 128 + m * 16));
#pragma unroll
                    for (int bj = 0; bj < 2; ++bj)
#pragma unroll
                        for (int n = 0; n < 2; ++n) acc[ai][bj][m][n] = __builtin_convertvector(__builtin_bit_cast(i32x4, acc[ai][bj][m][n]), f32x4) * rsv * csv[bj][n]; }
        }
        if constexpr (Epi::PRE) E(acc, cur, wr, wc, fr, fq, lds + SCL_OFF + (ui & 1) * 2048); else E(acc, cur, wr, wc, fr, fq);
        if (!has_next) break;
#pragma unroll
        for (int a = 0; a < 2; ++a)
#pragma unroll
            for (int b = 0; b < 2; ++b)
#pragma unroll
                for (int m = 0; m < 4; ++m)
#pragma unroll
                    for (int n = 0; n < 2; ++n) acc[a][b][m][n] = (f32x4){0.f, 0.f, 0.f, 0.f};
        cur = nxt; cA = nA; cB = nB; ++ui;
        if (GATHER) { _Pragma("unroll") for (int h = 0; h < 2; ++h) _Pragma("unroll") for (int i = 0; i < 2; ++i) voffAc[h][i] = voffAn[h][i]; }
        if (wr == 1) PG8_BAR;
    }
    PG8_WAIT_V(0);
    PG8_BAR;
#undef PG8_SA
#undef PG8_SB
#undef PG8_STAGE
#undef PG8_LDA
#undef PG8_LDB
#undef PG8_MMA
#undef PG8_WAIT_V
#undef PG8_WAIT_L
#undef PG8_BAR
#undef PG8_SCHED
#undef PG8_GOFF
#undef PG8_SCALES
}
typedef f32x4 Acc[2][2][4][2];
}

#define XB_TMO      128
#define XB_XCNT(j)  (256  + 64 * (j))
#define XB_XSUB(j)  (1280 + 64 * (j))
#define XB_XGEN(j)  (2304 + 64 * (j))
#define XB_TOP      3328
#define XB_TOPGEN   3392
#define XCD_BAR_WORDS 3456
#define XB_SPIN_CAP (1u << 18)
__device__ __forceinline__ unsigned xb_ld(unsigned* p)              { return __hip_atomic_load(p, __ATOMIC_RELAXED, __HIP_MEMORY_SCOPE_AGENT); }
__device__ __forceinline__ unsigned xb_add(unsigned* p, unsigned v) { return __hip_atomic_fetch_add(p, v, __ATOMIC_RELAXED, __HIP_MEMORY_SCOPE_AGENT); }
__device__ __forceinline__ unsigned xb_xcc_id() { return (unsigned)__builtin_amdgcn_s_getreg((3 << 11) | 20) & 0xFu; }
#define XB_SPIN(cond, bar) do { unsigned _sp = 0; while (cond) { __builtin_amdgcn_s_sleep(1); \
    if ((++_sp & 255u) == 0u) { if (xb_ld(&(bar)[XB_TMO])) break; if (_sp > XB_SPIN_CAP) { atomicAdd(&(bar)[XB_TMO], 1u); break; } } } } while (0)
struct XcdBarrier { unsigned* bar; unsigned x; volatile LAS unsigned* st; };
__device__ __forceinline__ XcdBarrier xcd_barrier_post(unsigned* bar, volatile LAS unsigned* st) {
    XcdBarrier b; b.bar = bar; b.x = xb_xcc_id(); b.st = st;
    if (threadIdx.x == 0) (void)xb_add(&bar[XB_XCNT(b.x)], 1u);
    return b;
}
__device__ __forceinline__ void xcd_barrier_complete(unsigned* bar, unsigned x, unsigned& nloc, unsigned& nx) {
    const unsigned G = gridDim.x * gridDim.y * gridDim.z;
    unsigned sum, cnt, mine, sp = 0u;
    for (;;) {
        sum = 0u; cnt = 0u; mine = 0u;
#pragma unroll
        for (unsigned j = 0; j < 16; ++j) { const unsigned c = xb_ld(&bar[XB_XCNT(j)]); sum += c; cnt += (c > 0u) ? 1u : 0u; mine = (j == x) ? c : mine; }
        if (sum == G) break;
        __builtin_amdgcn_s_sleep(1);
        if ((++sp & 255u) == 0u) { if (xb_ld(&bar[XB_TMO])) break; if (sp > XB_SPIN_CAP) { atomicAdd(&bar[XB_TMO], 1u); break; } }
    }
    nloc = mine > 0u ? mine : 1u; nx = cnt > 0u ? cnt : 1u;
}
__device__ __forceinline__ void xcd_barrier(const XcdBarrier& b) {
    asm volatile("s_waitcnt vmcnt(0)" ::: "memory");
    __syncthreads();
    if (threadIdx.x == 0) {
        unsigned* bar = b.bar;
        __builtin_amdgcn_s_waitcnt(0);
        unsigned nloc = b.st[0], nx = b.st[1];
        if (nloc == 0u) { xcd_barrier_complete(bar, b.x, nloc, nx); b.st[0] = nloc; b.st[1] = nx; }
        const unsigned old = xb_add(&bar[XB_XSUB(b.x)], 1u);
        const unsigned gen = old / nloc;
        if (old + 1u == (gen + 1u) * nloc) {
            __builtin_amdgcn_fence(__ATOMIC_RELEASE, "agent");
            asm volatile("s_waitcnt vmcnt(0)" ::: "memory");
            const unsigned og = xb_add(&bar[XB_TOP], 1u);
            const unsigned tg = og / nx;
            if (og + 1u == (tg + 1u) * nx) xb_add(&bar[XB_TOPGEN], 1u);
            else XB_SPIN(xb_ld(&bar[XB_TOPGEN]) == tg, bar);
            __builtin_amdgcn_fence(__ATOMIC_ACQUIRE, "agent");
            xb_add(&bar[XB_XGEN(b.x)], 1u);
            asm volatile("s_waitcnt vmcnt(0)" ::: "memory");
        } else {
            XB_SPIN(xb_ld(&bar[XB_XGEN(b.x)]) == gen, bar);
            __builtin_amdgcn_fence(__ATOMIC_ACQUIRE, "agent");
            asm volatile("s_waitcnt vmcnt(0)" ::: "memory");
        }
    }
    __syncthreads();
}

struct Args { const float* in[29]; float* out; unsigned char* ws; int ph_lo, ph_hi; };
enum { I_X = 0, I_P, I_LNIN_G, I_LNIN_B, I_RELB, I_WIN, I_GN_G, I_LQ1, I_LK1, I_LQ2, I_LK2, I_SUBLN_G, I_WRO, I_WDO, I_WO, I_LN1_G, I_LN1_B,
       I_ROUT_W, I_ROUT_B, I_EG, I_EU, I_ED, I_SG, I_SU, I_SD, I_PLE_W, I_PLE_GW, I_LN2_G, I_LN2_B };

struct Frame {
    LAS unsigned char* lds;
    volatile LAS unsigned* MISC;
    gu32* ctl;
    int wave, vcu, G;
};
#define FTID (F.wave * 64 + lane_id())
#define FLANE (lane_id())

__device__ __forceinline__ void p0_transpose_item(const float* W, int K, int N, bf16_t* WT, int k0, int n0, int dstrow0, LAS float* scr, int lane) {
    const int cg = lane & 7, r = lane >> 3;
    f32x4 v[8];
#pragma unroll
    for (int i = 0; i < 8; ++i) v[i] = *(const f32x4*)(W + (size_t)(k0 + r + 8 * i) * N + n0 + 4 * cg);
#pragma unroll
    for (int i = 0; i < 8; ++i) { LAS float* d = scr + (r + 8 * i) * 33 + 4 * cg; d[0] = v[i].x; d[1] = v[i].y; d[2] = v[i].z; d[3] = v[i].w; }
    LDS_WAIT(); asm volatile("" ::: "memory");
    const int c = lane & 7;
#pragma unroll
    for (int j = 0; j < 4; ++j) { const int n = (lane >> 3) + 8 * j; const LAS float* s = scr + (8 * c) * 33 + n;
        v4u o; o.x = pk2(s[0 * 33], s[1 * 33]); o.y = pk2(s[2 * 33], s[3 * 33]); o.z = pk2(s[4 * 33], s[5 * 33]); o.w = pk2(s[6 * 33], s[7 * 33]);
        *(GAS v4u*)(WT + (size_t)(dstrow0 + n) * K + k0 + 8 * c) = o; }
    LDS_WAIT(); asm volatile("" ::: "memory");
}
__device__ __forceinline__ void p0_transpose_item_f8(const float* W, int K, int N, unsigned char* WT8, int k0, int n0, int dstrow0, LAS float* scr, int lane, const float scale) {
    const int cg = lane & 7, r = lane >> 3;
    f32x4 v[8];
#pragma unroll
    for (int i = 0; i < 8; ++i) v[i] = *(const f32x4*)(W + (size_t)(k0 + r + 8 * i) * N + n0 + 4 * cg);
#pragma unroll
    for (int i = 0; i < 8; ++i) { LAS float* d = scr + (r + 8 * i) * 33 + 4 * cg; d[0] = v[i].x * scale; d[1] = v[i].y * scale; d[2] = v[i].z * scale; d[3] = v[i].w * scale; }
    LDS_WAIT(); asm volatile("" ::: "memory");
    const int c = lane & 7;
#pragma unroll
    for (int j = 0; j < 4; ++j) { const int n = (lane >> 3) + 8 * j; const LAS float* s = scr + (8 * c) * 33 + n;
        int w0 = 0, w1 = 0;
        w0 = __builtin_amdgcn_cvt_pk_fp8_f32(s[0 * 33], s[1 * 33], w0, false); w0 = __builtin_amdgcn_cvt_pk_fp8_f32(s[2 * 33], s[3 * 33], w0, true);
        w1 = __builtin_amdgcn_cvt_pk_fp8_f32(s[4 * 33], s[5 * 33], w1, false); w1 = __builtin_amdgcn_cvt_pk_fp8_f32(s[6 * 33], s[7 * 33], w1, true);
        *(GAS unsigned long long*)(WT8 + (size_t)(dstrow0 + n) * K + k0 + 8 * c) = (unsigned long long)(unsigned)w0 | ((unsigned long long)(unsigned)w1 << 32); }
    LDS_WAIT(); asm volatile("" ::: "memory");
}
__host__ __device__ __forceinline__ int win_dst_row(int c) {
    if (c >= 2048) return c;
    const int sb = c & ~1023, cs = c & 1023, hd = cs >> 7, half = (cs >> 6) & 1, j = cs & 63;
    return sb + (hd >> 1) * 256 + 64 * (2 * (hd & 1) + (j >> 5)) + 32 * half + (j & 31);
}
__device__ __forceinline__ void ln_row_to_bf16(int lane, const float* xrow, const float* g, const float* b, bf16_t* orow) {
    const GAS f32x4* xr = (const GAS f32x4*)xrow + lane;
    f32x4 v[4]; float s = 0.f;
#pragma unroll
    for (int j = 0; j < 4; ++j) { v[j] = xr[64 * j]; s += (v[j].x + v[j].y) + (v[j].z + v[j].w); }
    const float mean = wave_sum(s) * (1.f / DM); float s2 = 0.f;
#pragma unroll
    for (int j = 0; j < 4; ++j) { v[j] = v[j] - mean; s2 += (v[j].x * v[j].x + v[j].y * v[j].y) + (v[j].z * v[j].z + v[j].w * v[j].w); }
    const float rstd = 1.f / sqrtf(wave_sum(s2) * (1.f / DM) + LN_EPS);
    GAS unsigned long long* o8 = (GAS unsigned long long*)orow + lane;
#pragma unroll
    for (int j = 0; j < 4; ++j) { const f32x4 gg = *((const GAS f32x4*)g + lane + 64 * j), bb = *((const GAS f32x4*)b + lane + 64 * j);
        const f32x4 y = v[j] * rstd * gg + bb;
        o8[64 * j] = (unsigned long long)pk2(y.x, y.y) | ((unsigned long long)pk2(y.z, y.w) << 32); }
}

template <bool BF16IN>
__device__ __forceinline__ void ln_row_to_bf16_i8(int lane, const void* xrow, const float* g, const float* b, bf16_t* orow, signed char* qrow, float* srow) {
    f32x4 v[4]; float s = 0.f;
#pragma unroll
    for (int j = 0; j < 4; ++j) {
        if constexpr (BF16IN) { const unsigned long long w = ((const GAS unsigned long long*)xrow)[lane + 64 * j]; v[j] = (f32x4){bflo((unsigned)w), bfhi((unsigned)w), bflo((unsigned)(w >> 32)), bfhi((unsigned)(w >> 32))}; }
        else v[j] = ((const GAS f32x4*)xrow)[lane + 64 * j];
        s += (v[j].x + v[j].y) + (v[j].z + v[j].w); }
    const float mean = wave_sum(s) * (1.f / DM); float s2 = 0.f;
#pragma unroll
    for (int j = 0; j < 4; ++j) { v[j] = v[j] - mean; s2 += (v[j].x * v[j].x + v[j].y * v[j].y) + (v[j].z * v[j].z + v[j].w * v[j].w); }
    const float rstd = 1.f / sqrtf(wave_sum(s2) * (1.f / DM) + LN_EPS);
    GAS unsigned long long* o8 = (GAS unsigned long long*)orow + lane;
    float mx = 0.f;
#pragma unroll
    for (int j = 0; j < 4; ++j) { const f32x4 gg = *((const GAS f32x4*)g + lane + 64 * j), bb = *((const GAS f32x4*)b + lane + 64 * j);
        v[j] = v[j] * rstd * gg + bb;
        o8[64 * j] = (unsigned long long)pk2(v[j].x, v[j].y) | ((unsigned long long)pk2(v[j].z, v[j].w) << 32);
        mx = fmaxf(mx, fmaxf(fmaxf(fabsf(v[j].x), fabsf(v[j].y)), fmaxf(fabsf(v[j].z), fabsf(v[j].w)))); }
#pragma unroll
    for (int o = 1; o < 64; o <<= 1) mx = fmaxf(mx, __shfl_xor(mx, o));
    const float sc = mx > 0.f ? mx * (1.f / 127.f) : 1.f, inv = 1.f / sc;
    GAS unsigned* q4 = (GAS unsigned*)qrow + lane;
#pragma unroll
    for (int j = 0; j < 4; ++j) { const int q0 = (int)rintf(v[j].x * inv), q1 = (int)rintf(v[j].y * inv), q2 = (int)rintf(v[j].z * inv), q3 = (int)rintf(v[j].w * inv);
        q4[64 * j] = (unsigned)(q0 & 255) | ((unsigned)(q1 & 255) << 8) | ((unsigned)(q2 & 255) << 16) | ((unsigned)(q3 & 255) << 24); }
    if (lane == 0) *srow = sc;
}
template <bool BF16IN>
__device__ __forceinline__ void ln_rows_bf16_i8(int lane, const void* X, const float* g, const float* b, bf16_t* O, signed char* Q, float* S, int m0, int mstep, int M) {
    f32x4 gg[4], bb[4];
#pragma unroll
    for (int j = 0; j < 4; ++j) { gg[j] = *((const GAS f32x4*)g + lane + 64 * j); bb[j] = *((const GAS f32x4*)b + lane + 64 * j); }
    f32x4 cv[4], nv[4]; unsigned long long cw[4], nw[4];
#define LN_LOAD(dv, dw, m_) do { _Pragma("unroll") for (int j = 0; j < 4; ++j) { \
        if constexpr (BF16IN) dw[j] = ((const GAS unsigned long long*)((const bf16_t*)X + (size_t)(m_) * DM))[lane + 64 * j]; \
        else dv[j] = ((const GAS f32x4*)((const float*)X + (size_t)(m_) * DM))[lane + 64 * j]; } } while (0)
    int m = m0;
    if (m < M) LN_LOAD(cv, cw, m);
    while (m < M) {
        const int mn = m + mstep;
        if (mn < M) LN_LOAD(nv, nw, mn);
        f32x4 v[4]; float s = 0.f;
#pragma unroll
        for (int j = 0; j < 4; ++j) {
            if constexpr (BF16IN) { const unsigned long long w = cw[j]; v[j] = (f32x4){bflo((unsigned)w), bfhi((unsigned)w), bflo((unsigned)(w >> 32)), bfhi((unsigned)(w >> 32))}; }
            else v[j] = cv[j];
            s += (v[j].x + v[j].y) + (v[j].z + v[j].w); }
        const float mean = wave_sum(s) * (1.f / DM); float s2 = 0.f;
#pragma unroll
        for (int j = 0; j < 4; ++j) { v[j] = v[j] - mean; s2 += (v[j].x * v[j].x + v[j].y * v[j].y) + (v[j].z * v[j].z + v[j].w * v[j].w); }
        const float rstd = 1.f / sqrtf(wave_sum(s2) * (1.f / DM) + LN_EPS);
        GAS unsigned long long* o8 = (GAS unsigned long long*)(O + (size_t)m * DM) + lane;
        float mx = 0.f;
#pragma unroll
        for (int j = 0; j < 4; ++j) {
            v[j] = v[j] * rstd * gg[j] + bb[j];
            o8[64 * j] = (unsigned long long)pk2(v[j].x, v[j].y) | ((unsigned long long)pk2(v[j].z, v[j].w) << 32);
            mx = fmaxf(mx, fmaxf(fmaxf(fabsf(v[j].x), fabsf(v[j].y)), fmaxf(fabsf(v[j].z), fabsf(v[j].w)))); }
#pragma unroll
        for (int o = 1; o < 64; o <<= 1) mx = fmaxf(mx, __shfl_xor(mx, o));
        const float sc = mx > 0.f ? mx * (1.f / 127.f) : 1.f, inv = 1.f / sc;
        GAS unsigned* q4 = (GAS unsigned*)(Q + (size_t)m * DM) + lane;
#pragma unroll
        for (int j = 0; j < 4; ++j) { const int q0 = (int)rintf(v[j].x * inv), q1 = (int)rintf(v[j].y * inv), q2 = (int)rintf(v[j].z * inv), q3 = (int)rintf(v[j].w * inv);
            q4[64 * j] = (unsigned)(q0 & 255) | ((unsigned)(q1 & 255) << 8) | ((unsigned)(q2 & 255) << 16) | ((unsigned)(q3 & 255) << 24); }
        if (lane == 0) S[m] = sc;
#pragma unroll
        for (int j = 0; j < 4; ++j) { if constexpr (BF16IN) cw[j] = nw[j]; else cv[j] = nv[j]; }
        m = mn;
    }
#undef LN_LOAD
}
template <int KP>
__device__ __forceinline__ void quant_cols32(LAS unsigned char* lds, const float* W, int N, int n0, signed char* WT, float* scl, int dst0, int wave, int lane) {
    const int t = wave * 64 + lane, cg = t & 7, rg = t >> 3;
    constexpr int PITCH = 1040, K = 1024 * KP;
    LAS float* red = (LAS float*)(lds + 32 * PITCH);
    const float* Wp = W + (size_t)(4 * rg) * N + n0 + 4 * cg;
    f32x4 v[4][4]; f32x4 mx = (f32x4){0.f, 0.f, 0.f, 0.f};
#pragma unroll 1
    for (int part = 0; part < KP; ++part) {
#pragma unroll
        for (int i = 0; i < 4; ++i)
#pragma unroll
            for (int j = 0; j < 4; ++j) v[i][j] = *(const f32x4*)(Wp + (size_t)(1024 * part + 256 * i + j) * N);
#pragma unroll
        for (int i = 0; i < 4; ++i)
#pragma unroll
            for (int j = 0; j < 4; ++j) mx = __builtin_elementwise_max(mx, __builtin_elementwise_abs(v[i][j]));
    }
#pragma unroll
    for (int off = 8; off < 64; off <<= 1)
#pragma unroll
        for (int c = 0; c < 4; ++c) mx[c] = fmaxf(mx[c], __shfl_xor(mx[c], off));
    if (lane < 8) *(LAS f32x4*)(red + wave * 32 + 4 * cg) = mx;
    __syncthreads();
    f32x4 cm = *(const LAS f32x4*)(red + 4 * cg);
#pragma unroll
    for (int w = 1; w < 8; ++w) cm = __builtin_elementwise_max(cm, *(const LAS f32x4*)(red + w * 32 + 4 * cg));
    f32x4 sc, inv;
#pragma unroll
    for (int c = 0; c < 4; ++c) { sc[c] = cm[c] > 0.f ? cm[c] * (1.f / 127.f) : 1.f; inv[c] = 1.f / sc[c]; }
    if (t < 8) *(f32x4*)(scl + dst0 + 4 * cg) = sc;
#pragma unroll 1
    for (int part = 0; part < KP; ++part) {
        if (KP > 1) {
#pragma unroll
            for (int i = 0; i < 4; ++i)
#pragma unroll
                for (int j = 0; j < 4; ++j) v[i][j] = *(const f32x4*)(Wp + (size_t)(1024 * part + 256 * i + j) * N);
        }
#pragma unroll
        for (int i = 0; i < 4; ++i)
#pragma unroll
            for (int c = 0; c < 4; ++c) { const int q0 = (int)rintf(v[i][0][c] * inv[c]), q1 = (int)rintf(v[i][1][c] * inv[c]), q2 = (int)rintf(v[i][2][c] * inv[c]), q3 = (int)rintf(v[i][3][c] * inv[c]);
                *(LAS unsigned*)(lds + (4 * cg + c) * PITCH + 256 * i + 4 * rg) = (unsigned)(q0 & 255) | ((unsigned)(q1 & 255) << 8) | ((unsigned)(q2 & 255) << 16) | ((unsigned)(q3 & 255) << 24); }
        __syncthreads();
        { const int row = t >> 4, ch = t & 15;
#pragma unroll
          for (int e = 0; e < 4; ++e) *(GAS v4u*)(WT + (size_t)(dst0 + row) * K + 1024 * part + ch * 64 + e * 16) = *(const LAS v4u*)(lds + row * PITCH + ch * 64 + e * 16); }
        __syncthreads();
    }
}
__device__ __forceinline__ void quant_cols32_k1024(LAS unsigned char* lds, const float* W, int N, int n0, signed char* WT, float* scl, int dst0, int wave, int lane) { quant_cols32<1>(lds, W, N, n0, WT, scl, dst0, wave, lane); }
__device__ __forceinline__ void p0_prologue(Frame& F, const Args& a) {
    LAS float* scr = (LAS float*)(F.lds + F.wave * 16384);
    const int gw = F.vcu * NWAVES + F.wave, NGW = F.G * NWAVES;
    unsigned char* ws = a.ws;
    constexpr int I_WINc = 0;
    constexpr int I_WROc = 0, I_WDOc = 0, I_WOc = 16 * 32, I_ROUTc = 16 * 8, I_PLEWc = 4 * 32, I_PLEGc = 0, I_SGc = 0, I_SUc = 0, I_SDc = 4 * 32;
    constexpr int NITEMS = I_WINc + I_WROc + I_WDOc + I_WOc + I_ROUTc + I_PLEWc + I_PLEGc + I_SGc + I_SUc + I_SDc;
    for (int it = gw; it < NITEMS; it += NGW) {
        int r = it; const float* W; int K, N; bf16_t* WT; int kind = 0;
        if (r < I_WINc) { W = a.in[I_WIN]; K = 1024; N = INCOLS; WT = (bf16_t*)(ws + WS_WIN_T); kind = 1; }
        else if ((r -= I_WINc) < I_WROc) { W = a.in[I_WRO]; K = 2048; N = 1024; WT = (bf16_t*)(ws + WS_WRO_T); }
        else if ((r -= I_WROc) < I_WDOc) { W = a.in[I_WDO]; K = 1024; N = 1024; WT = (bf16_t*)(ws + WS_WDO_T); }
        else if ((r -= I_WDOc) < I_WOc) { W = a.in[I_WO]; K = 1024; N = 1024; WT = (bf16_t*)(ws + WS_WO_T); }
        else if ((r -= I_WOc) < I_ROUTc) { W = a.in[I_ROUT_W]; K = 1024; N = 256; WT = (bf16_t*)(ws + WS_ROUT_T); }
        else if ((r -= I_ROUTc) < I_PLEWc) { W = a.in[I_PLE_W]; K = 256; N = 1024; WT = (bf16_t*)(ws + WS_PLEW_T); }
        else if ((r -= I_PLEWc) < I_PLEGc) { W = a.in[I_PLE_GW]; K = 1024; N = 1024; WT = (bf16_t*)(ws + WS_PLEG_T); }
        else if ((r -= I_PLEGc) < I_SGc) { W = a.in[I_SG]; K = 1024; N = 256; WT = (bf16_t*)(ws + WS_SHGU_T); kind = 2; }
        else if ((r -= I_SGc) < I_SUc) { W = a.in[I_SU]; K = 1024; N = 256; WT = (bf16_t*)(ws + WS_SHGU_T); kind = 3; }
        else { r -= I_SUc; W = a.in[I_SD]; K = 256; N = 1024; WT = (bf16_t*)(ws + WS_SHD_T); }
        const int nblk = N / 32, kb = r / nblk, nb = r % nblk, n0 = 32 * nb;
        int d0 = n0;
        if (kind == 1) d0 = win_dst_row(n0);
        else if (kind == 2) d0 = (n0 >> 7) * 256 + (n0 & 127);
        else if (kind == 3) d0 = (n0 >> 7) * 256 + 128 + (n0 & 127);
        if (W == a.in[I_SD] || W == a.in[I_WO]) p0_transpose_item_f8(W, K, N, (unsigned char*)WT, 64 * kb, n0, d0, scr, FLANE, F8_WSCALE);
        else p0_transpose_item(W, K, N, WT, 64 * kb, n0, d0, scr, FLANE);
    }
    __syncthreads();
    for (int it = F.vcu; it < 32 + INCOLS / 32 + 32 + 16 + 32; it += F.G) {
        int r = it;
        if (r < 32) { quant_cols32<2>(F.lds, a.in[I_WRO], 1024, 32 * r, (signed char*)(ws + WS_WRO_T), (float*)(ws + WS_SWRO), 32 * r, F.wave, FLANE); continue; } r -= 32;
        if (r < INCOLS / 32) { quant_cols32_k1024(F.lds, a.in[I_WIN], INCOLS, 32 * r, (signed char*)(ws + WS_WIN_T), (float*)(ws + WS_SWIN), win_dst_row(32 * r), F.wave, FLANE); continue; } r -= INCOLS / 32;
        if (r < 32) { quant_cols32_k1024(F.lds, a.in[I_WDO], 1024, 32 * r, (signed char*)(ws + WS_WDO_T), (float*)(ws + WS_SWDO), 32 * r, F.wave, FLANE); continue; } r -= 32;
        if (r < 16) { const int up = r >> 3, n0 = 32 * (r & 7); quant_cols32_k1024(F.lds, a.in[up ? I_SU : I_SG], 256, n0, (signed char*)(ws + WS_SHGU_T), (float*)(ws + WS_SSHGU), (n0 >> 7) * 256 + up * 128 + (n0 & 127), F.wave, FLANE); continue; } r -= 16;
        quant_cols32_k1024(F.lds, a.in[I_PLE_GW], 1024, 32 * r, (signed char*)(ws + WS_PLEG_T), (float*)(ws + WS_SPLEG), 32 * r, F.wave, FLANE);
    }
    ln_rows_bf16_i8<false>(FLANE, a.in[I_X], a.in[I_LNIN_G], a.in[I_LNIN_B], (bf16_t*)(ws + WS_XN), (signed char*)(ws + WS_XN8), (float*)(ws + WS_SXN), gw, NGW, NTOK);
    { const size_t n8 = (size_t)NTOK * PLE / 8; const GAS f32x4* src = (const GAS f32x4*)a.in[I_P]; GAS v4u* dst = (GAS v4u*)(ws + WS_PB);
      for (size_t i = (size_t)F.vcu * 512 + FTID; i < n8; i += (size_t)F.G * 512) { const f32x4 x0 = src[2 * i], x1 = src[2 * i + 1];
          v4u o; o.x = pk2(x0.x, x0.y); o.y = pk2(x0.z, x0.w); o.z = pk2(x1.x, x1.y); o.w = pk2(x1.z, x1.w); dst[i] = o; } }
}

__device__ __forceinline__ void unpack8(const v4u w, float* f) { f[0] = bflo(w.x); f[1] = bfhi(w.x); f[2] = bflo(w.y); f[3] = bfhi(w.y); f[4] = bflo(w.z); f[5] = bfhi(w.z); f[6] = bflo(w.w); f[7] = bfhi(w.w); }
__device__ __forceinline__ unsigned long long pack8_fp8(const float* f) { int w0 = 0, w1 = 0;
    w0 = __builtin_amdgcn_cvt_pk_fp8_f32(f[0], f[1], w0, false); w0 = __builtin_amdgcn_cvt_pk_fp8_f32(f[2], f[3], w0, true);
    w1 = __builtin_amdgcn_cvt_pk_fp8_f32(f[4], f[5], w1, false); w1 = __builtin_amdgcn_cvt_pk_fp8_f32(f[6], f[7], w1, true);
    return (unsigned long long)(unsigned)w0 | ((unsigned long long)(unsigned)w1 << 32); }
__device__ __forceinline__ void unpack8_fp8(const unsigned long long yw, float* f) { const int w0 = (int)(unsigned)yw, w1 = (int)(unsigned)(yw >> 32);
    const auto f0 = __builtin_amdgcn_cvt_pk_f32_fp8(w0, false), f1 = __builtin_amdgcn_cvt_pk_f32_fp8(w0, true), f2 = __builtin_amdgcn_cvt_pk_f32_fp8(w1, false), f3 = __builtin_amdgcn_cvt_pk_f32_fp8(w1, true);
    f[0] = f0[0]; f[1] = f0[1]; f[2] = f1[0]; f[3] = f1[1]; f[4] = f2[0]; f[5] = f2[1]; f[6] = f3[0]; f[7] = f3[1]; }
__device__ __forceinline__ v4u pack8(const float* f) { v4u w; w.x = cvt_pk_bf16(f[0], f[1]); w.y = cvt_pk_bf16(f[2], f[3]); w.z = cvt_pk_bf16(f[4], f[5]); w.w = cvt_pk_bf16(f[6], f[7]); return w; }
struct EpiInProj {
    static constexpr bool PERM = true, WIDE = true, PRE = false;
    unsigned char* ws;
    __device__ __forceinline__ const float* rowscale_ptr(const pg8::Unit& u) const { return (const float*)(ws + WS_SXN) + u.pm * 256; }
    __device__ __forceinline__ bool fixed_rowscale() const { return false; }
    __device__ __forceinline__ float fixed_rs_value() const { return 1.f; }
    __device__ __forceinline__ const float* colscale(const pg8::Unit& u) const { return (const float*)(ws + WS_SWIN) + u.pn * 256; }
    __device__ __forceinline__ void operator()(const pg8::Acc& acc, const pg8::Unit& u, int wr, int wc, int fr, int fq) const {
        const int pn = u.pn; int seg, t0, ld; size_t boff;
        if (pn < 4) { seg = 0; t0 = 0; boff = WS_QR; ld = 1024; } else if (pn < 8) { seg = 1; t0 = 4; boff = WS_KR; ld = 1024; }
        else if (pn < 16) { seg = 2; t0 = 8; boff = WS_V8; ld = 2048; } else if (pn < 24) { seg = 3; t0 = 16; boff = WS_GR; ld = 2048; }
        else if (pn < 28) { seg = 4; t0 = 24; boff = WS_QD; ld = 1024; } else if (pn < 32) { seg = 5; t0 = 28; boff = WS_KD; ld = 1024; }
        else if (pn < 36) { seg = 6; t0 = 32; boff = WS_VD; ld = 1024; } else { seg = 7; t0 = 36; boff = WS_GT; ld = 2048; }
        bf16_t* base = (bf16_t*)(ws + boff);
        const int tl = pn - t0;
        const int row0 = u.pm * 256 + wr * 64 + fr;
        if (seg <= 1) {
            const int hl = wc >> 1, j0 = 32 * (wc & 1) + 8 * fq, head = 2 * tl + hl;
            const float sc = seg == 1 ? KR_SCALE : 1.f;
            float th[8];
#pragma unroll
            for (int i = 0; i < 8; ++i) th[i] = exp2f(-(float)(j0 + i) * (13.287712379549449f / 63.f));
#pragma unroll
            for (int ai = 0; ai < 2; ++ai)
#pragma unroll
                for (int m = 0; m < 4; ++m) {
                    const int row = row0 + ai * 128 + m * 16; const float pos = (float)(row & (SEQ - 1));
                    float o1[8], o2[8];
#pragma unroll
                    for (int i = 0; i < 8; ++i) {
                        const float t1 = acc[ai][0][m][i >> 2][i & 3], t2 = acc[ai][1][m][i >> 2][i & 3];
                        const float ang = pos * th[i]; const float k = rintf(ang * 0.15915494309189535f);
                        float r = fmaf(-k, 6.2831855f, ang); r = fmaf(-k, -1.7484555e-7f, r);
                        const float rr = r * 0.15915494309189535f;
                        const float c = __builtin_amdgcn_cosf(rr), s = __builtin_amdgcn_sinf(rr);
                        o1[i] = (t1 * c - t2 * s) * sc; o2[i] = (t2 * c + t1 * s) * sc;
                    }
                    bf16_t* rp = base + (size_t)row * ld + head * 128 + j0;
                    v4u w; w.x = cvt_pk_bf16(o1[0], o1[1]); w.y = cvt_pk_bf16(o1[2], o1[3]); w.z = cvt_pk_bf16(o1[4], o1[5]); w.w = cvt_pk_bf16(o1[6], o1[7]);
                    *(v4u*)rp = w;
                    w.x = cvt_pk_bf16(o2[0], o2[1]); w.y = cvt_pk_bf16(o2[2], o2[3]); w.z = cvt_pk_bf16(o2[4], o2[5]); w.w = cvt_pk_bf16(o2[6], o2[7]);
                    *(v4u*)(rp + 64) = w;
                }
        } else {
            const bool lo = fr < 8; const int rl = fr & 7;
            const int colb = tl * 256 + 64 * wc + 8 * fq;
            const bool f8 = (seg == 2 || seg == 3 || seg == 7);
#pragma unroll
            for (int ai = 0; ai < 2; ++ai)
#pragma unroll
                for (int m = 0; m < 4; ++m) {
                    const int rbase = u.pm * 256 + wr * 64 + ai * 128 + m * 16;
                    float vv[2][8];
#pragma unroll
                    for (int bj = 0; bj < 2; ++bj) {
                        f32x4 v0 = acc[ai][bj][m][0], v1 = acc[ai][bj][m][1];
                        if (seg == 3) { for (int i = 0; i < 4; ++i) { v0[i] = fast_silu(v0[i]); v1[i] = fast_silu(v1[i]); } }
                        else if (seg == 7) { for (int i = 0; i < 4; ++i) { v0[i] = fast_sigmoid(v0[i]); v1[i] = fast_sigmoid(v1[i]); } }
                        else if (seg == 4) { v0 = v0 * QD_SCALE; v1 = v1 * QD_SCALE; }
                        else if (seg == 2) { v0 = v0 * V8_SCALE; v1 = v1 * V8_SCALE; }
#pragma unroll
                        for (int i = 0; i < 4; ++i) { vv[bj][i] = v0[i]; vv[bj][4 + i] = v1[i]; }
                    }
                    if (f8) {
                        const unsigned long long p0 = pack8_fp8(vv[0]), p1 = pack8_fp8(vv[1]);
                        const unsigned p1l = (unsigned)p1, p1h = (unsigned)(p1 >> 32);
                        const unsigned tl_ = (unsigned)__builtin_amdgcn_update_dpp(0, (int)p1l, 0x118, 0xf, 0xf, false), th_ = (unsigned)__builtin_amdgcn_update_dpp(0, (int)p1h, 0x118, 0xf, 0xf, false);
                        const unsigned ul_ = (unsigned)__builtin_amdgcn_update_dpp(0, (int)p1l, 0x108, 0xf, 0xf, false), uh_ = (unsigned)__builtin_amdgcn_update_dpp(0, (int)p1h, 0x108, 0xf, 0xf, false);
                        const unsigned long long tt = (unsigned long long)tl_ | ((unsigned long long)th_ << 32), uu = (unsigned long long)ul_ | ((unsigned long long)uh_ << 32);
                        unsigned char* bp = (unsigned char*)base + colb + (lo ? 0 : 32);
                        *(unsigned long long*)(bp + (size_t)(rbase + rl) * 2048) = lo ? p0 : tt;
                        bp = (unsigned char*)base + colb + (lo ? 32 : 0);
                        *(unsigned long long*)(bp + (size_t)(rbase + 8 + rl) * 2048) = lo ? uu : p0;
                    } else {
                        const v4u w0 = pack8(vv[0]), w1 = pack8(vv[1]); v4u tt, uu;
#pragma unroll
                        for (int k = 0; k < 4; ++k) { tt[k] = (unsigned)__builtin_amdgcn_update_dpp(0, (int)w1[k], 0x118, 0xf, 0xf, false); uu[k] = (unsigned)__builtin_amdgcn_update_dpp(0, (int)w1[k], 0x108, 0xf, 0xf, false); }
                        bf16_t* bp = base + colb + (lo ? 0 : 32);
                        *(v4u*)(bp + (size_t)(rbase + rl) * ld) = lo ? w0 : tt;
                        bp = base + colb + (lo ? 32 : 0);
                        *(v4u*)(bp + (size_t)(rbase + 8 + rl) * ld) = lo ? uu : w0;
                    }
                }
        }
    }
};

namespace att {
using f32x16 = __attribute__((ext_vector_type(16))) float;
using s16x4  = __attribute__((ext_vector_type(4))) short;
constexpr int SHM_V = 16384, SHM_K64 = 8192;
constexpr int A_V = 0, A_K = 49152, A_WS = 73728, A_TAB = 75776, A_ST = 77312;
constexpr int R_KS = 0, R_KI = 32768, R_VI = 65536, R_ST = 98304, R_STP = 272, R_OS = 107008;
#define KSWZ(row, colB) ((row) * 256 + ((colB) ^ (((row) & 7) << 4)))
#define KSWZ64(row, colB) ((row) * 128 + ((colB) ^ ((((row) >> 1) & 7) << 4)))
#define SBAR() __builtin_amdgcn_sched_barrier(0)
__device__ __forceinline__ int crow(int r, int hi) { return (r & 3) + 8 * (r >> 2) + 4 * hi; }
__device__ __forceinline__ int v_st(int k, int c) { const int kk = (k & ~0xC) | ((k & 4) << 1) | ((k & 8) >> 1); return ((kk >> 3) * 4 + (c >> 5)) * 512 + ((kk & 7) * 32 + (c & 31)) * 2; }
__device__ __forceinline__ int v_rd_base(int lane) { return ((lane & 3) << 3) | (((lane >> 2) & 3) << 6) | (((lane >> 4) & 1) << 5) | (((lane >> 5) & 1) << 8); }
constexpr int v_rd_off(int d0, int ks, int half) { return d0 * 512 + ks * 4096 + half * 2048; }
template <int OFF> __device__ __forceinline__ s16x4 tr_read(int vb) {
  s16x4 r; asm volatile("ds_read_b64_tr_b16 %0, %1 offset:%2" : "=&v"(r) : "v"(vb), "i"(OFF) : "memory"); return r;
}
#define PKF(L, H) (bf16x8){L[0], L[1], L[2], L[3], H[0], H[1], H[2], H[3]}
template <int D0> __device__ __forceinline__ void pv_one(f32x16& od, int vb, bf16x8 pa0, bf16x8 pa1, bf16x8 pa2, bf16x8 pa3) {
  const s16x4 l0 = tr_read<v_rd_off(D0, 0, 0)>(vb), h0 = tr_read<v_rd_off(D0, 0, 1)>(vb), l1 = tr_read<v_rd_off(D0, 1, 0)>(vb), h1 = tr_read<v_rd_off(D0, 1, 1)>(vb);
  const s16x4 l2 = tr_read<v_rd_off(D0, 2, 0)>(vb), h2 = tr_read<v_rd_off(D0, 2, 1)>(vb), l3 = tr_read<v_rd_off(D0, 3, 0)>(vb), h3 = tr_read<v_rd_off(D0, 3, 1)>(vb);
  asm volatile("s_waitcnt lgkmcnt(0)" ::: "memory"); SBAR();
  od = __builtin_amdgcn_mfma_f32_32x32x16_bf16(pa0, PKF(l0, h0), od, 0, 0, 0);
  od = __builtin_amdgcn_mfma_f32_32x32x16_bf16(pa1, PKF(l1, h1), od, 0, 0, 0);
  od = __builtin_amdgcn_mfma_f32_32x32x16_bf16(pa2, PKF(l2, h2), od, 0, 0, 0);
  od = __builtin_amdgcn_mfma_f32_32x32x16_bf16(pa3, PKF(l3, h3), od, 0, 0, 0);
}
__device__ __forceinline__ void pv_d0(f32x16* o, int vb, bf16x8 pa0, bf16x8 pa1, bf16x8 pa2, bf16x8 pa3) {
  pv_one<0>(o[0], vb, pa0, pa1, pa2, pa3); pv_one<1>(o[1], vb, pa0, pa1, pa2, pa3); pv_one<2>(o[2], vb, pa0, pa1, pa2, pa3); pv_one<3>(o[3], vb, pa0, pa1, pa2, pa3);
}
#define PK4(P, BASE, OUT) do { unsigned a0 = cvt_pk_bf16(P[BASE + 0], P[BASE + 1]), a1 = cvt_pk_bf16(P[BASE + 2], P[BASE + 3]);   \
    unsigned b0 = cvt_pk_bf16(P[BASE + 4], P[BASE + 5]), b1 = cvt_pk_bf16(P[BASE + 6], P[BASE + 7]);                              \
    auto r0 = __builtin_amdgcn_permlane32_swap(a0, b0, false, false); auto r1 = __builtin_amdgcn_permlane32_swap(a1, b1, false, false); \
    v4u w = {r0[0], r1[0], r0[1], r1[1]}; OUT = *reinterpret_cast<bf16x8*>(&w); } while (0)

__device__ __forceinline__ int t5_bucket(int n) {
  if (n < 16) return n;
  int b = 16;
  b += (n >= 19); b += (n >= 21); b += (n >= 24); b += (n >= 27); b += (n >= 31); b += (n >= 35); b += (n >= 40); b += (n >= 46);
  b += (n >= 52); b += (n >= 59); b += (n >= 67); b += (n >= 77); b += (n >= 87); b += (n >= 99); b += (n >= 113);
  return b;
}
constexpr float THR2 = 8.f;
template <bool FIRST>
__device__ __forceinline__ void partialSM(f32x16& p0, f32x16& p1, float& m_reg, float& alpha) {
  float pmax = p0[0];
#pragma unroll
  for (int r = 1; r < 16; ++r) pmax = fmaxf(pmax, p0[r]);
#pragma unroll
  for (int r = 0; r < 16; ++r) pmax = fmaxf(pmax, p1[r]);
  { auto rr = __builtin_amdgcn_permlane32_swap(__float_as_uint(pmax), __float_as_uint(pmax), false, false);
    pmax = fmaxf(__uint_as_float(rr[0]), __uint_as_float(rr[1])); }
  if (FIRST) { m_reg = pmax; alpha = 1.f;
#pragma unroll
    for (int r = 0; r < 16; ++r) { p0[r] = p0[r] - pmax; p1[r] = p1[r] - pmax; } }
  else if (__builtin_expect(__all(pmax <= THR2), 1)) { alpha = 1.f; }
  else { const float d = fmaxf(pmax, 0.f); alpha = __builtin_amdgcn_exp2f(-d); m_reg += d;
#pragma unroll
    for (int r = 0; r < 16; ++r) { p0[r] = p0[r] - d; p1[r] = p1[r] - d; } }
#pragma unroll
  for (int r = 0; r < 16; ++r) p0[r] = __builtin_amdgcn_exp2f(p0[r]);
}
__device__ __forceinline__ void finishSM(f32x16& p0, f32x16& p1, float alpha, float& l_reg, bf16x8& pa0, bf16x8& pa1, bf16x8& pa2, bf16x8& pa3) {
#pragma unroll
  for (int r = 0; r < 16; ++r) p1[r] = __builtin_amdgcn_exp2f(p1[r]);
  f32x2 ps2 = (f32x2){p0[0], p0[1]};
#pragma unroll
  for (int r = 2; r < 16; r += 2) ps2 += (f32x2){p0[r], p0[r + 1]};
#pragma unroll
  for (int r = 0; r < 16; r += 2) ps2 += (f32x2){p1[r], p1[r + 1]};
  float ps = ps2.x + ps2.y;
  { auto rr = __builtin_amdgcn_permlane32_swap(__float_as_uint(ps), __float_as_uint(ps), false, false);
    ps = __uint_as_float(rr[0]) + __uint_as_float(rr[1]); }
  l_reg = l_reg * alpha + ps;
  PK4(p0, 0, pa0); PK4(p0, 8, pa1); PK4(p1, 0, pa2); PK4(p1, 8, pa3);
}
__device__ __forceinline__ void qkt64(f32x16& p0, f32x16& p1, const char* Ks, const bf16x8* qr, int r32, int hi, float init) {
#pragma unroll
  for (int r = 0; r < 16; ++r) { p0[r] = init; p1[r] = init; }
#pragma unroll
  for (int d0 = 0; d0 < 4; ++d0) { const int cb = d0 * 32 + hi * 16;
    const bf16x8 b0 = *reinterpret_cast<const bf16x8*>(Ks + KSWZ64(r32, cb));
    const bf16x8 b1 = *reinterpret_cast<const bf16x8*>(Ks + KSWZ64(32 + r32, cb));
    p0 = __builtin_amdgcn_mfma_f32_32x32x16_bf16(b0, qr[d0], p0, 0, 0, 0);
    p1 = __builtin_amdgcn_mfma_f32_32x32x16_bf16(b1, qr[d0], p1, 0, 0, 0); }
}
__device__ __forceinline__ void bias_mask(f32x16& p0, f32x16& p1, const float* tab, int dbase) {
#pragma unroll
  for (int r = 0; r < 16; ++r) {
    const int d0 = dbase - ((r & 3) + 8 * (r >> 2)), d1 = d0 - 32;
    const float b0 = tab[min(max(d0, 0), 383)], b1 = tab[min(max(d1, 0), 383)];
    p0[r] = d0 >= 0 ? p0[r] + b0 : -INFINITY; p1[r] = d1 >= 0 ? p1[r] + b1 : -INFINITY;
  }
}

__device__ __forceinline__ void attn_unit(int b, int h, int qb, const bf16_t* QD, signed char* OD, const float ad_inv, const bf16_t* __restrict__ KD, const bf16_t* __restrict__ VD,
                                          const float* relb, const float* subg, float lam, char* lds, const int wave_, bf16x8& vs0, bf16x8& vs1, bf16x8& ks, const bool have0) {
  const int wid = __builtin_amdgcn_readfirstlane(wave_); int lane = lane_id(); asm volatile("" : "+v"(lane));
  const int tid = wid * 64 + lane, r32 = lane & 31, hi = lane >> 5;
  char* V_lds = lds + A_V; char* K_lds = lds + A_K;
  float* wsf = (float*)(lds + A_WS) + wid * 64; float* li_l = wsf; float* al_l = wsf + 32;
  float* tab = (float*)(lds + A_TAB);
  unsigned* stash = (unsigned*)(lds + A_ST) + wid * 2048;
  const int q0 = qb * 256; const long rowbase = (long)b * SEQ;
  if (tid < 384) tab[tid] = relb[t5_bucket(tid) * 8 + h] * LOG2E;
  const float c31 = relb[31 * 8 + h] * LOG2E;
  const int NT = 4 * (qb + 1);
  const int sr = tid >> 4, sc = (tid & 15) * 8, vst0 = v_st(sr, sc), vst1 = v_st(32 + sr, sc);
  const int kr = tid >> 3, kcb = (tid & 7) * 16, kst = KSWZ64(kr, kcb);
  const int vb0 = (int)(uintptr_t)V_lds + v_rd_base(lane);
  const int qw = q0 + wid * 32;
  f32x16 o[4];
  bf16x8 qr[4];
  for (int m = 0; m < 2; ++m) {
    const bf16_t* Kh = KD + rowbase * 1024 + h * 128 + m * 64; const bf16_t* Vh = VD + rowbase * 1024 + h * 128;
    const bf16_t* Qw = QD + (rowbase + qw + r32) * 1024 + h * 128 + m * 64 + hi * 8;
#pragma unroll
    for (int d0 = 0; d0 < 4; ++d0) qr[d0] = *reinterpret_cast<const bf16x8*>(Qw + d0 * 16);
    float m_reg = 0.f, l_reg = 0;
#pragma unroll
    for (int d = 0; d < 4; ++d)
#pragma unroll
      for (int r = 0; r < 16; ++r) o[d][r] = 0.f;
    const unsigned vo0 = (unsigned)(sr * 1024 + sc) * 2u, vo1 = vo0 + 32u * 2048u, ko = (unsigned)(kr * 1024 + (tid & 7) * 8) * 2u;
    const __amdgpu_buffer_rsrc_t rsV = __builtin_amdgcn_make_buffer_rsrc((void*)Vh, 0, SEQ * 2048, 0x00020000), rsK = __builtin_amdgcn_make_buffer_rsrc((void*)Kh, 0, SEQ * 2048, 0x00020000);
#define SLOAD(k0) do { const int so_ = (k0) * 2048; vs0 = __builtin_bit_cast(bf16x8, __builtin_amdgcn_raw_buffer_load_b128(rsV, vo0, so_, 0)); \
    vs1 = __builtin_bit_cast(bf16x8, __builtin_amdgcn_raw_buffer_load_b128(rsV, vo1, so_, 0)); ks = __builtin_bit_cast(bf16x8, __builtin_amdgcn_raw_buffer_load_b128(rsK, ko, so_, 0)); } while (0)
#define SWRITE(bb) do { *(bf16x8*)(V_lds + (bb) * SHM_V + vst0) = vs0; *(bf16x8*)(V_lds + (bb) * SHM_V + vst1) = vs1; \
    *(bf16x8*)(K_lds + (bb) * SHM_K64 + kst) = ks; } while (0)
    const int E = (qb >= 1) ? 4 * qb - 4 : -1;
    if (E >= 0) {
      f32x16 pA0, pA1, pB0, pB1; float alA, alB; bf16x8 pa0, pa1, pa2, pa3;
#define RESC(a) do { if (__any((a) < 1.f)) { if (hi == 0) al_l[r32] = (a); asm volatile("s_waitcnt lgkmcnt(0)" ::: "memory"); \
    _Pragma("unroll") for (int d = 0; d < 4; ++d) _Pragma("unroll") for (int r = 0; r < 16; ++r) o[d][r] *= al_l[crow(r, hi)]; } } while (0)
      if (m == 0 && !have0) SLOAD(0);
      SWRITE(0); SLOAD(64); __syncthreads();
      qkt64(pA0, pA1, K_lds, qr, r32, hi, c31); partialSM<true>(pA0, pA1, m_reg, alA);
      SWRITE(1); SLOAD(2 * 64); __syncthreads();
      int sK = SHM_K64, sV = 0, sW = 2;
      for (int j = 1; j + 1 <= E; j += 2) {
        SBAR(); qkt64(pB0, pB1, K_lds + sK, qr, r32, hi, c31 - m_reg);
        finishSM(pA0, pA1, alA, l_reg, pa0, pa1, pa2, pa3); SBAR();
        SWRITE(sW); SLOAD((j + 2) * 64); SBAR();
        pv_d0(o, vb0 + sV, pa0, pa1, pa2, pa3); partialSM<false>(pB0, pB1, m_reg, alB);
        RESC(alB); __syncthreads();
        sK = (sK == 2 * SHM_K64) ? 0 : sK + SHM_K64; sV = (sV == 2 * SHM_V) ? 0 : sV + SHM_V; sW = (sW == 2) ? 0 : sW + 1;
        SBAR(); qkt64(pA0, pA1, K_lds + sK, qr, r32, hi, c31 - m_reg);
        finishSM(pB0, pB1, alB, l_reg, pa0, pa1, pa2, pa3); SBAR();
        SWRITE(sW); SLOAD((j + 3) * 64); SBAR();
        pv_d0(o, vb0 + sV, pa0, pa1, pa2, pa3); partialSM<false>(pA0, pA1, m_reg, alA);
        RESC(alA); __syncthreads();
        sK = (sK == 2 * SHM_K64) ? 0 : sK + SHM_K64; sV = (sV == 2 * SHM_V) ? 0 : sV + SHM_V; sW = (sW == 2) ? 0 : sW + 1;
      }
      finishSM(pA0, pA1, alA, l_reg, pa0, pa1, pa2, pa3); SBAR();
      pv_d0(o, vb0 + sV, pa0, pa1, pa2, pa3);
      __syncthreads();
#undef RESC
    } else {
      if (m == 0 && !have0) SLOAD(0);
      SWRITE(0); SLOAD(64); __syncthreads();
    }
    for (int t = E + 1; t < NT; ++t) {
      const int bb = t % 3, bn = (t + 1) % 3;
      const bool far = (qw - 64 * t - 63) >= 128;
      if (64 * t <= qw + 31) {
      f32x16 p0, p1; float al; bf16x8 pa0, pa1, pa2, pa3;
      const bool first = (E < 0) && (t == 0);
      qkt64(p0, p1, K_lds + bb * SHM_K64, qr, r32, hi, (far ? c31 : 0.f) - (first ? 0.f : m_reg));
      if (!far) bias_mask(p0, p1, tab, qw + r32 - 64 * t - 4 * hi);
      if (first) partialSM<true>(p0, p1, m_reg, al); else partialSM<false>(p0, p1, m_reg, al);
      if (__any(al < 1.f)) { if (hi == 0) al_l[r32] = al; asm volatile("s_waitcnt lgkmcnt(0)" ::: "memory");
#pragma unroll
        for (int d = 0; d < 4; ++d)
#pragma unroll
          for (int r = 0; r < 16; ++r) o[d][r] *= al_l[crow(r, hi)]; }
      finishSM(p0, p1, al, l_reg, pa0, pa1, pa2, pa3); SBAR();
      pv_d0(o, vb0 + bb * SHM_V, pa0, pa1, pa2, pa3);
      }
      if (t + 1 < NT) { SWRITE(bn); if (t + 2 < NT) SLOAD((t + 2) * 64); }
      __syncthreads();
    }
    {
      const __amdgpu_buffer_rsrc_t rsKn = __builtin_amdgcn_make_buffer_rsrc((void*)(m == 0 ? Kh + 64 : Kh - 64), 0, SEQ * 2048, 0x00020000);
      vs0 = __builtin_bit_cast(bf16x8, __builtin_amdgcn_raw_buffer_load_b128(rsV, vo0, 0, 0)); vs1 = __builtin_bit_cast(bf16x8, __builtin_amdgcn_raw_buffer_load_b128(rsV, vo1, 0, 0));
      ks = __builtin_bit_cast(bf16x8, __builtin_amdgcn_raw_buffer_load_b128(rsKn, ko, 0, 0)); }
#undef SLOAD
#undef SWRITE
    if (hi == 0) li_l[r32] = l_reg; asm volatile("s_waitcnt lgkmcnt(0)" ::: "memory");
    float rli[16];
#pragma unroll
    for (int r = 0; r < 16; ++r) rli[r] = __builtin_amdgcn_rcpf(li_l[crow(r, hi)]);
    if (m == 0) {
#pragma unroll
      for (int d = 0; d < 4; ++d)
#pragma unroll
        for (int r = 0; r < 16; r += 2) stash[(d * 8 + (r >> 1)) * 64 + lane] = pk2(o[d][r] * rli[r], o[d][r + 1] * rli[r + 1]);
    } else {
      float ss[16];
#pragma unroll
      for (int r = 0; r < 16; ++r) ss[r] = 0.f;
#pragma unroll
      for (int d = 0; d < 4; ++d)
#pragma unroll
        for (int r = 0; r < 16; r += 2) { const unsigned w = stash[(d * 8 + (r >> 1)) * 64 + lane];
          o[d][r] = bflo(w) - lam * o[d][r] * rli[r]; o[d][r + 1] = bfhi(w) - lam * o[d][r + 1] * rli[r + 1];
          ss[r] += o[d][r] * o[d][r]; ss[r + 1] += o[d][r + 1] * o[d][r + 1]; }
#pragma unroll
      for (int off = 1; off < 32; off <<= 1)
#pragma unroll
        for (int r = 0; r < 16; ++r) ss[r] += __shfl_xor(ss[r], off);
      float gv[4];
#pragma unroll
      for (int d = 0; d < 4; ++d) gv[d] = subg[d * 32 + r32] * 0.8f;
      char* stg = (char*)stash;
#pragma unroll
      for (int r = 0; r < 16; ++r) { const float rs = 1.f / sqrtf(ss[r] * (1.f / 128.f) + LN_EPS); const int orow = crow(r, hi);
#pragma unroll
        for (int d = 0; d < 4; ++d) *(signed char*)(stg + orow * 128 + d * 32 + r32) = (signed char)(int)rintf(fminf(fmaxf(o[d][r] * rs * gv[d] * ad_inv, -127.f), 127.f)); }
      asm volatile("s_waitcnt lgkmcnt(0)" ::: "memory");
      char* Ob = (char*)OD + ((size_t)(rowbase + qw) * 1024 + h * 128) + (size_t)(lane >> 3) * 1024 + (lane & 7) * 16;
#pragma unroll
      for (int i = 0; i < 4; ++i) { const v4u v = *(const v4u*)(stg + (i * 8 + (lane >> 3)) * 128 + (lane & 7) * 16); *(v4u*)(Ob + (size_t)i * 8192) = v; }
    }
    __syncthreads();
  }
}

__device__ __forceinline__ void ret_chain(int b, int h, int j, const bf16_t* __restrict__ QR, const bf16_t* __restrict__ KR, const bf16_t* VR, bf16_t* VRo, const long omask, f32x2* gnst, char* lds, const int wave_) {
  const int wid = __builtin_amdgcn_readfirstlane(wave_); int lane = lane_id(); asm volatile("" : "+v"(lane));
  const int tid = wid * 64 + lane, r32 = lane & 31, hi = lane >> 5;
  char* KS = lds + R_KS; char* KI = lds + R_KI; char* VI = lds + R_VI; char* ST = lds + R_ST;
  const float lg = log2f(1.f - exp2f(-5.f - (float)h));
  const float c_dec = exp2f(128.f * lg);
  const long rowbase = (long)b * SEQ;
  for (int i = tid; i < 32 * R_STP / 4; i += 512) ((unsigned*)ST)[i] = 0u;
  const int sr = tid >> 4, sc = (tid & 15) * 8;
  const int vt = tid >> 2, vc = (tid & 3) * 8;
  const bf16_t* Kg = KR + rowbase * 1024 + h * 128 + sc;
  const bf16_t* Vg = VR + rowbase * 2048 + h * 256 + j * 32 + vc;
  const bf16_t* Qg = QR + (rowbase + (wid & 3) * 32 + r32) * 1024 + h * 128 + hi * 8;
  const int vbV = (int)(uintptr_t)VI + v_rd_base(lane);
  const int vbK = (int)(uintptr_t)KI + v_rd_base(lane) + (wid & 3) * 512;
  const float kd = exp2f((float)(127 - vt) * lg);
  bf16x8 kreg[4], vreg;
#pragma unroll
  for (int i = 0; i < 4; ++i) kreg[i] = *reinterpret_cast<const bf16x8*>(Kg + (long)(sr + 32 * i) * 1024);
  vreg = *reinterpret_cast<const bf16x8*>(Vg + (long)vt * 2048);
  f32x16 sacc;
#pragma unroll
  for (int r = 0; r < 16; ++r) sacc[r] = 0.f;
  bf16x8 qr[8];
#pragma unroll
  for (int d0 = 0; d0 < 8; ++d0) qr[d0] = *reinterpret_cast<const bf16x8*>(Qg + d0 * 16);
  for (int n = 0; n < SEQ / 128; ++n) {
    const long t0 = (long)n * 128;
    float lgv = lg; asm volatile("" : "+v"(lgv));
#pragma unroll
    for (int i = 0; i < 4; ++i) { const int tok = sr + 32 * i;
      *(bf16x8*)(KS + KSWZ(tok, sc * 2)) = kreg[i];
      *(bf16x8*)(KI + (i >> 1) * SHM_V + v_st(tok & 63, sc)) = kreg[i]; }
    { *(bf16x8*)(VI + (vt >> 6) * SHM_V + v_st(vt & 63, vc)) = vreg;
      bf16x8 vd;
#pragma unroll
      for (int e = 0; e < 8; ++e) vd[e] = (short)f2bf(bf2f((unsigned short)vreg[e]) * kd);
      *(bf16x8*)(VI + (vt >> 6) * SHM_V + v_st(vt & 63, 32 + vc)) = vd; }
    if (n + 1 < SEQ / 128) {
#pragma unroll
      for (int i = 0; i < 4; ++i) kreg[i] = *reinterpret_cast<const bf16x8*>(Kg + (t0 + 128 + sr + 32 * i) * 1024);
      vreg = *reinterpret_cast<const bf16x8*>(Vg + (t0 + 128 + vt) * 2048);
    }
    __syncthreads();
    if (wid < 4) {
      f32x16 acc;
#pragma unroll
      for (int r = 0; r < 16; ++r) acc[r] = 0.f;
#pragma unroll
      for (int d0 = 0; d0 < 8; ++d0) { const bf16x8 bs = *reinterpret_cast<const bf16x8*>(ST + r32 * R_STP + (16 * d0 + 8 * hi) * 2);
        acc = __builtin_amdgcn_mfma_f32_32x32x16_bf16(qr[d0], bs, acc, 0, 0, 0); }
#pragma unroll
      for (int r = 0; r < 16; ++r) acc[r] *= __builtin_amdgcn_exp2f((float)(32 * wid + crow(r, hi) + 1) * lgv);
#define RET_KB(kb) if ((kb) <= wid) { f32x16 p; _Pragma("unroll") for (int r = 0; r < 16; ++r) p[r] = 0.f; \
        _Pragma("unroll") for (int d0 = 0; d0 < 8; ++d0) { const bf16x8 kf = *reinterpret_cast<const bf16x8*>(KS + KSWZ(32 * (kb) + r32, (16 * d0 + 8 * hi) * 2)); \
          p = __builtin_amdgcn_mfma_f32_32x32x16_bf16(kf, qr[d0], p, 0, 0, 0); } \
        _Pragma("unroll") for (int r = 0; r < 16; ++r) { const int rel = 32 * (wid - (kb)) + r32 - crow(r, hi); p[r] = rel >= 0 ? p[r] * __builtin_amdgcn_exp2f((float)rel * lgv) : 0.f; } \
        bf16x8 pa0, pa1; PK4(p, 0, pa0); PK4(p, 8, pa1); \
        const s16x4 l0 = tr_read<v_rd_off(0, ((kb) & 1) * 2 + 0, 0) + ((kb) >> 1) * SHM_V>(vbV), h0 = tr_read<v_rd_off(0, ((kb) & 1) * 2 + 0, 1) + ((kb) >> 1) * SHM_V>(vbV); \
        const s16x4 l1 = tr_read<v_rd_off(0, ((kb) & 1) * 2 + 1, 0) + ((kb) >> 1) * SHM_V>(vbV), h1 = tr_read<v_rd_off(0, ((kb) & 1) * 2 + 1, 1) + ((kb) >> 1) * SHM_V>(vbV); \
        asm volatile("s_waitcnt lgkmcnt(0)" ::: "memory"); SBAR(); \
        acc = __builtin_amdgcn_mfma_f32_32x32x16_bf16(pa0, PKF(l0, h0), acc, 0, 0, 0); \
        acc = __builtin_amdgcn_mfma_f32_32x32x16_bf16(pa1, PKF(l1, h1), acc, 0, 0, 0); }
      RET_KB(0) RET_KB(1) RET_KB(2) RET_KB(3)
#undef RET_KB
      if (n + 1 < SEQ / 128) {
#pragma unroll
        for (int d0 = 0; d0 < 8; ++d0) qr[d0] = *reinterpret_cast<const bf16x8*>(Qg + (t0 + 128) * 1024 + d0 * 16);
      }
      char* stg = lds + R_OS + wid * 2048;
#pragma unroll
      for (int r = 0; r < 16; ++r) *(bf16_t*)(stg + crow(r, hi) * 64 + r32 * 2) = (bf16_t)f2bf(acc[r]);
      asm volatile("s_waitcnt lgkmcnt(0)" ::: "memory");
      { const v4u v0 = *(const v4u*)(stg + (lane >> 1) * 64 + (lane & 1) * 32), v1 = *(const v4u*)(stg + (lane >> 1) * 64 + (lane & 1) * 32 + 16);
        const long orow = rowbase + t0 + 32 * wid + (lane >> 1);
        char* Ob = (char*)(VRo + (orow & omask) * 2048 + h * 256 + j * 32) + (lane & 1) * 32;
        *(v4u*)Ob = v0; *(v4u*)(Ob + 16) = v1;
        float s1 = 0.f, s2 = 0.f;
#pragma unroll
        for (int e = 0; e < 4; ++e) { const float a0 = bflo(v0[e]), a1 = bfhi(v0[e]), a2 = bflo(v1[e]), a3 = bfhi(v1[e]);
          s1 += (a0 + a1) + (a2 + a3); s2 += (a0 * a0 + a1 * a1) + (a2 * a2 + a3 * a3); }
        s1 += __shfl_xor(s1, 1); s2 += __shfl_xor(s2, 1);
        if ((lane & 1) == 0) gnst[((size_t)j * NTOK + orow) * 8 + h] = (f32x2){s1, s2}; }
    } else {
#pragma unroll
      for (int r = 0; r < 16; ++r) sacc[r] *= c_dec;
#define RET_KS(im, ks) { const s16x4 al = tr_read<v_rd_off(1, ks, 0) + (im) * SHM_V>(vbV), ah = tr_read<v_rd_off(1, ks, 1) + (im) * SHM_V>(vbV); \
        const s16x4 bl = tr_read<v_rd_off(0, ks, 0) + (im) * SHM_V>(vbK), bh = tr_read<v_rd_off(0, ks, 1) + (im) * SHM_V>(vbK); \
        asm volatile("s_waitcnt lgkmcnt(0)" ::: "memory"); SBAR(); \
        sacc = __builtin_amdgcn_mfma_f32_32x32x16_bf16(PKF(al, ah), PKF(bl, bh), sacc, 0, 0, 0); }
      RET_KS(0, 0) RET_KS(0, 1) RET_KS(0, 2) RET_KS(0, 3) RET_KS(1, 0) RET_KS(1, 1) RET_KS(1, 2) RET_KS(1, 3)
#undef RET_KS
    }
    __syncthreads();
    if (wid >= 4) {
#pragma unroll
      for (int r = 0; r < 16; ++r) *(bf16_t*)(ST + crow(r, hi) * R_STP + (32 * (wid - 4) + r32) * 2) = (bf16_t)f2bf(sacc[r]);
    }
  }
  __syncthreads();
}
__device__ __forceinline__ bf16x8 f8_to_bf8(const unsigned long long w) { float f[8]; unpack8_fp8(w, f); v4u o;
#pragma unroll
  for (int k = 0; k < 4; ++k) o[k] = cvtpk_(f[2 * k] * (1.f / V8_SCALE), f[2 * k + 1] * (1.f / V8_SCALE));
  return __builtin_bit_cast(bf16x8, o); }
constexpr int R2_KS = 0, R2_KI = 32768, R2_VI = 65536, R2_ST = 98304, R2_OS = R2_ST + 4 * 32 * R_STP;
constexpr int RA_KI = 0, RA_VI = 32768;
__device__ __forceinline__ bf16x8 scale8(bf16x8 v, float f) { bf16x8 o;
#pragma unroll
  for (int e = 0; e < 8; ++e) o[e] = (short)f2bf(bf2f((unsigned short)v[e]) * f);
  return o; }
#define RET_KS2(sa, S, im, ks) { const s16x4 al = tr_read<v_rd_off(S, ks, 0) + (im) * SHM_V>(vbV), ah = tr_read<v_rd_off(S, ks, 1) + (im) * SHM_V>(vbV); \
        const s16x4 bl = tr_read<v_rd_off(0, ks, 0) + (im) * SHM_V>(vbK), bh = tr_read<v_rd_off(0, ks, 1) + (im) * SHM_V>(vbK); \
        asm volatile("s_waitcnt lgkmcnt(0)" ::: "memory"); SBAR(); \
        sa = __builtin_amdgcn_mfma_f32_32x32x16_bf16(PKF(al, ah), PKF(bl, bh), sa, 0, 0, 0); }
template <int S> __device__ __forceinline__ void ret_state_slice(f32x16& sa, const float c_dec, const int vbV, const int vbK) {
#pragma unroll
  for (int r = 0; r < 16; ++r) sa[r] *= c_dec;
  RET_KS2(sa, S, 0, 0) RET_KS2(sa, S, 0, 1) RET_KS2(sa, S, 0, 2) RET_KS2(sa, S, 0, 3) RET_KS2(sa, S, 1, 0) RET_KS2(sa, S, 1, 1) RET_KS2(sa, S, 1, 2) RET_KS2(sa, S, 1, 3)
}
__device__ __forceinline__ void ret_passA(int b, int h, int seg, const bf16_t* __restrict__ KR, const unsigned char* __restrict__ V8, bf16_t* Sloc, char* lds, const int wave_) {
  const int wid = __builtin_amdgcn_readfirstlane(wave_); int lane = lane_id(); asm volatile("" : "+v"(lane));
  const int tid = wid * 64 + lane;
  char* KI = lds + RA_KI; char* VI = lds + RA_VI;
  const float lg = log2f(1.f - exp2f(-5.f - (float)h));
  const float c_dec = exp2f(128.f * lg);
  const long rowbase = (long)b * SEQ + (long)seg * 1024;
  const int sr = tid >> 4, sc = (tid & 15) * 8;
  const int vtk = tid >> 5, vcl = (tid & 31) * 8;
  const bf16_t* Kg = KR + rowbase * 1024 + h * 128 + sc;
  const unsigned char* Vg = V8 + (rowbase + vtk) * 2048 + h * 256 + vcl;
  const int vbV = (int)(uintptr_t)VI + v_rd_base(lane) + (wid >> 2) * 2 * SHM_V;
  const int vbK = (int)(uintptr_t)KI + v_rd_base(lane) + (wid & 3) * 512;
  bf16x8 kreg[4]; unsigned long long vreg[8];
#pragma unroll
  for (int i = 0; i < 4; ++i) kreg[i] = *reinterpret_cast<const bf16x8*>(Kg + (long)(sr + 32 * i) * 1024);
#pragma unroll
  for (int e = 0; e < 8; ++e) vreg[e] = *reinterpret_cast<const unsigned long long*>(Vg + (long)(16 * e) * 2048);
  f32x16 sacc[4];
#pragma unroll
  for (int s = 0; s < 4; ++s)
#pragma unroll
    for (int r = 0; r < 16; ++r) sacc[s][r] = 0.f;
  for (int n = 0; n < 8; ++n) {
    const long t0 = (long)n * 128;
    float lgv = lg; asm volatile("" : "+v"(lgv));
#pragma unroll
    for (int i = 0; i < 4; ++i) { const int tok = sr + 32 * i;
      *(bf16x8*)(KI + (i >> 1) * SHM_V + v_st(tok & 63, sc)) = scale8(kreg[i], __builtin_amdgcn_exp2f((float)(127 - tok) * lgv)); }
#pragma unroll
    for (int e = 0; e < 8; ++e) { const int tok = vtk + 16 * e;
      *(bf16x8*)(VI + ((vcl >> 7) * 2 + (tok >> 6)) * SHM_V + v_st(tok & 63, vcl & 127)) = f8_to_bf8(vreg[e]); }
    if (n + 1 < 8) {
#pragma unroll
      for (int i = 0; i < 4; ++i) kreg[i] = *reinterpret_cast<const bf16x8*>(Kg + (t0 + 128 + sr + 32 * i) * 1024);
#pragma unroll
      for (int e = 0; e < 8; ++e) vreg[e] = *reinterpret_cast<const unsigned long long*>(Vg + (t0 + 128 + 16 * e) * 2048);
    }
    __syncthreads();
    ret_state_slice<0>(sacc[0], c_dec, vbV, vbK); ret_state_slice<1>(sacc[1], c_dec, vbV, vbK); ret_state_slice<2>(sacc[2], c_dec, vbV, vbK); ret_state_slice<3>(sacc[3], c_dec, vbV, vbK);
    __syncthreads();
  }
#pragma unroll
  for (int s = 0; s < 4; ++s) { const int tile = (4 * (wid >> 2) + s) * 4 + (wid & 3); v4u o0, o1;
    o0.x = pk2(sacc[s][0], sacc[s][1]); o0.y = pk2(sacc[s][2], sacc[s][3]); o0.z = pk2(sacc[s][4], sacc[s][5]); o0.w = pk2(sacc[s][6], sacc[s][7]);
    o1.x = pk2(sacc[s][8], sacc[s][9]); o1.y = pk2(sacc[s][10], sacc[s][11]); o1.z = pk2(sacc[s][12], sacc[s][13]); o1.w = pk2(sacc[s][14], sacc[s][15]);
    v4u* dst = (v4u*)(Sloc + ((size_t)tile * 64 + lane) * 16); dst[0] = o0; dst[1] = o1; }
}
template <int S> __device__ __forceinline__ void ret_out_slice(const bf16x8* qr, const bf16x8 (&pa)[4][2], const float* qdv, const char* ST, const int vbV, char* stg, bf16_t* Orow, f32x2* gn, const int wid, int lane) {
  asm volatile("" : "+v"(lane));
  const int r32 = lane & 31, hi = lane >> 5;
  f32x16 acc;
#pragma unroll
  for (int r = 0; r < 16; ++r) acc[r] = 0.f;
#pragma unroll
  for (int d0 = 0; d0 < 8; ++d0) { const bf16x8 bs = *reinterpret_cast<const bf16x8*>(ST + (32 * S + r32) * R_STP + (16 * d0 + 8 * hi) * 2);
    acc = __builtin_amdgcn_mfma_f32_32x32x16_bf16(qr[d0], bs, acc, 0, 0, 0); }
#pragma unroll
  for (int r = 0; r < 16; ++r) acc[r] *= qdv[r];
#define RET_PV2(kb) if ((kb) <= wid) { \
    const s16x4 l0 = tr_read<v_rd_off(S, ((kb) & 1) * 2 + 0, 0) + ((kb) >> 1) * SHM_V>(vbV), h0 = tr_read<v_rd_off(S, ((kb) & 1) * 2 + 0, 1) + ((kb) >> 1) * SHM_V>(vbV); \
    const s16x4 l1 = tr_read<v_rd_off(S, ((kb) & 1) * 2 + 1, 0) + ((kb) >> 1) * SHM_V>(vbV), h1 = tr_read<v_rd_off(S, ((kb) & 1) * 2 + 1, 1) + ((kb) >> 1) * SHM_V>(vbV); \
    asm volatile("s_waitcnt lgkmcnt(0)" ::: "memory"); SBAR(); \
    acc = __builtin_amdgcn_mfma_f32_32x32x16_bf16(pa[kb][0], PKF(l0, h0), acc, 0, 0, 0); \
    acc = __builtin_amdgcn_mfma_f32_32x32x16_bf16(pa[kb][1], PKF(l1, h1), acc, 0, 0, 0); }
  RET_PV2(0) RET_PV2(1) RET_PV2(2) RET_PV2(3)
#undef RET_PV2
#pragma unroll
  for (int r = 0; r < 16; ++r) *(bf16_t*)(stg + crow(r, hi) * 64 + r32 * 2) = (bf16_t)f2bf(acc[r]);
  asm volatile("s_waitcnt lgkmcnt(0)" ::: "memory");
  { const v4u v0 = *(const v4u*)(stg + (lane >> 1) * 64 + (lane & 1) * 32), v1 = *(const v4u*)(stg + (lane >> 1) * 64 + (lane & 1) * 32 + 16);
    char* Ob = (char*)(Orow + (size_t)(lane >> 1) * 2048) + (lane & 1) * 32;
    *(v4u*)Ob = v0; *(v4u*)(Ob + 16) = v1;
    float s1 = 0.f, s2 = 0.f;
#pragma unroll
    for (int e = 0; e < 4; ++e) { const float a0 = bflo(v0[e]), a1 = bfhi(v0[e]), a2 = bflo(v1[e]), a3 = bfhi(v1[e]);
      s1 += (a0 + a1) + (a2 + a3); s2 += (a0 * a0 + a1 * a1) + (a2 * a2 + a3 * a3); }
    s1 += __shfl_xor(s1, 1); s2 += __shfl_xor(s2, 1);
    if ((lane & 1) == 0) gn[(size_t)(lane >> 1) * 8] = (f32x2){s1, s2}; }
  asm volatile("s_waitcnt lgkmcnt(0)" ::: "memory");
}
__device__ __forceinline__ void ret_passB(int b, int h, int seg, const bf16_t* __restrict__ QR, const bf16_t* __restrict__ KR, const unsigned char* __restrict__ V8, bf16_t* VR, const bf16_t* Sall, f32x2* gnst, char* lds, const int wave_) {
  const int wid = __builtin_amdgcn_readfirstlane(wave_);
  char* KS = lds + R2_KS; char* KI = lds + R2_KI; char* VI = lds + R2_VI; char* ST = lds + R2_ST;
  const float lg = log2f(1.f - exp2f(-5.f - (float)h));
  const float c_dec = exp2f(128.f * lg);
  const long rowbase = (long)b * SEQ + (long)seg * 1024;
#define R2_LANE() int lane = lane_id(); asm volatile("" : "+v"(lane)); const int tid = wid * 64 + lane, r32 = lane & 31, hi = lane >> 5; (void)r32; (void)hi; \
  const int sr = tid >> 4, sc = (tid & 15) * 8, vtk = tid >> 4, vcl = (tid & 15) * 8; \
  const bf16_t* Kg = KR + rowbase * 1024 + h * 128 + sc; const unsigned char* Vg = V8 + (rowbase + vtk) * 2048 + h * 256 + vcl; \
  const int vbV = (int)(uintptr_t)VI + v_rd_base(lane); const int vbK = (int)(uintptr_t)KI + v_rd_base(lane) + (wid & 3) * 512; (void)vbK;
  bf16x8 kreg[4]; unsigned long long vreg[4];
  { R2_LANE();
#pragma unroll
    for (int i = 0; i < 4; ++i) kreg[i] = *reinterpret_cast<const bf16x8*>(Kg + (long)(sr + 32 * i) * 1024);
#pragma unroll
    for (int e = 0; e < 4; ++e) vreg[e] = *reinterpret_cast<const unsigned long long*>(Vg + (long)(32 * e) * 2048); }
#define R2_STAGE_A() do { _Pragma("unroll") for (int i = 0; i < 4; ++i) { const int tok = sr + 32 * i; \
      *(bf16x8*)(KS + KSWZ(tok, sc * 2)) = kreg[i]; \
      *(bf16x8*)(KI + (i >> 1) * SHM_V + v_st(tok & 63, sc)) = scale8(kreg[i], __builtin_amdgcn_exp2f((float)(127 - tok) * lgv)); } \
    _Pragma("unroll") for (int e = 0; e < 4; ++e) { const int tok = vtk + 32 * e; *(bf16x8*)(VI + (tok >> 6) * SHM_V + v_st(tok & 63, vcl)) = f8_to_bf8(vreg[e]); } } while (0)
#define R2_STAGE_B() do { _Pragma("unroll") for (int e = 0; e < 4; ++e) { const int tok = vtk + 32 * e; *(bf16x8*)(VI + (tok >> 6) * SHM_V + v_st(tok & 63, vcl)) = f8_to_bf8(vreg[e]); } } while (0)
#define R2_PREF_A() do { if (n + 1 < 8) { _Pragma("unroll") for (int i = 0; i < 4; ++i) kreg[i] = *reinterpret_cast<const bf16x8*>(Kg + (t0 + 128 + sr + 32 * i) * 1024); } \
      _Pragma("unroll") for (int e = 0; e < 4; ++e) vreg[e] = *reinterpret_cast<const unsigned long long*>(Vg + (t0 + 32 * e) * 2048 + 128); } while (0)
#define R2_PREF_B() do { if (n + 1 < 8) { _Pragma("unroll") for (int e = 0; e < 4; ++e) vreg[e] = *reinterpret_cast<const unsigned long long*>(Vg + (t0 + 128 + 32 * e) * 2048); } } while (0)
  if (wid < 4) {
    bf16x8 qr[8];
    { R2_LANE(); const bf16_t* Qg = QR + (rowbase + wid * 32 + r32) * 1024 + h * 128 + hi * 8;
#pragma unroll
      for (int d0 = 0; d0 < 8; ++d0) qr[d0] = *reinterpret_cast<const bf16x8*>(Qg + d0 * 16); }
    char* stg = lds + R2_OS + wid * 2048;
    for (int n = 0; n < 8; ++n) {
      const long t0 = (long)n * 128;
      float lgv = lg; asm volatile("" : "+v"(lgv));
      R2_LANE();
      R2_STAGE_A(); R2_PREF_A();
      __syncthreads();
      bf16x8 pa[4][2]; float qdv[16];
      bf16_t* Orow = VR + (rowbase + t0 + 32 * wid) * 2048 + h * 256;
      f32x2* gn = gnst + ((size_t)(rowbase + t0 + 32 * wid)) * 8 + h;
#define RET_SC2(kb) if ((kb) <= wid) { f32x16 p; _Pragma("unroll") for (int r = 0; r < 16; ++r) p[r] = 0.f; \
        _Pragma("unroll") for (int d0 = 0; d0 < 8; ++d0) { const bf16x8 kf = *reinterpret_cast<const bf16x8*>(KS + KSWZ(32 * (kb) + r32, (16 * d0 + 8 * hi) * 2)); \
          p = __builtin_amdgcn_mfma_f32_32x32x16_bf16(kf, qr[d0], p, 0, 0, 0); } \
        _Pragma("unroll") for (int r = 0; r < 16; ++r) { const int rel = 32 * (wid - (kb)) + r32 - crow(r, hi); p[r] = rel >= 0 ? p[r] * __builtin_amdgcn_exp2f((float)rel * lgv) : 0.f; } \
        PK4(p, 0, pa[kb][0]); PK4(p, 8, pa[kb][1]); }
      RET_SC2(0) RET_SC2(1) RET_SC2(2) RET_SC2(3)
#undef RET_SC2
#pragma unroll
      for (int r = 0; r < 16; ++r) qdv[r] = __builtin_amdgcn_exp2f((float)(32 * wid + crow(r, hi) + 1) * lgv);
      ret_out_slice<0>(qr, pa, qdv, ST, vbV, stg, Orow + 0 * 32, gn + (size_t)0 * NTOK * 8, wid, lane);
      ret_out_slice<1>(qr, pa, qdv, ST, vbV, stg, Orow + 1 * 32, gn + (size_t)1 * NTOK * 8, wid, lane);
      ret_out_slice<2>(qr, pa, qdv, ST, vbV, stg, Orow + 2 * 32, gn + (size_t)2 * NTOK * 8, wid, lane);
      ret_out_slice<3>(qr, pa, qdv, ST, vbV, stg, Orow + 3 * 32, gn + (size_t)3 * NTOK * 8, wid, lane);
      __syncthreads();
      R2_STAGE_B(); R2_PREF_B();
      __syncthreads();
      ret_out_slice<0>(qr, pa, qdv, ST, vbV, stg, Orow + 4 * 32, gn + (size_t)4 * NTOK * 8, wid, lane);
      ret_out_slice<1>(qr, pa, qdv, ST, vbV, stg, Orow + 5 * 32, gn + (size_t)5 * NTOK * 8, wid, lane);
      ret_out_slice<2>(qr, pa, qdv, ST, vbV, stg, Orow + 6 * 32, gn + (size_t)6 * NTOK * 8, wid, lane);
      ret_out_slice<3>(qr, pa, qdv, ST, vbV, stg, Orow + 7 * 32, gn + (size_t)7 * NTOK * 8, wid, lane);
      if (n + 1 < 8) { const bf16_t* Qg = QR + (rowbase + wid * 32 + r32) * 1024 + h * 128 + hi * 8;
#pragma unroll
        for (int d0 = 0; d0 < 8; ++d0) qr[d0] = *reinterpret_cast<const bf16x8*>(Qg + (t0 + 128) * 1024 + d0 * 16);
      }
      __syncthreads();
    }
  } else {
    f32x16 sacc[8];
#pragma unroll
    for (int s = 0; s < 8; ++s)
#pragma unroll
      for (int r = 0; r < 16; ++r) sacc[s][r] = 0.f;
    for (int sp = 0; sp < seg; ++sp) {
      int lane = lane_id(); asm volatile("" : "+v"(lane));
      const float f = exp2f(1024.f * lg * (float)(seg - 1 - sp));
      const bf16_t* Sp = Sall + (size_t)sp * (256 * 128);
#pragma unroll
      for (int s = 0; s < 8; ++s) { const int tile = s * 4 + (wid - 4);
        const v4u* src = (const v4u*)(Sp + ((size_t)tile * 64 + lane) * 16); const v4u a0 = src[0], a1 = src[1];
#pragma unroll
        for (int k = 0; k < 4; ++k) { sacc[s][2 * k] += f * bflo(a0[k]); sacc[s][2 * k + 1] += f * bfhi(a0[k]); sacc[s][8 + 2 * k] += f * bflo(a1[k]); sacc[s][8 + 2 * k + 1] += f * bfhi(a1[k]); } }
    }
#define R2_ST_WRITE(base) do { _Pragma("unroll") for (int s = 0; s < 4; ++s) _Pragma("unroll") for (int r = 0; r < 16; ++r) \
      *(bf16_t*)(ST + (32 * s + crow(r, hi)) * R_STP + (32 * (wid - 4) + r32) * 2) = (bf16_t)f2bf(sacc[(base) + s][r]); } while (0)
    for (int n = 0; n < 8; ++n) {
      const long t0 = (long)n * 128;
      float lgv = lg; asm volatile("" : "+v"(lgv));
      R2_LANE();
      R2_STAGE_A(); R2_ST_WRITE(0); R2_PREF_A();
      __syncthreads();
      ret_state_slice<0>(sacc[0], c_dec, vbV, vbK); ret_state_slice<1>(sacc[1], c_dec, vbV, vbK); ret_state_slice<2>(sacc[2], c_dec, vbV, vbK); ret_state_slice<3>(sacc[3], c_dec, vbV, vbK);
      __syncthreads();
      R2_STAGE_B(); R2_ST_WRITE(4); R2_PREF_B();
      __syncthreads();
      ret_state_slice<0>(sacc[4], c_dec, vbV, vbK); ret_state_slice<1>(sacc[5], c_dec, vbV, vbK); ret_state_slice<2>(sacc[6], c_dec, vbV, vbK); ret_state_slice<3>(sacc[7], c_dec, vbV, vbK);
      __syncthreads();
    }
#undef R2_ST_WRITE
  }
#undef R2_LANE
#undef R2_STAGE_A
#undef R2_STAGE_B
#undef R2_PREF_A
#undef R2_PREF_B
}
#undef RET_KS2
#undef SBAR
}

__device__ __forceinline__ void gn_pass(Frame& F, unsigned char* ws, const float* gn_g, const bool dummy) {
    const int gw = F.vcu * NWAVES + F.wave, NGW = F.G * NWAVES, lane = FLANE;
    const f32x2* gnst = (const f32x2*)(ws + WS_GNST);
    f32x4 w0[4], w1[4];
#pragma unroll
    for (int i = 0; i < 4; ++i) { const int c8 = i * 64 + lane; w0[i] = *((const GAS f32x4*)gn_g + 2 * c8); w1[i] = *((const GAS f32x4*)gn_g + 2 * c8 + 1); }
    v4u co[4], no[4]; unsigned long long cg[4], ng[4]; f32x2 cs[8], ns[8];
#define GN_LOAD(o_, g_, s_, t_) do { const GAS v4u* o4 = (const GAS v4u*)(ws + WS_VR + (size_t)(t_) * 4096); const GAS unsigned long long* g4 = (const GAS unsigned long long*)(ws + WS_GR + (size_t)(t_) * 2048); \
        _Pragma("unroll") for (int i = 0; i < 4; ++i) { o_[i] = o4[i * 64 + lane]; g_[i] = g4[i * 64 + lane]; } \
        _Pragma("unroll") for (int j = 0; j < 8; ++j) s_[j] = gnst[((size_t)j * NTOK + (t_)) * 8 + (lane & 7)]; } while (0)
    int t = gw;
    if (t < NTOK) GN_LOAD(co, cg, cs, t);
    while (t < NTOK) {
        const int tn = t + NGW;
        if (tn < NTOK) GN_LOAD(no, ng, ns, tn);
        float mean, rstd;
        { float s = 0.f, q = 0.f;
#pragma unroll
          for (int j = 0; j < 8; ++j) { s += cs[j].x; q += cs[j].y; }
          mean = s * (1.f / 256.f); rstd = 1.f / sqrtf(fmaxf(q * (1.f / 256.f) - mean * mean, 0.f) + LN_EPS); }
        float y[4][8]; float mx = 0.f;
#pragma unroll
        for (int i = 0; i < 4; ++i) { const int c8 = i * 64 + lane, hd = c8 >> 5;
            const float mu = __shfl(mean, hd), rs = __shfl(rstd, hd);
            float of[8], gf[8]; unpack8(co[i], of); unpack8_fp8(cg[i], gf);
            const float wv[8] = {w0[i].x, w0[i].y, w0[i].z, w0[i].w, w1[i].x, w1[i].y, w1[i].z, w1[i].w};
#pragma unroll
            for (int e = 0; e < 8; ++e) { y[i][e] = gf[e] * wv[e] * (of[e] - mu) * rs; mx = fmaxf(mx, fabsf(y[i][e])); } }
#pragma unroll
        for (int o = 1; o < 64; o <<= 1) mx = fmaxf(mx, __shfl_xor(mx, o));
        const float sc = mx > 0.f ? mx * (1.f / 127.f) : 1.f, inv = 1.f / sc;
        if (!dummy) {
            GAS unsigned long long* q8 = (GAS unsigned long long*)(ws + WS_AR8 + (size_t)t * 2048);
#pragma unroll
            for (int i = 0; i < 4; ++i) { unsigned long long w = 0;
#pragma unroll
                for (int e = 0; e < 8; ++e) w |= (unsigned long long)((unsigned)((int)rintf(y[i][e] * inv) & 255)) << (8 * e);
                q8[i * 64 + lane] = w; }
            if (lane == 0) ((float*)(ws + WS_SAR))[t] = sc;
        }
#pragma unroll
        for (int i = 0; i < 4; ++i) { co[i] = no[i]; cg[i] = ng[i]; }
#pragma unroll
        for (int j = 0; j < 8; ++j) cs[j] = ns[j];
        t = tn;
    }
#undef GN_LOAD
}

#define EPI_ROWS_BEGIN const int row0 = u.pm * 256 + wr * 64 + fr; const int colw = wc * 32 + 8 * fq; \
    _Pragma("unroll") for (int ai = 0; ai < 2; ++ai) _Pragma("unroll") for (int m = 0; m < 4; ++m) { const int row = row0 + ai * 128 + m * 16; (void)row; \
    _Pragma("unroll") for (int bj = 0; bj < 2; ++bj) { float v[8]; _Pragma("unroll") for (int i = 0; i < 8; ++i) v[i] = acc[ai][bj][m][i >> 2][i & 3]; const int colt = bj * 128 + colw; (void)colt;
#define EPI_ROWS_END } }
struct EpiM { static constexpr bool PERM = true, WIDE = false, PRE = false; unsigned char* ws; int which; int dummy; float fixed_rs;
    __device__ __forceinline__ const float* rowscale_ptr(const pg8::Unit& u) const { return (const float*)(ws + WS_SAR) + u.pm * 256; }
    __device__ __forceinline__ bool fixed_rowscale() const { return which != 0; }
    __device__ __forceinline__ float fixed_rs_value() const { return fixed_rs; }
    __device__ __forceinline__ const float* colscale(const pg8::Unit& u) const { return (const float*)(ws + (which ? WS_SWDO : WS_SWRO)) + u.pn * 256; }
    __device__ __forceinline__ void operator()(const pg8::Acc& acc, const pg8::Unit& u, int wr, int wc, int fr, int fq) const {
        EPI_ROWS_BEGIN
            const int col = u.pn * 256 + colt; float g[8]; unpack8_fp8(*(const unsigned long long*)(ws + WS_GT + (size_t)row * 2048 + which * 1024 + col), g);
            bf16_t* mp = (bf16_t*)(ws + WS_M) + (size_t)row * 1024 + col;
            if (which) { float o[8]; unpack8(*(const v4u*)mp, o);
#pragma unroll
                for (int i = 0; i < 8; ++i) v[i] = o[i] + g[i] * v[i]; }
            else {
#pragma unroll
                for (int i = 0; i < 8; ++i) v[i] = g[i] * v[i]; }
            if (!dummy) { if (which) {
#pragma unroll
                    for (int i = 0; i < 8; ++i) v[i] *= M8_SCALE;
                    *(unsigned long long*)(ws + WS_M8 + (size_t)row * 1024 + col) = pack8_fp8(v); }
                else *(v4u*)mp = pack8(v); }
        EPI_ROWS_END
    } };
struct EpiZ { static constexpr bool PERM = true, WIDE = false, PRE = false; unsigned char* ws;
    __device__ __forceinline__ void operator()(const pg8::Acc& acc, const pg8::Unit& u, int wr, int wc, int fr, int fq) const {
        EPI_ROWS_BEGIN
            const int col = u.pn * 256 + colt; float x[8]; unpack8(*(const v4u*)((const bf16_t*)(ws + WS_XN) + (size_t)row * 1024 + col), x);
#pragma unroll
            for (int i = 0; i < 8; ++i) v[i] = DN_ALPHA * x[i] + v[i] * (1.f / (M8_SCALE * F8_WSCALE));
            *(v4u*)((bf16_t*)(ws + WS_Z) + (size_t)row * 1024 + col) = pack8(v);
        EPI_ROWS_END
    } };
struct EpiP5 { static constexpr bool PERM = true, WIDE = false, PRE = false; unsigned char* ws;
    __device__ __forceinline__ void operator()(const pg8::Acc& acc, const pg8::Unit& u, int wr, int wc, int fr, int fq) const {
        EPI_ROWS_BEGIN
            const int col = u.pn * 256 + colt;
            if (u.type == 0) { float* zp = (float*)(ws + WS_LOGIT) + (size_t)row * 256 + col; *(f32x4*)zp = (f32x4){v[0], v[1], v[2], v[3]}; *(f32x4*)(zp + 4) = (f32x4){v[4], v[5], v[6], v[7]}; }
            else {
#pragma unroll
                for (int i = 0; i < 8; ++i) v[i] *= B8_SCALE;
                *(unsigned long long*)(ws + WS_BASE + (size_t)row * 1024 + col) = pack8_fp8(v); }
        EPI_ROWS_END
    } };
struct EpiP8 { static constexpr bool PERM = true, WIDE = false, PRE = false; unsigned char* ws; int dummy;
    __device__ __forceinline__ const float* rowscale_ptr(const pg8::Unit& u) const { return (const float*)(ws + M_RS) + u.grow; }
    __device__ __forceinline__ bool fixed_rowscale() const { return false; }
    __device__ __forceinline__ float fixed_rs_value() const { return 1.f; }
    __device__ __forceinline__ const float* colscale(const pg8::Unit& u) const { return u.cs; }
    __device__ __forceinline__ void operator()(const pg8::Acc& acc, const pg8::Unit& u, int wr, int wc, int fr, int fq) const {
        const int lrow0 = wr * 64 + fr, colw = wc * 32 + 8 * fq;
        if (u.type == 0) {
#pragma unroll
            for (int ai = 0; ai < 2; ++ai)
#pragma unroll
                for (int m = 0; m < 4; ++m) { const int lrow = lrow0 + ai * 128 + m * 16; float v[8];
#pragma unroll
                    for (int i = 0; i < 8; ++i) v[i] = fast_silu(acc[ai][0][m][i >> 2][i & 3]) * acc[ai][1][m][i >> 2][i & 3];
#pragma unroll
                    for (int i = 0; i < 8; ++i) v[i] *= F8_ASCALE;
                    *(unsigned long long*)(ws + WS_ACT + (size_t)(u.aux + lrow) * 256 + u.pn * 128 + colw) = pack8_fp8(v); }
        } else {
#pragma unroll
            for (int ai = 0; ai < 2; ++ai)
#pragma unroll
                for (int m = 0; m < 4; ++m)
#pragma unroll
                    for (int bj = 0; bj < 2; ++bj) { const int row = u.pm * 256 + lrow0 + ai * 128 + m * 16, col = u.pn * 256 + bj * 128 + colw;
                        unsigned char* bp = ws + WS_BASE + (size_t)row * 1024 + col; float o[8]; unpack8_fp8(*(const unsigned long long*)bp, o);
#pragma unroll
                        for (int i = 0; i < 8; ++i) o[i] *= fast_sigmoid(acc[ai][bj][m][i >> 2][i & 3]);
                        if (!dummy) *(unsigned long long*)bp = pack8_fp8(o); }
        }
    } };
struct EpiP9 { static constexpr bool PERM = true, WIDE = false, PRE = true; unsigned char* ws; int dummy;
    __device__ __forceinline__ const float* rowscale_ptr(const pg8::Unit& u) const { return (const float*)(ws + M_RASSIGN) + u.aux; }
    __device__ __forceinline__ const float* colscale(const pg8::Unit& u) const { return (const float*)(ws + M_RW) + u.aux; }
    __device__ __forceinline__ void operator()(const pg8::Acc& acc, const pg8::Unit& u, int wr, int wc, int fr, int fq, const LAS unsigned char* scl) const {
        int lrow0 = wr * 64 + fr, colw = wc * 32 + 8 * fq; asm volatile("" : "+v"(lrow0), "+v"(colw));
        if (u.type == 0) {
            int av[8]; float wv[8];
#pragma unroll
            for (int q = 0; q < 8; ++q) { const int lrow = lrow0 + (q >> 2) * 128 + (q & 3) * 16; av[q] = *(const LAS int*)(scl + 4 * lrow); wv[q] = *(const LAS float*)(scl + 1024 + 4 * lrow); }
#pragma unroll
            for (int q = 0; q < 8; ++q) { int a = av[q]; asm volatile("" : "+v"(a) :: "memory");
                if (a >= 0) { unsigned char* yp = ws + WS_Y + (size_t)a * 1024 + u.pn * 256 + colw * 2;
                    const float w16 = wv[q] * (16.f / (F8_WSCALE * F8_ASCALE)); v4u o;
#pragma unroll
                    for (int bj = 0; bj < 2; ++bj) { float v[8];
#pragma unroll
                        for (int i = 0; i < 8; ++i) v[i] = w16 * acc[q >> 2][bj][q & 3][i >> 2][i & 3];
                        int w0 = 0, w1 = 0;
                        w0 = __builtin_amdgcn_cvt_pk_fp8_f32(v[0], v[1], w0, false); w0 = __builtin_amdgcn_cvt_pk_fp8_f32(v[2], v[3], w0, true);
                        w1 = __builtin_amdgcn_cvt_pk_fp8_f32(v[4], v[5], w1, false); w1 = __builtin_amdgcn_cvt_pk_fp8_f32(v[6], v[7], w1, true);
                        o[2 * bj] = (unsigned)w0; o[2 * bj + 1] = (unsigned)w1; }
                    *(v4u*)yp = o; } }
        } else {
#pragma unroll
            for (int q = 0; q < 8; ++q) { int lrow = lrow0 + (q >> 2) * 128 + (q & 3) * 16; asm volatile("" : "+v"(lrow) :: "memory");
                unsigned char* bp = ws + WS_BASE + (size_t)(u.pm * 256 + lrow) * 1024 + u.pn * 256 + colw;
#pragma unroll
                for (int bj = 0; bj < 2; ++bj) { float o[8]; unpack8_fp8(*(const unsigned long long*)(bp + bj * 128), o);
#pragma unroll
                    for (int i = 0; i < 8; ++i) o[i] += acc[q >> 2][bj][q & 3][i >> 2][i & 3] * (B8_SCALE / (F8_WSCALE * F8_ASCALE));
                    if (!dummy) *(unsigned long long*)(bp + bj * 128) = pack8_fp8(o); } }
        }
    } };

struct P5Order {
    unsigned char* ws; int G, c, which;
    __device__ __forceinline__ bool next(int i, pg8::Unit& u) const {
        int idx = i * G + c;
        if (which == 1 && G == 256) { if (c < 128 || i >= 4) return false; idx = i * 128 + (c - 128); }
        if (which == 0) { if (idx >= 128) return false; u.pm = idx; u.pn = 0; u.type = 0; u.aux = 0; u.A = (const char*)(ws + WS_H1) + (size_t)idx * 256 * 1024 * 2; u.B = (const char*)(ws + WS_ROUT_T); u.grow = -1; return true; }
        if (idx >= 512) return false; u.pm = idx >> 2; u.pn = idx & 3; u.type = 1; u.aux = 0; u.A = (const char*)(ws + WS_PB) + (size_t)u.pm * 256 * 256 * 2; u.B = (const char*)(ws + WS_PLEW_T) + (size_t)u.pn * 256 * 256 * 2; u.grow = -1; return true;
    } };
struct P8Order {
    unsigned char* ws; int G, c, nblk;
    __device__ __forceinline__ bool next(int i, pg8::Unit& u) const {
        int idx = i * G + c; u.A = (const char*)(ws + WS_H18);
        if (idx < 2 * nblk) { const int blk = idx >> 1, e = __builtin_amdgcn_readfirstlane(((const volatile int*)(ws + M_BLKE))[blk]); u.pm = blk; u.pn = idx & 1; u.type = 0; u.aux = blk * 256; u.grow = blk * 256;
            u.B = (const char*)(ws + WS_EGU_T) + (size_t)e * (512 * 1024) + (size_t)u.pn * (256 * 1024); u.cs = (const float*)(ws + WS_SEGU) + e * 512 + u.pn * 256; return true; }
        idx -= 2 * nblk;
        if (idx < 256) { u.pm = idx >> 1; u.pn = idx & 1; u.type = 0; u.aux = SH_ACT_ROW0 + u.pm * 256; u.grow = NROWS_MAX + u.pm * 256;
            u.B = (const char*)(ws + WS_SHGU_T) + (size_t)u.pn * (256 * 1024); u.cs = (const float*)(ws + WS_SSHGU) + u.pn * 256; return true; }
        idx -= 256;
        if (idx < 512) { u.pm = idx >> 2; u.pn = idx & 3; u.type = 2; u.aux = 0; u.grow = NROWS_MAX + u.pm * 256;
            u.B = (const char*)(ws + WS_PLEG_T) + (size_t)u.pn * (256 * 1024); u.cs = (const float*)(ws + WS_SPLEG) + u.pn * 256; return true; }
        return false;
    } };
struct P9Order {
    unsigned char* ws; int G, c, nblk;
    __device__ __forceinline__ bool next(int i, pg8::Unit& u) const {
        int idx = i * G + c; u.grow = -1;
        if (idx < 4 * nblk) { const int blk = idx >> 2, e = __builtin_amdgcn_readfirstlane(((const volatile int*)(ws + M_BLKE))[blk]); u.pm = blk; u.pn = idx & 3; u.type = 0; u.aux = blk * 256;
            u.A = (const char*)(ws + WS_ACT) + (size_t)blk * (256 * 256); u.B = (const char*)(ws + ed_off(e)) + (size_t)u.pn * (256 * 256); return true; }
        idx -= 4 * nblk;
        if (idx < 512) { u.pm = idx >> 2; u.pn = idx & 3; u.type = 1; u.aux = 0;
            u.A = (const char*)(ws + WS_ACT) + (size_t)(SH_ACT_ROW0 + u.pm * 256) * 256; u.B = (const char*)(ws + WS_SHD_T) + (size_t)u.pn * (256 * 256); return true; }
        return false;
    } };

__device__ __forceinline__ void px_convert(Frame& F, const Args& a) {
    LAS float* scr = (LAS float*)(F.lds + F.wave * 16384);
    const int gw = F.vcu * NWAVES + F.wave, NGW = F.G * NWAVES; unsigned char* ws = a.ws;
    for (int it = gw; it < 256 * 128; it += NGW) { const int e = it >> 7, q = it & 127, kb = q >> 5, nb = q & 31, n0 = 32 * nb;
        p0_transpose_item_f8(a.in[I_ED] + (size_t)e * 256 * 1024, 256, 1024, ws + ed_off(e), 64 * kb, n0, n0, scr, FLANE, F8_WSCALE); }
    __syncthreads();
}
__device__ __forceinline__ void px_convert_dyn(Frame& F, const Args& a) {
    unsigned char* ws = a.ws;
    unsigned nx = 0u; if (FTID == 0) nx = __hip_atomic_fetch_add(F.ctl + CW_STEAL, 1u, RLX_AGENT);
    for (;;) {
        if (FTID == 0) F.MISC[4] = nx;
        __syncthreads();
        const int it = __builtin_amdgcn_readfirstlane((int)F.MISC[4]);
        if (it >= 256 * 16) break;
        if (FTID == 0) nx = __hip_atomic_fetch_add(F.ctl + CW_STEAL, 1u, RLX_AGENT);
        const int e = it >> 4, up = (it >> 3) & 1, n0 = 32 * (it & 7);
        quant_cols32_k1024(F.lds, a.in[up ? I_EU : I_EG] + (size_t)e * 1024 * 256, 256, n0, (signed char*)(ws + WS_EGU_T) + (size_t)e * 512 * 1024, (float*)(ws + WS_SEGU) + e * 512,
                           (n0 >> 7) * 256 + up * 128 + (n0 & 127), F.wave, FLANE);
    }
    __syncthreads();
}

__device__ __forceinline__ void route_pass(Frame& F, const Args& a, const bool dummy) {
    unsigned char* ws = a.ws; const int lane = FLANE;
    LAS unsigned* hist = (LAS unsigned*)F.lds;
    if (FTID < 256) hist[FTID] = 0u;
    __syncthreads();
    const int gw = F.vcu * NWAVES + F.wave, NGW = F.G * NWAVES;
    const f32x4 bb = ((const GAS f32x4*)a.in[I_ROUT_B])[lane];
    constexpr int U = 4;
    for (int t0 = gw; t0 < NTOK; t0 += U * NGW) {
        f32x4 x[U];
#pragma unroll
        for (int u = 0; u < U; ++u) { const int t = t0 + u * NGW; x[u] = (t < NTOK) ? ((const GAS f32x4*)(ws + WS_LOGIT + (size_t)t * 1024))[lane] : (f32x4){0.f, 0.f, 0.f, 0.f}; }
        float sc[U][4], c[U][4], a1[U], a2[U];
#pragma unroll
        for (int u = 0; u < U; ++u) {
#pragma unroll
            for (int i = 0; i < 4; ++i) { sc[u][i] = 1.f / (1.f + expf(-x[u][i])); c[u][i] = sc[u][i] + bb[i]; }
            a1[u] = fmaxf(c[u][0], c[u][1]); a2[u] = fminf(c[u][0], c[u][1]);
#pragma unroll
            for (int i = 2; i < 4; ++i) { if (c[u][i] > a1[u]) { a2[u] = a1[u]; a1[u] = c[u][i]; } else if (c[u][i] > a2[u]) a2[u] = c[u][i]; } }
#pragma unroll
        for (int off = 1; off < 8; off <<= 1) {
#pragma unroll
            for (int u = 0; u < U; ++u) { const float b1 = __shfl_xor(a1[u], off), b2 = __shfl_xor(a2[u], off); const float n1 = fmaxf(a1[u], b1), n2 = fmaxf(fminf(a1[u], b1), fmaxf(a2[u], b2)); a1[u] = n1; a2[u] = n2; } }
        const int g = lane >> 3;
#pragma unroll
        for (int u = 0; u < U; ++u) { const float gs = a1[u] + a2[u]; int rank = 0;
#pragma unroll
            for (int g2 = 0; g2 < 8; ++g2) { const float o = __shfl(gs, g2 * 8); rank += (o > gs || (o == gs && g2 < g)) ? 1 : 0; }
            if (rank >= 4) { c[u][0] = c[u][1] = c[u][2] = c[u][3] = -INFINITY; } }
        float sel_s[U]; int sel_e[U];
#pragma unroll
        for (int u = 0; u < U; ++u) { sel_s[u] = 0.f; sel_e[u] = 0; }
#pragma unroll
        for (int k = 0; k < 8; ++k) {
            float bv[U]; int be[U];
#pragma unroll
            for (int u = 0; u < U; ++u) { bv[u] = c[u][0]; int bi = 0;
#pragma unroll
                for (int i = 1; i < 4; ++i) if (c[u][i] > bv[u]) { bv[u] = c[u][i]; bi = i; }
                be[u] = lane * 4 + bi; }
#pragma unroll
            for (int off = 1; off < 64; off <<= 1) {
#pragma unroll
                for (int u = 0; u < U; ++u) { const float ov = __shfl_xor(bv[u], off); const int oe = __shfl_xor(be[u], off); if (ov > bv[u] || (ov == bv[u] && oe < be[u])) { bv[u] = ov; be[u] = oe; } } }
#pragma unroll
            for (int u = 0; u < U; ++u) { const int owner = be[u] >> 2, wi = be[u] & 3;
                float sv = wi == 0 ? sc[u][0] : wi == 1 ? sc[u][1] : wi == 2 ? sc[u][2] : sc[u][3];
                sv = __shfl(sv, owner);
                if (lane == owner) {
#pragma unroll
                    for (int i = 0; i < 4; ++i) if (wi == i) c[u][i] = -INFINITY; }
                if (lane == k) { sel_s[u] = sv; sel_e[u] = be[u]; } }
        }
        float tot[U];
#pragma unroll
        for (int u = 0; u < U; ++u) tot[u] = lane < 8 ? sel_s[u] : 0.f;
#pragma unroll
        for (int o = 1; o < 64; o <<= 1) {
#pragma unroll
            for (int u = 0; u < U; ++u) tot[u] += __shfl_xor(tot[u], o); }
#pragma unroll
        for (int u = 0; u < U; ++u) { const int t = t0 + u * NGW;
            if (t < NTOK && lane < 8) { ((int*)(ws + M_IDX))[(size_t)t * 8 + lane] = sel_e[u]; ((float*)(ws + M_W))[(size_t)t * 8 + lane] = sel_s[u] / tot[u] * 2.5f; atomicAdd((unsigned*)&hist[sel_e[u]], 1u); } }
    }
    __syncthreads();
    if (!dummy && FTID < 256 && hist[FTID]) __hip_atomic_fetch_add(F.ctl + CW_CNT + FTID * CW_PAD, hist[FTID], RLX_AGENT);
    __syncthreads();
    for (int i = blockIdx.x * 512 + FTID; i < NROWS_MAX; i += F.G * 512) { ((int*)(ws + M_RASSIGN))[i] = -1; ((int*)(ws + M_RTOK))[i] = 0; ((float*)(ws + M_RW))[i] = 0.f; ((float*)(ws + M_RS))[i] = 0.f; }
    for (int i = blockIdx.x * 512 + FTID; i < NTOK; i += F.G * 512) { ((int*)(ws + M_RTOK))[NROWS_MAX + i] = i; ((float*)(ws + M_RS))[NROWS_MAX + i] = ((const float*)(ws + WS_SH1))[i]; }
}
__device__ __forceinline__ void scatter_pass(Frame& F, const Args& a) {
    unsigned char* ws = a.ws;
    LAS int* bst = (LAS int*)F.lds;
    LAS int* nbk = bst + 320;
    { const int t = FTID; if (t < NEXP) nbk[t] = (int)((__hip_atomic_load(F.ctl + CW_CNT + t * CW_PAD, RLX_AGENT) + 255u) >> 8); }
    __syncthreads();
    if (F.wave == 0) {
        const int l = lane_id(); const int c0 = nbk[4 * l], c1 = nbk[4 * l + 1], c2 = nbk[4 * l + 2], c3 = nbk[4 * l + 3];
        int tot = c0 + c1 + c2 + c3, inc = tot;
#pragma unroll
        for (int off = 1; off < 64; off <<= 1) { const int o = __shfl_up(inc, off); if (l >= off) inc += o; }
        const int ex = inc - tot;
        bst[4 * l] = ex; bst[4 * l + 1] = ex + c0; bst[4 * l + 2] = ex + c0 + c1; bst[4 * l + 3] = ex + c0 + c1 + c2;
        if (l == 63) bst[NEXP] = inc;
    }
    __syncthreads();
    if (blockIdx.x == 0) { if (FTID < NEXP) { for (int b = bst[FTID]; b < bst[FTID + 1]; ++b) ((int*)(ws + M_BLKE))[b] = FTID; } if (FTID == 0) *(int*)(ws + M_NBLK) = bst[NEXP]; }
    LAS unsigned* lcnt = (LAS unsigned*)(bst + 640); LAS unsigned* gb = lcnt + 256;
    if (FTID < 256) lcnt[FTID] = 0u;
    __syncthreads();
    constexpr int SCK = (NTOK * 8 + 256 * 512 - 1) / (256 * 512);
    int ev[SCK]; unsigned lr[SCK];
#pragma unroll
    for (int k = 0; k < SCK; ++k) { const int i = blockIdx.x * 512 + FTID + k * F.G * 512; ev[k] = -1; lr[k] = 0u;
        if (i < NTOK * 8) { ev[k] = ((const int*)(ws + M_IDX))[i]; lr[k] = atomicAdd((unsigned*)&lcnt[ev[k]], 1u); } }
    __syncthreads();
    if (FTID < 256) { const unsigned n = lcnt[FTID]; gb[FTID] = n ? __hip_atomic_fetch_add(F.ctl + CW_CUR + FTID * CW_PAD, n, RLX_AGENT) : 0u; }
    __syncthreads();
#pragma unroll
    for (int k = 0; k < SCK; ++k) { const int i = blockIdx.x * 512 + FTID + k * F.G * 512; const int e = ev[k]; if (e < 0) continue;
        const int row = bst[e] * 256 + (int)(gb[e] + lr[k]);
        ((int*)(ws + M_RASSIGN))[row] = i; ((int*)(ws + M_RTOK))[row] = i >> 3; ((float*)(ws + M_RW))[row] = ((const float*)(ws + M_W))[i]; ((float*)(ws + M_RS))[row] = ((const float*)(ws + WS_SH1))[i >> 3];
    }
}
__device__ __forceinline__ void final_pass(Frame& F, const Args& a) {
    unsigned char* ws = a.ws; const int lane = FLANE; const int gw = F.vcu * NWAVES + F.wave, NGW = F.G * NWAVES;
    for (int t = gw; t < NTOK; t += NGW) {
        float v[16];
#pragma unroll
        for (int i = 0; i < 2; ++i) { const int c8 = lane + 64 * i; float hh[8], bs[8];
            unpack8(((const GAS v4u*)(ws + WS_H1 + (size_t)t * 2048))[c8], hh); unpack8_fp8(((const GAS unsigned long long*)(ws + WS_BASE + (size_t)t * 1024))[c8], bs);
#pragma unroll
            for (int e = 0; e < 8; ++e) v[i * 8 + e] = DN_ALPHA * hh[e] + bs[e] * (1.f / B8_SCALE);
            float ys[8] = {0.f, 0.f, 0.f, 0.f, 0.f, 0.f, 0.f, 0.f};
            const int p8 = (c8 & ~31) | ((c8 & 15) << 1) | ((c8 >> 4) & 1);
#pragma unroll
            for (int k = 0; k < 8; ++k) { const unsigned long long yw = ((const GAS unsigned long long*)(ws + WS_Y + ((size_t)t * 8 + k) * 1024))[p8];
                const int w0 = (int)(unsigned)yw, w1 = (int)(unsigned)(yw >> 32);
                const auto f0 = __builtin_amdgcn_cvt_pk_f32_fp8(w0, false), f1 = __builtin_amdgcn_cvt_pk_f32_fp8(w0, true), f2 = __builtin_amdgcn_cvt_pk_f32_fp8(w1, false), f3 = __builtin_amdgcn_cvt_pk_f32_fp8(w1, true);
                ys[0] += f0[0]; ys[1] += f0[1]; ys[2] += f1[0]; ys[3] += f1[1]; ys[4] += f2[0]; ys[5] += f2[1]; ys[6] += f3[0]; ys[7] += f3[1]; }
#pragma unroll
            for (int e = 0; e < 8; ++e) v[i * 8 + e] += ys[e] * (1.f / 16.f); }
        float s = 0.f;
#pragma unroll
        for (int e = 0; e < 16; ++e) s += v[e];
        const float mean = wave_sum(s) * (1.f / DM); float q = 0.f;
#pragma unroll
        for (int e = 0; e < 16; ++e) { v[e] -= mean; q += v[e] * v[e]; }
        const float rstd = 1.f / sqrtf(wave_sum(q) * (1.f / DM) + LN_EPS);
#pragma unroll
        for (int i = 0; i < 2; ++i) { const int c8 = lane + 64 * i;
#pragma unroll
            for (int hlf = 0; hlf < 2; ++hlf) { const f32x4 gg = ((const GAS f32x4*)a.in[I_LN2_G])[c8 * 2 + hlf], bb = ((const GAS f32x4*)a.in[I_LN2_B])[c8 * 2 + hlf];
                f32x4 o; o.x = v[i * 8 + hlf * 4 + 0] * rstd * gg.x + bb.x; o.y = v[i * 8 + hlf * 4 + 1] * rstd * gg.y + bb.y; o.z = v[i * 8 + hlf * 4 + 2] * rstd * gg.z + bb.z; o.w = v[i * 8 + hlf * 4 + 3] * rstd * gg.w + bb.w;
                ((GAS f32x4*)(a.out + (size_t)t * DM))[c8 * 2 + hlf] = o; } }
    }
}

__global__ void __launch_bounds__(NWAVES * 64, 2) mega_fwd(Args args) {
    extern __shared__ __attribute__((aligned(16))) unsigned char lds[];
    Frame F;
    F.lds = (LAS unsigned char*)lds;
    F.MISC = (volatile LAS unsigned*)(F.lds + MISC_OFF);
    F.wave = __builtin_amdgcn_readfirstlane((int)threadIdx.x >> 6);
    F.G = gridDim.x; { const int bx = blockIdx.x; F.vcu = (F.G % 8 == 0) ? (bx % 8) * (F.G / 8) + bx / 8 : bx; }
    unsigned char* ws = args.ws;
    F.ctl = (gu32*)(ws + WS_CTL);
    for (int u = FTID; u < (LDS_BYTES - LDSCTL_OFF) / 4; u += NWAVES * 64) ((LAS unsigned*)(F.lds + LDSCTL_OFF))[u] = 0u;
    __syncthreads();
    XcdBarrier bar = xcd_barrier_post((unsigned*)(F.ctl + CW_BAR), F.MISC + 8);
    const int lo = args.ph_lo, hi = args.ph_hi;
#define STAMP(k) do { if (TIMING && F.wave == 0) { const unsigned long long t_ = __builtin_amdgcn_s_memrealtime(); F.MISC[16 + 2 * (k)] = (unsigned)t_; F.MISC[17 + 2 * (k)] = (unsigned)(t_ >> 32); } } while (0)
    STAMP(0);
#define IN(k) (lo <= (k) && (k) < hi)
#define GRID_BAR() xcd_barrier(bar)

    if (IN(0)) { p0_prologue(F, args); if (REP & 1) p0_prologue(F, args); GRID_BAR(); }
    STAMP(1);
    if (IN(1)) {
        pg8::DenseOrder S; S.init(ws + WS_XN8, ws + WS_WIN_T, NTOK, INCOLS, 512, F.G, (int)blockIdx.x);
        EpiInProj E{ws};
        pg8::gemm_phase<EpiInProj, pg8::DenseOrder, false, true>(F.lds, 512, S, E, nullptr, F.wave);
        if (REP & 2) pg8::gemm_phase<EpiInProj, pg8::DenseOrder, false, true>(F.lds, 512, S, E, nullptr, F.wave);
        GRID_BAR();
    }
    STAMP(2);
#if DEBUG_CHECK
    if (IN(2)) {
        const GAS v4u* src = (const GAS v4u*)(ws + WS_VR); GAS v4u* dst = (GAS v4u*)(ws + WS_DBGV);
        for (size_t i = (size_t)blockIdx.x * 512 + FTID; i < (size_t)64 * MiB / 16; i += (size_t)F.G * 512) dst[i] = src[i];
        GRID_BAR();
    }
#endif
    if (IN(2)) {
        const int bh = F.vcu >> 3, s = F.vcu & 7, b = bh >> 3, h = bh & 7;
        if (REP & 8) att::ret_chain(b, h, s, (const bf16_t*)(ws + WS_QR), (const bf16_t*)(ws + WS_KR), (const bf16_t*)(ws + WS_VR), (bf16_t*)(ws + WS_DBGV), 16383L, (f32x2*)(ws + WS_GNST), (char*)lds, F.wave);
        if (s < 7) att::ret_passA(b, h, s, (const bf16_t*)(ws + WS_KR), (const unsigned char*)(ws + WS_V8), (bf16_t*)(ws + WS_META) + (size_t)F.vcu * (256 * 128), (char*)lds, F.wave);
        GRID_BAR();
        att::ret_passB(b, h, s, (const bf16_t*)(ws + WS_QR), (const bf16_t*)(ws + WS_KR), (const unsigned char*)(ws + WS_V8), (bf16_t*)(ws + WS_VR), (const bf16_t*)(ws + WS_META) + (size_t)(bh * 8) * (256 * 128), (f32x2*)(ws + WS_GNST), (char*)lds, F.wave);
        STAMP(3);
        float lam;
        { float d1 = 0.f, d2 = 0.f; for (int i = 0; i < 64; ++i) { d1 += args.in[I_LQ1][i] * args.in[I_LK1][i]; d2 += args.in[I_LQ2][i] * args.in[I_LK2][i]; }
          lam = expf(d1) - expf(d2) + 0.2f; }
        float gmax = 0.f; for (int i = 0; i < 128; ++i) gmax = fmaxf(gmax, fabsf(args.in[I_SUBLN_G][i]));
        const float ad_scale = fmaxf(gmax, 1e-20f) * (0.8f * 11.313708499f / 127.f), ad_inv = 1.f / ad_scale;
        bf16x8 avs0, avs1, aks;
        if (REP & 4) for (int i = 0; i < 4; ++i) {
            const int qb = (i == 0) ? 31 - s : (i == 1) ? 16 + s : (i == 2) ? 15 - s : s;
            att::attn_unit(b, h, qb, (const bf16_t*)(ws + WS_QD), (signed char*)(ws + WS_DBGV), ad_inv, (const bf16_t*)(ws + WS_KD), (const bf16_t*)(ws + WS_VD), args.in[I_RELB], args.in[I_SUBLN_G], lam, (char*)lds, F.wave, avs0, avs1, aks, i > 0);
        }
        for (int i = 0; i < 4; ++i) {
            const int qb = (i == 0) ? 31 - s : (i == 1) ? 16 + s : (i == 2) ? 15 - s : s;
            att::attn_unit(b, h, qb, (const bf16_t*)(ws + WS_QD), (signed char*)(ws + WS_AD8), ad_inv, (const bf16_t*)(ws + WS_KD), (const bf16_t*)(ws + WS_VD), args.in[I_RELB], args.in[I_SUBLN_G], lam, (char*)lds, F.wave, avs0, avs1, aks, i > 0);
            if (i == (bh & 3)) { px_convert(F, args); if (REP & 128) px_convert(F, args); }
        }
        px_convert_dyn(F, args);
        GRID_BAR();
    }
    STAMP(4);
    if (IN(3)) { if (REP & 256) gn_pass(F, ws, args.in[I_GN_G], true); gn_pass(F, ws, args.in[I_GN_G], false); GRID_BAR(); }
    STAMP(5);
    if (IN(4)) {
        pg8::DenseOrder S; S.init(ws + WS_AR8, ws + WS_WRO_T, NTOK, 1024, 1024, F.G, (int)blockIdx.x);
        EpiM E{ws, 0, 0, 0.f}; pg8::gemm_phase<EpiM, pg8::DenseOrder, false, true>(F.lds, 1024, S, E, nullptr, F.wave);
        __syncthreads();
    }
    STAMP(6);
    if (IN(5)) {
        pg8::DenseOrder S; S.init(ws + WS_AD8, ws + WS_WDO_T, NTOK, 1024, 512, F.G, (int)blockIdx.x);
        float gmax = 0.f; for (int i = 0; i < 128; ++i) gmax = fmaxf(gmax, fabsf(args.in[I_SUBLN_G][i]));
        EpiM E{ws, 1, 0, fmaxf(gmax, 1e-20f) * (0.8f * 11.313708499f / 127.f)}; pg8::gemm_phase<EpiM, pg8::DenseOrder, false, true>(F.lds, 512, S, E, nullptr, F.wave); GRID_BAR();
    }
    STAMP(7);
    if (IN(6)) {
        pg8::DenseOrder S; S.init(ws + WS_M8, ws + WS_WO_T, NTOK, 1024, 512, F.G, (int)blockIdx.x);
        EpiZ E{ws}; pg8::gemm_phase<EpiZ, pg8::DenseOrder, false, false, true>(F.lds, 512, S, E, nullptr, F.wave); GRID_BAR();
    }
    STAMP(8);
    if (IN(7)) {
        const int gw = F.vcu * NWAVES + F.wave, NGW = F.G * NWAVES;
        ln_rows_bf16_i8<true>(FLANE, ws + WS_Z, args.in[I_LN1_G], args.in[I_LN1_B], (bf16_t*)(ws + WS_H1), (signed char*)(ws + WS_H18), (float*)(ws + WS_SH1), gw, NGW, NTOK);
        GRID_BAR();
    }
    STAMP(9);
    if (IN(8)) {
        EpiP5 E{ws};
        { P5Order S{ws, F.G, F.vcu, 0}; pg8::gemm_phase<EpiP5, P5Order, false>(F.lds, 1024, S, E, nullptr, F.wave); }
        { P5Order S{ws, F.G, F.vcu, 1}; pg8::gemm_phase<EpiP5, P5Order, false>(F.lds, 256, S, E, nullptr, F.wave); }
        if (REP & 1024) { { P5Order S{ws, F.G, F.vcu, 0}; pg8::gemm_phase<EpiP5, P5Order, false>(F.lds, 1024, S, E, nullptr, F.wave); }
          { P5Order S{ws, F.G, F.vcu, 1}; pg8::gemm_phase<EpiP5, P5Order, false>(F.lds, 256, S, E, nullptr, F.wave); } }
        GRID_BAR();
    }
    STAMP(10);
    if (IN(9)) { if (REP & 16384) route_pass(F, args, true); route_pass(F, args, false); GRID_BAR(); }
    STAMP(11);
    if (IN(10)) { scatter_pass(F, args); GRID_BAR(); }
    STAMP(12);
    if (IN(11)) {
        const int nblk = __builtin_amdgcn_readfirstlane(*(const volatile int*)(ws + M_NBLK));
        P8Order S{ws, F.G, F.vcu  , nblk}; EpiP8 E{ws, 0};
        if (REP & 2048) { EpiP8 E2{ws, 1}; pg8::gemm_phase<EpiP8, P8Order, true, true>(F.lds, 512, S, E2, (const int*)(ws + M_RTOK), F.wave); }
        pg8::gemm_phase<EpiP8, P8Order, true, true>(F.lds, 512, S, E, (const int*)(ws + M_RTOK), F.wave); GRID_BAR();
    }
    STAMP(13);
    if (IN(12)) {
        const int nblk = __builtin_amdgcn_readfirstlane(*(const volatile int*)(ws + M_NBLK));
        P9Order S{ws, F.G, F.vcu, nblk}; EpiP9 E{ws, 0};
        if (REP & 4096) { EpiP9 E2{ws, 1}; pg8::gemm_phase<EpiP9, P9Order, false, false, true>(F.lds, 128, S, E2, nullptr, F.wave); }
        pg8::gemm_phase<EpiP9, P9Order, false, false, true>(F.lds, 128, S, E, nullptr, F.wave); GRID_BAR();
    }
    STAMP(14);
    if (REP & 32768) { for (int i = 0; i < 20; ++i) GRID_BAR(); }
    if (IN(13)) { final_pass(F, args); if (REP & 8192) final_pass(F, args); }
#if TIMING
    GRID_BAR(); STAMP(15);
    if (blockIdx.x == 0 && FTID == 0) {
      const unsigned long long t1 = ((unsigned long long)F.MISC[17 + 2 * T_A1] << 32) | F.MISC[16 + 2 * T_A1], t0 = ((unsigned long long)F.MISC[17 + 2 * T_A0] << 32) | F.MISC[16 + 2 * T_A0];
      args.out[0] = 10.f + (float)(t1 - t0) * 0.01f / (float)(T_SCALE); }
#endif
#undef IN
#undef GRID_BAR
}

#if DEBUG_CHECK
__device__ __forceinline__ unsigned hash_u32(unsigned x) { x ^= x >> 16; x *= 0x7feb352du; x ^= x >> 15; x *= 0x846ca68bu; x ^= x >> 16; return x; }
__device__ __forceinline__ void dbg_fail(unsigned* ctl, int stage, bool bad) { if (bad) atomicAdd(&ctl[CW_DBG + stage], 1u); }
__device__ float ref_ln_dot(const float* xrow, const float* g, const float* b, const float* W, int N, int col) {
    float s = 0.f; for (int k = 0; k < DM; ++k) s += xrow[k]; const float mean = s / DM;
    float q = 0.f; for (int k = 0; k < DM; ++k) { const float d = xrow[k] - mean; q += d * d; } const float rstd = 1.f / sqrtf(q / DM + LN_EPS);
    float acc = 0.f; for (int k = 0; k < DM; ++k) acc += ((xrow[k] - mean) * rstd * g[k] + b[k]) * W[(size_t)k * N + col];
    return acc;
}
__global__ void dbg_check(Args a) {
    unsigned* ctl = (unsigned*)(a.ws + WS_CTL); unsigned char* ws = a.ws;
    const unsigned gid = blockIdx.x * blockDim.x + threadIdx.x;
    {
        const unsigned h = hash_u32(gid * 2654435761u + 17u);
        const int row = h % NTOK; int col = (h >> 15) % INCOLS;
        const float* xrow = a.in[I_X] + (size_t)row * DM;
        int seg; int cs; size_t boff; int ld;
        if (col < 1024) { seg = 0; cs = col; boff = WS_QR; ld = 1024; } else if (col < 2048) { seg = 1; cs = col - 1024; boff = WS_KR; ld = 1024; }
        else if (col < 4096) { seg = 2; cs = col - 2048; boff = WS_VR; ld = 2048; } else if (col < 6144) { seg = 3; cs = col - 4096; boff = WS_GR; ld = 2048; }
        else if (col < 7168) { seg = 4; cs = col - 6144; boff = WS_QD; ld = 1024; } else if (col < 8192) { seg = 5; cs = col - 7168; boff = WS_KD; ld = 1024; }
        else if (col < 9216) { seg = 6; cs = col - 8192; boff = WS_VD; ld = 1024; } else { seg = 7; cs = col - 9216; boff = WS_GT; ld = 2048; }
        float e;
        if (seg <= 1) {
            const int j = cs & 63, half = (cs >> 6) & 1; const int c1 = col - half * 64, c2 = c1 + 64;
            const float t1 = ref_ln_dot(xrow, a.in[I_LNIN_G], a.in[I_LNIN_B], a.in[I_WIN], INCOLS, c1);
            const float t2 = ref_ln_dot(xrow, a.in[I_LNIN_G], a.in[I_LNIN_B], a.in[I_WIN], INCOLS, c2);
            const double theta = 1.0 / pow(10000.0, (double)j / 63.0); const double ang = (double)(row % SEQ) * theta;
            const float c = (float)cos(ang), s = (float)sin(ang);
            e = half ? (t2 * c + t1 * s) : (t1 * c - t2 * s);
            if (seg == 1) e *= KR_SCALE;
        } else {
            e = ref_ln_dot(xrow, a.in[I_LNIN_G], a.in[I_LNIN_B], a.in[I_WIN], INCOLS, col);
            if (seg == 3) e = e / (1.f + expf(-e)); else if (seg == 7) e = 1.f / (1.f + expf(-e)); else if (seg == 4) e *= QD_SCALE;
        }
        const float got = bf2f(((const bf16_t*)(ws + boff))[(size_t)row * ld + cs]);
        if (seg != 2 && seg != 3 && seg != 4)
            dbg_fail(ctl, 1, !(fabsf(got - e) <= 0.08f + 0.05f * fabsf(e)));
    }
}
__device__ float dbg_inproj(const Args& a, int row, int col) { return ref_ln_dot(a.in[I_X] + (size_t)row * DM, a.in[I_LNIN_G], a.in[I_LNIN_B], a.in[I_WIN], INCOLS, col); }
__global__ void __launch_bounds__(256) dbg_check_ret(Args a) {
    __shared__ float sc[256]; __shared__ float red[256]; __shared__ float qs[128];
    unsigned* ctl = (unsigned*)(a.ws + WS_CTL); unsigned char* ws = a.ws;
    const int tid = threadIdx.x;
    const unsigned hsh = hash_u32(blockIdx.x * 7919u + 13u);
    const int b = hsh & 1, h = (hsh >> 1) & 7; int pos = (hsh >> 4) % SEQ; if (blockIdx.x & 1) pos = pos % 700;
    const int t = b * SEQ + pos;
    const bf16_t* QR = (const bf16_t*)(ws + WS_QR); const bf16_t* KR = (const bf16_t*)(ws + WS_KR); const bf16_t* VV = (const bf16_t*)(ws + WS_DBGV);
    if (tid < 128) qs[tid] = bf2f(QR[(size_t)t * 1024 + h * 128 + tid]);
    __syncthreads();
    const float lgam = logf(1.f - exp2f(-5.f - (float)h));
    float o = 0.f;
    for (int s0 = 0; s0 <= pos; s0 += 256) {
        const int s = s0 + tid; float v = 0.f;
        if (s <= pos) { const bf16_t* kp = KR + (size_t)(b * SEQ + s) * 1024 + h * 128; float d = 0.f; for (int k = 0; k < 128; ++k) d += qs[k] * bf2f(kp[k]); v = d * expf((float)(pos - s) * lgam); }
        sc[tid] = v; __syncthreads();
        const int n = min(256, pos + 1 - s0);
        for (int i = 0; i < n; ++i) o += sc[i] * bf2f(VV[(size_t)(b * SEQ + s0 + i) * 2048 + h * 256 + tid]);
        __syncthreads();
    }
    red[tid] = o; __syncthreads(); for (int st = 128; st > 0; st >>= 1) { if (tid < st) red[tid] += red[tid + st]; __syncthreads(); }
    const float mu = red[0] / 256.f; __syncthreads();
    red[tid] = (o - mu) * (o - mu); __syncthreads(); for (int st = 128; st > 0; st >>= 1) { if (tid < st) red[tid] += red[tid + st]; __syncthreads(); }
    const float rstd = 1.f / sqrtf(red[0] / 256.f + LN_EPS);
    const float g = dbg_inproj(a, t, 4096 + h * 256 + tid);
    const float e = g / (1.f + expf(-g)) * (o - mu) * rstd * a.in[I_GN_G][h * 256 + tid];
    const float got = bf2f(((const bf16_t*)(ws + WS_GR))[(size_t)t * 2048 + h * 256 + tid]);
    dbg_fail(ctl, 2, !(fabsf(got - e) <= 0.06f + 0.06f * fabsf(e)));
}
__global__ void __launch_bounds__(256) dbg_check_att(Args a) {
    __shared__ float pr[SEQ]; __shared__ float red[256]; __shared__ float qs[128]; __shared__ float o1[128];
    unsigned* ctl = (unsigned*)(a.ws + WS_CTL); unsigned char* ws = a.ws;
    const int tid = threadIdx.x;
    const unsigned hsh = hash_u32(blockIdx.x * 104729u + 71u);
    const int b = hsh & 3, h = (hsh >> 2) & 7; int pos = (hsh >> 5) % SEQ; if ((blockIdx.x & 3) == 1) pos = pos % 300;
    const int t = b * SEQ + pos;
    const bf16_t* KD = (const bf16_t*)(ws + WS_KD); const bf16_t* VD = (const bf16_t*)(ws + WS_VD);
    if (tid < 128) qs[tid] = dbg_inproj(a, t, 6144 + h * 128 + tid) * 0.125f;
    float lam; { float d1 = 0.f, d2 = 0.f; for (int i = 0; i < 64; ++i) { d1 += a.in[I_LQ1][i] * a.in[I_LK1][i]; d2 += a.in[I_LQ2][i] * a.in[I_LK2][i]; } lam = expf(d1) - expf(d2) + 0.2f; }
    __syncthreads();
    float ov = 0.f;
    for (int m = 0; m < 2; ++m) {
        float mx = -INFINITY;
        for (int s = tid; s <= pos; s += 256) { const bf16_t* kp = KD + (size_t)(b * SEQ + s) * 1024 + h * 128 + m * 64; float d = 0.f; for (int k = 0; k < 64; ++k) d += qs[m * 64 + k] * bf2f(kp[k]);
            const int n = pos - s; int bk; if (n < 16) bk = n; else { bk = 16 + (int)(logf((float)n / 16.f) / logf(8.f) * 16.f); if (bk > 31) bk = 31; }
            d += a.in[I_RELB][bk * 8 + h]; pr[s] = d; mx = fmaxf(mx, d); }
        red[tid] = mx; __syncthreads(); for (int st = 128; st > 0; st >>= 1) { if (tid < st) red[tid] = fmaxf(red[tid], red[tid + st]); __syncthreads(); }
        mx = red[0]; __syncthreads();
        float sm = 0.f; for (int s = tid; s <= pos; s += 256) { const float p = expf(pr[s] - mx); pr[s] = p; sm += p; }
        red[tid] = sm; __syncthreads(); for (int st = 128; st > 0; st >>= 1) { if (tid < st) red[tid] += red[tid + st]; __syncthreads(); }
        sm = red[0]; __syncthreads();
        if (tid < 128) { float acc = 0.f; for (int s = 0; s <= pos; ++s) acc += pr[s] * bf2f(VD[(size_t)(b * SEQ + s) * 1024 + h * 128 + tid]); acc /= sm;
            if (m == 0) o1[tid] = acc; else ov = o1[tid] - lam * acc; }
        __syncthreads();
    }
    red[tid] = tid < 128 ? ov * ov : 0.f; __syncthreads(); for (int st = 128; st > 0; st >>= 1) { if (tid < st) red[tid] += red[tid + st]; __syncthreads(); }
    const float rs = 1.f / sqrtf(red[0] / 128.f + LN_EPS);
    if (tid < 128) { const float e = ov * rs * a.in[I_SUBLN_G][tid] * 0.8f;
        const float got = bf2f(((const bf16_t*)(ws + WS_QD))[(size_t)t * 1024 + h * 128 + tid]);
        dbg_fail(ctl, 3, !(fabsf(got - e) <= 0.06f + 0.06f * fabsf(e))); }
}
__global__ void dbg_report(Args a, int nout) {
    unsigned* ctl = (unsigned*)(a.ws + WS_CTL);
    int first = 0;
    if (ctl[CW_TMO] != 0u || ctl[CW_BAR + XB_TMO] != 0u) first = 15;
    for (int s = 14; s >= 1; --s) if (ctl[CW_DBG + s] > (s == 1 ? 16u : 64u)) first = s;
    const float c = first ? (float)(1 << first) : 0.5f;
    for (size_t i = (size_t)blockIdx.x * blockDim.x + threadIdx.x; i < (size_t)nout; i += (size_t)gridDim.x * blockDim.x) a.out[i] = c;
}
#endif

extern "C" void kernel_launch(void* const* d_in, const int* in_sizes, int n_in, void* d_out, int out_size, void* d_ws, size_t ws_size, hipStream_t stream) {
    static int grid = 0;
    if (grid == 0) {
        if (n_in != 29 || in_sizes[0] != NTOK * DM || out_size != NTOK * DM || ws_size < WS_END) {
            fprintf(stderr, "kernel_launch: unexpected shapes: n_in %d in0 %d out %d ws %zu (need >= %zu)\n", n_in, n_in > 0 ? in_sizes[0] : -1, out_size, ws_size, (size_t)WS_END); grid = -1; return; }
        int dev = 0, cus = 0;
        if (hipGetDevice(&dev) != hipSuccess || hipDeviceGetAttribute(&cus, hipDeviceAttributeMultiprocessorCount, dev) != hipSuccess) { grid = -1; return; }
        if (hipFuncSetAttribute((const void*)mega_fwd, hipFuncAttributeMaxDynamicSharedMemorySize, LDS_BYTES) != hipSuccess) { fprintf(stderr, "kernel_launch: hipFuncSetAttribute failed\n"); grid = -1; return; }
        int per_cu = 0;
        if (hipOccupancyMaxActiveBlocksPerMultiprocessor(&per_cu, (const void*)mega_fwd, NWAVES * 64, LDS_BYTES) != hipSuccess || per_cu < 1)
            fprintf(stderr, "kernel_launch: occupancy query says %d\n", per_cu);
        (void)hipGetLastError();
        grid = cus;
        if (grid != 256) fprintf(stderr, "kernel_launch: %d CUs (expected 256)\n", grid);
    }
    if (grid < 0) return;
    (void)hipMemsetAsync((char*)d_ws + WS_CTL, 0, CTL_ZERO_BYTES, stream);
    Args a{};
    for (int i = 0; i < 29; ++i) a.in[i] = (const float*)d_in[i];
    a.out = (float*)d_out; a.ws = (unsigned char*)d_ws; a.ph_lo = 0; a.ph_hi = DEBUG_CHECK ? 4 : 100;
    hipLaunchKernelGGL(mega_fwd, dim3(grid), dim3(NWAVES * 64), LDS_BYTES, stream, a);
#if DEBUG_CHECK
    hipLaunchKernelGGL(dbg_check, dim3(256), dim3(256), 0, stream, a);
    hipLaunchKernelGGL(dbg_check_ret, dim3(512), dim3(256), 0, stream, a);
    hipLaunchKernelGGL(dbg_check_att, dim3(512), dim3(256), 0, stream, a);
    hipLaunchKernelGGL(dbg_report, dim3(1024), dim3(256), 0, stream, a, out_size);
#endif
}
```
